# Optimizing an MI355X kernel written in HIP

```python
import math
import jax
import jax.numpy as jnp
from jax import lax
import numpy as np

D_MODEL = 1024
BATCH = 2
SEQ = 8192
DEPTH = 2

N_META = 16
BLOCK = 128
META_PAD = BLOCK - N_META
ROPE_THETA = 10000.0
LN_EPS = 1e-5
NEG = -1e30

DA_HEADS = 4
DA_DIM = 64
WB_HEADS = 8
WB_KV = 2
WB_DIM = 64
WINDOW = 128
MC_HEADS = 4
MC_QK = 128
MC_V = 128
CONV_W = 3
N_BRANCH = 3
BRANCH_W = 512
N_GROUPS = 4
EXP_PER_GROUP = 8
N_EXPERTS = N_GROUPS * EXP_PER_GROUP
TOP_K = 2
D_EXPERT = 512

A_Q = DA_HEADS * 2 * DA_DIM
A_K = DA_HEADS * 2 * DA_DIM
A_V = DA_HEADS * 2 * DA_DIM
B_Q = WB_HEADS * WB_DIM
B_K = WB_KV * WB_DIM
B_V = WB_KV * WB_DIM
C_Q = MC_HEADS * MC_QK
C_K = MC_HEADS * MC_QK
C_V = MC_HEADS * MC_V
C_O = MC_HEADS * MC_V
C_G = 4 * MC_HEADS
GATE_W = N_BRANCH * D_MODEL
SPLITS = (A_Q, A_K, A_V, B_Q, B_K, B_V, C_Q, C_K, C_V, C_O, C_G, GATE_W)
D_IN = sum(SPLITS)

kernel_name = "hybrid_diffattn_swa_mlstm_hmoe_encoder"

F32 = jnp.float32


def layer_norm(x, g, b):
    x32 = x.astype(F32)
    mu = x32.mean(-1, keepdims=True)
    var = jnp.square(x32 - mu).mean(-1, keepdims=True)
    return ((x32 - mu) * lax.rsqrt(var + LN_EPS) * g.astype(F32) + b.astype(F32)).astype(x.dtype)


def rope_tables(length, dim):
    pos = jnp.arange(length, dtype=F32)
    inv = 1.0 / (ROPE_THETA ** (jnp.arange(0, dim, 2, dtype=F32) / dim))
    ang = pos[:, None] * inv[None, :]
    return jnp.cos(ang), jnp.sin(ang)


def apply_rope(x, cos, sin):
    shape = (cos.shape[0],) + (1,) * (x.ndim - 3) + (cos.shape[1],)
    c = cos.reshape(shape).astype(x.dtype)
    s = sin.reshape(shape).astype(x.dtype)
    x1, x2 = jnp.split(x, 2, axis=-1)
    return jnp.concatenate([x1 * c - x2 * s, x2 * c + x1 * s], axis=-1)


def pad_front(x, n, value=0.0):
    return jnp.pad(x, [(0, 0), (n, 0)] + [(0, 0)] * (x.ndim - 2), constant_values=value)


def diff_attention(q, k, v, lam, lam_init, norm_g):
    bsz, length = q.shape[:2]
    qp = pad_front(q, META_PAD)
    nb = qp.shape[1] // BLOCK
    qb = qp.reshape(bsz, nb, BLOCK, DA_HEADS, 2, DA_DIM).transpose(1, 0, 2, 3, 4, 5)
    scale = DA_DIM ** -0.5

    def one_block(qblk):
        s = jnp.einsum('bqhcd,bkhcd->bhcqk', qblk, k).astype(F32) * scale
        p = jax.nn.softmax(s, axis=-1)
        a = p[:, :, 0] - lam * p[:, :, 1]
        return jnp.einsum('bhqk,bkhe->bqhe', a.astype(v.dtype), v)

    o = lax.map(one_block, qb)
    o = o.transpose(1, 0, 2, 3, 4).reshape(bsz, nb * BLOCK, DA_HEADS, 2 * DA_DIM)[:, META_PAD:]
    o32 = o.astype(F32)
    o32 = o32 * lax.rsqrt(jnp.mean(jnp.square(o32), -1, keepdims=True) + LN_EPS) * norm_g.astype(F32) * (1.0 - lam_init)
    return o32.astype(v.dtype).reshape(bsz, length, A_V)


def windowed_gqa(q, k, v, sink):
    bsz, length = q.shape[:2]
    lp = length + META_PAD
    nb = lp // BLOCK
    grp = WB_HEADS // WB_KV
    qb = pad_front(q, META_PAD).reshape(bsz, nb, BLOCK, WB_KV, grp, WB_DIM)
    k_meta, v_meta = k[:, :N_META], v[:, :N_META]

    def band(t):
        tp = jnp.pad(t, [(0, 0), (META_PAD + BLOCK, BLOCK), (0, 0), (0, 0)])
        tp = tp.reshape(bsz, nb + 2, BLOCK, WB_KV, WB_DIM)
        return jnp.concatenate([tp[:, :-2], tp[:, 1:-1], tp[:, 2:]], axis=2)

    kb, vb = band(k), band(v)
    scale = WB_DIM ** -0.5
    s_band = jnp.einsum('bnqkgd,bnskd->bnkgqs', qb, kb).astype(F32) * scale
    s_meta = jnp.einsum('bnqkgd,bmkd->bnkgqm', qb, k_meta).astype(F32) * scale
    qidx = jnp.arange(nb)[:, None] * BLOCK + jnp.arange(BLOCK)[None, :]
    kidx = (jnp.arange(nb)[:, None] - 1) * BLOCK + jnp.arange(3 * BLOCK)[None, :]
    valid = ((kidx[:, None, :] >= BLOCK) & (kidx[:, None, :] < lp)
             & (jnp.abs(qidx[:, :, None] - kidx[:, None, :]) <= WINDOW))
    s_band = jnp.where(valid[None, :, None, None], s_band, NEG)
    s_sink = jnp.broadcast_to(sink.astype(F32).reshape(1, 1, WB_KV, grp, 1, 1), s_meta.shape[:-1] + (1,))
    p = jax.nn.softmax(jnp.concatenate([s_band, s_meta, s_sink], axis=-1), axis=-1)
    p_band = p[..., :3 * BLOCK].astype(v.dtype)
    p_meta = p[..., 3 * BLOCK:3 * BLOCK + N_META].astype(v.dtype)
    o = (jnp.einsum('bnkgqs,bnskd->bnqkgd', p_band, vb)
         + jnp.einsum('bnkgqm,bmkd->bnqkgd', p_meta, v_meta))
    return o.reshape(bsz, lp, B_Q)[:, META_PAD:]


def mlstm_direction(q, k, v, li, lf):
    bsz, lp, heads, dk = q.shape
    dv = v.shape[-1]
    nch = lp // BLOCK

    def chunks(t):
        return jnp.moveaxis(t.reshape((bsz, nch, BLOCK, heads) + t.shape[3:]), 3, 1)

    qc, kc, vc, lic, lfc = chunks(q), chunks(k), chunks(v), chunks(li), chunks(lf)
    b = jnp.cumsum(lfc, axis=-1)
    g = b[..., -1]
    a = g[..., None] - b + lic
    tril = jnp.tril(jnp.ones((BLOCK, BLOCK), dtype=bool))
    dmat = jnp.where(tril, b[..., :, None] - b[..., None, :] + lic[..., None, :], NEG)

    def step(carry, inp):
        c_st, n_st, m_st = carry
        k_i, v_i, a_i, g_i = inp
        m_new = jnp.maximum(g_i + m_st, a_i.max(-1))
        decay = jnp.exp(g_i + m_st - m_new)
        w = jnp.exp(a_i - m_new[..., None])
        c_new = decay[..., None, None] * c_st + jnp.einsum('bhc,bhcd,bhce->bhde', w, k_i, v_i)
        n_new = decay[..., None] * n_st + jnp.einsum('bhc,bhcd->bhd', w, k_i)
        return (c_new, n_new, m_new), (c_st, n_st, m_st)

    init = (jnp.zeros((bsz, heads, dk, dv), F32), jnp.zeros((bsz, heads, dk), F32), jnp.zeros((bsz, heads), F32))
    xs = (jnp.moveaxis(kc, 2, 0), jnp.moveaxis(vc, 2, 0), jnp.moveaxis(a, 2, 0), jnp.moveaxis(g, 2, 0))
    _, (c_prev, n_prev, m_prev) = lax.scan(step, init, xs)
    c_prev = jnp.moveaxis(c_prev, 0, 2)
    n_prev = jnp.moveaxis(n_prev, 0, 2)
    m_prev = jnp.moveaxis(m_prev, 0, 2)
    inter_log = b + m_prev[..., None]
    m_t = jnp.maximum(inter_log, dmat.max(-1))
    inter = jnp.exp(inter_log - m_t)
    s = jnp.einsum('bhncd,bhnsd->bhncs', qc, kc) * jnp.exp(dmat - m_t[..., None])
    num = inter[..., None] * jnp.einsum('bhncd,bhnde->bhnce', qc, c_prev) + jnp.einsum('bhncs,bhnse->bhnce', s, vc)
    den = inter * jnp.einsum('bhncd,bhnd->bhnc', qc, n_prev) + s.sum(-1)
    h = num / jnp.maximum(jnp.abs(den), jnp.exp(-m_t))[..., None]
    return jnp.moveaxis(h, 1, 3).reshape(bsz, lp, heads, dv)


def mlstm_mixer(cq, ck, cv, co, cg, conv_w, conv_b, gate_b, norm_g):
    bsz, length, _ = cq.shape
    qk = jnp.concatenate([cq, ck], axis=-1)
    qk = lax.conv_general_dilated(qk, conv_w[:, None, :].astype(qk.dtype), (1,), [(CONV_W // 2, CONV_W // 2)],
                                  dimension_numbers=('NWC', 'WIO', 'NWC'), feature_group_count=C_Q + C_K)
    qk = jax.nn.silu(qk + conv_b.astype(qk.dtype)).astype(F32)
    q = qk[..., :C_Q].reshape(bsz, length, MC_HEADS, MC_QK)
    k = qk[..., C_Q:].reshape(bsz, length, MC_HEADS, MC_QK) * (MC_QK ** -0.5)
    v = cv.astype(F32).reshape(bsz, length, MC_HEADS, MC_V)
    gates = (cg.astype(F32) + gate_b.astype(F32)).reshape(bsz, length, 4, MC_HEADS)
    li_f = gates[:, :, 0]
    lf_f = jax.nn.log_sigmoid(gates[:, :, 1])
    li_b = gates[:, :, 2]
    lf_b = jax.nn.log_sigmoid(gates[:, :, 3])
    qp, kp, vp = pad_front(q, META_PAD), pad_front(k, META_PAD), pad_front(v, META_PAD)
    h_f = mlstm_direction(qp, kp, vp, pad_front(li_f, META_PAD, NEG), pad_front(lf_f, META_PAD))

    def flip(t):
        return jnp.flip(t, axis=1)

    h_b = flip(mlstm_direction(flip(qp), flip(kp), flip(vp),
                               flip(pad_front(li_b, META_PAD, NEG)), flip(pad_front(lf_b, META_PAD))))
    h = h_f[:, META_PAD:] + h_b[:, META_PAD:]
    mu = h.mean(-1, keepdims=True)
    var = jnp.square(h - mu).mean(-1, keepdims=True)
    hn = (h - mu) * lax.rsqrt(var + LN_EPS) * norm_g.astype(F32).reshape(MC_HEADS, MC_V)
    return (hn.reshape(bsz, length, C_V) * jax.nn.sigmoid(co.astype(F32))).astype(cq.dtype)


def token_mixer(h, cos, sin, lam_init, w_in, conv_w, conv_b, gate_b, lam_q1, lam_k1, lam_q2, lam_k2,
                diff_g, sink, mlstm_g, w_branch, w_out):
    bsz, length, _ = h.shape
    z = h @ w_in
    cuts = np.cumsum(SPLITS)[:-1].tolist()
    aq, ak, av, bq, bk, bv, cq, ck, cv, co, cg, gz = jnp.split(z, cuts, axis=-1)
    qa = apply_rope(aq.reshape(bsz, length, DA_HEADS, 2, DA_DIM), cos, sin)
    ka = apply_rope(ak.reshape(bsz, length, DA_HEADS, 2, DA_DIM), cos, sin)
    va = av.reshape(bsz, length, DA_HEADS, 2 * DA_DIM)
    lam = (jnp.exp(jnp.sum(lam_q1.astype(F32) * lam_k1.astype(F32)))
           - jnp.exp(jnp.sum(lam_q2.astype(F32) * lam_k2.astype(F32))) + lam_init)
    out_a = diff_attention(qa, ka, va, lam, lam_init, diff_g)
    qb = apply_rope(bq.reshape(bsz, length, WB_HEADS, WB_DIM), cos, sin)
    kb = apply_rope(bk.reshape(bsz, length, WB_KV, WB_DIM), cos, sin)
    vb = bv.reshape(bsz, length, WB_KV, WB_DIM)
    out_b = windowed_gqa(qb, kb, vb, sink)
    out_c = mlstm_mixer(cq, ck, cv, co, cg, conv_w, conv_b, gate_b, mlstm_g)
    gates = jax.nn.sigmoid(gz.reshape(bsz, length, N_BRANCH, D_MODEL))
    merged = (gates[:, :, 0] * (out_a @ w_branch[0])
              + gates[:, :, 1] * (out_b @ w_branch[1])
              + gates[:, :, 2] * (out_c @ w_branch[2]))
    return merged @ w_out


def hier_moe(h, w_rg, b_rg, w_re, b_re, w_gate, w_up, w_down):
    bsz, length, dm = h.shape
    n_tok = bsz * length
    xf = h.reshape(n_tok, dm)
    g_logits = (xf @ w_rg).astype(F32) + b_rg.astype(F32)
    g_prob = jax.nn.softmax(g_logits, axis=-1)
    g_sel = jnp.argmax(g_logits, axis=-1)
    p_grp = jnp.max(g_prob, axis=-1)
    e_logits = ((xf @ w_re).astype(F32) + b_re.astype(F32)).reshape(n_tok, N_GROUPS, EXP_PER_GROUP)
    e_logits = e_logits[jnp.arange(n_tok), g_sel]
    top_v, top_i = lax.top_k(e_logits, TOP_K)
    w_tok = jax.nn.softmax(top_v, axis=-1) * p_grp[:, None]
    expert = g_sel[:, None].astype(jnp.int32) * EXP_PER_GROUP + top_i.astype(jnp.int32)
    n_assign = n_tok * TOP_K
    n_blocks = -(-(n_assign + N_EXPERTS * (BLOCK - 1)) // BLOCK)
    e_flat = expert.reshape(-1)
    t_flat = jnp.repeat(jnp.arange(n_tok, dtype=jnp.int32), TOP_K)
    w_flat = w_tok.reshape(-1)
    order = jnp.argsort(e_flat)
    e_s, t_s, w_s = e_flat[order], t_flat[order], w_flat[order]
    counts = jnp.bincount(e_flat, length=N_EXPERTS)
    start = jnp.cumsum(counts) - counts
    pcounts = (counts + BLOCK - 1) // BLOCK * BLOCK
    pend = jnp.cumsum(pcounts)
    pstart = pend - pcounts
    dest = pstart[e_s] + jnp.arange(n_assign, dtype=jnp.int32) - start[e_s]
    slot_tok = jnp.zeros((n_blocks * BLOCK,), jnp.int32).at[dest].set(t_s)
    slot_w = jnp.zeros((n_blocks * BLOCK,), F32).at[dest].set(w_s)
    block_e = jnp.minimum(jnp.searchsorted(pend, jnp.arange(n_blocks) * BLOCK, side='right'), N_EXPERTS - 1)
    xs = xf[slot_tok].reshape(n_blocks, BLOCK, dm)

    def run_expert(args):
        xb, e = args
        return (jax.nn.silu(xb @ w_gate[e]) * (xb @ w_up[e])) @ w_down[e]

    ys = lax.map(run_expert, (xs, block_e)).reshape(n_blocks * BLOCK, dm)
    y = jnp.zeros_like(xf).at[slot_tok].add(ys * slot_w[:, None].astype(ys.dtype))
    return y.reshape(bsz, length, dm)


def setup_inputs(seed: int = 0) -> dict:
    key = jax.random.key(seed)
    ks = jax.random.split(key, 32)
    beta = (8.0 * DEPTH) ** -0.25

    def nrm(k, shape, scale):
        return jax.random.normal(k, shape, F32) * scale

    offs = np.cumsum((0,) + SPLITS)
    col_scale = np.ones((D_IN,), np.float32)
    for i in (2, 5, 8):
        col_scale[offs[i]:offs[i + 1]] = beta
    f_bias = jnp.linspace(3.0, 6.0, MC_HEADS, dtype=F32)
    zeros_h = jnp.zeros((MC_HEADS,), F32)
    gate_base = jnp.stack([zeros_h, f_bias, zeros_h, f_bias])
    return {
        "x": nrm(ks[0], (BATCH, SEQ, D_MODEL), 1.0),
        "meta": nrm(ks[1], (N_META, D_MODEL), 1.0),
        "ln_in_g": 1.0 + nrm(ks[2], (D_MODEL,), 0.02),
        "ln_in_b": nrm(ks[3], (D_MODEL,), 0.02),
        "w_in": nrm(ks[4], (DEPTH, D_MODEL, D_IN), D_MODEL ** -0.5) * jnp.asarray(col_scale),
        "conv_w": nrm(ks[5], (DEPTH, CONV_W, C_Q + C_K), CONV_W ** -0.5),
        "conv_b": nrm(ks[6], (DEPTH, C_Q + C_K), 0.02),
        "gate_b": (gate_base[None] + nrm(ks[7], (DEPTH, 4, MC_HEADS), 0.1)).reshape(DEPTH, C_G),
        "lam_q1": nrm(ks[8], (DEPTH, DA_DIM), 0.1),
        "lam_k1": nrm(ks[9], (DEPTH, DA_DIM), 0.1),
        "lam_q2": nrm(ks[10], (DEPTH, DA_DIM), 0.1),
        "lam_k2": nrm(ks[11], (DEPTH, DA_DIM), 0.1),
        "diff_g": 1.0 + nrm(ks[12], (DEPTH, 2 * DA_DIM), 0.02),
        "sink": nrm(ks[13], (DEPTH, WB_HEADS), 0.5),
        "mlstm_g": 1.0 + nrm(ks[14], (DEPTH, C_V), 0.02),
        "w_branch": nrm(ks[15], (DEPTH, N_BRANCH, BRANCH_W, D_MODEL), BRANCH_W ** -0.5),
        "w_out": nrm(ks[16], (DEPTH, D_MODEL, D_MODEL), D_MODEL ** -0.5 * beta),
        "ln1_g": 1.0 + nrm(ks[17], (DEPTH, D_MODEL), 0.02),
        "ln1_b": nrm(ks[18], (DEPTH, D_MODEL), 0.02),
        "ln2_g": 1.0 + nrm(ks[19], (DEPTH, D_MODEL), 0.02),
        "ln2_b": nrm(ks[20], (DEPTH, D_MODEL), 0.02),
        "w_rg": nrm(ks[21], (DEPTH, D_MODEL, N_GROUPS), D_MODEL ** -0.5),
        "b_rg": nrm(ks[22], (DEPTH, N_GROUPS), 0.01),
        "w_re": nrm(ks[23], (DEPTH, D_MODEL, N_EXPERTS), D_MODEL ** -0.5),
        "b_re": nrm(ks[24], (DEPTH, N_EXPERTS), 0.01),
        "w_gate": nrm(ks[25], (DEPTH, N_EXPERTS, D_MODEL, D_EXPERT), D_MODEL ** -0.5 * beta),
        "w_up": nrm(ks[26], (DEPTH, N_EXPERTS, D_MODEL, D_EXPERT), D_MODEL ** -0.5 * beta),
        "w_down": nrm(ks[27], (DEPTH, N_EXPERTS, D_EXPERT, D_MODEL), D_EXPERT ** -0.5 * beta),
    }


def reference(x, meta, ln_in_g, ln_in_b, w_in, conv_w, conv_b, gate_b, lam_q1, lam_k1, lam_q2, lam_k2,
              diff_g, sink, mlstm_g, w_branch, w_out, ln1_g, ln1_b, ln2_g, ln2_b,
              w_rg, b_rg, w_re, b_re, w_gate, w_up, w_down):
    bsz = x.shape[0]
    alpha = (2.0 * DEPTH) ** 0.25
    h = jnp.concatenate([jnp.broadcast_to(meta.astype(x.dtype)[None], (bsz, N_META, D_MODEL)), x], axis=1)
    h = layer_norm(h, ln_in_g, ln_in_b)
    cos, sin = rope_tables(h.shape[1], DA_DIM)
    for l in range(DEPTH):
        lam_init = 0.8 - 0.6 * math.exp(-0.3 * l)
        y = token_mixer(h, cos, sin, lam_init, w_in[l], conv_w[l], conv_b[l], gate_b[l],
                        lam_q1[l], lam_k1[l], lam_q2[l], lam_k2[l], diff_g[l], sink[l], mlstm_g[l],
                        w_branch[l], w_out[l])
        h = layer_norm(alpha * h + y, ln1_g[l], ln1_b[l])
        y = hier_moe(h, w_rg[l], b_rg[l], w_re[l], b_re[l], w_gate[l], w_up[l], w_down[l])
        h = layer_norm(alpha * h + y, ln2_g[l], ln2_b[l])
    return h[:, N_META:]
```

```cpp
#include <hip/hip_runtime.h>
#include <stdint.h>

#define DI __device__ __forceinline__
typedef unsigned short bf16_t;
typedef __attribute__((ext_vector_type(8))) short bf16x8;
typedef __attribute__((ext_vector_type(16))) float f32x16;
typedef __attribute__((ext_vector_type(2))) float f32x2;
typedef __attribute__((ext_vector_type(4))) float f32x4;
typedef __attribute__((ext_vector_type(4))) unsigned u32x4;
typedef __attribute__((ext_vector_type(2))) unsigned u32x2;
typedef __attribute__((ext_vector_type(2))) __bf16 bf16x2v;
#define MFMA32(a, b, c) __builtin_amdgcn_mfma_f32_32x32x16_bf16((a), (b), (c), 0, 0, 0)

constexpr int NB = 2, SEQ = 8192, NMETA = 16, L = 8208, T = NB * L, TP = 16512, D = 1024;
constexpr int DIN = 7440, DINP = 7680;
constexpr int LPAD = 8320, NCH = 65, MPAD = 112, LK = 8256;
constexpr int NEXP = 32, CAP = 2 * T, HROWS = 2 * T + NEXP * 256;
constexpr int NT = 256;
constexpr int CSTR = 64;
constexpr float LN_EPS = 1e-5f;
constexpr float NEGF = -1e30f;
constexpr int SMEM_TQ = 65536 + 4096 + 64;
constexpr float ALPHA = 1.41421356237309515f;
constexpr float QSCALE = 0.125f * 1.44269504088896341f;

DI f32x4 mk4(float a, float b, float c, float d) { f32x4 v = {a, b, c, d}; return v; }
DI f32x2 mk2(float a, float b) { f32x2 v = {a, b}; return v; }
DI unsigned pk2(float a, float b) { f32x2 v = {a, b}; bf16x2v r = __builtin_convertvector(v, bf16x2v); return __builtin_bit_cast(unsigned, r); }
DI bf16_t f2bf(float a) { return (bf16_t)(pk2(a, 0.f) & 0xffffu); }
DI float bf2f(bf16_t b) { return __uint_as_float(((unsigned)b) << 16); }
DI float bflo(unsigned u) { return __uint_as_float(u << 16); }
DI float bfhi(unsigned u) { return __uint_as_float(u & 0xffff0000u); }
typedef __attribute__((address_space(3))) int LAS_I;
constexpr int WIDTAB_OFF = 2 * (2 * 32768 + 4096 + 256) + 64;
DI int rtid() {
  const unsigned hw = (unsigned)__builtin_amdgcn_s_getreg((5 << 11) | 4) & 63u;
  const int wid = *(volatile __attribute__((address_space(3))) int*)(size_t)(WIDTAB_OFF + 4 * hw);
  return wid * 64 + (int)__builtin_amdgcn_mbcnt_hi(~0u, __builtin_amdgcn_mbcnt_lo(~0u, 0u));
}
DI int otid() { int t = rtid() & 255; asm volatile("" : "+v"(t)); return t; }
DI int crow(int r, int h) { return (r & 3) + 8 * (r >> 2) + 4 * h; }
DI int keyoff(int r, int h) { return (r & 7) + 8 * h + 16 * (r >> 3); }
DI int swz(int row) { return (row >> 1) & 7; }
DI int kswap(int r) { return (r & 0x13) | ((r & 4) << 1) | ((r & 8) >> 1); }
template <int O> DI float sxor(float v) { return __builtin_bit_cast(float, __builtin_amdgcn_ds_swizzle(__builtin_bit_cast(int, v), 0x1f | (O << 10))); }
DI float sx32(float v) {
  int ln = (int)__builtin_amdgcn_mbcnt_hi(~0u, __builtin_amdgcn_mbcnt_lo(~0u, 0u)); asm volatile("" : "+v"(ln));
  return __builtin_bit_cast(float, __builtin_amdgcn_ds_bpermute((ln ^ 32) << 2, __builtin_bit_cast(int, v)));
}
DI float xsum32(float v) { return v + sx32(v); }
DI float xmax32(float v) { return fmaxf(v, sx32(v)); }
DI float wave_sum(float v) { v = xsum32(v); v += sxor<16>(v); v += sxor<8>(v); v += sxor<4>(v); v += sxor<2>(v); v += sxor<1>(v); return v; }
DI float wave_max(float v) { v = xmax32(v); v = fmaxf(v, sxor<16>(v)); v = fmaxf(v, sxor<8>(v)); v = fmaxf(v, sxor<4>(v)); v = fmaxf(v, sxor<2>(v)); v = fmaxf(v, sxor<1>(v)); return v; }
DI float fexp2(float x) { return __builtin_amdgcn_exp2f(x); }
DI float frcp(float x) { return __builtin_amdgcn_rcpf(x); }
DI float shfl_up_f(float v, int d, int lane) { return __builtin_bit_cast(float, __builtin_amdgcn_ds_bpermute(((lane - d) & 63) << 2, __builtin_bit_cast(int, v))); }
DI float sigmoidf_(float x) { return frcp(1.f + __expf(-x)); }
DI bf16x8 ldfrag(const bf16_t* p) { return *(const bf16x8*)p; }
DI f32x16 zero16() { f32x16 z; _Pragma("unroll") for (int i = 0; i < 16; ++i) z[i] = 0.f; return z; }
DI bf16x8 packfrag(const f32x16& x, int s) {
  union { unsigned u[4]; bf16x8 v; } t;
  t.u[0] = pk2(x[8 * s + 0], x[8 * s + 1]); t.u[1] = pk2(x[8 * s + 2], x[8 * s + 3]);
  t.u[2] = pk2(x[8 * s + 4], x[8 * s + 5]); t.u[3] = pk2(x[8 * s + 6], x[8 * s + 7]);
  return t.v;
}

struct Params {
  const float *x, *meta, *ln_in_g, *ln_in_b, *w_in, *conv_w, *conv_b, *gate_b, *lam_q1, *lam_k1, *lam_q2, *lam_k2;
  const float *diff_g, *sink, *mlstm_g, *w_branch, *w_out, *ln1_g, *ln1_b, *ln2_g, *ln2_b, *w_rg, *b_rg, *w_re, *b_re;
  const float *w_gate, *w_up, *w_down;
  float* out;
  float* h; bf16_t* hb; bf16_t *w_in_t, *w_br_t, *w_out_t; f32x2* cs; float* lam; unsigned* ctl; float* rwp; float* rgb;
  int* counts; int* tok_slot; float* tok_w; int* slot_tok;
  float* mstat;
  float* nvec;
  float* wgt;
  float* bcum;
  float* ligate;
  bf16_t *qa, *ka, *vaT, *qb, *kb, *vbT, *cq, *ck, *cvT, *co, *gz, *qc, *kc, *kcT, *merged;
  float* cg; float* U;
  bf16_t *oa, *ob, *oc;
  bf16_t *w_gu_t, *w_dn_t, *H, *ys;
};

typedef __attribute__((address_space(3))) unsigned lds_u32;
DI void gemm_issue(const bf16_t* (&arow)[4], const bf16_t* (&brow)[4], int koff, char* st, int w) {
  _Pragma("unroll") for (int i = 0; i < 4; ++i) {
    __builtin_amdgcn_global_load_lds((const unsigned*)(arow[i] + koff), (lds_u32*)(st + (4 * i + w) * 1024), 16, 0, 0);
    __builtin_amdgcn_global_load_lds((const unsigned*)(brow[i] + koff), (lds_u32*)(st + 16384 + (4 * i + w) * 1024), 16, 0, 0);
  }
}
DI void gemm_tile(const bf16_t* (&arow)[4], const bf16_t* (&brow)[4], int K, char* smem, f32x16 (&acc)[2][2], int rows = 128) {
  const int tid = otid(), lane = tid & 63, w = tid >> 6, wm = w >> 1, wn = w & 1;
  const int lr = lane & 31, lh = lane >> 5;
  const int cs = ((lane & 7) ^ (4 * (w & 1) + (lane >> 4))) * 8;
  const int nkt = K >> 6;
  const int myrows = rows - wm * 64;
  __syncthreads();
  gemm_issue(arow, brow, cs, smem, w);
  for (int kt = 0; kt < nkt; ++kt) {
    __syncthreads();
    if (kt + 1 < nkt) gemm_issue(arow, brow, (kt + 1) * 64 + cs, smem + ((kt + 1) & 1) * 32768, w);
    const char* sA = smem + (kt & 1) * 32768; const char* sB = sA + 16384;
    if (myrows > 32) {
      bf16x8 a[4][2], b[4][2];
      _Pragma("unroll") for (int ks = 0; ks < 4; ++ks) {
        const int ch = 2 * ks + lh;
        _Pragma("unroll") for (int i = 0; i < 2; ++i) {
          const int rowa = wm * 64 + 32 * i + lr;
          a[ks][i] = *(const bf16x8*)(sA + rowa * 128 + ((ch ^ swz(rowa)) << 4));
          const int rowb = wn * 64 + 32 * i + lr;
          b[ks][i] = *(const bf16x8*)(sB + rowb * 128 + ((ch ^ swz(rowb)) << 4));
        }
      }
      _Pragma("unroll") for (int ks = 0; ks < 4; ++ks)
        _Pragma("unroll") for (int i = 0; i < 2; ++i)
          _Pragma("unroll") for (int j = 0; j < 2; ++j) acc[i][j] = MFMA32(a[ks][i], b[ks][j], acc[i][j]);
    } else if (myrows > 0) {
      _Pragma("unroll") for (int ks = 0; ks < 4; ++ks) {
        const int ch = 2 * ks + lh;
        const int rowa = wm * 64 + lr;
        const bf16x8 a0 = *(const bf16x8*)(sA + rowa * 128 + ((ch ^ swz(rowa)) << 4));
        _Pragma("unroll") for (int j = 0; j < 2; ++j) {
          const int rowb = wn * 64 + 32 * j + lr;
          acc[0][j] = MFMA32(a0, *(const bf16x8*)(sB + rowb * 128 + ((ch ^ swz(rowb)) << 4)), acc[0][j]);
        }
      }
    }
  }
  __syncthreads();
}


namespace g8 {
typedef __attribute__((address_space(3))) unsigned char lds_u8;
typedef float f32x4 __attribute__((ext_vector_type(4)));
constexpr int BK = 64, HALF = 128, HTB = HALF * BK * 2, STAGE_BYTES = 8 * HTB;
DI int lds_byte(int r, int c) { const int st = (r >> 4) * 2 + (c >> 5), rr = r & 15, cc = c & 31, ob = rr * 64 + cc * 2; return st * 1024 + (ob ^ (((ob >> 9) & 1) << 5)); }
DI void stage_rc(int b, int& R, int& C) { const int st = b / 1024, sb = b % 1024, swz = sb ^ (((sb >> 9) & 1) << 5); R = (st >> 1) * 16 + swz / 64; C = (st & 1) * 32 + (swz % 64) / 2; }
DI int perm32(int rho) { const int n = rho >> 4, i = rho & 15; return 8 * (i >> 2) + 4 * n + (i & 3); }
struct Unit { const char* a; const char* b; int pm, pn, tag, x0, x1; };
template <class Epi, class Sched>
DI void gemm_phase(lds_u8* lds, int K, const Sched& S, const Epi& E) {
  int tid = rtid(); asm volatile("" : "+v"(tid));
  const int wid = __builtin_amdgcn_readfirstlane(tid >> 6), lane = tid & 63, wr = wid >> 2, wc = wid & 3, fr = lane & 15, fq = lane >> 4;
  const int nt = K / BK;
  int R[2], C[2]; unsigned voffB[2];
  _Pragma("unroll") for (int i = 0; i < 2; ++i) { stage_rc(tid * 16 + i * 8192, R[i], C[i]); const int Rb = Epi::PERM ? ((R[i] & ~31) + perm32(R[i] & 31)) : R[i]; voffB[i] = (unsigned)(Rb * K + C[i]) * 2u; }
  const size_t kstep = (size_t)(BK * 2), hstep = (size_t)HALF * K * 2;
  const unsigned ldsw = (unsigned)wid * 1024u;
  const int aoff = lds_byte(wr * 64 + fr, fq * 8), boff = lds_byte(wc * 32 + fr, fq * 8);
#define G8_SA(b, h) (((b) * 2 + (h)) * HTB)
#define G8_SB(b, h) ((4 + (b) * 2 + (h)) * HTB)
#define G8_STAGE(bufoff, gbase, voff) do { _Pragma("unroll") for (int _i = 0; _i < 2; ++_i) \
    __builtin_amdgcn_global_load_lds((const unsigned*)((const char*)(gbase) + (voff)[_i]), (lds_u32*)(lds + (bufoff) + ldsw + _i * 8192), 16, 0, 0); } while (0)
#define G8_LDA(dst, b, h) do { _Pragma("unroll") for (int m = 0; m < 4; ++m) _Pragma("unroll") for (int k = 0; k < 2; ++k) dst[m][k] = *(const __attribute__((address_space(3))) bf16x8*)(lds + G8_SA(b, h) + aoff + m * 2048 + k * 1024); } while (0)
#define G8_LDB(dst, b, h) do { _Pragma("unroll") for (int n = 0; n < 2; ++n) _Pragma("unroll") for (int k = 0; k < 2; ++k) dst[n][k] = *(const __attribute__((address_space(3))) bf16x8*)(lds + G8_SB(b, h) + boff + n * 2048 + k * 1024); } while (0)
#define G8_MMA(ai, bj, At, Bt) do { __builtin_amdgcn_s_setprio(1); _Pragma("unroll") for (int m = 0; m < 4; ++m) _Pragma("unroll") for (int n = 0; n < 2; ++n) _Pragma("unroll") for (int k = 0; k < 2; ++k) \
    acc[ai][bj][m][n] = __builtin_amdgcn_mfma_f32_16x16x32_bf16(Bt[n][k], At[m][k], acc[ai][bj][m][n], 0, 0, 0); __builtin_amdgcn_s_setprio(0); } while (0)
#define G8_WAIT_V(n) asm volatile("s_waitcnt vmcnt(" #n ")" ::: "memory")
#define G8_WAIT_L(n) asm volatile("s_waitcnt lgkmcnt(" #n ")" ::: "memory")
#define G8_BAR __builtin_amdgcn_s_barrier()
#define G8_SCHED __builtin_amdgcn_sched_barrier(0)
  Unit cur, nxt; int ui = 0;
  if (!S.next(0, cur)) return;
  f32x4 acc[2][2][4][2];
  _Pragma("unroll") for (int a = 0; a < 2; ++a) _Pragma("unroll") for (int b = 0; b < 2; ++b) _Pragma("unroll") for (int m = 0; m < 4; ++m) _Pragma("unroll") for (int n = 0; n < 2; ++n) acc[a][b][m][n] = (f32x4){0.f, 0.f, 0.f, 0.f};
  bf16x8 At[4][2], B0[2][2], B1[2][2];
  constexpr bool GA = Sched::GATHER;
  unsigned voffA[2]; unsigned cpk[2], npk[2];
  _Pragma("unroll") for (int i = 0; i < 2; ++i) voffA[i] = (unsigned)(R[i] * K + C[i]) * 2u;
  const unsigned gc2 = (unsigned)C[0] * 2u, gk2 = (unsigned)K * 2u;
  if (GA) S.arows(cur, R[0], cpk);
#define G8_STAGE_G(bufoff, base, pk) do { const unsigned _v[2] = { ((pk) & 0xffffu) * gk2 + gc2, ((pk) >> 16) * gk2 + gc2 }; G8_STAGE(bufoff, base, _v); } while (0)
#define G8_STAGE_A(bufoff, base, h, nx) do { if (GA) { if (nx) G8_STAGE_G(bufoff, base, npk[h]); else G8_STAGE_G(bufoff, base, cpk[h]); } else G8_STAGE(bufoff, (base) + (h) * hstep, voffA); } while (0)
  const char* cA = cur.a; const char* cB = cur.b;
  G8_STAGE(G8_SB(0, 0), cB, voffB); G8_STAGE_A(G8_SA(0, 0), cA, 0, false); G8_STAGE(G8_SB(0, 1), cB + hstep, voffB); G8_STAGE_A(G8_SA(0, 1), cA, 1, false);
  if (wr == 1) G8_BAR;
  G8_WAIT_V(4); G8_BAR;
  G8_STAGE(G8_SB(1, 0), cB + kstep, voffB); G8_STAGE_A(G8_SA(1, 0), cA + kstep, 0, false); G8_STAGE(G8_SB(1, 1), cB + hstep + kstep, voffB);
  G8_WAIT_V(6); G8_BAR;
  for (;;) {
    const bool has_next = S.next(ui + 1, nxt);
    const char* nA = has_next ? nxt.a : cA; const char* nB = has_next ? nxt.b : cB;
    if (GA) { if (has_next) S.arows(nxt, R[0], npk); else { npk[0] = cpk[0]; npk[1] = cpk[1]; } }
    for (int t = 0; t < nt; t += 2) {
      const bool last = (t == nt - 2);
      const char* a1 = cA + (size_t)(t + 1) * kstep;
      const char* a2 = last ? nA : cA + (size_t)(t + 2) * kstep; const char* b2 = last ? nB : cB + (size_t)(t + 2) * kstep;
      const char* a3 = a2 + kstep; const char* b3 = b2 + kstep;
      G8_LDB(B0, 0, 0); G8_SCHED; G8_LDA(At, 0, 0); G8_STAGE_A(G8_SA(1, 1), a1, 1, false);
      G8_WAIT_L(8); G8_BAR; G8_WAIT_L(0); G8_MMA(0, 0, At, B0); G8_BAR; G8_SCHED;
      G8_LDB(B1, 0, 1); G8_STAGE(G8_SB(0, 0), b2, voffB);
      G8_BAR; G8_WAIT_L(0); G8_MMA(0, 1, At, B1); G8_BAR;
      G8_LDA(At, 0, 1); G8_STAGE_A(G8_SA(0, 0), a2, 0, last);
      G8_BAR; G8_WAIT_L(0); G8_MMA(1, 0, At, B0); G8_BAR; G8_SCHED;
      G8_STAGE(G8_SB(0, 1), b2 + hstep, voffB);
      G8_WAIT_V(6); G8_BAR; G8_MMA(1, 1, At, B1); G8_BAR;
      G8_LDB(B0, 1, 0); G8_SCHED; G8_LDA(At, 1, 0); G8_STAGE_A(G8_SA(0, 1), a2, 1, last);
      G8_WAIT_L(8); G8_BAR; G8_WAIT_L(0); G8_MMA(0, 0, At, B0); G8_BAR; G8_SCHED;
      G8_LDB(B1, 1, 1); G8_STAGE(G8_SB(1, 0), b3, voffB);
      G8_BAR; G8_WAIT_L(0); G8_MMA(0, 1, At, B1); G8_BAR;
      G8_LDA(At, 1, 1); G8_STAGE_A(G8_SA(1, 0), a3, 0, last);
      G8_BAR; G8_WAIT_L(0); G8_MMA(1, 0, At, B0); G8_BAR; G8_SCHED;
      G8_STAGE(G8_SB(1, 1), b3 + hstep, voffB);
      G8_WAIT_V(6); G8_BAR; G8_MMA(1, 1, At, B1); G8_BAR;
    }
    E(acc, cur, wr, wc, fr, fq);
    if (!has_next) break;
    if (!E.keep(cur)) { _Pragma("unroll") for (int a = 0; a < 2; ++a) _Pragma("unroll") for (int b = 0; b < 2; ++b) _Pragma("unroll") for (int m = 0; m < 4; ++m) _Pragma("unroll") for (int n = 0; n < 2; ++n) acc[a][b][m][n] = (f32x4){0.f, 0.f, 0.f, 0.f}; }
    cur = nxt; cA = nA; cB = nB; ++ui;
    if (GA) { cpk[0] = npk[0]; cpk[1] = npk[1]; }
  }
  G8_WAIT_V(0);
  if (wr == 0) G8_BAR;
  G8_BAR;
#undef G8_SA
#undef G8_SB
#undef G8_STAGE
#undef G8_STAGE_A
#undef G8_STAGE_G
#undef G8_LDA
#undef G8_LDB
#undef G8_MMA
#undef G8_WAIT_V
#undef G8_WAIT_L
#undef G8_BAR
#undef G8_SCHED
}
DI void dense_arows(int K, int R0, int R1, int C0, int C1, unsigned (&vo)[2][2]) {
  vo[0][0] = (unsigned)(R0 * K + C0) * 2u; vo[0][1] = (unsigned)(R1 * K + C1) * 2u;
  vo[1][0] = (unsigned)((128 + R0) * K + C0) * 2u; vo[1][1] = (unsigned)((128 + R1) * K + C1) * 2u;
}
DI void grid_lin(int wgid, int nM, int nN, int& pm, int& pn) {
  const int nwg = nM * nN;
  { const int q = nwg / 8, r = nwg % 8, xcd = wgid % 8, off = wgid / 8; wgid = (xcd < r ? xcd * (q + 1) : r * (q + 1) + (xcd - r) * q) + off; }
  const int nig = 8 * nN, gid = wgid / nig, fm = gid * 8, gsz = (nM - fm) < 8 ? (nM - fm) : 8;
  pm = fm + ((wgid % nig) % gsz); pn = (wgid % nig) / gsz;
}
DI bool grid_unit(int i, int G, int c, int nM, int nN, int& pm, int& pn) {
  const int nwg = nM * nN; const long Lq = (long)i * G + c; if (Lq >= nwg) return false;
  int wgid = (int)Lq; { const int q = nwg / 8, r = nwg % 8, xcd = wgid % 8, off = wgid / 8; wgid = (xcd < r ? xcd * (q + 1) : r * (q + 1) + (xcd - r) * q) + off; }
  const int nig = 8 * nN, gid = wgid / nig, fm = gid * 8, gsz = (nM - fm) < 8 ? (nM - fm) : 8;
  pm = fm + ((wgid % nig) % gsz); pn = (wgid % nig) / gsz; return true;
}
}

DI int ropep(int x) { const int d = x & 63; return (x & ~63) + 8 * ((d & 31) >> 2) + 4 * (d >> 5) + (d & 3); }
DI int wmap(int mode, int n) {
  if (mode == 1) {
    if (n < 512) return ropep(n);
    if (n < 1024) return 512 + ropep(n - 512);
    if (n < 1536) return 6400 + (n - 1024);
    if (n < 2048) return 1024 + ropep(n - 1536);
    if (n < 2176) return 1536 + ropep(n - 2048);
    if (n < 2304) return 6400 + 512 + (n - 2176);
    if (n < 2816) return 1664 + (n - 2304);
    if (n < 3328) return 2176 + (n - 2816);
    if (n < 3840) return 6400 + 640 + (n - 3328);
    if (n < 4352) return 2688 + (n - 3840);
    if (n < 4368) return 6272 + (n - 4352);
    return 3200 + (n - 4368);
  }
  if (mode == 2) return 8 * (n >> 2) + (n & 3);
  if (mode == 3) return 8 * (n >> 2) + 4 + (n & 3);
  return n;
}
struct CvJob { const float* src; bf16_t* dst; int K, N, mode, tk, tn; };
DI void cv_load(const CvJob& j, int tid, f32x4 (&v)[4]) {
  const int kk = tid >> 4, c4 = tid & 15, n = j.tn * 64 + 4 * c4;
  _Pragma("unroll") for (int i = 0; i < 4; ++i) {
    v[i] = mk4(0.f, 0.f, 0.f, 0.f);
    if (n < j.N) v[i] = *(const f32x4*)(j.src + (size_t)(j.tk * 64 + kk + 16 * i) * j.N + n);
  }
}
DI void cv_finish(const CvJob& j, int tid, const f32x4 (&v)[4], char* smem) {
  bf16_t* sT = (bf16_t*)smem;
  const int kk = tid >> 4, c4 = tid & 15;
  __syncthreads();
  _Pragma("unroll") for (int i = 0; i < 4; ++i) {
    const int k = kk + 16 * i;
    sT[(4 * c4 + 0) * 72 + k] = f2bf(v[i].x); sT[(4 * c4 + 1) * 72 + k] = f2bf(v[i].y);
    sT[(4 * c4 + 2) * 72 + k] = f2bf(v[i].z); sT[(4 * c4 + 3) * 72 + k] = f2bf(v[i].w);
  }
  __syncthreads();
  const int nn = tid >> 2, kc = tid & 3;
  const int ng = j.tn * 64 + nn;
  if (ng < j.N) {
    const u32x4 v0 = *(const u32x4*)(sT + nn * 72 + 16 * kc);
    const u32x4 v1 = *(const u32x4*)(sT + nn * 72 + 16 * kc + 8);
    bf16_t* d = j.dst + (size_t)wmap(j.mode, ng) * j.K + j.tk * 64 + 16 * kc;
    *(u32x4*)d = v0; *(u32x4*)(d + 8) = v1;
  }
}

constexpr int WS_TILES_IN = 16 * 117, WS_TILES_BR = 3 * 8 * 16, WS_TILES_OUT = 16 * 16;
constexpr int WS_TILES = WS_TILES_IN + WS_TILES_BR + WS_TILES_OUT;
DI CvJob ws_job(const Params& P, int l, int it) {
  CvJob j;
  if (it < WS_TILES_IN) { j.src = P.w_in + (size_t)l * D * DIN; j.K = D; j.N = DIN; j.dst = P.w_in_t; j.mode = 1; j.tk = it / 117; j.tn = it % 117; }
  else if (it < WS_TILES_IN + WS_TILES_BR) {
    const int q = it - WS_TILES_IN, i = q / 128, r = q % 128;
    j.src = P.w_branch + ((size_t)l * 3 + i) * 512 * 1024; j.K = 512; j.N = 1024; j.dst = P.w_br_t + (size_t)i * 1024 * 512; j.mode = 0; j.tk = r / 16; j.tn = r % 16;
  } else {
    const int q = it - WS_TILES_IN - WS_TILES_BR;
    j.src = P.w_out + (size_t)l * D * D; j.K = D; j.N = D; j.dst = P.w_out_t; j.mode = 0; j.tk = q / 16; j.tn = q % 16;
  }
  return j;
}
DI void phase_wconv_small(const Params& P, int l, char* smem, int bid, int nblk) {
  const int tid = otid();
  if (bid >= WS_TILES) return;
  CvJob j = ws_job(P, l, bid); f32x4 v[4];
  cv_load(j, tid, v);
  for (int it = bid; it < WS_TILES; it += nblk) {
    CvJob jn = j; f32x4 vn[4];
    _Pragma("unroll") for (int i = 0; i < 4; ++i) vn[i] = v[i];
    if (it + nblk < WS_TILES) { jn = ws_job(P, l, it + nblk); cv_load(jn, tid, vn); }
    cv_finish(j, tid, v, smem);
    j = jn;
    _Pragma("unroll") for (int i = 0; i < 4; ++i) v[i] = vn[i];
  }
}
constexpr int WE_TILES = NEXP * 384;
DI CvJob we_job(const Params& P, int l, int it) {
  const int e = it / 384, q = it % 384, which = q / 128, r = q % 128;
  const size_t eo = (size_t)l * NEXP + e;
  CvJob j;
  if (which == 0) { j.src = P.w_gate + eo * 1024 * 512; j.K = 1024; j.N = 512; j.dst = P.w_gu_t + (size_t)e * 1024 * 1024; j.mode = 2; j.tk = r / 8; j.tn = r % 8; }
  else if (which == 1) { j.src = P.w_up + eo * 1024 * 512; j.K = 1024; j.N = 512; j.dst = P.w_gu_t + (size_t)e * 1024 * 1024; j.mode = 3; j.tk = r / 8; j.tn = r % 8; }
  else { j.src = P.w_down + eo * 512 * 1024; j.K = 512; j.N = 1024; j.dst = P.w_dn_t + (size_t)e * 1024 * 512; j.mode = 0; j.tk = r / 16; j.tn = r % 16; }
  return j;
}
DI void phase_wconv_experts(const Params& P, int l, char* smem, int half, volatile __attribute__((address_space(3))) int* wgslot) {
  unsigned* ctr = P.ctl + (l * 8 + 6) * 16;
  const int tid = otid();
  for (;;) {
    __syncthreads();
    if (rtid() == 0) wgslot[0] = (int)__hip_atomic_fetch_add(ctr, 2u, __ATOMIC_RELAXED, __HIP_MEMORY_SCOPE_AGENT);
    __syncthreads();
    const int c0 = (wgslot[0] + half) * 8;
    if (c0 >= WE_TILES) break;
    CvJob j = we_job(P, l, c0); f32x4 v[4];
    cv_load(j, tid, v);
    for (int it = c0; it < c0 + 8; ++it) {
      CvJob jn = j; f32x4 vn[4];
      _Pragma("unroll") for (int i = 0; i < 4; ++i) vn[i] = v[i];
      if (it + 1 < c0 + 8) { jn = we_job(P, l, it + 1); cv_load(jn, tid, vn); }
      cv_finish(j, tid, v, smem);
      j = jn;
      _Pragma("unroll") for (int i = 0; i < 4; ++i) v[i] = vn[i];
    }
  }
}

DI void ln16(f32x4 (&v)[4], const float* g, const float* b, int lane) {
  float s = 0.f;
  _Pragma("unroll") for (int i = 0; i < 4; ++i) s += v[i].x + v[i].y + v[i].z + v[i].w;
  const float mu = wave_sum(s) * (1.f / 1024.f);
  float q = 0.f;
  _Pragma("unroll") for (int i = 0; i < 4; ++i) { v[i].x -= mu; v[i].y -= mu; v[i].z -= mu; v[i].w -= mu; q += v[i].x * v[i].x + v[i].y * v[i].y + v[i].z * v[i].z + v[i].w * v[i].w; }
  const float rs = rsqrtf(wave_sum(q) * (1.f / 1024.f) + LN_EPS);
  _Pragma("unroll") for (int i = 0; i < 4; ++i) {
    const f32x4 gg = ((const f32x4*)g)[lane + 64 * i], bb = ((const f32x4*)b)[lane + 64 * i];
    v[i].x = v[i].x * rs * gg.x + bb.x; v[i].y = v[i].y * rs * gg.y + bb.y; v[i].z = v[i].z * rs * gg.z + bb.z; v[i].w = v[i].w * rs * gg.w + bb.w;
  }
}
DI void store_row(const f32x4 (&v)[4], float* hf, bf16_t* hbf, int lane) {
  _Pragma("unroll") for (int i = 0; i < 4; ++i) {
    if (hf) ((f32x4*)hf)[lane + 64 * i] = v[i];
    if (hbf) { u32x2 u; u.x = pk2(v[i].x, v[i].y); u.y = pk2(v[i].z, v[i].w); ((u32x2*)hbf)[lane + 64 * i] = u; }
  }
}

DI void phase_prologue(const Params& P, int bid, int nblk) {
  const int tid = otid(), gtid = bid * NT + tid, gn = nblk * NT;
  for (int i = gtid; i < L * 32; i += gn) {
    const int pos = i >> 5, f = i & 31;
    const float e = (float)(2 * f) / 64.0f;
    const float pw = (float)pow(10000.0, (double)e);
    const float inv = 1.0f / pw;
    const float ang = (float)pos * inv;
    P.cs[i] = mk2((float)cos((double)ang), (float)sin((double)ang));
  }
  if (gtid < 2) {
    const int l = gtid;
    float s1 = 0.f, s2 = 0.f;
    for (int i = 0; i < 64; ++i) { s1 += P.lam_q1[l * 64 + i] * P.lam_k1[l * 64 + i]; s2 += P.lam_q2[l * 64 + i] * P.lam_k2[l * 64 + i]; }
    const float li = (float)(0.8 - 0.6 * exp(-0.3 * (double)l));
    P.lam[l] = expf(s1) - expf(s2) + li;
    P.lam[2 + l] = (float)(1.0 - (0.8 - 0.6 * exp(-0.3 * (double)l)));
  }
  const int lane = tid & 63, wv = (bid * NT + tid) >> 6, nwv = (nblk * NT) >> 6;
  for (int t = wv; t < T; t += nwv) {
    const int b = t >= L ? 1 : 0, pos = t - b * L;
    const float* src = pos < NMETA ? P.meta + (size_t)pos * D : P.x + ((size_t)b * SEQ + (pos - NMETA)) * D;
    f32x4 v[4];
    _Pragma("unroll") for (int i = 0; i < 4; ++i) v[i] = ((const f32x4*)src)[lane + 64 * i];
    ln16(v, P.ln_in_g, P.ln_in_b, lane);
    store_row(v, P.h + (size_t)t * D, P.hb + (size_t)t * D, lane);
  }
}
DI void phase_zero_pads(const Params& P, int bid, int nblk) {
  const int gtid = bid * NT + otid(), gn = nblk * NT;
  for (int i = gtid; i < 8 * 128 * (LK - L); i += gn) { const int r = i / (LK - L), cidx = i % (LK - L); P.vaT[(size_t)r * LK + L + cidx] = 0; }
  for (int i = gtid; i < 4 * 64 * (LK - L); i += gn) { const int r = i / (LK - L), cidx = i % (LK - L); P.vbT[(size_t)r * LK + L + cidx] = 0; }
  for (int i = gtid; i < 8 * 128 * MPAD; i += gn) { const int r = i / MPAD, cidx = i % MPAD; P.cvT[(size_t)r * LPAD + cidx] = 0; }
  for (int i = gtid; i < 8 * MPAD * 128; i += gn) { const int bh = i / (MPAD * 128), r = i % (MPAD * 128); P.qc[(size_t)bh * LPAD * 128 + r] = 0; P.kc[(size_t)bh * LPAD * 128 + r] = 0; }
  if (gtid < NEXP) P.counts[gtid * CSTR] = 0;
}

constexpr int P1_MT = TP / 128, P1_NT = DINP / 128;
#define WT_FENCE() asm volatile("s_waitcnt lgkmcnt(0)" ::: "memory")
DI void p1_epilogue(const Params& P, int m0, int n0, f32x16 (&acc)[2][2], char* smem) {
  const int tid = otid(), lane = tid & 63, w = tid >> 6, wm = w >> 1, wn = w & 1, lr = lane & 31, lh = lane >> 5;
  const int nw = n0 + wn * 64;
  bf16_t* wt = (bf16_t*)(smem + w * 9216);
  const int mw = m0 + wm * 64;
  int seg;
  if (nw < 512) seg = 0; else if (nw < 1024) seg = 1; else if (nw < 1536) seg = 2; else if (nw < 2048) seg = 3; else if (nw < 2176) seg = 4;
  else if (nw < 2304) seg = 5; else if (nw < 2816) seg = 6; else if (nw < 3328) seg = 7; else if (nw < 3840) seg = 8; else if (nw < 4352) seg = 9;
  else if (nw < 7424) seg = 10; else seg = 11;
  if (seg == 11) {
    _Pragma("unroll") for (int i = 0; i < 2; ++i) _Pragma("unroll") for (int r = 0; r < 16; ++r) {
      const int t = mw + 32 * i + crow(r, lh);
      const int cn = nw + lr - 7424;
      if (t < T && cn < 16) P.cg[(size_t)t * 16 + cn] = acc[i][0][r];
    }
    return;
  }
  if (seg == 0 || seg == 1 || seg == 3 || seg == 4) {
    _Pragma("unroll") for (int i = 0; i < 2; ++i) _Pragma("unroll") for (int r = 0; r < 16; ++r) {
      const int row = 32 * i + crow(r, lh);
      const int t = min(mw + row, T - 1);
      const int pos = t >= L ? t - L : t;
      const f32x2 csv = P.cs[pos * 32 + lr];
      const float x1 = acc[i][0][r], x2 = acc[i][1][r];
      float o1 = x1 * csv.x - x2 * csv.y, o2 = x2 * csv.x + x1 * csv.y;
      if (seg == 0 || seg == 3) { o1 *= QSCALE; o2 *= QSCALE; }
      wt[row * 72 + lr] = f2bf(o1); wt[row * 72 + 32 + lr] = f2bf(o2);
    }
  } else if (seg == 2 || seg == 5 || seg == 8) {
    _Pragma("unroll") for (int i = 0; i < 2; ++i) _Pragma("unroll") for (int j = 0; j < 2; ++j) _Pragma("unroll") for (int rg = 0; rg < 4; ++rg) {
      u32x2 u; u.x = pk2(acc[i][j][4 * rg], acc[i][j][4 * rg + 1]); u.y = pk2(acc[i][j][4 * rg + 2], acc[i][j][4 * rg + 3]);
      *(u32x2*)(wt + (32 * j + lr) * 72 + 32 * i + 8 * rg + 4 * lh) = u;
    }
  } else if (seg == 10) {
    _Pragma("unroll") for (int i = 0; i < 2; ++i) _Pragma("unroll") for (int j = 0; j < 2; ++j) _Pragma("unroll") for (int r = 0; r < 16; ++r)
      wt[(32 * i + crow(r, lh)) * 72 + 32 * j + lr] = f2bf(fmaxf(sigmoidf_(acc[i][j][r]), 1e-12f));
  } else {
    _Pragma("unroll") for (int i = 0; i < 2; ++i) _Pragma("unroll") for (int j = 0; j < 2; ++j) _Pragma("unroll") for (int r = 0; r < 16; ++r)
      wt[(32 * i + crow(r, lh)) * 72 + 32 * j + lr] = f2bf(acc[i][j][r]);
  }
  WT_FENCE();
  _Pragma("unroll") for (int it = 0; it < 8; ++it) {
    const int id = it * 64 + lane, row = id >> 3, ch = id & 7;
    const u32x4 v = *(const u32x4*)(wt + row * 72 + ch * 8);
    if (seg == 2 || seg == 5 || seg == 8) {
      const int t0 = mw + ch * 8;
      if (t0 < T) {
        const int b = t0 >= L ? 1 : 0, pos0 = t0 - b * L;
        bf16_t* dst;
        if (seg == 2) { const int cc = nw - 1024 + row; dst = P.vaT + ((size_t)(b * 4 + (cc >> 7)) * 128 + (cc & 127)) * LK + pos0; }
        else if (seg == 5) { const int cc = nw - 2176 + row; dst = P.vbT + ((size_t)(b * 2 + (cc >> 6)) * 64 + (cc & 63)) * LK + pos0; }
        else { const int cc = nw - 3328 + row; dst = P.cvT + ((size_t)(b * 4 + (cc >> 7)) * 128 + (cc & 127)) * LPAD + MPAD + pos0; }
        *(u32x4*)dst = v;
      }
    } else {
      const int t = mw + row;
      if (t < T) {
        const int b = t >= L ? 1 : 0, pos = t - b * L;
        bf16_t* dst;
        if (seg == 0) { const int u = nw >> 6; dst = P.qa + ((size_t)((b * 4 + (u >> 1)) * 2 + (u & 1)) * L + pos) * 64; }
        else if (seg == 1) { const int u = (nw - 512) >> 6; dst = P.ka + ((size_t)((b * 4 + (u >> 1)) * 2 + (u & 1)) * L + pos) * 64; }
        else if (seg == 3) { const int hq = (nw - 1536) >> 6; dst = P.qb + ((size_t)(b * 8 + hq) * L + pos) * 64; }
        else if (seg == 4) { const int kv = (nw - 2048) >> 6; dst = P.kb + ((size_t)(b * 2 + kv) * L + pos) * 64; }
        else if (seg == 6) dst = P.cq + (size_t)t * 512 + nw - 2304;
        else if (seg == 7) dst = P.ck + (size_t)t * 512 + nw - 2816;
        else if (seg == 9) dst = P.co + (size_t)t * 512 + nw - 3840;
        else dst = P.gz + (size_t)t * 3072 + nw - 4352;
        *(u32x4*)(dst + ch * 8) = v;
      }
    }
  }
}
DI float logsigmoidf_(float x) { return fminf(x, 0.f) - log1pf(__expf(-fabsf(x))); }
DI void phase_mprep(const Params& P, int l, char* smem, int bid, int nblk) {
  const int tid = otid();
  float* sli = (float*)smem;
  float* slf = sli + 256;
  float* sb = slf + 256;
  float* sw = sb + 256;
  float* sred = sw + 256;
  float* sst = sred + 16 * 256;
  for (int it = bid; it < 8 * NCH; it += nblk) {
    const int bh = it < 8 * (NCH - 1) ? it / (NCH - 1) : it - 8 * (NCH - 1), n = it < 8 * (NCH - 1) ? 1 + it % (NCH - 1) : 0, b = bh >> 2, hh = bh & 3;
    __syncthreads();
    if (tid < 128) {
      const int p = 128 * n + tid, pos = p - MPAD;
      float lif = NEGF, lff = 0.f, lib = NEGF, lfb = 0.f;
      if (pos >= 0) {
        const float* g = P.cg + (size_t)(b * L + pos) * 16;
        const float* gb = P.gate_b + l * 16;
        lif = g[0 + hh] + gb[0 + hh]; lff = logsigmoidf_(g[4 + hh] + gb[4 + hh]);
        lib = g[8 + hh] + gb[8 + hh]; lfb = logsigmoidf_(g[12 + hh] + gb[12 + hh]);
      }
      sli[tid] = lif; sli[128 + tid] = lib; slf[tid] = lff; slf[128 + tid] = lfb;
    }
    __syncthreads();
    if (tid < 128) {
      const int t2 = otid(), wd = t2 >> 6, ln = t2 & 63;
      const int i0 = wd == 0 ? 2 * ln : 127 - 2 * ln, i1 = wd == 0 ? 2 * ln + 1 : 126 - 2 * ln;
      const float e0 = slf[wd * 128 + i0], e1 = slf[wd * 128 + i1];
      float scan = e0 + e1;
      _Pragma("unroll") for (int d = 1; d < 64; d <<= 1) { const float tt = shfl_up_f(scan, d, ln); if (ln >= d) scan += tt; }
      float excl = shfl_up_f(scan, 1, ln); if (ln == 0) excl = 0.f;
      sb[wd * 128 + i0] = excl + e0; sb[wd * 128 + i1] = excl + e0 + e1;
    }
    __syncthreads();
    if (tid < 128) {
      const int dir = tid >> 6, lane = tid & 63;
      const float g = dir == 0 ? sb[127] : sb[128];
      const float a0 = g - sb[dir * 128 + lane] + sli[dir * 128 + lane];
      const float a1 = g - sb[dir * 128 + lane + 64] + sli[dir * 128 + lane + 64];
      const float am = wave_max(fmaxf(a0, a1));
      const float w0 = __expf(a0 - am), w1 = __expf(a1 - am);
      sw[dir * 128 + lane] = w0; sw[dir * 128 + lane + 64] = w1;
      const size_t base = ((size_t)dir * 8 + bh) * LPAD + 128 * n;
      P.wgt[base + lane] = w0; P.wgt[base + lane + 64] = w1;
      P.bcum[base + lane] = sb[dir * 128 + lane]; P.bcum[base + lane + 64] = sb[dir * 128 + lane + 64];
      P.ligate[base + lane] = sli[dir * 128 + lane]; P.ligate[base + lane + 64] = sli[dir * 128 + lane + 64];
      if (lane == 0) { float* ms = P.mstat + ((size_t)(dir * 8 + bh) * NCH + n) * 4; ms[0] = g; ms[1] = am; }
    }
    __syncthreads();
    bf16_t* skT = (bf16_t*)(smem + 32768);
    if (n == 0) { for (int i = tid; i < 128 * MPAD; i += NT) skT[(i / MPAD) * 136 + (i % MPAD)] = 0; }
    const int tid3 = otid();
    const int dg = tid3 & 15, tl = tid3 >> 4;
    float nf[8], nbk[8];
    _Pragma("unroll") for (int j = 0; j < 8; ++j) { nf[j] = 0.f; nbk[j] = 0.f; }
    const int ch = hh * 128 + dg * 8;
    float cw[2][3][8], cb[2][8];
    _Pragma("unroll") for (int j = 0; j < 8; ++j) {
      _Pragma("unroll") for (int ww = 0; ww < 3; ++ww) { cw[0][ww][j] = P.conv_w[((size_t)l * 3 + ww) * 1024 + ch + j]; cw[1][ww][j] = P.conv_w[((size_t)l * 3 + ww) * 1024 + 512 + ch + j]; }
      cb[0][j] = P.conv_b[l * 1024 + ch + j]; cb[1][j] = P.conv_b[l * 1024 + 512 + ch + j];
    }
    _Pragma("unroll") for (int i = 0; i < 8; ++i) {
      const int tau = tl + 16 * i, p = 128 * n + tau, pos = p - MPAD;
      if (pos < 0) continue;
      float q[8], k[8];
      _Pragma("unroll") for (int j = 0; j < 8; ++j) { q[j] = cb[0][j]; k[j] = cb[1][j]; }
      _Pragma("unroll") for (int ww = 0; ww < 3; ++ww) {
        const int pp = pos + ww - 1;
        if (pp < 0 || pp >= L) continue;
        const u32x4 uq = *(const u32x4*)(P.cq + (size_t)(b * L + pp) * 512 + ch);
        const u32x4 uk = *(const u32x4*)(P.ck + (size_t)(b * L + pp) * 512 + ch);
        const unsigned aq[4] = {uq.x, uq.y, uq.z, uq.w}, ak[4] = {uk.x, uk.y, uk.z, uk.w};
        _Pragma("unroll") for (int j = 0; j < 4; ++j) {
          q[2 * j] += bflo(aq[j]) * cw[0][ww][2 * j]; q[2 * j + 1] += bfhi(aq[j]) * cw[0][ww][2 * j + 1];
          k[2 * j] += bflo(ak[j]) * cw[1][ww][2 * j]; k[2 * j + 1] += bfhi(ak[j]) * cw[1][ww][2 * j + 1];
        }
      }
      const float wf = sw[tau], wb = sw[128 + tau];
      _Pragma("unroll") for (int j = 0; j < 8; ++j) {
        q[j] = q[j] * sigmoidf_(q[j]);
        k[j] = k[j] * sigmoidf_(k[j]) * 0.08838834764831845f;
        nf[j] += wf * k[j]; nbk[j] += wb * k[j];
      }
      u32x4 oq, ok;
      oq.x = pk2(q[0], q[1]); oq.y = pk2(q[2], q[3]); oq.z = pk2(q[4], q[5]); oq.w = pk2(q[6], q[7]);
      ok.x = pk2(k[0], k[1]); ok.y = pk2(k[2], k[3]); ok.z = pk2(k[4], k[5]); ok.w = pk2(k[6], k[7]);
      *(u32x4*)(P.qc + ((size_t)bh * LPAD + p) * 128 + dg * 8) = oq;
      *(u32x4*)(P.kc + ((size_t)bh * LPAD + p) * 128 + dg * 8) = ok;
      _Pragma("unroll") for (int j = 0; j < 8; ++j) skT[(dg * 8 + j) * 136 + tau] = f2bf(k[j]);
    }
    _Pragma("unroll") for (int j = 0; j < 8; ++j) { sred[tl * 256 + dg * 8 + j] = nf[j]; sred[tl * 256 + 128 + dg * 8 + j] = nbk[j]; }
    __syncthreads();
    {
      const int tid2 = otid();
      const int lane = tid2 & 63, w = tid2 >> 6, wi = w >> 1, wj = w & 1, lr = lane & 31, lh = lane >> 5;
      unsigned vo = (unsigned)((bh * 128 + 64 * wi + lr) * LPAD + 128 * n + 8 * lh);
      asm volatile("" : "+v"(vo));
      _Pragma("unroll 1") for (int dir = 0; dir < 2; ++dir) {
        f32x16 acc[2][2];
        _Pragma("unroll") for (int i = 0; i < 2; ++i) _Pragma("unroll") for (int j = 0; j < 2; ++j) acc[i][j] = zero16();
        unsigned koff = (unsigned)((64 * wj + lr) * 136 + 8 * lh);
        asm volatile("" : "+v"(koff));
        _Pragma("unroll") for (int ks = 0; ks < 8; ++ks) {
          if (n == 0 && ks < 7) continue;
          const int tau = 16 * ks + 8 * lh;
          const f32x4 w0 = *(const f32x4*)(sw + dir * 128 + tau), w1 = *(const f32x4*)(sw + dir * 128 + tau + 4);
          bf16x8 bq[2];
          _Pragma("unroll") for (int i = 0; i < 2; ++i) {
            const u32x4 kr = *(const u32x4*)(skT + koff + (32 * i) * 136 + 16 * ks);
            union { unsigned u[4]; bf16x8 v; } tt;
            tt.u[0] = pk2(bflo(kr.x) * w0.x, bfhi(kr.x) * w0.y); tt.u[1] = pk2(bflo(kr.y) * w0.z, bfhi(kr.y) * w0.w);
            tt.u[2] = pk2(bflo(kr.z) * w1.x, bfhi(kr.z) * w1.y); tt.u[3] = pk2(bflo(kr.w) * w1.z, bfhi(kr.w) * w1.w);
            bq[i] = tt.v;
          }
          bf16x8 af[2];
          _Pragma("unroll") for (int i = 0; i < 2; ++i) af[i] = ldfrag(P.cvT + vo + (unsigned)(32 * i) * LPAD + 16 * ks);
          _Pragma("unroll") for (int i = 0; i < 2; ++i) _Pragma("unroll") for (int j = 0; j < 2; ++j) acc[i][j] = MFMA32(af[i], bq[j], acc[i][j]);
        }
        float* U = P.U + ((size_t)(dir * 8 + bh) * NCH + n) * 16384;
        _Pragma("unroll") for (int i = 0; i < 2; ++i) _Pragma("unroll") for (int j = 0; j < 2; ++j) _Pragma("unroll") for (int r = 0; r < 16; ++r)
          U[(64 * wi + 32 * i + crow(r, lh)) * 128 + 64 * wj + 32 * j + lr] = acc[i][j][r];
      }
    }
    {
      float s = 0.f;
      _Pragma("unroll") for (int i = 0; i < 16; ++i) s += sred[i * 256 + tid];
      const int dir = tid >> 7, dk = tid & 127;
      P.nvec[((size_t)(dir * 8 + bh) * NCH + n) * 128 + dk] = s;
    }
  }
}

DI void phase_mscan(const Params& P, int bid, int nblk) {
  constexpr int SB = 13;
  for (int gt = bid * NT + otid(); gt < 16 * 2048 + 256; gt += nblk * NT) {
    if (gt < 16 * 2048) {
      const int seq = gt >> 11, e = gt & 2047, dir = seq >> 3;
      float C[8];
      _Pragma("unroll") for (int j = 0; j < 8; ++j) C[j] = 0.f;
      float m = 0.f;
      for (int sb = 0; sb < NCH; sb += SB) {
        f32x4 u0[SB], u1[SB]; float gg[SB], aa[SB];
        _Pragma("unroll") for (int k = 0; k < SB; ++k) {
          const int n = dir == 0 ? sb + k : NCH - 1 - sb - k;
          const size_t item = (size_t)seq * NCH + n;
          const float* up = P.U + item * 16384 + e * 8;
          u0[k] = *(const f32x4*)up; u1[k] = *(const f32x4*)(up + 4);
          gg[k] = P.mstat[item * 4]; aa[k] = P.mstat[item * 4 + 1];
        }
        _Pragma("unroll") for (int k = 0; k < SB; ++k) {
          const int n = dir == 0 ? sb + k : NCH - 1 - sb - k;
          const size_t item = (size_t)seq * NCH + n;
          const float mn = fmaxf(gg[k] + m, aa[k]);
          const float decay = __expf(gg[k] + m - mn), f = __expf(aa[k] - mn);
          u32x4 cb; cb.x = pk2(C[0], C[1]); cb.y = pk2(C[2], C[3]); cb.z = pk2(C[4], C[5]); cb.w = pk2(C[6], C[7]);
          *(u32x4*)(P.U + item * 16384 + e * 8) = cb;
          C[0] = decay * C[0] + f * u0[k].x; C[1] = decay * C[1] + f * u0[k].y; C[2] = decay * C[2] + f * u0[k].z; C[3] = decay * C[3] + f * u0[k].w;
          C[4] = decay * C[4] + f * u1[k].x; C[5] = decay * C[5] + f * u1[k].y; C[6] = decay * C[6] + f * u1[k].z; C[7] = decay * C[7] + f * u1[k].w;
          m = mn;
        }
      }
    } else {
      const int q = gt - 16 * 2048, seq = q >> 4, e = q & 15, dir = seq >> 3;
      float nst[8];
      _Pragma("unroll") for (int j = 0; j < 8; ++j) nst[j] = 0.f;
      float m = 0.f;
      for (int sb = 0; sb < NCH; sb += SB) {
        f32x4 n0[SB], n1[SB]; float gg[SB], aa[SB];
        _Pragma("unroll") for (int k = 0; k < SB; ++k) {
          const int n = dir == 0 ? sb + k : NCH - 1 - sb - k;
          const size_t item = (size_t)seq * NCH + n;
          const float* np = P.nvec + item * 128 + e * 8;
          n0[k] = *(const f32x4*)np; n1[k] = *(const f32x4*)(np + 4);
          gg[k] = P.mstat[item * 4]; aa[k] = P.mstat[item * 4 + 1];
        }
        _Pragma("unroll") for (int k = 0; k < SB; ++k) {
          const int n = dir == 0 ? sb + k : NCH - 1 - sb - k;
          const size_t item = (size_t)seq * NCH + n;
          const float mn = fmaxf(gg[k] + m, aa[k]);
          const float decay = __expf(gg[k] + m - mn), f = __expf(aa[k] - mn);
          float* np = P.nvec + item * 128 + e * 8;
          *(f32x4*)np = mk4(nst[0], nst[1], nst[2], nst[3]); *(f32x4*)(np + 4) = mk4(nst[4], nst[5], nst[6], nst[7]);
          nst[0] = decay * nst[0] + f * n0[k].x; nst[1] = decay * nst[1] + f * n0[k].y; nst[2] = decay * nst[2] + f * n0[k].z; nst[3] = decay * nst[3] + f * n0[k].w;
          nst[4] = decay * nst[4] + f * n1[k].x; nst[5] = decay * nst[5] + f * n1[k].y; nst[6] = decay * nst[6] + f * n1[k].z; nst[7] = decay * nst[7] + f * n1[k].w;
          if (e == 0) P.mstat[item * 4 + 2] = m;
          m = mn;
        }
      }
    }
  }
}

DI void mout_item(const Params& P, int l, int it, char* smem) {
  const int tid = otid(), lane = tid & 63, w = tid >> 6, lr = lane & 31, lh = lane >> 5;
  const int bh = it / NCH, n = it % NCH, b = bh >> 2, hh = bh & 3;
  char* sK = smem;
  char* sV = smem + 32768;
  float* sb = (float*)(smem + 65536);
  float* sc = sb + 256;
  float* spm = sc + 256;
  float* snp = spm + 256;
  __syncthreads();
  {
    const int rin = lane >> 4, cpos = lane & 15;
    _Pragma("unroll") for (int i = 0; i < 16; ++i) {
      const int dir = i >> 3, R = (i & 7) * 4 + w, row = 4 * R + rin;
      const char* src = (const char*)(P.U + ((size_t)(dir * 8 + bh) * NCH + n) * 16384) + (size_t)row * 512 + (cpos ^ (row & 15)) * 32;
      __builtin_amdgcn_global_load_lds((const unsigned*)src, (lds_u32*)(smem + dir * 32768 + R * 1024), 16, 0, 0);
    }
  }
  {
    const int dir = tid >> 7, tau = tid & 127;
    const size_t base = ((size_t)dir * 8 + bh) * LPAD + 128 * n + tau;
    const float bb = P.bcum[base], li = P.ligate[base];
    sb[tid] = bb; sc[tid] = li - bb;
    snp[tid] = P.nvec[((size_t)(dir * 8 + bh) * NCH + n) * 128 + tau];
  }
  __syncthreads();
  if (w < 2) {
    const int i0 = w == 0 ? 2 * lane : 127 - 2 * lane, i1 = w == 0 ? 2 * lane + 1 : 126 - 2 * lane;
    const float e0 = sc[w * 128 + i0], e1 = sc[w * 128 + i1];
    const float p1 = fmaxf(e0, e1);
    float scan = p1;
    _Pragma("unroll") for (int d = 1; d < 64; d <<= 1) { const float tt = shfl_up_f(scan, d, lane); if (lane >= d) scan = fmaxf(scan, tt); }
    float excl = shfl_up_f(scan, 1, lane); if (lane == 0) excl = -3.0e38f;
    spm[w * 128 + i0] = fmaxf(excl, e0); spm[w * 128 + i1] = fmaxf(excl, p1);
  }
  __syncthreads();
  const int t = 32 * w + lr, p = 128 * n + t;
  bf16x8 qf[8];
  _Pragma("unroll") for (int ks = 0; ks < 8; ++ks) qf[ks] = ldfrag(P.qc + ((size_t)bh * LPAD + p) * 128 + 16 * ks + 8 * lh);
  f32x16 acc[2][4];
  float btv[2], mtv[2], den0[2];
  _Pragma("unroll") for (int dir = 0; dir < 2; ++dir) {
    const size_t item = (size_t)(dir * 8 + bh) * NCH + n;
    const float mprev = P.mstat[item * 4 + 2];
    const float bt = sb[dir * 128 + t];
    const float mt = bt + fmaxf(mprev, spm[dir * 128 + t]);
    const float inter = __expf(bt + mprev - mt);
    float qn = 0.f;
    _Pragma("unroll") for (int ks = 0; ks < 8; ++ks) {
      union { bf16x8 v; unsigned u[4]; } tt; tt.v = qf[ks];
      const float* np = snp + dir * 128 + 16 * ks + 8 * lh;
      _Pragma("unroll") for (int j = 0; j < 4; ++j) qn += bflo(tt.u[j]) * np[2 * j] + bfhi(tt.u[j]) * np[2 * j + 1];
    }
    qn = xsum32(qn);
    btv[dir] = bt; mtv[dir] = mt; den0[dir] = inter * qn;
    const char* sU = smem + dir * 32768;
    _Pragma("unroll") for (int d = 0; d < 4; ++d) {
      const int urow = 32 * d + lr;
      acc[dir][d] = zero16();
      _Pragma("unroll") for (int ks = 0; ks < 8; ++ks) acc[dir][d] = MFMA32(*(const bf16x8*)(sU + urow * 256 + (((2 * ks + lh) ^ (urow & 15)) << 4)), qf[ks], acc[dir][d]);
      _Pragma("unroll") for (int r = 0; r < 16; ++r) acc[dir][d][r] *= inter;
    }
  }
  __syncthreads();
  {
    const int rin = lane >> 4, cpos = lane & 15;
    _Pragma("unroll") for (int i = 0; i < 16; ++i) {
      const int R = i * 4 + w, row = (i < 8 ? 4 * R : 4 * (R - 32)) + rin;
      const int ce = (cpos ^ (row & 15)) * 8;
      const bf16_t* src = i < 8 ? P.kc + ((size_t)bh * LPAD + 128 * n + row) * 128 + ce : P.cvT + ((size_t)bh * 128 + row) * LPAD + 128 * n + ce;
      __builtin_amdgcn_global_load_lds((const unsigned*)src, (lds_u32*)(smem + R * 1024), 16, 0, 0);
    }
  }
  __syncthreads();
  _Pragma("unroll") for (int dir = 0; dir < 2; ++dir) {
    const float bt = btv[dir], mt = mtv[dir];
    float den = 0.f;
    const int st0 = dir == 0 ? 0 : w, st1 = dir == 0 ? w : 3;
    for (int st = st0; st <= st1; ++st) {
      f32x16 s = zero16();
      _Pragma("unroll") for (int ks = 0; ks < 8; ++ks) {
        const int krow = 32 * st + kswap(lr);
        s = MFMA32(*(const bf16x8*)(sK + krow * 256 + (((2 * ks + lh) ^ (krow & 15)) << 4)), qf[ks], s);
      }
      _Pragma("unroll") for (int r = 0; r < 16; ++r) {
        const int sidx = 32 * st + keyoff(r, lh);
        const bool ok = dir == 0 ? (sidx <= t) : (sidx >= t);
        const float dd = __expf(fminf(bt + sc[dir * 128 + sidx] - mt, 0.f));
        const float pv = ok ? s[r] * dd : 0.f;
        s[r] = pv; den += pv;
      }
      const bf16x8 p0 = packfrag(s, 0), p1 = packfrag(s, 1);
      _Pragma("unroll") for (int d = 0; d < 4; ++d) {
        const int vrow = 32 * d + lr;
        const char* vp = sV + vrow * 256;
        acc[dir][d] = MFMA32(*(const bf16x8*)(vp + (((4 * st + lh) ^ (vrow & 15)) << 4)), p0, acc[dir][d]);
        acc[dir][d] = MFMA32(*(const bf16x8*)(vp + (((4 * st + 2 + lh) ^ (vrow & 15)) << 4)), p1, acc[dir][d]);
      }
    }
    den = xsum32(den);
    den = den0[dir] + den;
    const float sca = frcp(fmaxf(fabsf(den), __expf(-mt)));
    _Pragma("unroll") for (int d = 0; d < 4; ++d) _Pragma("unroll") for (int r = 0; r < 16; ++r) acc[dir][d][r] *= sca;
  }
  float hacc[4][16];
  _Pragma("unroll") for (int d = 0; d < 4; ++d) _Pragma("unroll") for (int r = 0; r < 16; ++r) hacc[d][r] = acc[0][d][r] + acc[1][d][r];
  float s1 = 0.f;
  _Pragma("unroll") for (int d = 0; d < 4; ++d) _Pragma("unroll") for (int r = 0; r < 16; ++r) s1 += hacc[d][r];
  s1 = xsum32(s1);
  const float mu = s1 * (1.f / 128.f);
  float s2 = 0.f;
  _Pragma("unroll") for (int d = 0; d < 4; ++d) _Pragma("unroll") for (int r = 0; r < 16; ++r) { hacc[d][r] -= mu; s2 += hacc[d][r] * hacc[d][r]; }
  s2 = xsum32(s2);
  const float rs = rsqrtf(s2 * (1.f / 128.f) + LN_EPS);
  const int pos = p - MPAD;
  if (pos >= 0) {
    const size_t tok = (size_t)b * L + pos;
    _Pragma("unroll") for (int d = 0; d < 4; ++d) _Pragma("unroll") for (int rg = 0; rg < 4; ++rg) {
      const int dv = 32 * d + 8 * rg + 4 * lh;
      const int col = hh * 128 + dv;
      const u32x2 cu = *(const u32x2*)(P.co + tok * 512 + col);
      const f32x4 g4 = *(const f32x4*)(P.mlstm_g + l * 512 + col);
      const float o0 = hacc[d][4 * rg + 0] * rs * g4.x * sigmoidf_(bflo(cu.x));
      const float o1 = hacc[d][4 * rg + 1] * rs * g4.y * sigmoidf_(bfhi(cu.x));
      const float o2 = hacc[d][4 * rg + 2] * rs * g4.z * sigmoidf_(bflo(cu.y));
      const float o3 = hacc[d][4 * rg + 3] * rs * g4.w * sigmoidf_(bfhi(cu.y));
      u32x2 ou; ou.x = pk2(o0, o1); ou.y = pk2(o2, o3);
      *(u32x2*)(P.oc + tok * 512 + col) = ou;
    }
  }
}

constexpr int DA_STAGE = 32768;
constexpr float DA_THR = 8.f;
DI void dattn_issue(const Params& P, int bh, int k0, char* stage, unsigned vk, unsigned vv, int w) {
  const char* kb0 = (const char*)(P.ka + ((size_t)(bh * 2) * L + k0) * 64);
  const char* vb0 = (const char*)(P.vaT + (size_t)bh * 128 * LK + k0);
  _Pragma("unroll") for (int i = 0; i < 8; ++i) {
    const char* src = i < 4 ? kb0 + (size_t)(i >> 1) * (L * 128) + (i & 1) * 4096 + vk : vb0 + (size_t)(i - 4) * 32 * LK * 2 + vv;
    __builtin_amdgcn_global_load_lds((const unsigned*)src, (lds_u32*)(stage + (i * 4 + w) * 1024), 16, 0, 0);
  }
}
DI void dattn_merge4(f32x16 (&O)[2][4], float (&m)[2], float (&ls)[2], char* smem, int lane, int w) {
  float* xf = (float*)smem;
  for (int src = 1; src < 4; ++src) {
    __syncthreads();
    if (w == src) {
      _Pragma("unroll") for (int c = 0; c < 2; ++c) {
        _Pragma("unroll") for (int d = 0; d < 4; ++d) _Pragma("unroll") for (int r = 0; r < 16; ++r) xf[((c * 4 + d) * 16 + r) * 64 + lane] = O[c][d][r];
        xf[8192 + c * 64 + lane] = m[c]; xf[8192 + 128 + c * 64 + lane] = ls[c];
      }
    }
    __syncthreads();
    if (w == 0) {
      _Pragma("unroll") for (int c = 0; c < 2; ++c) {
        const float mb = xf[8192 + c * 64 + lane], lb = xf[8192 + 128 + c * 64 + lane];
        const float M = fmaxf(m[c], mb), fa = fexp2(m[c] - M), fb = fexp2(mb - M);
        ls[c] = ls[c] * fa + lb * fb; m[c] = M;
        _Pragma("unroll") for (int d = 0; d < 4; ++d) _Pragma("unroll") for (int r = 0; r < 16; ++r) O[c][d][r] = O[c][d][r] * fa + xf[((c * 4 + d) * 16 + r) * 64 + lane] * fb;
      }
    }
  }
}
DI void dattn_finish(const Params& P, int l, int bh, int q0, f32x16 (&O)[2][4], const float (&ls)[2], int lr, int lh) {
  const int b = bh >> 2, hh = bh & 3;
  const float lam = P.lam[l], omli = P.lam[2 + l];
  const float i0 = 1.f / ls[0], i1 = lam / ls[1];
  float ss = 0.f;
  _Pragma("unroll") for (int d = 0; d < 4; ++d) _Pragma("unroll") for (int r = 0; r < 16; ++r) { const float o = O[0][d][r] * i0 - O[1][d][r] * i1; O[0][d][r] = o; ss += o * o; }
  ss = xsum32(ss);
  const float rs = rsqrtf(ss * (1.f / 128.f) + LN_EPS);
  if (q0 + lr < L) {
    const size_t tok = (size_t)b * L + q0 + lr;
    _Pragma("unroll") for (int d = 0; d < 4; ++d) _Pragma("unroll") for (int rg = 0; rg < 4; ++rg) {
      const int dv = 32 * d + 8 * rg + 4 * lh;
      const f32x4 g4 = *(const f32x4*)(P.diff_g + l * 128 + dv);
      u32x2 ou;
      ou.x = pk2(O[0][d][4 * rg + 0] * rs * g4.x * omli, O[0][d][4 * rg + 1] * rs * g4.y * omli);
      ou.y = pk2(O[0][d][4 * rg + 2] * rs * g4.z * omli, O[0][d][4 * rg + 3] * rs * g4.w * omli);
      *(u32x2*)(P.oa + tok * 512 + hh * 128 + dv) = ou;
    }
  }
}
DI void da_softmax(f32x16& s, float& m, float& ls, f32x16 (&O)[4], bool last, int key0, int lh, bf16x8& p0, bf16x8& p1) {
  if (last) {
    asm volatile("; last key tile: mask" ::: "memory");
    _Pragma("unroll") for (int r = 0; r < 16; ++r) if (key0 + keyoff(r, lh) >= L) s[r] = -3.0e38f;
  }
  float mx = s[0];
  _Pragma("unroll") for (int r = 1; r < 16; ++r) mx = fmaxf(mx, s[r]);
  if (__any(mx - m > DA_THR)) {
    asm volatile("; rare: move the softmax reference" ::: "memory");
    const float dlt = fmaxf(xmax32(mx) - m, 0.f);
    const float al = fexp2(-dlt);
    m += dlt; ls *= al;
    _Pragma("unroll") for (int d = 0; d < 4; ++d) _Pragma("unroll") for (int r = 0; r < 16; ++r) O[d][r] *= al;
  }
  f32x2 rs2 = mk2(0.f, 0.f);
  _Pragma("unroll") for (int i = 0; i < 8; ++i) {
    f32x2 x = mk2(s[2 * i], s[2 * i + 1]) - mk2(m, m);
    x.x = fexp2(x.x); x.y = fexp2(x.y);
    s[2 * i] = x.x; s[2 * i + 1] = x.y;
    rs2 += x;
  }
  ls += rs2.x + rs2.y;
  p0 = packfrag(s, 0); p1 = packfrag(s, 1);
}
constexpr int DA_PART = 2 * 4 * 16 * 64 + 256;
DI void dattn_item(const Params& P, int l, int it, bool part, char* smem) {
  const int tid = otid(), lane = tid & 63, w = tid >> 6, lr = lane & 31, lh = lane >> 5;
  const int bh = it & 7, jq = it >> 3;
  const int q0 = part ? 8192 : jq * 128 + 32 * w;
  const int qi = min(q0 + lr, L - 1);
  constexpr int NTILE = (L + 63) / 64;
  const int t0 = part ? 2 * jq : 0, t1 = part ? (jq == 63 ? NTILE : 2 * jq + 2) : NTILE;
  bf16x8 qf[2][4];
  _Pragma("unroll") for (int c = 0; c < 2; ++c) _Pragma("unroll") for (int ks = 0; ks < 4; ++ks)
    qf[c][ks] = ldfrag(P.qa + ((size_t)(bh * 2 + c) * L + qi) * 64 + 16 * ks + 8 * lh);
  f32x16 O[2][4];
  float m[2], ls[2];
  _Pragma("unroll") for (int c = 0; c < 2; ++c) {
    f32x16 s = zero16();
    const bf16_t* kp = P.ka + ((size_t)(bh * 2 + c) * L + t0 * 64 + kswap(lr)) * 64 + 8 * lh;
    _Pragma("unroll") for (int ks = 0; ks < 4; ++ks) s = MFMA32(ldfrag(kp + 16 * ks), qf[c][ks], s);
    float mx = s[0];
    _Pragma("unroll") for (int r = 1; r < 16; ++r) mx = fmaxf(mx, s[r]);
    m[c] = xmax32(mx); ls[c] = 0.f;
    _Pragma("unroll") for (int d = 0; d < 4; ++d) O[c][d] = zero16();
  }
  const unsigned vk = (unsigned)((w * 8 + (lane >> 3)) * 128 + (((lane & 7) ^ (4 * (w & 1) + (lane >> 4))) << 4));
  const unsigned vv = (unsigned)((w * 8 + (lane >> 3)) * (LK * 2) + (((lane & 7) ^ (4 * (w & 1) + (lane >> 4))) << 4));
  __syncthreads();
  dattn_issue(P, bh, t0 * 64, smem + (t0 & 1) * DA_STAGE, vk, vv, w);
  for (int t = t0; t < t1; ++t) {
    __syncthreads();
    if (t + 1 < t1) dattn_issue(P, bh, (t + 1) * 64, smem + ((t + 1) & 1) * DA_STAGE, vk, vv, w);
    const char* st = smem + (t & 1) * DA_STAGE;
    _Pragma("unroll") for (int kb = 0; kb < 2; ++kb) {
      if (part && ((((t - t0) * 2 + kb) & 3) != w)) continue;
      bf16x8 pf[2][2];
      _Pragma("unroll") for (int c = 0; c < 2; ++c) {
        f32x16 s;
        _Pragma("unroll") for (int r = 0; r < 16; ++r) s[r] = -m[c];
        const int krow = kb * 32 + kswap(lr);
        const char* kp = st + c * 8192 + krow * 128;
        _Pragma("unroll") for (int ks = 0; ks < 4; ++ks) s = MFMA32(*(const bf16x8*)(kp + (((2 * ks + lh) ^ swz(krow)) << 4)), qf[c][ks], s);
        if (t == NTILE - 1) {
          _Pragma("unroll") for (int r = 0; r < 16; ++r) if (t * 64 + kb * 32 + keyoff(r, lh) >= L) s[r] = -3.0e38f;
        }
        float mx = s[0];
        _Pragma("unroll") for (int r = 1; r < 16; ++r) mx = fmaxf(mx, s[r]);
        if (__any(mx > DA_THR)) {
          asm volatile("; rare: move the softmax reference" ::: "memory");
          const float dlt = fmaxf(xmax32(mx), 0.f);
          const float al = fexp2(-dlt);
          m[c] += dlt; ls[c] *= al;
          _Pragma("unroll") for (int d = 0; d < 4; ++d) _Pragma("unroll") for (int r = 0; r < 16; ++r) O[c][d][r] *= al;
          _Pragma("unroll") for (int r = 0; r < 16; ++r) s[r] -= dlt;
        }
        float rsum = 0.f;
        _Pragma("unroll") for (int r = 0; r < 16; ++r) { const float pv = fexp2(s[r]); s[r] = pv; rsum += pv; }
        ls[c] += rsum;
        pf[c][0] = packfrag(s, 0); pf[c][1] = packfrag(s, 1);
      }
      _Pragma("unroll") for (int d = 0; d < 4; ++d) {
        const int vrow = 32 * d + lr;
        const char* vp = st + 16384 + vrow * 128;
        const bf16x8 v0 = *(const bf16x8*)(vp + (((kb * 4 + lh) ^ swz(vrow)) << 4));
        const bf16x8 v1 = *(const bf16x8*)(vp + (((kb * 4 + 2 + lh) ^ swz(vrow)) << 4));
        _Pragma("unroll") for (int c = 0; c < 2; ++c) { O[c][d] = MFMA32(v0, pf[c][0], O[c][d]); O[c][d] = MFMA32(v1, pf[c][1], O[c][d]); }
      }
    }
  }
  _Pragma("unroll") for (int c = 0; c < 2; ++c) ls[c] = xsum32(ls[c]);
  if (part) {
    dattn_merge4(O, m, ls, smem, lane, w);
    if (w == 0) {
      float* pb = (float*)P.merged + (size_t)it * DA_PART + lane;
      _Pragma("unroll") for (int c = 0; c < 2; ++c) {
        _Pragma("unroll") for (int d = 0; d < 4; ++d) {
          float* pp = pb + (c * 4 + d) * 1024;
          asm volatile("" : "+v"(pp));
          _Pragma("unroll") for (int r = 0; r < 16; ++r) pp[r * 64] = O[c][d][r];
        }
        pb[8192 + c * 64] = m[c]; pb[8192 + 128 + c * 64] = ls[c];
      }
    }
    return;
  }
  dattn_finish(P, l, bh, q0, O, ls, lr, lh);
}
DI void da_qk(f32x16& s, const char* st, int c, int kb, int lr, int lh, const bf16x8 (&qf)[4]) {
  s = zero16();
  const int krow = kb * 32 + kswap(lr);
  const char* kp = st + c * 8192 + krow * 128;
  _Pragma("unroll") for (int ks = 0; ks < 4; ++ks) s = MFMA32(*(const bf16x8*)(kp + (((2 * ks + lh) ^ swz(krow)) << 4)), qf[ks], s);
}
DI void dattn_item8(const Params& P, int l, int it, char* smem_wg) {
  int tid = rtid(); asm volatile("" : "+v"(tid));
  const int lane = tid & 63, w = __builtin_amdgcn_readfirstlane(tid >> 6), g = w & 3, c = w >> 2, lr = lane & 31, lh = lane >> 5;
  const int bh = it & 7, jq = it >> 3;
  const int q0 = jq * 128 + 32 * g;
  constexpr int NT8 = (L + 127) / 128;
  bf16x8 qf[4];
  _Pragma("unroll") for (int ks = 0; ks < 4; ++ks) qf[ks] = ldfrag(P.qa + ((size_t)(bh * 2 + c) * L + q0 + lr) * 64 + 16 * ks + 8 * lh);
  f32x16 O[4];
  float m, ls = 0.f;
  {
    f32x16 s = zero16();
    const bf16_t* kp = P.ka + ((size_t)(bh * 2 + c) * L + kswap(lr)) * 64 + 8 * lh;
    _Pragma("unroll") for (int ks = 0; ks < 4; ++ks) s = MFMA32(ldfrag(kp + 16 * ks), qf[ks], s);
    float mx = s[0];
    _Pragma("unroll") for (int r = 1; r < 16; ++r) mx = fmaxf(mx, s[r]);
    m = xmax32(mx);
    _Pragma("unroll") for (int d = 0; d < 4; ++d) O[d] = zero16();
  }
  const unsigned vk = (unsigned)((g * 8 + (lane >> 3)) * 128 + (((lane & 7) ^ (4 * (g & 1) + (lane >> 4))) << 4));
  const unsigned vv = (unsigned)((g * 8 + (lane >> 3)) * (LK * 2) + (((lane & 7) ^ (4 * (g & 1) + (lane >> 4))) << 4));
  constexpr int ST8 = 2 * DA_STAGE;
  __syncthreads();
  dattn_issue(P, bh, c * 64, smem_wg + c * DA_STAGE, vk, vv, g);
  for (int t = 0; t < NT8; ++t) {
    __syncthreads();
    if (t + 1 < NT8) dattn_issue(P, bh, (t + 1) * 128 + c * 64, smem_wg + ((t + 1) & 1) * ST8 + c * DA_STAGE, vk, vv, g);
    const char* stt = smem_wg + (t & 1) * ST8;
    f32x16 S[4];
    _Pragma("unroll") for (int b = 0; b < 4; ++b) da_qk(S[b], stt + (b >> 1) * DA_STAGE, c, b & 1, lr, lh, qf);
    if (t == NT8 - 1) {
      asm volatile("; last key tile: mask" ::: "memory");
      _Pragma("unroll") for (int b = 0; b < 4; ++b) _Pragma("unroll") for (int r = 0; r < 16; ++r) if (t * 128 + b * 32 + keyoff(r, lh) >= L) S[b][r] = -3.0e38f;
    }
    float mx = S[0][0];
    _Pragma("unroll") for (int b = 0; b < 4; ++b) _Pragma("unroll") for (int r = 0; r < 16; ++r) mx = fmaxf(mx, S[b][r]);
    if (__any(mx - m > DA_THR)) {
      asm volatile("; rare: move the softmax reference" ::: "memory");
      const float dlt = fmaxf(xmax32(mx) - m, 0.f);
      const float al = fexp2(-dlt);
      m += dlt; ls *= al;
      _Pragma("unroll") for (int d = 0; d < 4; ++d) _Pragma("unroll") for (int r = 0; r < 16; ++r) O[d][r] *= al;
    }
    f32x2 rs2 = mk2(0.f, 0.f);
    const f32x2 mm = mk2(m, m);
    _Pragma("unroll") for (int h2 = 0; h2 < 2; ++h2) {
      bf16x8 pf[2][2];
      _Pragma("unroll") for (int kb = 0; kb < 2; ++kb) {
        f32x16& s = S[2 * h2 + kb];
        _Pragma("unroll") for (int i = 0; i < 8; ++i) {
          f32x2 x = mk2(s[2 * i], s[2 * i + 1]) - mm;
          x.x = fexp2(x.x); x.y = fexp2(x.y);
          s[2 * i] = x.x; s[2 * i + 1] = x.y;
          rs2 += x;
        }
        pf[kb][0] = packfrag(s, 0); pf[kb][1] = packfrag(s, 1);
      }
      const char* st = stt + h2 * DA_STAGE;
      _Pragma("unroll") for (int kb = 0; kb < 2; ++kb) _Pragma("unroll") for (int d = 0; d < 4; ++d) {
        const int vrow = 32 * d + lr;
        const char* vp = st + 16384 + vrow * 128;
        const bf16x8 v0 = *(const bf16x8*)(vp + (((kb * 4 + lh) ^ swz(vrow)) << 4));
        const bf16x8 v1 = *(const bf16x8*)(vp + (((kb * 4 + 2 + lh) ^ swz(vrow)) << 4));
        O[d] = MFMA32(v0, pf[kb][0], O[d]); O[d] = MFMA32(v1, pf[kb][1], O[d]);
      }
    }
    ls += rs2.x + rs2.y;
  }
  ls = xsum32(ls);
  float* xf = (float*)smem_wg + g * 4096;
  __syncthreads();
  if (c == 1) {
    const float i1 = P.lam[l] / ls;
    _Pragma("unroll") for (int d = 0; d < 4; ++d) _Pragma("unroll") for (int r = 0; r < 16; ++r) xf[(d * 16 + r) * 64 + lane] = O[d][r] * i1;
  }
  __syncthreads();
  if (c == 0) {
    const int b = bh >> 2, hh = bh & 3;
    const float omli = P.lam[2 + l], i0 = 1.f / ls;
    float ss = 0.f;
    _Pragma("unroll") for (int d = 0; d < 4; ++d) _Pragma("unroll") for (int r = 0; r < 16; ++r) { const float o = O[d][r] * i0 - xf[(d * 16 + r) * 64 + lane]; O[d][r] = o; ss += o * o; }
    ss = xsum32(ss);
    const float rs = rsqrtf(ss * (1.f / 128.f) + LN_EPS);
    const size_t tok = (size_t)b * L + q0 + lr;
    _Pragma("unroll") for (int d = 0; d < 4; ++d) _Pragma("unroll") for (int rg = 0; rg < 4; ++rg) {
      const int dv = 32 * d + 8 * rg + 4 * lh;
      const f32x4 g4 = *(const f32x4*)(P.diff_g + l * 128 + dv);
      u32x2 ou;
      ou.x = pk2(O[d][4 * rg + 0] * rs * g4.x * omli, O[d][4 * rg + 1] * rs * g4.y * omli);
      ou.y = pk2(O[d][4 * rg + 2] * rs * g4.z * omli, O[d][4 * rg + 3] * rs * g4.w * omli);
      *(u32x2*)(P.oa + tok * 512 + hh * 128 + dv) = ou;
    }
  }
}
DI void dattn_combine(const Params& P, int l, int bh, char* smem) {
  const int tid = otid(), lane = tid & 63, w = tid >> 6, lr = lane & 31, lh = lane >> 5;
  f32x16 O[2][4];
  float m[2], ls[2];
  __syncthreads();
  for (int k = 0; k < 16; ++k) {
    const float* pb = (const float*)P.merged + (size_t)(bh + 8 * (w * 16 + k)) * DA_PART + lane;
    _Pragma("unroll") for (int c = 0; c < 2; ++c) {
      const float mb = pb[8192 + c * 64], lb = pb[8192 + 128 + c * 64];
      float fa, fb;
      if (k == 0) { m[c] = mb; ls[c] = lb; fa = 0.f; fb = 1.f; }
      else { const float M = fmaxf(m[c], mb); fa = fexp2(m[c] - M); fb = fexp2(mb - M); ls[c] = ls[c] * fa + lb * fb; m[c] = M; }
      _Pragma("unroll") for (int d = 0; d < 4; ++d) {
        const float* pp = pb + (c * 4 + d) * 1024;
        asm volatile("" : "+v"(pp));
        _Pragma("unroll") for (int r = 0; r < 16; ++r) {
          const float ov = pp[r * 64];
          O[c][d][r] = k == 0 ? ov : O[c][d][r] * fa + ov * fb;
        }
      }
    }
  }
  dattn_merge4(O, m, ls, smem, lane, w);
  if (w == 0) dattn_finish(P, l, bh, 8192, O, ls, lr, lh);
}

DI void swa_item(const Params& P, int l, int it, char* smem) {
  const int tid = otid(), lane = tid & 63, w = tid >> 6, lr = lane & 31, lh = lane >> 5;
  const int NQT = (L + 31) / 32;
  const int bk = it / NQT, qt = it % NQT, b = bk >> 1, kv = bk & 1, hq = kv * 4 + w;
  const int q0 = qt * 32;
  const int qi = min(q0 + lr, L - 1);
  bf16x8 qf[4];
  _Pragma("unroll") for (int ks = 0; ks < 4; ++ks) qf[ks] = ldfrag(P.qb + ((size_t)(b * 8 + hq) * L + qi) * 64 + 16 * ks + 8 * lh);
  f32x16 O[2]; O[0] = zero16(); O[1] = zero16();
  float m = P.sink[l * 8 + hq] * 1.44269504088896341f, ls = 1.f;
  const bf16_t* kbase = P.kb + (size_t)(b * 2 + kv) * L * 64;
  const bf16_t* vbase = P.vbT + (size_t)(b * 2 + kv) * 64 * LK;
  const int qpos = q0 + lr;
  char* wk = smem + w * 16384;
  char* wv = wk + 4096;
  bf16x8 tk[3][4], tv[2][4];
#define SWA_LDK(dst, bi_) { const int k1_ = (bi_) == 0 ? 0 : q0 - 160 + 32 * (bi_); \
    _Pragma("unroll") for (int i = 0; i < 4; ++i) { const int krow_ = min(max(k1_ + 8 * i + (lane >> 3), 0), L - 1); dst[i] = ldfrag(kbase + (size_t)krow_ * 64 + (lane & 7) * 8); } }
#define SWA_LDV(dst, bi_) { const int k0_ = (bi_) == 0 ? 0 : q0 - 160 + 32 * (bi_); const int kc0_ = min(max(k0_, 0), LK - 32); \
    _Pragma("unroll") for (int i = 0; i < 4; ++i) dst[i] = ldfrag(vbase + (size_t)(16 * i + (lane >> 2)) * LK + kc0_ + (lane & 3) * 8); }
  SWA_LDK(tk[0], 0) SWA_LDK(tk[1], 1) SWA_LDV(tv[0], 0)
  __builtin_amdgcn_sched_barrier(0);
  _Pragma("unroll") for (int bi = 0; bi < 10; ++bi) {
    const int k0 = bi == 0 ? 0 : q0 - 160 + 32 * bi;
    if (bi + 2 < 10) SWA_LDK(tk[(bi + 2) % 3], bi + 2)
    if (bi + 1 < 10) SWA_LDV(tv[(bi + 1) & 1], bi + 1)
    __builtin_amdgcn_sched_barrier(0);
    _Pragma("unroll") for (int i = 0; i < 4; ++i) {
      const int r = 8 * i + (lane >> 3);
      *(bf16x8*)(wk + r * 128 + ((((lane & 7)) ^ swz(r)) << 4)) = tk[bi % 3][i];
      const int rv = 16 * i + (lane >> 2);
      *(bf16x8*)(wv + rv * 64 + ((((lane & 3)) ^ ((rv >> 2) & 3)) << 4)) = tv[bi & 1][i];
    }
    f32x16 s = zero16();
    {
      const int krow = kswap(lr);
      _Pragma("unroll") for (int ks = 0; ks < 4; ++ks) s = MFMA32(*(const bf16x8*)(wk + krow * 128 + (((2 * ks + lh) ^ swz(krow)) << 4)), qf[ks], s);
    }
    float mx = -3.0e38f;
    _Pragma("unroll") for (int r = 0; r < 16; ++r) {
      const int kj = k0 + keyoff(r, lh);
      bool ok;
      if (bi == 0) ok = kj < NMETA;
      else ok = kj >= NMETA && kj < L && kj >= qpos - 128 && kj <= qpos + 128;
      const float v = ok ? s[r] : -3.0e38f;
      s[r] = v; mx = fmaxf(mx, v);
    }
    mx = xmax32(mx);
    const float mn = fmaxf(m, mx);
    const float al = fexp2(m - mn);
    float rsum = 0.f;
    _Pragma("unroll") for (int r = 0; r < 16; ++r) { const float pv = fexp2(s[r] - mn); s[r] = pv; rsum += pv; }
    rsum = xsum32(rsum);
    ls = ls * al + rsum; m = mn;
    _Pragma("unroll") for (int d = 0; d < 2; ++d) _Pragma("unroll") for (int r = 0; r < 16; ++r) O[d][r] *= al;
    const bf16x8 p0 = packfrag(s, 0), p1 = packfrag(s, 1);
    _Pragma("unroll") for (int d = 0; d < 2; ++d) {
      const int vrow = 32 * d + lr;
      const char* vp = wv + vrow * 64;
      const int sx = (vrow >> 2) & 3;
      O[d] = MFMA32(*(const bf16x8*)(vp + ((lh ^ sx) << 4)), p0, O[d]);
      O[d] = MFMA32(*(const bf16x8*)(vp + (((2 + lh) ^ sx) << 4)), p1, O[d]);
    }
    __builtin_amdgcn_sched_barrier(0);
  }
#undef SWA_LDK
#undef SWA_LDV
  if (qpos < L) {
    const float inv = 1.f / ls;
    const size_t tok = (size_t)b * L + qpos;
    _Pragma("unroll") for (int d = 0; d < 2; ++d) _Pragma("unroll") for (int rg = 0; rg < 4; ++rg) {
      const int dv = 32 * d + 8 * rg + 4 * lh;
      u32x2 ou;
      ou.x = pk2(O[d][4 * rg + 0] * inv, O[d][4 * rg + 1] * inv);
      ou.y = pk2(O[d][4 * rg + 2] * inv, O[d][4 * rg + 3] * inv);
      *(u32x2*)(P.ob + tok * 512 + hq * 64 + dv) = ou;
    }
  }
}

constexpr int P3_MT = TP / 128, P3_NT = D / 128;
DI void tail_reduce(const f32x16& acc, char* smem_wg, int w, int lane, float (&v)[2]) {
  float* red = (float*)smem_wg;
  __syncthreads();
  _Pragma("unroll") for (int r = 0; r < 16; ++r) red[(w * 16 + r) * 64 + lane] = acc[r];
  __syncthreads();
  _Pragma("unroll") for (int j = 0; j < 2; ++j) {
    float s = 0.f;
    _Pragma("unroll") for (int x = 0; x < 8; ++x) s += red[(x * 16 + 2 * w + j) * 64 + lane];
    v[j] = s;
  }
  __syncthreads();
}
DI void p3a_tail(const Params& P, char* smem_wg, int wg) {
  int tid = rtid(); asm volatile("" : "+v"(tid));
  const int lane = tid & 63, w = tid >> 6, lr = lane & 31, lh = lane >> 5;
  const int n0 = 32 * wg, k0 = 64 * w + 8 * lh;
  f32x16 tot = zero16();
  _Pragma("unroll 1") for (int br = 0; br < 3; ++br) {
    const bf16_t* A = P.oa + ((size_t)br * TP + 16384 + lr) * 512 + k0;
    const bf16_t* B = P.w_br_t + ((size_t)br * 1024 + n0 + lr) * 512 + k0;
    f32x16 part = zero16();
    _Pragma("unroll") for (int ks = 0; ks < 4; ++ks) part = MFMA32(ldfrag(A + 16 * ks), ldfrag(B + 16 * ks), part);
    _Pragma("unroll") for (int r = 0; r < 16; ++r) tot[r] += bf2f(P.gz[(size_t)(16384 + crow(r, lh)) * 3072 + br * 1024 + n0 + lr]) * part[r];
  }
  float v[2];
  tail_reduce(tot, smem_wg, w, lane, v);
  _Pragma("unroll") for (int j = 0; j < 2; ++j) P.merged[(size_t)(16384 + crow(2 * w + j, lh)) * D + n0 + lr] = f2bf(v[j]);
}
DI void p3b_tail(const Params& P, char* smem_wg, int wg) {
  int tid = rtid(); asm volatile("" : "+v"(tid));
  const int lane = tid & 63, w = tid >> 6, lr = lane & 31, lh = lane >> 5;
  const int n0 = 32 * wg, k0 = 128 * w + 8 * lh;
  const bf16_t* A = P.merged + (size_t)(16384 + lr) * D + k0;
  const bf16_t* B = P.w_out_t + (size_t)(n0 + lr) * D + k0;
  f32x16 acc = zero16();
  _Pragma("unroll") for (int ks = 0; ks < 8; ++ks) acc = MFMA32(ldfrag(A + 16 * ks), ldfrag(B + 16 * ks), acc);
  float v[2];
  tail_reduce(acc, smem_wg, w, lane, v);
  _Pragma("unroll") for (int j = 0; j < 2; ++j) { float* hp = P.h + (size_t)(16384 + crow(2 * w + j, lh)) * D + n0 + lr; *hp = ALPHA * (*hp) + v[j]; }
}
struct SchedP3a {
  static constexpr bool GATHER = false;
  const char* A; const char* B; int G, c;
  DI bool next(int i, g8::Unit& u) const {
    const int ti = i / 3, br = i - 3 * ti; int pm, pn;
    if (!g8::grid_unit(ti, G, c, 64, 4, pm, pn)) return false;
    u.pm = pm; u.pn = pn; u.tag = br;
    u.a = A + ((size_t)br * TP + (size_t)pm * 256) * 512 * 2; u.b = B + ((size_t)br * 1024 + (size_t)pn * 256) * 512 * 2; return true;
  }
  DI void arows(const g8::Unit&, int, unsigned (&)[2]) const {}
};
struct EpiP3a {
  static constexpr bool PERM = true;
  const bf16_t* gz; bf16_t* merged;
  DI bool keep(const g8::Unit& u) const { return u.tag < 2; }
  DI void operator()(g8::f32x4 (&acc)[2][2][4][2], const g8::Unit& u, int wr, int wc, int fr, int fq) const {
    const int br = u.tag;
    const bf16_t* g0 = gz + (size_t)(u.pm * 256 + 64 * wr + fr) * 3072 + br * 1024 + u.pn * 256 + 32 * wc + 8 * fq;
    _Pragma("unroll") for (int ai = 0; ai < 2; ++ai) {
      u32x4 ga[4][2], gb[4][2];
      _Pragma("unroll") for (int m = 0; m < 4; ++m) _Pragma("unroll") for (int bj = 0; bj < 2; ++bj) ga[m][bj] = *(const u32x4*)(g0 + (size_t)(128 * ai + 16 * m) * 3072 + 128 * bj);
      if (br < 2) {
        _Pragma("unroll") for (int m = 0; m < 4; ++m) _Pragma("unroll") for (int bj = 0; bj < 2; ++bj) gb[m][bj] = *(const u32x4*)(g0 + (size_t)(128 * ai + 16 * m) * 3072 + 128 * bj + 1024);
        __builtin_amdgcn_sched_barrier(0);
        _Pragma("unroll") for (int m = 0; m < 4; ++m) _Pragma("unroll") for (int bj = 0; bj < 2; ++bj) {
          const u32x4 a = ga[m][bj], b = gb[m][bj];
          acc[ai][bj][m][0][0] *= bflo(a.x) * frcp(bflo(b.x)); acc[ai][bj][m][0][1] *= bfhi(a.x) * frcp(bfhi(b.x));
          acc[ai][bj][m][0][2] *= bflo(a.y) * frcp(bflo(b.y)); acc[ai][bj][m][0][3] *= bfhi(a.y) * frcp(bfhi(b.y));
          acc[ai][bj][m][1][0] *= bflo(a.z) * frcp(bflo(b.z)); acc[ai][bj][m][1][1] *= bfhi(a.z) * frcp(bfhi(b.z));
          acc[ai][bj][m][1][2] *= bflo(a.w) * frcp(bflo(b.w)); acc[ai][bj][m][1][3] *= bfhi(a.w) * frcp(bfhi(b.w));
        }
      } else {
        __builtin_amdgcn_sched_barrier(0);
        _Pragma("unroll") for (int m = 0; m < 4; ++m) _Pragma("unroll") for (int bj = 0; bj < 2; ++bj) {
          const u32x4 a = ga[m][bj];
          u32x4 o;
          o.x = pk2(acc[ai][bj][m][0][0] * bflo(a.x), acc[ai][bj][m][0][1] * bfhi(a.x)); o.y = pk2(acc[ai][bj][m][0][2] * bflo(a.y), acc[ai][bj][m][0][3] * bfhi(a.y));
          o.z = pk2(acc[ai][bj][m][1][0] * bflo(a.z), acc[ai][bj][m][1][1] * bfhi(a.z)); o.w = pk2(acc[ai][bj][m][1][2] * bflo(a.w), acc[ai][bj][m][1][3] * bfhi(a.w));
          *(u32x4*)(merged + (size_t)(u.pm * 256 + 128 * ai + 64 * wr + 16 * m + fr) * D + u.pn * 256 + 128 * bj + 32 * wc + 8 * fq) = o;
        }
      }
      __builtin_amdgcn_sched_barrier(0);
    }
  }
};
DI void phase_p3a(const Params& P, int l, char* smem, char* smem_wg, int bid, int nblk) {
  if ((bid >> 1) < 32) p3a_tail(P, smem_wg, bid >> 1);
  {
    SchedP3a S; S.A = (const char*)P.oa; S.B = (const char*)P.w_br_t; S.G = nblk >> 1; S.c = bid >> 1;
    EpiP3a E; E.gz = P.gz; E.merged = P.merged;
    g8::gemm_phase((g8::lds_u8*)smem_wg, 512, S, E);
  }
}
struct SchedP3b {
  static constexpr bool GATHER = false;
  const char* A; const char* B; int G, c;
  DI bool next(int i, g8::Unit& u) const { int pm, pn; if (!g8::grid_unit(i, G, c, 64, 4, pm, pn)) return false; u.pm = pm; u.pn = pn; u.tag = 0; u.a = A + (size_t)pm * 256 * D * 2; u.b = B + (size_t)pn * 256 * D * 2; return true; }
  DI void arows(const g8::Unit&, int, unsigned (&)[2]) const {}
};
struct EpiP3b {
  static constexpr bool PERM = false;
  float* h;
  DI bool keep(const g8::Unit&) const { return false; }
  DI void operator()(g8::f32x4 (&acc)[2][2][4][2], const g8::Unit& u, int wr, int wc, int fr, int fq) const {
    float* h0 = h + (size_t)(u.pm * 256 + 64 * wr + fr) * D + u.pn * 256 + 32 * wc + 4 * fq;
    _Pragma("unroll") for (int ai = 0; ai < 2; ++ai) {
      g8::f32x4 hv[4][2][2];
      _Pragma("unroll") for (int m = 0; m < 4; ++m) _Pragma("unroll") for (int bj = 0; bj < 2; ++bj) _Pragma("unroll") for (int n = 0; n < 2; ++n)
        hv[m][bj][n] = *(const g8::f32x4*)(h0 + (size_t)(128 * ai + 16 * m) * D + 128 * bj + 16 * n);
      __builtin_amdgcn_sched_barrier(0);
      _Pragma("unroll") for (int m = 0; m < 4; ++m) _Pragma("unroll") for (int bj = 0; bj < 2; ++bj) _Pragma("unroll") for (int n = 0; n < 2; ++n)
        *(g8::f32x4*)(h0 + (size_t)(128 * ai + 16 * m) * D + 128 * bj + 16 * n) = ALPHA * hv[m][bj][n] + acc[ai][bj][m][n];
      __builtin_amdgcn_sched_barrier(0);
    }
  }
};
DI void phase_p3b(const Params& P, int l, char* smem, char* smem_wg, int bid, int nblk) {
  if ((bid >> 1) < 32) p3b_tail(P, smem_wg, bid >> 1);
  {
    SchedP3b S; S.A = (const char*)P.merged; S.B = (const char*)P.w_out_t; S.G = nblk >> 1; S.c = bid >> 1;
    EpiP3b E; E.h = P.h;
    g8::gemm_phase(( g8::lds_u8*)smem_wg, D, S, E);
  }
}

typedef __attribute__((ext_vector_type(4))) float f32x4v;
DI void phase_router_prep(const Params& P, int bid, int nblk) {
  const int gtid = bid * NT + otid(), gn = nblk * NT;
  for (int i = gtid; i < 2 * 64 * 3 * 64 * 4; i += gn) {
    const int sidx = i & 3, lane = (i >> 2) & 63, n = (i >> 8) % 3, chunk = ((i >> 8) / 3) & 63, l = (i >> 8) / 192;
    const int c = 16 * chunk + 4 * (lane >> 4) + sidx, j = lane & 15;
    float wv = 0.f;
    if (n < 2) wv = P.w_re[((size_t)l * D + c) * 32 + 16 * n + j];
    else if (j < 4) wv = P.w_rg[((size_t)l * D + c) * 4 + j];
    P.rwp[i] = wv * P.ln1_g[l * D + c];
  }
  const int wv_ = gtid >> 6, lane = gtid & 63;
  if (wv_ < 2 * 36) {
    const int l = wv_ / 36, o = wv_ % 36;
    float sg = 0.f, sb = 0.f;
    for (int c = lane; c < D; c += 64) {
      const float wv = o < 32 ? P.w_re[((size_t)l * D + c) * 32 + o] : P.w_rg[((size_t)l * D + c) * 4 + o - 32];
      sg += P.ln1_g[l * D + c] * wv; sb += P.ln1_b[l * D + c] * wv;
    }
    sg = wave_sum(sg); sb = wave_sum(sb);
    if (lane == 0) { P.rgb[(l * 2 + 0) * 48 + o] = sg; P.rgb[(l * 2 + 1) * 48 + o] = sb + (o < 32 ? P.b_re[l * 32 + o] : P.b_rg[l * 4 + o - 32]); }
  }
}
DI void phase_p4(const Params& P, int l, char* smem, int bid, int nblk) {
  const int tid = otid(), lane = tid & 63, w = tid >> 6, wv = (bid * NT + tid) >> 6, nwv = (nblk * NT) >> 6;
  float* raw = (float*)smem + w * 768;
  const f32x4* wp = (const f32x4*)P.rwp + (size_t)l * 64 * 3 * 64 + lane;
  const int nrb = min(nblk, (T / 16 + 3) / 4), nwr = nrb * 4;
  for (int wt = bid < nrb ? bid * 4 + w : T / 16; wt < T / 16; wt += nwr) {
    const int t0 = wt * 16;
    f32x4v acc[3];
    _Pragma("unroll") for (int n = 0; n < 3; ++n) { acc[n][0] = 0.f; acc[n][1] = 0.f; acc[n][2] = 0.f; acc[n][3] = 0.f; }
    const float* xa = P.h + (size_t)(t0 + (lane & 15)) * D + 4 * (lane >> 4);
    f32x4 A0[4], B0[4][3], A1[4], B1[4][3];
    float s1 = 0.f, s2 = 0.f;
#define P4_LOAD(Ab, Bb, c0) _Pragma("unroll") for (int u = 0; u < 4; ++u) { Ab[u] = *(const f32x4*)(xa + 16 * ((c0) + u)); \
      _Pragma("unroll") for (int n = 0; n < 3; ++n) Bb[u][n] = wp[(((c0) + u) * 3 + n) * 64]; }
#define P4_MMA(Ab, Bb) _Pragma("unroll") for (int u = 0; u < 4; ++u) { const f32x4 a = Ab[u]; \
      s1 += (a.x + a.y) + (a.z + a.w); s2 += (a.x * a.x + a.y * a.y) + (a.z * a.z + a.w * a.w); \
      _Pragma("unroll") for (int n = 0; n < 3; ++n) acc[n] = __builtin_amdgcn_mfma_f32_16x16x4f32(a.x, Bb[u][n].x, acc[n], 0, 0, 0); \
      _Pragma("unroll") for (int n = 0; n < 3; ++n) acc[n] = __builtin_amdgcn_mfma_f32_16x16x4f32(a.y, Bb[u][n].y, acc[n], 0, 0, 0); \
      _Pragma("unroll") for (int n = 0; n < 3; ++n) acc[n] = __builtin_amdgcn_mfma_f32_16x16x4f32(a.z, Bb[u][n].z, acc[n], 0, 0, 0); \
      _Pragma("unroll") for (int n = 0; n < 3; ++n) acc[n] = __builtin_amdgcn_mfma_f32_16x16x4f32(a.w, Bb[u][n].w, acc[n], 0, 0, 0); }
    P4_LOAD(A0, B0, 0)
    _Pragma("unroll 1") for (int ch = 0; ch < 64; ch += 8) {
      P4_LOAD(A1, B1, ch + 4)
      __builtin_amdgcn_sched_barrier(0);
      P4_MMA(A0, B0)
      __builtin_amdgcn_sched_barrier(0);
      if (ch + 8 < 64) { P4_LOAD(A0, B0, ch + 8) }
      __builtin_amdgcn_sched_barrier(0);
      P4_MMA(A1, B1)
      __builtin_amdgcn_sched_barrier(0);
    }
#undef P4_LOAD
#undef P4_MMA
    s1 += sxor<16>(s1); s2 += sxor<16>(s2); s1 = xsum32(s1); s2 = xsum32(s2);
    const float mu_r = s1 * (1.f / 1024.f), rs_r = rsqrtf(fmaxf(s2 * (1.f / 1024.f) - mu_r * mu_r, 0.f) + LN_EPS);
    WT_FENCE();
    _Pragma("unroll") for (int r = 0; r < 4; ++r) {
      const int tok = 4 * (lane >> 4) + r, j = lane & 15;
      raw[tok * 40 + j] = acc[0][r]; raw[tok * 40 + 16 + j] = acc[1][r];
      if (j < 4) raw[tok * 40 + 32 + j] = acc[2][r];
    }
    if (lane < 16) { raw[640 + 2 * lane] = mu_r; raw[640 + 2 * lane + 1] = rs_r; }
    WT_FENCE();
    f32x4 gg[4], bb[4];
    _Pragma("unroll") for (int i = 0; i < 4; ++i) { gg[i] = ((const f32x4*)(P.ln1_g + l * D))[lane + 64 * i]; bb[i] = ((const f32x4*)(P.ln1_b + l * D))[lane + 64 * i]; }
    _Pragma("unroll 1") for (int q0 = 0; q0 < 16; q0 += 4) {
      f32x4 v[4][4];
      _Pragma("unroll") for (int j = 0; j < 4; ++j) _Pragma("unroll") for (int i = 0; i < 4; ++i) v[j][i] = ((const f32x4*)(P.h + (size_t)(t0 + q0 + j) * D))[lane + 64 * i];
      __builtin_amdgcn_sched_barrier(0);
      _Pragma("unroll") for (int j = 0; j < 4; ++j) {
        const float mu = raw[640 + 2 * (q0 + j)], rs = raw[640 + 2 * (q0 + j) + 1];
        _Pragma("unroll") for (int i = 0; i < 4; ++i) {
          v[j][i].x = (v[j][i].x - mu) * rs * gg[i].x + bb[i].x; v[j][i].y = (v[j][i].y - mu) * rs * gg[i].y + bb[i].y;
          v[j][i].z = (v[j][i].z - mu) * rs * gg[i].z + bb[i].z; v[j][i].w = (v[j][i].w - mu) * rs * gg[i].w + bb[i].w;
        }
        store_row(v[j], P.h + (size_t)(t0 + q0 + j) * D, P.hb + (size_t)(t0 + q0 + j) * D, lane);
      }
    }
    WT_FENCE();
    if (lane < 16) {
      const int t = t0 + lane;
      const float mu = raw[640 + 2 * lane], rs = raw[640 + 2 * lane + 1];
      const float* G = P.rgb + (l * 2) * 48; const float* Bc = G + 48;
      float gl[4];
      _Pragma("unroll") for (int g = 0; g < 4; ++g) gl[g] = rs * (raw[lane * 40 + 32 + g] - mu * G[32 + g]) + Bc[32 + g];
      int gs = 0; float gm = gl[0];
      for (int g = 1; g < 4; ++g) if (gl[g] > gm) { gm = gl[g]; gs = g; }
      float den = 0.f;
      _Pragma("unroll") for (int g = 0; g < 4; ++g) den += expf(gl[g] - gm);
      const float pg = 1.f / den;
      float el[8];
      _Pragma("unroll") for (int e = 0; e < 8; ++e) el[e] = rs * (raw[lane * 40 + gs * 8 + e] - mu * G[gs * 8 + e]) + Bc[gs * 8 + e];
      int i1 = 0; float v1 = el[0];
      for (int e = 1; e < 8; ++e) if (el[e] > v1) { v1 = el[e]; i1 = e; }
      int i2 = -1; float v2 = -3.0e38f;
      _Pragma("unroll") for (int e = 0; e < 8; ++e) if (e != i1 && el[e] > v2) { v2 = el[e]; i2 = e; }
      if (i2 < 0) i2 = (i1 + 1) & 7;
      const float ex = expf(v2 - v1);
      const float w1 = pg / (1.f + ex), w2 = pg * ex / (1.f + ex);
      const int e1 = gs * 8 + i1, e2 = gs * 8 + i2;
      const int r1 = atomicAdd(P.counts + e1 * CSTR, 1), r2 = atomicAdd(P.counts + e2 * CSTR, 1);
      P.tok_slot[2 * t] = e1 * CAP + r1; P.tok_slot[2 * t + 1] = e2 * CAP + r2;
      P.tok_w[2 * t] = w1; P.tok_w[2 * t + 1] = w2;
      P.slot_tok[(size_t)e1 * CAP + r1] = t; P.slot_tok[(size_t)e2 * CAP + r2] = t;
    }
  }
}

DI bool moe_unit(const int* counts, int i, int G, int c, int& e, int& mi, int& pn, int& cnt, int& hs) {
  int tot = 0;
  for (int x = 0; x < NEXP; ++x) tot += (counts[x * CSTR] + 255) >> 8;
  const int U = tot * 4, g = i * G + c;
  if (g >= U) return false;
  const int q = U / 8, r = U % 8, xcd = g % 8, off = g / 8;
  const int idx = (xcd < r ? xcd * (q + 1) : r * (q + 1) + (xcd - r) * q) + off;
  const int mt = idx >> 2; pn = idx & 3;
  int acc = 0; e = 0; mi = 0; cnt = 0; hs = 0;
  for (int x = 0; x < NEXP; ++x) {
    const int cx = counts[x * CSTR], n = (cx + 255) >> 8;
    if (mt < acc + n) { e = x; mi = mt - acc; cnt = cx; hs = acc * 256; return true; }
    acc += n;
  }
  return false;
}
constexpr int MOE_TAB = 131072 + 512, MOE_MAXU = 8;
DI void moe_table(const int* counts, int G, int c, char* smem_wg) {
  const int tid = rtid();
  __syncthreads();
  if (tid < MOE_MAXU) {
    int e = 0, mi = 0, pn = 0, cnt = 0, hs = 0;
    const bool ok = moe_unit(counts, tid, G, c, e, mi, pn, cnt, hs);
    int* tb = (int*)(smem_wg + MOE_TAB) + tid * 8;
    tb[0] = ok ? 1 : 0; tb[1] = e; tb[2] = mi; tb[3] = pn; tb[4] = cnt; tb[5] = hs;
  }
  __syncthreads();
}
DI bool moe_next(int i, int& e, int& mi, int& pn, int& cnt, int& hs) {
  if (i >= MOE_MAXU) return false;
  const LAS_I* tb = (const LAS_I*)(size_t)(MOE_TAB + i * 32);
  const int ok = __builtin_amdgcn_readfirstlane(tb[0]);
  e = __builtin_amdgcn_readfirstlane(tb[1]); mi = __builtin_amdgcn_readfirstlane(tb[2]); pn = __builtin_amdgcn_readfirstlane(tb[3]);
  cnt = __builtin_amdgcn_readfirstlane(tb[4]); hs = __builtin_amdgcn_readfirstlane(tb[5]);
  return ok != 0;
}
struct SchedP5a {
  static constexpr bool GATHER = true;
  const int* counts; const int* slot_tok; const char* hb; const char* w; int G, c;
  DI bool next(int i, g8::Unit& u) const {
    int e, mi, pn, cnt, hs;
    if (!moe_next(i, e, mi, pn, cnt, hs)) return false;
    u.pm = hs + mi * 256; u.pn = pn; u.tag = e; u.x0 = e * CAP + mi * 256; u.x1 = cnt - mi * 256;
    u.a = hb; u.b = w + ((size_t)e * 1024 + (size_t)pn * 256) * D * 2; return true;
  }
  DI void arows(const g8::Unit& u, int R0, unsigned (&pk)[2]) const {
    const int* st = slot_tok + u.x0; const int lim = u.x1 - 1;
    const int t0 = st[min(R0, lim)], t1 = st[min(R0 + 64, lim)], t2 = st[min(R0 + 128, lim)], t3 = st[min(R0 + 192, lim)];
    pk[0] = (unsigned)t0 | ((unsigned)t1 << 16); pk[1] = (unsigned)t2 | ((unsigned)t3 << 16);
  }
};
struct EpiP5a {
  static constexpr bool PERM = true;
  bf16_t* H;
  DI bool keep(const g8::Unit&) const { return false; }
  DI void operator()(g8::f32x4 (&acc)[2][2][4][2], const g8::Unit& u, int wr, int wc, int fr, int fq) const {
    _Pragma("unroll") for (int ai = 0; ai < 2; ++ai) _Pragma("unroll") for (int m = 0; m < 4; ++m) {
      bf16_t* rowp = H + (size_t)(u.pm + 128 * ai + 64 * wr + 16 * m + fr) * 512 + u.pn * 128 + 16 * wc + 4 * fq;
      _Pragma("unroll") for (int bj = 0; bj < 2; ++bj) {
        const g8::f32x4 g = acc[ai][bj][m][0], up = acc[ai][bj][m][1];
        u32x2 o; o.x = pk2(g[0] * sigmoidf_(g[0]) * up[0], g[1] * sigmoidf_(g[1]) * up[1]); o.y = pk2(g[2] * sigmoidf_(g[2]) * up[2], g[3] * sigmoidf_(g[3]) * up[3]);
        *(u32x2*)(rowp + 64 * bj) = o;
      }
    }
  }
};
DI void phase_p5a(const Params& P, int l, char* smem_wg, int bid, int nblk) {
  SchedP5a S; S.counts = P.counts; S.slot_tok = P.slot_tok; S.hb = (const char*)P.hb; S.w = (const char*)P.w_gu_t; S.G = nblk >> 1; S.c = bid >> 1;
  EpiP5a E; E.H = P.H;
  moe_table(P.counts, S.G, S.c, smem_wg);
  g8::gemm_phase((g8::lds_u8*)smem_wg, D, S, E);
}
struct SchedP5b {
  static constexpr bool GATHER = false;
  const int* counts; const char* H; const char* w; int G, c;
  DI bool next(int i, g8::Unit& u) const {
    int e, mi, pn, cnt, hs;
    if (!moe_next(i, e, mi, pn, cnt, hs)) return false;
    u.pm = hs + mi * 256; u.pn = pn; u.tag = e; u.x0 = 0; u.x1 = 0;
    u.a = H + (size_t)u.pm * 512 * 2; u.b = w + ((size_t)e * 1024 + (size_t)pn * 256) * 512 * 2; return true;
  }
  DI void arows(const g8::Unit&, int, unsigned (&)[2]) const {}
};
struct EpiP5b {
  static constexpr bool PERM = true;
  bf16_t* ys;
  DI bool keep(const g8::Unit&) const { return false; }
  DI void operator()(g8::f32x4 (&acc)[2][2][4][2], const g8::Unit& u, int wr, int wc, int fr, int fq) const {
    _Pragma("unroll") for (int ai = 0; ai < 2; ++ai) _Pragma("unroll") for (int m = 0; m < 4; ++m) {
      bf16_t* rowp = ys + (size_t)(u.pm + 128 * ai + 64 * wr + 16 * m + fr) * D + u.pn * 256 + 32 * wc + 8 * fq;
      _Pragma("unroll") for (int bj = 0; bj < 2; ++bj) {
        const g8::f32x4 a = acc[ai][bj][m][0], b = acc[ai][bj][m][1];
        u32x4 o; o.x = pk2(a[0], a[1]); o.y = pk2(a[2], a[3]); o.z = pk2(b[0], b[1]); o.w = pk2(b[2], b[3]);
        *(u32x4*)(rowp + 128 * bj) = o;
      }
    }
  }
};
DI void phase_p5b(const Params& P, int l, char* smem_wg, int bid, int nblk) {
  SchedP5b S; S.counts = P.counts; S.H = (const char*)P.H; S.w = (const char*)P.w_dn_t; S.G = nblk >> 1; S.c = bid >> 1;
  EpiP5b E; E.ys = P.ys;
  moe_table(P.counts, S.G, S.c, smem_wg);
  g8::gemm_phase((g8::lds_u8*)smem_wg, 512, S, E);
}
DI void phase_p6(const Params& P, int l, char* smem, int bid, int nblk) {
  const int tid = otid(), lane = tid & 63, wv = (bid * NT + tid) >> 6, nwv = (nblk * NT) >> 6;
  int* shs = (int*)smem;
  __syncthreads();
  if (tid == 0) { int hs = 0; for (int x = 0; x < NEXP; ++x) { shs[x] = hs; hs += ((P.counts[x * CSTR] + 255) >> 8) * 256; } }
  __syncthreads();
  int ns1 = 0, ns2 = 0; float nw1 = 0.f, nw2 = 0.f;
  if (wv < T) { ns1 = P.tok_slot[2 * wv]; ns2 = P.tok_slot[2 * wv + 1]; nw1 = P.tok_w[2 * wv]; nw2 = P.tok_w[2 * wv + 1]; }
  for (int t = wv; t < T; t += nwv) {
    const int s1 = ns1, s2 = ns2;
    const float w1 = nw1, w2 = nw2;
    { const int tn = min(t + nwv, T - 1); ns1 = P.tok_slot[2 * tn]; ns2 = P.tok_slot[2 * tn + 1]; nw1 = P.tok_w[2 * tn]; nw2 = P.tok_w[2 * tn + 1]; }
    const bf16_t* y1 = P.ys + (size_t)(shs[s1 / CAP] + s1 % CAP) * D;
    const bf16_t* y2 = P.ys + (size_t)(shs[s2 / CAP] + s2 % CAP) * D;
    f32x4 v[4];
    _Pragma("unroll") for (int i = 0; i < 4; ++i) {
      const f32x4 hv = ((const f32x4*)(P.h + (size_t)t * D))[lane + 64 * i];
      const u32x2 a = ((const u32x2*)y1)[lane + 64 * i], c = ((const u32x2*)y2)[lane + 64 * i];
      v[i].x = ALPHA * hv.x + (bflo(a.x) * w1 + bflo(c.x) * w2); v[i].y = ALPHA * hv.y + (bfhi(a.x) * w1 + bfhi(c.x) * w2);
      v[i].z = ALPHA * hv.z + (bflo(a.y) * w1 + bflo(c.y) * w2); v[i].w = ALPHA * hv.w + (bfhi(a.y) * w1 + bfhi(c.y) * w2);
    }
    ln16(v, P.ln2_g + l * D, P.ln2_b + l * D, lane);
    if (l == 1) {
      const int b = t >= L ? 1 : 0, pos = t - b * L;
      if (pos >= NMETA) store_row(v, P.out + ((size_t)b * SEQ + pos - NMETA) * D, nullptr, lane);
    } else store_row(v, P.h + (size_t)t * D, P.hb + (size_t)t * D, lane);
  }
}

#define XB_TMO      128
#define XB_XCNT(j)  (256  + 64 * (j))
#define XB_XSUB(j)  (1280 + 64 * (j))
#define XB_XGEN(j)  (2304 + 64 * (j))
#define XB_TOP      3328
#define XB_TOPGEN   3392
#define XCD_BAR_WORDS 3456
#define XB_SPIN_CAP (1u << 20)
#define LAS __attribute__((address_space(3)))
DI unsigned xb_ld(unsigned* p) { return __hip_atomic_load(p, __ATOMIC_RELAXED, __HIP_MEMORY_SCOPE_AGENT); }
DI unsigned xb_add(unsigned* p, unsigned v) { return __hip_atomic_fetch_add(p, v, __ATOMIC_RELAXED, __HIP_MEMORY_SCOPE_AGENT); }
DI unsigned xb_xcc_id() { return (unsigned)__builtin_amdgcn_s_getreg((3 << 11) | 20) & 0xFu; }
#define XB_SPIN(cond, bar) do { unsigned _sp = 0; while (cond) { __builtin_amdgcn_s_sleep(1); \
    if ((++_sp & 255u) == 0u) { if (xb_ld(&(bar)[XB_TMO])) break; if (_sp > XB_SPIN_CAP) { atomicAdd(&(bar)[XB_TMO], 1u); break; } } } } while (0)
struct XcdBarrier { unsigned* bar; unsigned x; volatile LAS unsigned* st; };
DI XcdBarrier xcd_barrier_post(unsigned* bar, volatile LAS unsigned* st) {
  XcdBarrier b; b.bar = bar; b.x = xb_xcc_id(); b.st = st;
  if (rtid() == 0) (void)xb_add(&bar[XB_XCNT(b.x)], 1u);
  return b;
}
DI void xcd_barrier_complete(unsigned* bar, unsigned x, unsigned& nloc, unsigned& nx) {
  const unsigned G = gridDim.x * gridDim.y * gridDim.z;
  unsigned sum, cnt, mine, sp = 0u;
  for (;;) {
    sum = 0u; cnt = 0u; mine = 0u;
    _Pragma("unroll") for (unsigned j = 0; j < 16; ++j) { const unsigned c = xb_ld(&bar[XB_XCNT(j)]); sum += c; cnt += (c > 0u) ? 1u : 0u; mine = (j == x) ? c : mine; }
    if (sum == G) break;
    __builtin_amdgcn_s_sleep(1);
    if ((++sp & 255u) == 0u) { if (xb_ld(&bar[XB_TMO])) break; if (sp > XB_SPIN_CAP) { atomicAdd(&bar[XB_TMO], 1u); break; } }
  }
  nloc = mine > 0u ? mine : 1u; nx = cnt > 0u ? cnt : 1u;
}
DI void xcd_barrier(const XcdBarrier& b) {
  asm volatile("s_waitcnt vmcnt(0)" ::: "memory");
  __syncthreads();
  if (rtid() == 0) {
    unsigned* bar = b.bar; unsigned bx = b.x;
    asm volatile("" : "+s"(bar), "+s"(bx));
    __builtin_amdgcn_s_waitcnt(0);
    unsigned nloc = b.st[0], nx = b.st[1];
    if (nloc == 0u) { xcd_barrier_complete(bar, bx, nloc, nx); b.st[0] = nloc; b.st[1] = nx; }
    const unsigned old = xb_add(&bar[XB_XSUB(bx)], 1u);
    const unsigned gen = old / nloc;
    if (old + 1u == (gen + 1u) * nloc) {
      __builtin_amdgcn_fence(__ATOMIC_RELEASE, "agent");
      asm volatile("s_waitcnt vmcnt(0)" ::: "memory");
      const unsigned og = xb_add(&bar[XB_TOP], 1u);
      const unsigned tg = og / nx;
      if (og + 1u == (tg + 1u) * nx) xb_add(&bar[XB_TOPGEN], 1u);
      else XB_SPIN(xb_ld(&bar[XB_TOPGEN]) == tg, bar);
      __builtin_amdgcn_fence(__ATOMIC_ACQUIRE, "agent");
      xb_add(&bar[XB_XGEN(bx)], 1u);
      asm volatile("s_waitcnt vmcnt(0)" ::: "memory");
    } else {
      XB_SPIN(xb_ld(&bar[XB_XGEN(bx)]) == gen, bar);
      __builtin_amdgcn_fence(__ATOMIC_ACQUIRE, "agent");
      asm volatile("s_waitcnt vmcnt(0)" ::: "memory");
    }
  }
  __syncthreads();
}

constexpr size_t al256(size_t v) { return (v + 255) & ~(size_t)255; }
struct WsLayout {
  size_t bar, ctl, h, hb, w_in_t, w_br_t, w_out_t, cs, rwp, rgb, lam, counts, tok_slot, tok_w, slot_tok, mstat, nvec, wgt, bcum, ligate;
  size_t qa, ka, vaT, qb, kb, vbT, cq, ck, cvT, co, cg, gz, qc, kc, kcT, U, end_mixer;
  size_t w_gu_t, w_dn_t, H, ys, end_moe, need;
};
constexpr WsLayout make_layout() {
  WsLayout w{}; size_t off = 0;
#define TAKE(f, bytes) w.f = off; off = al256(off + (size_t)(bytes));
  TAKE(bar, XCD_BAR_WORDS * 4) TAKE(ctl, 4096)
  TAKE(h, (size_t)TP * D * 4) TAKE(hb, (size_t)TP * D * 2) TAKE(w_in_t, (size_t)DINP * D * 2) TAKE(w_br_t, (size_t)3 * 1024 * 512 * 2) TAKE(w_out_t, (size_t)D * D * 2)
  TAKE(cs, (size_t)L * 32 * 8) TAKE(rwp, (size_t)2 * 64 * 3 * 64 * 4 * 4) TAKE(rgb, 2 * 2 * 48 * 4) TAKE(lam, 256) TAKE(counts, NEXP * CSTR * 4) TAKE(tok_slot, (size_t)T * 2 * 4) TAKE(tok_w, (size_t)T * 2 * 4) TAKE(slot_tok, (size_t)NEXP * CAP * 4)
  TAKE(mstat, (size_t)16 * NCH * 4 * 4) TAKE(nvec, (size_t)16 * NCH * 128 * 4) TAKE(wgt, (size_t)16 * LPAD * 4) TAKE(bcum, (size_t)16 * LPAD * 4) TAKE(ligate, (size_t)16 * LPAD * 4)
  const size_t scratch0 = off;
  TAKE(qa, (size_t)NB * 4 * 2 * L * 64 * 2) TAKE(ka, (size_t)NB * 4 * 2 * L * 64 * 2 + 4096) TAKE(vaT, (size_t)NB * 4 * 128 * LK * 2)
  TAKE(qb, (size_t)NB * 8 * L * 64 * 2) TAKE(kb, (size_t)NB * 2 * L * 64 * 2 + 4096) TAKE(vbT, (size_t)NB * 2 * 64 * LK * 2)
  TAKE(cq, (size_t)TP * 512 * 2) TAKE(ck, (size_t)TP * 512 * 2) TAKE(cvT, (size_t)8 * 128 * LPAD * 2) TAKE(co, (size_t)TP * 512 * 2) TAKE(cg, (size_t)TP * 16 * 4)
  TAKE(gz, (size_t)TP * 3072 * 2) TAKE(qc, (size_t)8 * LPAD * 128 * 2) TAKE(kc, (size_t)8 * LPAD * 128 * 2) TAKE(kcT, (size_t)8 * 128 * LPAD * 2) TAKE(U, (size_t)16 * NCH * 16384 * 4)
  w.end_mixer = off;
  off = scratch0;
  TAKE(w_gu_t, (size_t)NEXP * 1024 * 1024 * 2) TAKE(w_dn_t, (size_t)NEXP * 1024 * 512 * 2) TAKE(H, (size_t)HROWS * 512 * 2) TAKE(ys, (size_t)HROWS * D * 2)
  w.end_moe = off;
#undef TAKE
  w.need = w.end_mixer > w.end_moe ? w.end_mixer : w.end_moe;
  return w;
}
constexpr WsLayout WL = make_layout();
static_assert(WL.need <= (size_t)552 * 1000 * 1000, "workspace");

struct SchedP1 {
  static constexpr bool GATHER = false;
  const char* hb; const char* w; int G, c;
  DI bool next(int i, g8::Unit& u) const {
    const int Lq = i * G + c; int pm, pn;
    if (Lq < 65 * 25) { g8::grid_lin(Lq, 65, 25, pm, pn); u.tag = 0; u.a = hb + (size_t)pm * 256 * D * 2; u.b = w + (size_t)pn * 256 * D * 2; }
    else if (Lq < 65 * 25 + 5 * 65) { g8::grid_lin(Lq - 65 * 25, 5, 65, pm, pn); u.tag = 1; u.a = w + (size_t)(6400 + pm * 256) * D * 2; u.b = hb + (size_t)pn * 256 * D * 2; }
    else return false;
    u.pm = pm; u.pn = pn; return true;
  }
  DI void arows(const g8::Unit&, int, unsigned (&)[2]) const {}
};
DI u32x4 pack8(const g8::f32x4& a, const g8::f32x4& b) { u32x4 o; o.x = pk2(a[0], a[1]); o.y = pk2(a[2], a[3]); o.z = pk2(b[0], b[1]); o.w = pk2(b[2], b[3]); return o; }
struct EpiP1 {
  static constexpr bool PERM = true;
  char* ws;
  DI bool keep(const g8::Unit&) const { return false; }
  DI void operator()(g8::f32x4 (&acc)[2][2][4][2], const g8::Unit& u, int wr, int wc, int fr, int fq) const {
    char* wb = ws; asm volatile("" : "+s"(wb));
    if (u.tag == 0) {
      const int r0 = u.pm * 256 + 64 * wr + fr;
      _Pragma("unroll") for (int bj = 0; bj < 2; ++bj) {
        const int c0 = u.pn * 256 + 128 * bj + 32 * wc;
        const int c = c0 + 8 * fq;
        if (c0 < 1664) {
          const int u64 = c0 >> 6, q = ((c0 >> 5) & 1) * 4 + fq;
          bf16_t* base; int nh, uu; float sc;
          if (u64 < 8) { base = (bf16_t*)(wb + WL.qa); nh = 8; uu = u64; sc = QSCALE; }
          else if (u64 < 16) { base = (bf16_t*)(wb + WL.ka); nh = 8; uu = u64 - 8; sc = 1.f; }
          else if (u64 < 24) { base = (bf16_t*)(wb + WL.qb); nh = 8; uu = u64 - 16; sc = QSCALE; }
          else { base = (bf16_t*)(wb + WL.kb); nh = 2; uu = u64 - 24; sc = 1.f; }
          const f32x2* cs = (const f32x2*)(wb + WL.cs);
          _Pragma("unroll") for (int ai = 0; ai < 2; ++ai) {
            g8::f32x4 c01[4], c23[4];
            _Pragma("unroll") for (int m = 0; m < 4; ++m) {
              const int t = r0 + 128 * ai + 16 * m, tt = min(t, T - 1), b = tt >= L ? 1 : 0, pos = tt - b * L;
              const g8::f32x4* cp = (const g8::f32x4*)(cs + (size_t)pos * 32 + 4 * q);
              c01[m] = cp[0]; c23[m] = cp[1];
            }
            __builtin_amdgcn_sched_barrier(0);
            _Pragma("unroll") for (int m = 0; m < 4; ++m) {
              const int t = r0 + 128 * ai + 16 * m, tt = min(t, T - 1), b = tt >= L ? 1 : 0, pos = tt - b * L;
              const g8::f32x4 x1 = acc[ai][bj][m][0], x2 = acc[ai][bj][m][1];
              g8::f32x4 o1, o2;
              o1[0] = (x1[0] * c01[m][0] - x2[0] * c01[m][1]) * sc; o2[0] = (x2[0] * c01[m][0] + x1[0] * c01[m][1]) * sc;
              o1[1] = (x1[1] * c01[m][2] - x2[1] * c01[m][3]) * sc; o2[1] = (x2[1] * c01[m][2] + x1[1] * c01[m][3]) * sc;
              o1[2] = (x1[2] * c23[m][0] - x2[2] * c23[m][1]) * sc; o2[2] = (x2[2] * c23[m][0] + x1[2] * c23[m][1]) * sc;
              o1[3] = (x1[3] * c23[m][2] - x2[3] * c23[m][3]) * sc; o2[3] = (x2[3] * c23[m][2] + x1[3] * c23[m][3]) * sc;
              if (t < T) *(u32x4*)(base + ((size_t)(b * nh + uu) * L + pos) * 64 + 8 * q) = pack8(o1, o2);
            }
            __builtin_amdgcn_sched_barrier(0);
          }
        } else if (c0 < 6272) {
          bf16_t* dst0; int stride; bool sig = false;
          if (c0 < 2176) { dst0 = (bf16_t*)(wb + WL.cq) + (c - 1664); stride = 512; }
          else if (c0 < 2688) { dst0 = (bf16_t*)(wb + WL.ck) + (c - 2176); stride = 512; }
          else if (c0 < 3200) { dst0 = (bf16_t*)(wb + WL.co) + (c - 2688); stride = 512; }
          else { dst0 = (bf16_t*)(wb + WL.gz) + (c - 3200); stride = 3072; sig = true; }
          _Pragma("unroll") for (int ai = 0; ai < 2; ++ai) _Pragma("unroll") for (int m = 0; m < 4; ++m) {
            const int t = r0 + 128 * ai + 16 * m;
            g8::f32x4 v0 = acc[ai][bj][m][0], v1 = acc[ai][bj][m][1];
            if (sig) { _Pragma("unroll") for (int e = 0; e < 4; ++e) { v0[e] = fmaxf(sigmoidf_(v0[e]), 1e-12f); v1[e] = fmaxf(sigmoidf_(v1[e]), 1e-12f); } }
            if (t < T) *(u32x4*)(dst0 + (size_t)t * stride) = pack8(v0, v1);
          }
        } else if (c0 == 6272) {
          if (fq < 2) {
            float* cg = (float*)(wb + WL.cg);
            _Pragma("unroll") for (int ai = 0; ai < 2; ++ai) _Pragma("unroll") for (int m = 0; m < 4; ++m) {
              const int t = r0 + 128 * ai + 16 * m;
              if (t < T) { g8::f32x4* d = (g8::f32x4*)(cg + (size_t)t * 16 + 8 * fq); d[0] = acc[ai][bj][m][0]; d[1] = acc[ai][bj][m][1]; }
            }
          }
        }
      }
    } else {
      const int chb0 = u.pm * 256 + 64 * wr;
      _Pragma("unroll") for (int ai = 0; ai < 2; ++ai) _Pragma("unroll") for (int m = 0; m < 4; ++m) {
        const int chb = chb0 + 128 * ai + 16 * m;
        if (chb < 1152) {
          const int ch = chb + fr; bf16_t* rp; size_t bs;
          if (chb < 512) { rp = (bf16_t*)(wb + WL.vaT) + (size_t)ch * LK; bs = (size_t)512 * LK; }
          else if (chb < 640) { rp = (bf16_t*)(wb + WL.vbT) + (size_t)(ch - 512) * LK; bs = (size_t)128 * LK; }
          else { rp = (bf16_t*)(wb + WL.cvT) + (size_t)(ch - 640) * LPAD + MPAD; bs = (size_t)512 * LPAD; }
          _Pragma("unroll") for (int bj = 0; bj < 2; ++bj) {
            const int t0 = u.pn * 256 + 128 * bj + 32 * wc + 8 * fq;
            if (t0 < T) { const int b = t0 >= L ? 1 : 0, pos0 = t0 - b * L; *(u32x4*)(rp + b * bs + pos0) = pack8(acc[ai][bj][m][0], acc[ai][bj][m][1]); }
          }
        }
      }
    }
  }
};
DI void phase_p1(const Params& P, int l, char* smem_wg, int bid, int nblk) {
  SchedP1 S; S.hb = (const char*)P.hb; S.w = (const char*)P.w_in_t; S.G = nblk >> 1; S.c = bid >> 1;
  EpiP1 E; E.ws = (char*)P.h - WL.h;
  g8::gemm_phase((g8::lds_u8*)smem_wg, D, S, E);
}

struct KArgs { const float* in[28]; float* out; char* ws; };
typedef const __attribute__((address_space(4))) KArgs* KAP;
DI Params make_params(KAP k) {
  Params P;
  P.x = k->in[0]; P.meta = k->in[1]; P.ln_in_g = k->in[2]; P.ln_in_b = k->in[3]; P.w_in = k->in[4]; P.conv_w = k->in[5]; P.conv_b = k->in[6]; P.gate_b = k->in[7];
  P.lam_q1 = k->in[8]; P.lam_k1 = k->in[9]; P.lam_q2 = k->in[10]; P.lam_k2 = k->in[11]; P.diff_g = k->in[12]; P.sink = k->in[13]; P.mlstm_g = k->in[14];
  P.w_branch = k->in[15]; P.w_out = k->in[16]; P.ln1_g = k->in[17]; P.ln1_b = k->in[18]; P.ln2_g = k->in[19]; P.ln2_b = k->in[20]; P.w_rg = k->in[21]; P.b_rg = k->in[22];
  P.w_re = k->in[23]; P.b_re = k->in[24]; P.w_gate = k->in[25]; P.w_up = k->in[26]; P.w_down = k->in[27];
  P.out = k->out;
  char* ws = k->ws;
  P.h = (float*)(ws + WL.h); P.hb = (bf16_t*)(ws + WL.hb); P.w_in_t = (bf16_t*)(ws + WL.w_in_t); P.w_br_t = (bf16_t*)(ws + WL.w_br_t); P.w_out_t = (bf16_t*)(ws + WL.w_out_t);
  P.cs = (f32x2*)(ws + WL.cs); P.lam = (float*)(ws + WL.lam); P.ctl = (unsigned*)(ws + WL.ctl); P.rwp = (float*)(ws + WL.rwp); P.rgb = (float*)(ws + WL.rgb); P.counts = (int*)(ws + WL.counts); P.tok_slot = (int*)(ws + WL.tok_slot); P.tok_w = (float*)(ws + WL.tok_w);
  P.slot_tok = (int*)(ws + WL.slot_tok); P.mstat = (float*)(ws + WL.mstat); P.nvec = (float*)(ws + WL.nvec); P.wgt = (float*)(ws + WL.wgt); P.bcum = (float*)(ws + WL.bcum);
  P.ligate = (float*)(ws + WL.ligate);
  P.qa = (bf16_t*)(ws + WL.qa); P.ka = (bf16_t*)(ws + WL.ka); P.vaT = (bf16_t*)(ws + WL.vaT); P.qb = (bf16_t*)(ws + WL.qb); P.kb = (bf16_t*)(ws + WL.kb); P.vbT = (bf16_t*)(ws + WL.vbT);
  P.cq = (bf16_t*)(ws + WL.cq); P.ck = (bf16_t*)(ws + WL.ck); P.merged = P.cq; P.cvT = (bf16_t*)(ws + WL.cvT); P.co = (bf16_t*)(ws + WL.co); P.cg = (float*)(ws + WL.cg);
  P.gz = (bf16_t*)(ws + WL.gz); P.qc = (bf16_t*)(ws + WL.qc); P.kc = (bf16_t*)(ws + WL.kc); P.kcT = (bf16_t*)(ws + WL.kcT); P.U = (float*)(ws + WL.U);
  P.w_gu_t = (bf16_t*)(ws + WL.w_gu_t); P.w_dn_t = (bf16_t*)(ws + WL.w_dn_t); P.H = (bf16_t*)(ws + WL.H); P.ys = (bf16_t*)(ws + WL.ys);
  P.oa = (bf16_t*)k->out; P.ob = P.oa + (size_t)TP * 512; P.oc = P.ob + (size_t)TP * 512;
  return P;
}

constexpr int SMEM_BYTES = 2 * DA_STAGE + 4096 + 256;
constexpr int WG_LDS = 2 * SMEM_BYTES + 64 + 256;
static_assert(WIDTAB_OFF == 2 * SMEM_BYTES + 64, "wave-slot table offset");
#define PH(...) { KAP k_ = ka; int bid = bid0, nblk = nblk0; asm volatile("" : "+s"(k_), "+s"(bid), "+s"(nblk)); const Params P = make_params(k_); __VA_ARGS__; }
__global__ void __launch_bounds__(512, 2) mega(KArgs kargs) {
  extern __shared__ __attribute__((aligned(16))) char smem_wg[];
  (void)kargs;
  const KAP ka = (KAP)__builtin_amdgcn_kernarg_segment_ptr();
  {
    const unsigned hw = (unsigned)__builtin_amdgcn_s_getreg((5 << 11) | 4) & 63u;
    *(volatile LAS int*)(size_t)(WIDTAB_OFF + 4 * hw) = (int)(threadIdx.x >> 6);
  }
  __syncthreads();
  const int half = __builtin_amdgcn_readfirstlane(rtid() >> 8);
  char* smem = smem_wg + half * SMEM_BYTES;
  const int bid0 = 2 * blockIdx.x + half, nblk0 = 2 * gridDim.x;
  volatile LAS unsigned* st = (volatile LAS unsigned*)(smem_wg + 2 * SMEM_BYTES);
  volatile LAS int* wgq = (volatile LAS int*)(smem_wg + 2 * SMEM_BYTES + 16);
  if (rtid() == 0) { st[0] = 0u; st[1] = 0u; }
  __syncthreads();
  const XcdBarrier xb = xcd_barrier_post((unsigned*)(ka->ws + WL.bar), st);

  PH(phase_prologue(P, bid, nblk))
  PH(phase_router_prep(P, bid, nblk))
  PH(phase_wconv_small(P, 0, smem, bid, nblk))
  xcd_barrier(xb);
  auto layer = [&](const int l) __attribute__((always_inline)) {
    PH(phase_zero_pads(P, bid, nblk))
    PH(phase_p1(P, l, smem_wg, bid, nblk))
    xcd_barrier(xb);
    PH(phase_mprep(P, l, smem, bid, nblk))
    xcd_barrier(xb);
    for (int it = bid0; it < 512; it += nblk0) PH(dattn_item(P, l, it, true, smem))
    PH(phase_mscan(P, bid, nblk))
    xcd_barrier(xb);
    {
      for (int it = (int)blockIdx.x; it < 512; it += (int)gridDim.x) PH(dattn_item8(P, l, it, smem_wg))
      unsigned* qctr = (unsigned*)(ka->ws + WL.ctl) + (l * 8 + 5) * 16;
      const int NP = 4 + 4 * NCH + 2 * 257;
      for (;;) {
        __syncthreads();
        if (rtid() == 0) wgq[0] = (int)xb_add(qctr, 1u);
        __syncthreads();
        const int pr = wgq[0];
        if (pr >= NP) break;
        if (pr < 4) PH(dattn_combine(P, l, 2 * pr + half, smem))
        else if (pr < 4 + 4 * NCH) PH(mout_item(P, l, 2 * (pr - 4) + half, smem))
        else PH(swa_item(P, l, 2 * (pr - 4 - 4 * NCH) + half, smem))
      }
    }
    xcd_barrier(xb);
    PH(phase_p3a(P, l, smem, smem_wg, bid, nblk))
    xcd_barrier(xb);
    PH(phase_p3b(P, l, smem, smem_wg, bid, nblk))
    xcd_barrier(xb);
    PH(phase_p4(P, l, smem, bid, nblk))
    PH(phase_wconv_experts(P, l, smem, half, wgq))
    xcd_barrier(xb);
    PH(phase_p5a(P, l, smem_wg, bid, nblk))
    xcd_barrier(xb);
    PH(phase_p5b(P, l, smem_wg, bid, nblk))
    xcd_barrier(xb);
    PH(phase_p6(P, l, smem, bid, nblk))
    if (l == 0) PH(phase_wconv_small(P, 1, smem, bid, nblk))
    xcd_barrier(xb);
  };
  layer(0);
  layer(1);
}

extern "C" void kernel_launch(void* const* d_in, const int* in_sizes, int n_in, void* d_out, int out_size, void* d_ws, size_t ws_size, hipStream_t stream) {
  (void)in_sizes; (void)n_in; (void)out_size;
  if (WL.need > ws_size) return;
  KArgs a{};
  for (int i = 0; i < 28; ++i) a.in[i] = (const float*)d_in[i];
  a.out = (float*)d_out; a.ws = (char*)d_ws;
  static int grid = 0;
  if (!grid) {
    int dev = 0, cus = 0, per_cu = 0;
    (void)hipGetDevice(&dev);
    (void)hipDeviceGetAttribute(&cus, hipDeviceAttributeMultiprocessorCount, dev);
    (void)hipFuncSetAttribute((const void*)mega, hipFuncAttributeMaxDynamicSharedMemorySize, WG_LDS);
    (void)hipOccupancyMaxActiveBlocksPerMultiprocessor(&per_cu, (const void*)mega, 512, WG_LDS);
    if (per_cu > 1) per_cu = 1;
    if (per_cu < 1) per_cu = 1;
    grid = cus * per_cu;
  }
  (void)hipMemsetAsync((char*)d_ws + WL.bar, 0, WL.h - WL.bar, stream);
  hipLaunchKernelGGL(mega, dim3(grid), dim3(512), WG_LDS, stream, a);
}
```

```cpp
#include <hip/hip_runtime.h>
#include <stdint.h>

#define DI __device__ __forceinline__
typedef unsigned short bf16_t;
typedef __attribute__((ext_vector_type(8))) short bf16x8;
typedef __attribute__((ext_vector_type(16))) float f32x16;
typedef __attribute__((ext_vector_type(2))) float f32x2;
typedef __attribute__((ext_vector_type(4))) float f32x4;
typedef __attribute__((ext_vector_type(4))) unsigned u32x4;
typedef __attribute__((ext_vector_type(2))) unsigned u32x2;
typedef __attribute__((ext_vector_type(2))) __bf16 bf16x2v;
#define MFMA32(a, b, c) __builtin_amdgcn_mfma_f32_32x32x16_bf16((a), (b), (c), 0, 0, 0)

constexpr int NB = 2, SEQ = 8192, NMETA = 16, L = 8208, T = NB * L, TP = 16512, D = 1024;
constexpr int DIN = 7440, DINP = 7680;
constexpr int LPAD = 8320, NCH = 65, MPAD = 112, LK = 8256;
constexpr int NEXP = 32, CAP = 2 * T, HROWS = 2 * T + NEXP * 256;
constexpr int NT = 256;
constexpr int CSTR = 64;
constexpr float LN_EPS = 1e-5f;
constexpr float NEGF = -1e30f;
constexpr int SMEM_TQ = 65536 + 4096 + 64;
constexpr float ALPHA = 1.41421356237309515f;
constexpr float QSCALE = 0.125f * 1.44269504088896341f;

DI f32x4 mk4(float a, float b, float c, float d) { f32x4 v = {a, b, c, d}; return v; }
DI f32x2 mk2(float a, float b) { f32x2 v = {a, b}; return v; }
DI unsigned pk2(float a, float b) { f32x2 v = {a, b}; bf16x2v r = __builtin_convertvector(v, bf16x2v); return __builtin_bit_cast(unsigned, r); }
DI bf16_t f2bf(float a) { return (bf16_t)(pk2(a, 0.f) & 0xffffu); }
DI float bf2f(bf16_t b) { return __uint_as_float(((unsigned)b) << 16); }
DI float bflo(unsigned u) { return __uint_as_float(u << 16); }
DI float bfhi(unsigned u) { return __uint_as_float(u & 0xffff0000u); }
typedef __attribute__((address_space(3))) int LAS_I;
constexpr int WIDTAB_OFF = 2 * (2 * 32768 + 4096 + 256) + 64;
DI int rtid() {
  const unsigned hw = (unsigned)__builtin_amdgcn_s_getreg((5 << 11) | 4) & 63u;
  const int wid = *(volatile __attribute__((address_space(3))) int*)(size_t)(WIDTAB_OFF + 4 * hw);
  return wid * 64 + (int)__builtin_amdgcn_mbcnt_hi(~0u, __builtin_amdgcn_mbcnt_lo(~0u, 0u));
}
DI int otid() { int t = rtid() & 255; asm volatile("" : "+v"(t)); return t; }
DI int crow(int r, int h) { return (r & 3) + 8 * (r >> 2) + 4 * h; }
DI int keyoff(int r, int h) { return (r & 7) + 8 * h + 16 * (r >> 3); }
DI int swz(int row) { return (row >> 1) & 7; }
DI int kswap(int r) { return (r & 0x13) | ((r & 4) << 1) | ((r & 8) >> 1); }
template <int O> DI float sxor(float v) { return __builtin_bit_cast(float, __builtin_amdgcn_ds_swizzle(__builtin_bit_cast(int, v), 0x1f | (O << 10))); }
DI float sx32(float v) {
  int ln = (int)__builtin_amdgcn_mbcnt_hi(~0u, __builtin_amdgcn_mbcnt_lo(~0u, 0u)); asm volatile("" : "+v"(ln));
  return __builtin_bit_cast(float, __builtin_amdgcn_ds_bpermute((ln ^ 32) << 2, __builtin_bit_cast(int, v)));
}
DI float xsum32(float v) { return v + sx32(v); }
DI float xmax32(float v) { return fmaxf(v, sx32(v)); }
DI float wave_sum(float v) { v = xsum32(v); v += sxor<16>(v); v += sxor<8>(v); v += sxor<4>(v); v += sxor<2>(v); v += sxor<1>(v); return v; }
DI float wave_max(float v) { v = xmax32(v); v = fmaxf(v, sxor<16>(v)); v = fmaxf(v, sxor<8>(v)); v = fmaxf(v, sxor<4>(v)); v = fmaxf(v, sxor<2>(v)); v = fmaxf(v, sxor<1>(v)); return v; }
DI float fexp2(float x) { return __builtin_amdgcn_exp2f(x); }
DI float frcp(float x) { return __builtin_amdgcn_rcpf(x); }
DI float shfl_up_f(float v, int d, int lane) { return __builtin_bit_cast(float, __builtin_amdgcn_ds_bpermute(((lane - d) & 63) << 2, __builtin_bit_cast(int, v))); }
DI float sigmoidf_(float x) { return frcp(1.f + __expf(-x)); }
DI bf16x8 ldfrag(const bf16_t* p) { return *(const bf16x8*)p; }
DI f32x16 zero16() { f32x16 z; _Pragma("unroll") for (int i = 0; i < 16; ++i) z[i] = 0.f; return z; }
DI bf16x8 packfrag(const f32x16& x, int s) {
  union { unsigned u[4]; bf16x8 v; } t;
  t.u[0] = pk2(x[8 * s + 0], x[8 * s + 1]); t.u[1] = pk2(x[8 * s + 2], x[8 * s + 3]);
  t.u[2] = pk2(x[8 * s + 4], x[8 * s + 5]); t.u[3] = pk2(x[8 * s + 6], x[8 * s + 7]);
  return t.v;
}

struct Params {
  const float *x, *meta, *ln_in_g, *ln_in_b, *w_in, *conv_w, *conv_b, *gate_b, *lam_q1, *lam_k1, *lam_q2, *lam_k2;
  const float *diff_g, *sink, *mlstm_g, *w_branch, *w_out, *ln1_g, *ln1_b, *ln2_g, *ln2_b, *w_rg, *b_rg, *w_re, *b_re;
  const float *w_gate, *w_up, *w_down;
  float* out;
  float* h; bf16_t* hb; bf16_t *w_in_t, *w_br_t, *w_out_t; f32x2* cs; float* lam; unsigned* ctl; float* rwp; float* rgb;
  int* counts; int* tok_slot; float* tok_w; int* slot_tok;
  float* mstat;
  float* nvec;
  float* wgt;
  float* bcum;
  float* ligate;
  bf16_t *qa, *ka, *vaT, *qb, *kb, *vbT, *cq, *ck, *cvT, *co, *gz, *qc, *kc, *kcT, *merged;
  float* cg; float* U;
  bf16_t *oa, *ob, *oc;
  bf16_t *w_gu_t, *w_dn_t, *H, *ys;
};

typedef __attribute__((address_space(3))) unsigned lds_u32;
DI void gemm_issue(const bf16_t* (&arow)[4], const bf16_t* (&brow)[4], int koff, char* st, int w) {
  _Pragma("unroll") for (int i = 0; i < 4; ++i) {
    __builtin_amdgcn_global_load_lds((const unsigned*)(arow[i] + koff), (lds_u32*)(st + (4 * i + w) * 1024), 16, 0, 0);
    __builtin_amdgcn_global_load_lds((const unsigned*)(brow[i] + koff), (lds_u32*)(st + 16384 + (4 * i + w) * 1024), 16, 0, 0);
  }
}
DI void gemm_tile(const bf16_t* (&arow)[4], const bf16_t* (&brow)[4], int K, char* smem, f32x16 (&acc)[2][2], int rows = 128) {
  const int tid = otid(), lane = tid & 63, w = tid >> 6, wm = w >> 1, wn = w & 1;
  const int lr = lane & 31, lh = lane >> 5;
  const int cs = ((lane & 7) ^ (4 * (w & 1) + (lane >> 4))) * 8;
  const int nkt = K >> 6;
  const int myrows = rows - wm * 64;
  __syncthreads();
  gemm_issue(arow, brow, cs, smem, w);
  for (int kt = 0; kt < nkt; ++kt) {
    __syncthreads();
    if (kt + 1 < nkt) gemm_issue(arow, brow, (kt + 1) * 64 + cs, smem + ((kt + 1) & 1) * 32768, w);
    const char* sA = smem + (kt & 1) * 32768; const char* sB = sA + 16384;
    if (myrows > 32) {
      bf16x8 a[4][2], b[4][2];
      _Pragma("unroll") for (int ks = 0; ks < 4; ++ks) {
        const int ch = 2 * ks + lh;
        _Pragma("unroll") for (int i = 0; i < 2; ++i) {
          const int rowa = wm * 64 + 32 * i + lr;
          a[ks][i] = *(const bf16x8*)(sA + rowa * 128 + ((ch ^ swz(rowa)) << 4));
          const int rowb = wn * 64 + 32 * i + lr;
          b[ks][i] = *(const bf16x8*)(sB + rowb * 128 + ((ch ^ swz(rowb)) << 4));
        }
      }
      _Pragma("unroll") for (int ks = 0; ks < 4; ++ks)
        _Pragma("unroll") for (int i = 0; i < 2; ++i)
          _Pragma("unroll") for (int j = 0; j < 2; ++j) acc[i][j] = MFMA32(a[ks][i], b[ks][j], acc[i][j]);
    } else if (myrows > 0) {
      _Pragma("unroll") for (int ks = 0; ks < 4; ++ks) {
        const int ch = 2 * ks + lh;
        const int rowa = wm * 64 + lr;
        const bf16x8 a0 = *(const bf16x8*)(sA + rowa * 128 + ((ch ^ swz(rowa)) << 4));
        _Pragma("unroll") for (int j = 0; j < 2; ++j) {
          const int rowb = wn * 64 + 32 * j + lr;
          acc[0][j] = MFMA32(a0, *(const bf16x8*)(sB + rowb * 128 + ((ch ^ swz(rowb)) << 4)), acc[0][j]);
        }
      }
    }
  }
  __syncthreads();
}


namespace g8 {
typedef __attribute__((address_space(3))) unsigned char lds_u8;
typedef float f32x4 __attribute__((ext_vector_type(4)));
constexpr int BK = 64, HALF = 128, HTB = HALF * BK * 2, STAGE_BYTES = 8 * HTB;
DI int lds_byte(int r, int c) { const int st = (r >> 4) * 2 + (c >> 5), rr = r & 15, cc = c & 31, ob = rr * 64 + cc * 2; return st * 1024 + (ob ^ (((ob >> 9) & 1) << 5)); }
DI void stage_rc(int b, int& R, int& C) { const int st = b / 1024, sb = b % 1024, swz = sb ^ (((sb >> 9) & 1) << 5); R = (st >> 1) * 16 + swz / 64; C = (st & 1) * 32 + (swz % 64) / 2; }
DI int perm32(int rho) { const int n = rho >> 4, i = rho & 15; return 8 * (i >> 2) + 4 * n + (i & 3); }
struct Unit { const char* a; const char* b; int pm, pn, tag, x0, x1; };
template <class Epi, class Sched>
DI void gemm_phase(lds_u8* lds, int K, const Sched& S, const Epi& E) {
  int tid = rtid(); asm volatile("" : "+v"(tid));
  const int wid = __builtin_amdgcn_readfirstlane(tid >> 6), lane = tid & 63, wr = wid >> 2, wc = wid & 3, fr = lane & 15, fq = lane >> 4;
  const int nt = K / BK;
  int R[2], C[2]; unsigned voffB[2];
  _Pragma("unroll") for (int i = 0; i < 2; ++i) { stage_rc(tid * 16 + i * 8192, R[i], C[i]); const int Rb = Epi::PERM ? ((R[i] & ~31) + perm32(R[i] & 31)) : R[i]; voffB[i] = (unsigned)(Rb * K + C[i]) * 2u; }
  const size_t kstep = (size_t)(BK * 2), hstep = (size_t)HALF * K * 2;
  const unsigned ldsw = (unsigned)wid * 1024u;
  const int aoff = lds_byte(wr * 64 + fr, fq * 8), boff = lds_byte(wc * 32 + fr, fq * 8);
#define G8_SA(b, h) (((b) * 2 + (h)) * HTB)
#define G8_SB(b, h) ((4 + (b) * 2 + (h)) * HTB)
#define G8_STAGE(bufoff, gbase, voff) do { _Pragma("unroll") for (int _i = 0; _i < 2; ++_i) \
    __builtin_amdgcn_global_load_lds((const unsigned*)((const char*)(gbase) + (voff)[_i]), (lds_u32*)(lds + (bufoff) + ldsw + _i * 8192), 16, 0, 0); } while (0)
#define G8_LDA(dst, b, h) do { _Pragma("unroll") for (int m = 0; m < 4; ++m) _Pragma("unroll") for (int k = 0; k < 2; ++k) dst[m][k] = *(const __attribute__((address_space(3))) bf16x8*)(lds + G8_SA(b, h) + aoff + m * 2048 + k * 1024); } while (0)
#define G8_LDB(dst, b, h) do { _Pragma("unroll") for (int n = 0; n < 2; ++n) _Pragma("unroll") for (int k = 0; k < 2; ++k) dst[n][k] = *(const __attribute__((address_space(3))) bf16x8*)(lds + G8_SB(b, h) + boff + n * 2048 + k * 1024); } while (0)
#define G8_MMA(ai, bj, At, Bt) do { __builtin_amdgcn_s_setprio(1); _Pragma("unroll") for (int m = 0; m < 4; ++m) _Pragma("unroll") for (int n = 0; n < 2; ++n) _Pragma("unroll") for (int k = 0; k < 2; ++k) \
    acc[ai][bj][m][n] = __builtin_amdgcn_mfma_f32_16x16x32_bf16(Bt[n][k], At[m][k], acc[ai][bj][m][n], 0, 0, 0); __builtin_amdgcn_s_setprio(0); } while (0)
#define G8_WAIT_V(n) asm volatile("s_waitcnt vmcnt(" #n ")" ::: "memory")
#define G8_WAIT_L(n) asm volatile("s_waitcnt lgkmcnt(" #n ")" ::: "memory")
#define G8_BAR __builtin_amdgcn_s_barrier()
#define G8_SCHED __builtin_amdgcn_sched_barrier(0)
  Unit cur, nxt; int ui = 0;
  if (!S.next(0, cur)) return;
  f32x4 acc[2][2][4][2];
  _Pragma("unroll") for (int a = 0; a < 2; ++a) _Pragma("unroll") for (int b = 0; b < 2; ++b) _Pragma("unroll") for (int m = 0; m < 4; ++m) _Pragma("unroll") for (int n = 0; n < 2; ++n) acc[a][b][m][n] = (f32x4){0.f, 0.f, 0.f, 0.f};
  bf16x8 At[4][2], B0[2][2], B1[2][2];
  constexpr bool GA = Sched::GATHER;
  unsigned voffA[2]; unsigned cpk[2], npk[2];
  _Pragma("unroll") for (int i = 0; i < 2; ++i) voffA[i] = (unsigned)(R[i] * K + C[i]) * 2u;
  const unsigned gc2 = (unsigned)C[0] * 2u, gk2 = (unsigned)K * 2u;
  if (GA) S.arows(cur, R[0], cpk);
#define G8_STAGE_G(bufoff, base, pk) do { const unsigned _v[2] = { ((pk) & 0xffffu) * gk2 + gc2, ((pk) >> 16) * gk2 + gc2 }; G8_STAGE(bufoff, base, _v); } while (0)
#define G8_STAGE_A(bufoff, base, h, nx) do { if (GA) { if (nx) G8_STAGE_G(bufoff, base, npk[h]); else G8_STAGE_G(bufoff, base, cpk[h]); } else G8_STAGE(bufoff, (base) + (h) * hstep, voffA); } while (0)
  const char* cA = cur.a; const char* cB = cur.b;
  G8_STAGE(G8_SB(0, 0), cB, voffB); G8_STAGE_A(G8_SA(0, 0), cA, 0, false); G8_STAGE(G8_SB(0, 1), cB + hstep, voffB); G8_STAGE_A(G8_SA(0, 1), cA, 1, false);
  if (wr == 1) G8_BAR;
  G8_WAIT_V(4); G8_BAR;
  G8_STAGE(G8_SB(1, 0), cB + kstep, voffB); G8_STAGE_A(G8_SA(1, 0), cA + kstep, 0, false); G8_STAGE(G8_SB(1, 1), cB + hstep + kstep, voffB);
  G8_WAIT_V(6); G8_BAR;
  for (;;) {
    const bool has_next = S.next(ui + 1, nxt);
    const char* nA = has_next ? nxt.a : cA; const char* nB = has_next ? nxt.b : cB;
    if (GA) { if (has_next) S.arows(nxt, R[0], npk); else { npk[0] = cpk[0]; npk[1] = cpk[1]; } }
    for (int t = 0; t < nt; t += 2) {
      const bool last = (t == nt - 2);
      const char* a1 = cA + (size_t)(t + 1) * kstep;
      const char* a2 = last ? nA : cA + (size_t)(t + 2) * kstep; const char* b2 = last ? nB : cB + (size_t)(t + 2) * kstep;
      const char* a3 = a2 + kstep; const char* b3 = b2 + kstep;
      G8_LDB(B0, 0, 0); G8_SCHED; G8_LDA(At, 0, 0); G8_STAGE_A(G8_SA(1, 1), a1, 1, false);
      G8_WAIT_L(8); G8_BAR; G8_WAIT_L(0); G8_MMA(0, 0, At, B0); G8_BAR; G8_SCHED;
      G8_LDB(B1, 0, 1); G8_STAGE(G8_SB(0, 0), b2, voffB);
      G8_BAR; G8_WAIT_L(0); G8_MMA(0, 1, At, B1); G8_BAR;
      G8_LDA(At, 0, 1); G8_STAGE_A(G8_SA(0, 0), a2, 0, last);
      G8_BAR; G8_WAIT_L(0); G8_MMA(1, 0, At, B0); G8_BAR; G8_SCHED;
      G8_STAGE(G8_SB(0, 1), b2 + hstep, voffB);
      G8_WAIT_V(6); G8_BAR; G8_MMA(1, 1, At, B1); G8_BAR;
      G8_LDB(B0, 1, 0); G8_SCHED; G8_LDA(At, 1, 0); G8_STAGE_A(G8_SA(0, 1), a2, 1, last);
      G8_WAIT_L(8); G8_BAR; G8_WAIT_L(0); G8_MMA(0, 0, At, B0); G8_BAR; G8_SCHED;
      G8_LDB(B1, 1, 1); G8_STAGE(G8_SB(1, 0), b3, voffB);
      G8_BAR; G8_WAIT_L(0); G8_MMA(0, 1, At, B1); G8_BAR;
      G8_LDA(At, 1, 1); G8_STAGE_A(G8_SA(1, 0), a3, 0, last);
      G8_BAR; G8_WAIT_L(0); G8_MMA(1, 0, At, B0); G8_BAR; G8_SCHED;
      G8_STAGE(G8_SB(1, 1), b3 + hstep, voffB);
      G8_WAIT_V(6); G8_BAR; G8_MMA(1, 1, At, B1); G8_BAR;
    }
    E(acc, cur, wr, wc, fr, fq);
    if (!has_next) break;
    if (!E.keep(cur)) { _Pragma("unroll") for (int a = 0; a < 2; ++a) _Pragma("unroll") for (int b = 0; b < 2; ++b) _Pragma("unroll") for (int m = 0; m < 4; ++m) _Pragma("unroll") for (int n = 0; n < 2; ++n) acc[a][b][m][n] = (f32x4){0.f, 0.f, 0.f, 0.f}; }
    cur = nxt; cA = nA; cB = nB; ++ui;
    if (GA) { cpk[0] = npk[0]; cpk[1] = npk[1]; }
  }
  G8_WAIT_V(0);
  if (wr == 0) G8_BAR;
  G8_BAR;
#undef G8_SA
#undef G8_SB
#undef G8_STAGE
#undef G8_STAGE_A
#undef G8_STAGE_G
#undef G8_LDA
#undef G8_LDB
#undef G8_MMA
#undef G8_WAIT_V
#undef G8_WAIT_L
#undef G8_BAR
#undef G8_SCHED
}
DI void dense_arows(int K, int R0, int R1, int C0, int C1, unsigned (&vo)[2][2]) {
  vo[0][0] = (unsigned)(R0 * K + C0) * 2u; vo[0][1] = (unsigned)(R1 * K + C1) * 2u;
  vo[1][0] = (unsigned)((128 + R0) * K + C0) * 2u; vo[1][1] = (unsigned)((128 + R1) * K + C1) * 2u;
}
DI void grid_lin(int wgid, int nM, int nN, int& pm, int& pn) {
  const int nwg = nM * nN;
  { const int q = nwg / 8, r = nwg % 8, xcd = wgid % 8, off = wgid / 8; wgid = (xcd < r ? xcd * (q + 1) : r * (q + 1) + (xcd - r) * q) + off; }
  const int nig = 8 * nN, gid = wgid / nig, fm = gid * 8, gsz = (nM - fm) < 8 ? (nM - fm) : 8;
  pm = fm + ((wgid % nig) % gsz); pn = (wgid % nig) / gsz;
}
DI bool grid_unit(int i, int G, int c, int nM, int nN, int& pm, int& pn) {
  const int nwg = nM * nN; const long Lq = (long)i * G + c; if (Lq >= nwg) return false;
  int wgid = (int)Lq; { const int q = nwg / 8, r = nwg % 8, xcd = wgid % 8, off = wgid / 8; wgid = (xcd < r ? xcd * (q + 1) : r * (q + 1) + (xcd - r) * q) + off; }
  const int nig = 8 * nN, gid = wgid / nig, fm = gid * 8, gsz = (nM - fm) < 8 ? (nM - fm) : 8;
  pm = fm + ((wgid % nig) % gsz); pn = (wgid % nig) / gsz; return true;
}
}

DI int ropep(int x) { const int d = x & 63; return (x & ~63) + 8 * ((d & 31) >> 2) + 4 * (d >> 5) + (d & 3); }
DI int wmap(int mode, int n) {
  if (mode == 1) {
    if (n < 512) return ropep(n);
    if (n < 1024) return 512 + ropep(n - 512);
    if (n < 1536) return 6400 + (n - 1024);
    if (n < 2048) return 1024 + ropep(n - 1536);
    if (n < 2176) return 1536 + ropep(n - 2048);
    if (n < 2304) return 6400 + 512 + (n - 2176);
    if (n < 2816) return 1664 + (n - 2304);
    if (n < 3328) return 2176 + (n - 2816);
    if (n < 3840) return 6400 + 640 + (n - 3328);
    if (n < 4352) return 2688 + (n - 3840);
    if (n < 4368) return 6272 + (n - 4352);
    return 3200 + (n - 4368);
  }
  if (mode == 2) return 8 * (n >> 2) + (n & 3);
  if (mode == 3) return 8 * (n >> 2) + 4 + (n & 3);
  return n;
}
struct CvJob { const float* src; bf16_t* dst; int K, N, mode, tk, tn; };
DI void cv_load(const CvJob& j, int tid, f32x4 (&v)[4]) {
  const int kk = tid >> 4, c4 = tid & 15, n = j.tn * 64 + 4 * c4;
  _Pragma("unroll") for (int i = 0; i < 4; ++i) {
    v[i] = mk4(0.f, 0.f, 0.f, 0.f);
    if (n < j.N) v[i] = *(const f32x4*)(j.src + (size_t)(j.tk * 64 + kk + 16 * i) * j.N + n);
  }
}
DI void cv_finish(const CvJob& j, int tid, const f32x4 (&v)[4], char* smem) {
  bf16_t* sT = (bf16_t*)smem;
  const int kk = tid >> 4, c4 = tid & 15;
  __syncthreads();
  _Pragma("unroll") for (int i = 0; i < 4; ++i) {
    const int k = kk + 16 * i;
    sT[(4 * c4 + 0) * 72 + k] = f2bf(v[i].x); sT[(4 * c4 + 1) * 72 + k] = f2bf(v[i].y);
    sT[(4 * c4 + 2) * 72 + k] = f2bf(v[i].z); sT[(4 * c4 + 3) * 72 + k] = f2bf(v[i].w);
  }
  __syncthreads();
  const int nn = tid >> 2, kc = tid & 3;
  const int ng = j.tn * 64 + nn;
  if (ng < j.N) {
    const u32x4 v0 = *(const u32x4*)(sT + nn * 72 + 16 * kc);
    const u32x4 v1 = *(const u32x4*)(sT + nn * 72 + 16 * kc + 8);
    bf16_t* d = j.dst + (size_t)wmap(j.mode, ng) * j.K + j.tk * 64 + 16 * kc;
    *(u32x4*)d = v0; *(u32x4*)(d + 8) = v1;
  }
}

constexpr int WS_TILES_IN = 16 * 117, WS_TILES_BR = 3 * 8 * 16, WS_TILES_OUT = 16 * 16;
constexpr int WS_TILES = WS_TILES_IN + WS_TILES_BR + WS_TILES_OUT;
DI CvJob ws_job(const Params& P, int l, int it) {
  CvJob j;
  if (it < WS_TILES_IN) { j.src = P.w_in + (size_t)l * D * DIN; j.K = D; j.N = DIN; j.dst = P.w_in_t; j.mode = 1; j.tk = it / 117; j.tn = it % 117; }
  else if (it < WS_TILES_IN + WS_TILES_BR) {
    const int q = it - WS_TILES_IN, i = q / 128, r = q % 128;
    j.src = P.w_branch + ((size_t)l * 3 + i) * 512 * 1024; j.K = 512; j.N = 1024; j.dst = P.w_br_t + (size_t)i * 1024 * 512; j.mode = 0; j.tk = r / 16; j.tn = r % 16;
  } else {
    const int q = it - WS_TILES_IN - WS_TILES_BR;
    j.src = P.w_out + (size_t)l * D * D; j.K = D; j.N = D; j.dst = P.w_out_t; j.mode = 0; j.tk = q / 16; j.tn = q % 16;
  }
  return j;
}
DI void phase_wconv_small(const Params& P, int l, char* smem, int bid, int nblk) {
  const int tid = otid();
  if (bid >= WS_TILES) return;
  CvJob j = ws_job(P, l, bid); f32x4 v[4];
  cv_load(j, tid, v);
  for (int it = bid; it < WS_TILES; it += nblk) {
    CvJob jn = j; f32x4 vn[4];
    _Pragma("unroll") for (int i = 0; i < 4; ++i) vn[i] = v[i];
    if (it + nblk < WS_TILES) { jn = ws_job(P, l, it + nblk); cv_load(jn, tid, vn); }
    cv_finish(j, tid, v, smem);
    j = jn;
    _Pragma("unroll") for (int i = 0; i < 4; ++i) v[i] = vn[i];
  }
}
constexpr int WE_TILES = NEXP * 384;
DI CvJob we_job(const Params& P, int l, int it) {
  const int e = it / 384, q = it % 384, which = q / 128, r = q % 128;
  const size_t eo = (size_t)l * NEXP + e;
  CvJob j;
  if (which == 0) { j.src = P.w_gate + eo * 1024 * 512; j.K = 1024; j.N = 512; j.dst = P.w_gu_t + (size_t)e * 1024 * 1024; j.mode = 2; j.tk = r / 8; j.tn = r % 8; }
  else if (which == 1) { j.src = P.w_up + eo * 1024 * 512; j.K = 1024; j.N = 512; j.dst = P.w_gu_t + (size_t)e * 1024 * 1024; j.mode = 3; j.tk = r / 8; j.tn = r % 8; }
  else { j.src = P.w_down + eo * 512 * 1024; j.K = 512; j.N = 1024; j.dst = P.w_dn_t + (size_t)e * 1024 * 512; j.mode = 0; j.tk = r / 16; j.tn = r % 16; }
  return j;
}
DI void phase_wconv_experts(const Params& P, int l, char* smem, int half, volatile __attribute__((address_space(3))) int* wgslot) {
  unsigned* ctr = P.ctl + (l * 8 + 6) * 16;
  const int tid = otid();
  for (;;) {
    __syncthreads();
    if (rtid() == 0) wgslot[0] = (int)__hip_atomic_fetch_add(ctr, 2u, __ATOMIC_RELAXED, __HIP_MEMORY_SCOPE_AGENT);
    __syncthreads();
    const int c0 = (wgslot[0] + half) * 8;
    if (c0 >= WE_TILES) break;
    CvJob j = we_job(P, l, c0); f32x4 v[4];
    cv_load(j, tid, v);
    for (int it = c0; it < c0 + 8; ++it) {
      CvJob jn = j; f32x4 vn[4];
      _Pragma("unroll") for (int i = 0; i < 4; ++i) vn[i] = v[i];
      if (it + 1 < c0 + 8) { jn = we_job(P, l, it + 1); cv_load(jn, tid, vn); }
      cv_finish(j, tid, v, smem);
      j = jn;
      _Pragma("unroll") for (int i = 0; i < 4; ++i) v[i] = vn[i];
    }
  }
}

DI void ln16(f32x4 (&v)[4], const float* g, const float* b, int lane) {
  float s = 0.f;
  _Pragma("unroll") for (int i = 0; i < 4; ++i) s += v[i].x + v[i].y + v[i].z + v[i].w;
  const float mu = wave_sum(s) * (1.f / 1024.f);
  float q = 0.f;
  _Pragma("unroll") for (int i = 0; i < 4; ++i) { v[i].x -= mu; v[i].y -= mu; v[i].z -= mu; v[i].w -= mu; q += v[i].x * v[i].x + v[i].y * v[i].y + v[i].z * v[i].z + v[i].w * v[i].w; }
  const float rs = rsqrtf(wave_sum(q) * (1.f / 1024.f) + LN_EPS);
  _Pragma("unroll") for (int i = 0; i < 4; ++i) {
    const f32x4 gg = ((const f32x4*)g)[lane + 64 * i], bb = ((const f32x4*)b)[lane + 64 * i];
    v[i].x = v[i].x * rs * gg.x + bb.x; v[i].y = v[i].y * rs * gg.y + bb.y; v[i].z = v[i].z * rs * gg.z + bb.z; v[i].w = v[i].w * rs * gg.w + bb.w;
  }
}
DI void store_row(const f32x4 (&v)[4], float* hf, bf16_t* hbf, int lane) {
  _Pragma("unroll") for (int i = 0; i < 4; ++i) {
    if (hf) ((f32x4*)hf)[lane + 64 * i] = v[i];
    if (hbf) { u32x2 u; u.x = pk2(v[i].x, v[i].y); u.y = pk2(v[i].z, v[i].w); ((u32x2*)hbf)[lane + 64 * i] = u; }
  }
}

DI void phase_prologue(const Params& P, int bid, int nblk) {
  const int tid = otid(), gtid = bid * NT + tid, gn = nblk * NT;
  for (int i = gtid; i < L * 32; i += gn) {
    const int pos = i >> 5, f = i & 31;
    const float e = (float)(2 * f) / 64.0f;
    const float pw = (float)pow(10000.0, (double)e);
    const float inv = 1.0f / pw;
    const float ang = (float)pos * inv;
    P.cs[i] = mk2((float)cos((double)ang), (float)sin((double)ang));
  }
  if (gtid < 2) {
    const int l = gtid;
    float s1 = 0.f, s2 = 0.f;
    for (int i = 0; i < 64; ++i) { s1 += P.lam_q1[l * 64 + i] * P.lam_k1[l * 64 + i]; s2 += P.lam_q2[l * 64 + i] * P.lam_k2[l * 64 + i]; }
    const float li = (float)(0.8 - 0.6 * exp(-0.3 * (double)l));
    P.lam[l] = expf(s1) - expf(s2) + li;
    P.lam[2 + l] = (float)(1.0 - (0.8 - 0.6 * exp(-0.3 * (double)l)));
  }
  const int lane = tid & 63, wv = (bid * NT + tid) >> 6, nwv = (nblk * NT) >> 6;
  for (int t = wv; t < T; t += nwv) {
    const int b = t >= L ? 1 : 0, pos = t - b * L;
    const float* src = pos < NMETA ? P.meta + (size_t)pos * D : P.x + ((size_t)b * SEQ + (pos - NMETA)) * D;
    f32x4 v[4];
    _Pragma("unroll") for (int i = 0; i < 4; ++i) v[i] = ((const f32x4*)src)[lane + 64 * i];
    ln16(v, P.ln_in_g, P.ln_in_b, lane);
    store_row(v, P.h + (size_t)t * D, P.hb + (size_t)t * D, lane);
  }
}
DI void phase_zero_pads(const Params& P, int bid, int nblk) {
  const int gtid = bid * NT + otid(), gn = nblk * NT;
  for (int i = gtid; i < 8 * 128 * (LK - L); i += gn) { const int r = i / (LK - L), cidx = i % (LK - L); P.vaT[(size_t)r * LK + L + cidx] = 0; }
  for (int i = gtid; i < 4 * 64 * (LK - L); i += gn) { const int r = i / (LK - L), cidx = i % (LK - L); P.vbT[(size_t)r * LK + L + cidx] = 0; }
  for (int i = gtid; i < 8 * 128 * MPAD; i += gn) { const int r = i / MPAD, cidx = i % MPAD; P.cvT[(size_t)r * LPAD + cidx] = 0; }
  for (int i = gtid; i < 8 * MPAD * 128; i += gn) { const int bh = i / (MPAD * 128), r = i % (MPAD * 128); P.qc[(size_t)bh * LPAD * 128 + r] = 0; P.kc[(size_t)bh * LPAD * 128 + r] = 0; }
  if (gtid < NEXP) P.counts[gtid * CSTR] = 0;
}

constexpr int P1_MT = TP / 128, P1_NT = DINP / 128;
#define WT_FENCE() asm volatile("s_waitcnt lgkmcnt(0)" ::: "memory")
DI void p1_epilogue(const Params& P, int m0, int n0, f32x16 (&acc)[2][2], char* smem) {
  const int tid = otid(), lane = tid & 63, w = tid >> 6, wm = w >> 1, wn = w & 1, lr = lane & 31, lh = lane >> 5;
  const int nw = n0 + wn * 64;
  bf16_t* wt = (bf16_t*)(smem + w * 9216);
  const int mw = m0 + wm * 64;
  int seg;
  if (nw < 512) seg = 0; else if (nw < 1024) seg = 1; else if (nw < 1536) seg = 2; else if (nw < 2048) seg = 3; else if (nw < 2176) seg = 4;
  else if (nw < 2304) seg = 5; else if (nw < 2816) seg = 6; else if (nw < 3328) seg = 7; else if (nw < 3840) seg = 8; else if (nw < 4352) seg = 9;
  else if (nw < 7424) seg = 10; else seg = 11;
  if (seg == 11) {
    _Pragma("unroll") for (int i = 0; i < 2; ++i) _Pragma("unroll") for (int r = 0; r < 16; ++r) {
      const int t = mw + 32 * i + crow(r, lh);
      const int cn = nw + lr - 7424;
      if (t < T && cn < 16) P.cg[(size_t)t * 16 + cn] = acc[i][0][r];
    }
    return;
  }
  if (seg == 0 || seg == 1 || seg == 3 || seg == 4) {
    _Pragma("unroll") for (int i = 0; i < 2; ++i) _Pragma("unroll") for (int r = 0; r < 16; ++r) {
      const int row = 32 * i + crow(r, lh);
      const int t = min(mw + row, T - 1);
      const int pos = t >= L ? t - L : t;
      const f32x2 csv = P.cs[pos * 32 + lr];
      const float x1 = acc[i][0][r], x2 = acc[i][1][r];
      float o1 = x1 * csv.x - x2 * csv.y, o2 = x2 * csv.x + x1 * csv.y;
      if (seg == 0 || seg == 3) { o1 *= QSCALE; o2 *= QSCALE; }
      wt[row * 72 + lr] = f2bf(o1); wt[row * 72 + 32 + lr] = f2bf(o2);
    }
  } else if (seg == 2 || seg == 5 || seg == 8) {
    _Pragma("unroll") for (int i = 0; i < 2; ++i) _Pragma("unroll") for (int j = 0; j < 2; ++j) _Pragma("unroll") for (int rg = 0; rg < 4; ++rg) {
      u32x2 u; u.x = pk2(acc[i][j][4 * rg], acc[i][j][4 * rg + 1]); u.y = pk2(acc[i][j][4 * rg + 2], acc[i][j][4 * rg + 3]);
      *(u32x2*)(wt + (32 * j + lr) * 72 + 32 * i + 8 * rg + 4 * lh) = u;
    }
  } else if (seg == 10) {
    _Pragma("unroll") for (int i = 0; i < 2; ++i) _Pragma("unroll") for (int j = 0; j < 2; ++j) _Pragma("unroll") for (int r = 0; r < 16; ++r)
      wt[(32 * i + crow(r, lh)) * 72 + 32 * j + lr] = f2bf(fmaxf(sigmoidf_(acc[i][j][r]), 1e-12f));
  } else {
    _Pragma("unroll") for (int i = 0; i < 2; ++i) _Pragma("unroll") for (int j = 0; j < 2; ++j) _Pragma("unroll") for (int r = 0; r < 16; ++r)
      wt[(32 * i + crow(r, lh)) * 72 + 32 * j + lr] = f2bf(acc[i][j][r]);
  }
  WT_FENCE();
  _Pragma("unroll") for (int it = 0; it < 8; ++it) {
    const int id = it * 64 + lane, row = id >> 3, ch = id & 7;
    const u32x4 v = *(const u32x4*)(wt + row * 72 + ch * 8);
    if (seg == 2 || seg == 5 || seg == 8) {
      const int t0 = mw + ch * 8;
      if (t0 < T) {
        const int b = t0 >= L ? 1 : 0, pos0 = t0 - b * L;
        bf16_t* dst;
        if (seg == 2) { const int cc = nw - 1024 + row; dst = P.vaT + ((size_t)(b * 4 + (cc >> 7)) * 128 + (cc & 127)) * LK + pos0; }
        else if (seg == 5) { const int cc = nw - 2176 + row; dst = P.vbT + ((size_t)(b * 2 + (cc >> 6)) * 64 + (cc & 63)) * LK + pos0; }
        else { const int cc = nw - 3328 + row; dst = P.cvT + ((size_t)(b * 4 + (cc >> 7)) * 128 + (cc & 127)) * LPAD + MPAD + pos0; }
        *(u32x4*)dst = v;
      }
    } else {
      const int t = mw + row;
      if (t < T) {
        const int b = t >= L ? 1 : 0, pos = t - b * L;
        bf16_t* dst;
        if (seg == 0) { const int u = nw >> 6; dst = P.qa + ((size_t)((b * 4 + (u >> 1)) * 2 + (u & 1)) * L + pos) * 64; }
        else if (seg == 1) { const int u = (nw - 512) >> 6; dst = P.ka + ((size_t)((b * 4 + (u >> 1)) * 2 + (u & 1)) * L + pos) * 64; }
        else if (seg == 3) { const int hq = (nw - 1536) >> 6; dst = P.qb + ((size_t)(b * 8 + hq) * L + pos) * 64; }
        else if (seg == 4) { const int kv = (nw - 2048) >> 6; dst = P.kb + ((size_t)(b * 2 + kv) * L + pos) * 64; }
        else if (seg == 6) dst = P.cq + (size_t)t * 512 + nw - 2304;
        else if (seg == 7) dst = P.ck + (size_t)t * 512 + nw - 2816;
        else if (seg == 9) dst = P.co + (size_t)t * 512 + nw - 3840;
        else dst = P.gz + (size_t)t * 3072 + nw - 4352;
        *(u32x4*)(dst + ch * 8) = v;
      }
    }
  }
}
DI float logsigmoidf_(float x) { return fminf(x, 0.f) - log1pf(__expf(-fabsf(x))); }
DI void phase_mprep(const Params& P, int l, char* smem, int bid, int nblk) {
  const int tid = otid();
  float* sli = (float*)smem;
  float* slf = sli + 256;
  float* sb = slf + 256;
  float* sw = sb + 256;
  float* sred = sw + 256;
  float* sst = sred + 16 * 256;
  for (int it = bid; it < 8 * NCH; it += nblk) {
    const int bh = it < 8 * (NCH - 1) ? it / (NCH - 1) : it - 8 * (NCH - 1), n = it < 8 * (NCH - 1) ? 1 + it % (NCH - 1) : 0, b = bh >> 2, hh = bh & 3;
    __syncthreads();
    if (tid < 128) {
      const int p = 128 * n + tid, pos = p - MPAD;
      float lif = NEGF, lff = 0.f, lib = NEGF, lfb = 0.f;
      if (pos >= 0) {
        const float* g = P.cg + (size_t)(b * L + pos) * 16;
        const float* gb = P.gate_b + l * 16;
        lif = g[0 + hh] + gb[0 + hh]; lff = logsigmoidf_(g[4 + hh] + gb[4 + hh]);
        lib = g[8 + hh] + gb[8 + hh]; lfb = logsigmoidf_(g[12 + hh] + gb[12 + hh]);
      }
      sli[tid] = lif; sli[128 + tid] = lib; slf[tid] = lff; slf[128 + tid] = lfb;
    }
    __syncthreads();
    if (tid < 128) {
      const int t2 = otid(), wd = t2 >> 6, ln = t2 & 63;
      const int i0 = wd == 0 ? 2 * ln : 127 - 2 * ln, i1 = wd == 0 ? 2 * ln + 1 : 126 - 2 * ln;
      const float e0 = slf[wd * 128 + i0], e1 = slf[wd * 128 + i1];
      float scan = e0 + e1;
      _Pragma("unroll") for (int d = 1; d < 64; d <<= 1) { const float tt = shfl_up_f(scan, d, ln); if (ln >= d) scan += tt; }
      float excl = shfl_up_f(scan, 1, ln); if (ln == 0) excl = 0.f;
      sb[wd * 128 + i0] = excl + e0; sb[wd * 128 + i1] = excl + e0 + e1;
    }
    __syncthreads();
    if (tid < 128) {
      const int dir = tid >> 6, lane = tid & 63;
      const float g = dir == 0 ? sb[127] : sb[128];
      const float a0 = g - sb[dir * 128 + lane] + sli[dir * 128 + lane];
      const float a1 = g - sb[dir * 128 + lane + 64] + sli[dir * 128 + lane + 64];
      const float am = wave_max(fmaxf(a0, a1));
      const float w0 = __expf(a0 - am), w1 = __expf(a1 - am);
      sw[dir * 128 + lane] = w0; sw[dir * 128 + lane + 64] = w1;
      const size_t base = ((size_t)dir * 8 + bh) * LPAD + 128 * n;
      P.wgt[base + lane] = w0; P.wgt[base + lane + 64] = w1;
      P.bcum[base + lane] = sb[dir * 128 + lane]; P.bcum[base + lane + 64] = sb[dir * 128 + lane + 64];
      P.ligate[base + lane] = sli[dir * 128 + lane]; P.ligate[base + lane + 64] = sli[dir * 128 + lane + 64];
      if (lane == 0) { float* ms = P.mstat + ((size_t)(dir * 8 + bh) * NCH + n) * 4; ms[0] = g; ms[1] = am; }
    }
    __syncthreads();
    bf16_t* skT = (bf16_t*)(smem + 32768);
    if (n == 0) { for (int i = tid; i < 128 * MPAD; i += NT) skT[(i / MPAD) * 136 + (i % MPAD)] = 0; }
    const int tid3 = otid();
    const int dg = tid3 & 15, tl = tid3 >> 4;
    float nf[8], nbk[8];
    _Pragma("unroll") for (int j = 0; j < 8; ++j) { nf[j] = 0.f; nbk[j] = 0.f; }
    const int ch = hh * 128 + dg * 8;
    float cw[2][3][8], cb[2][8];
    _Pragma("unroll") for (int j = 0; j < 8; ++j) {
      _Pragma("unroll") for (int ww = 0; ww < 3; ++ww) { cw[0][ww][j] = P.conv_w[((size_t)l * 3 + ww) * 1024 + ch + j]; cw[1][ww][j] = P.conv_w[((size_t)l * 3 + ww) * 1024 + 512 + ch + j]; }
      cb[0][j] = P.conv_b[l * 1024 + ch + j]; cb[1][j] = P.conv_b[l * 1024 + 512 + ch + j];
    }
    _Pragma("unroll 1") for (int hb4 = 0; hb4 < 8; hb4 += 4) {
      u32x4 uq[4][3], uk[4][3];
      _Pragma("unroll") for (int i4 = 0; i4 < 4; ++i4) {
        const int pos = 128 * n + tl + 16 * (hb4 + i4) - MPAD;
        _Pragma("unroll") for (int ww = 0; ww < 3; ++ww) {
          const int pp = min(max(pos + ww - 1, 0), L - 1);
          uq[i4][ww] = *(const u32x4*)(P.cq + (size_t)(b * L + pp) * 512 + ch);
          uk[i4][ww] = *(const u32x4*)(P.ck + (size_t)(b * L + pp) * 512 + ch);
        }
      }
      __builtin_amdgcn_sched_barrier(0);
      _Pragma("unroll") for (int i4 = 0; i4 < 4; ++i4) {
        const int tau = tl + 16 * (hb4 + i4), p = 128 * n + tau, pos = p - MPAD;
        float q[8], k[8];
        _Pragma("unroll") for (int j = 0; j < 8; ++j) { q[j] = cb[0][j]; k[j] = cb[1][j]; }
        _Pragma("unroll") for (int ww = 0; ww < 3; ++ww) {
          const int pp = pos + ww - 1;
          const float vm = (pp >= 0 && pp < L) ? 1.f : 0.f;
          const unsigned aq[4] = {uq[i4][ww].x, uq[i4][ww].y, uq[i4][ww].z, uq[i4][ww].w}, ak[4] = {uk[i4][ww].x, uk[i4][ww].y, uk[i4][ww].z, uk[i4][ww].w};
          _Pragma("unroll") for (int j = 0; j < 4; ++j) {
            q[2 * j] += bflo(aq[j]) * (cw[0][ww][2 * j] * vm); q[2 * j + 1] += bfhi(aq[j]) * (cw[0][ww][2 * j + 1] * vm);
            k[2 * j] += bflo(ak[j]) * (cw[1][ww][2 * j] * vm); k[2 * j + 1] += bfhi(ak[j]) * (cw[1][ww][2 * j + 1] * vm);
          }
        }
        const float wf = sw[tau], wb = sw[128 + tau];
        _Pragma("unroll") for (int j = 0; j < 8; ++j) {
          q[j] = q[j] * sigmoidf_(q[j]);
          k[j] = k[j] * sigmoidf_(k[j]) * 0.08838834764831845f;
          nf[j] += wf * k[j]; nbk[j] += wb * k[j];
        }
        if (pos >= 0) {
          u32x4 oq, ok;
          oq.x = pk2(q[0], q[1]); oq.y = pk2(q[2], q[3]); oq.z = pk2(q[4], q[5]); oq.w = pk2(q[6], q[7]);
          ok.x = pk2(k[0], k[1]); ok.y = pk2(k[2], k[3]); ok.z = pk2(k[4], k[5]); ok.w = pk2(k[6], k[7]);
          *(u32x4*)(P.qc + ((size_t)bh * LPAD + p) * 128 + dg * 8) = oq;
          *(u32x4*)(P.kc + ((size_t)bh * LPAD + p) * 128 + dg * 8) = ok;
          _Pragma("unroll") for (int j = 0; j < 8; ++j) skT[(dg * 8 + j) * 136 + tau] = f2bf(k[j]);
        }
      }
    }
    _Pragma("unroll") for (int j = 0; j < 8; ++j) { sred[tl * 256 + dg * 8 + j] = nf[j]; sred[tl * 256 + 128 + dg * 8 + j] = nbk[j]; }
    __syncthreads();
    {
      const int tid2 = otid();
      const int lane = tid2 & 63, w = tid2 >> 6, wi = w >> 1, wj = w & 1, lr = lane & 31, lh = lane >> 5;
      unsigned vo = (unsigned)((bh * 128 + 64 * wi + lr) * LPAD + 128 * n + 8 * lh);
      asm volatile("" : "+v"(vo));
      _Pragma("unroll 1") for (int dir = 0; dir < 2; ++dir) {
        f32x16 acc[2][2];
        _Pragma("unroll") for (int i = 0; i < 2; ++i) _Pragma("unroll") for (int j = 0; j < 2; ++j) acc[i][j] = zero16();
        unsigned koff = (unsigned)((64 * wj + lr) * 136 + 8 * lh);
        asm volatile("" : "+v"(koff));
        _Pragma("unroll") for (int ks = 0; ks < 8; ++ks) {
          if (n == 0 && ks < 7) continue;
          const int tau = 16 * ks + 8 * lh;
          const f32x4 w0 = *(const f32x4*)(sw + dir * 128 + tau), w1 = *(const f32x4*)(sw + dir * 128 + tau + 4);
          bf16x8 bq[2];
          _Pragma("unroll") for (int i = 0; i < 2; ++i) {
            const u32x4 kr = *(const u32x4*)(skT + koff + (32 * i) * 136 + 16 * ks);
            union { unsigned u[4]; bf16x8 v; } tt;
            tt.u[0] = pk2(bflo(kr.x) * w0.x, bfhi(kr.x) * w0.y); tt.u[1] = pk2(bflo(kr.y) * w0.z, bfhi(kr.y) * w0.w);
            tt.u[2] = pk2(bflo(kr.z) * w1.x, bfhi(kr.z) * w1.y); tt.u[3] = pk2(bflo(kr.w) * w1.z, bfhi(kr.w) * w1.w);
            bq[i] = tt.v;
          }
          bf16x8 af[2];
          _Pragma("unroll") for (int i = 0; i < 2; ++i) af[i] = ldfrag(P.cvT + vo + (unsigned)(32 * i) * LPAD + 16 * ks);
          _Pragma("unroll") for (int i = 0; i < 2; ++i) _Pragma("unroll") for (int j = 0; j < 2; ++j) acc[i][j] = MFMA32(af[i], bq[j], acc[i][j]);
        }
        float* U = P.U + ((size_t)(dir * 8 + bh) * NCH + n) * 16384;
        _Pragma("unroll") for (int i = 0; i < 2; ++i) _Pragma("unroll") for (int j = 0; j < 2; ++j) _Pragma("unroll") for (int r = 0; r < 16; ++r)
          U[(64 * wi + 32 * i + crow(r, lh)) * 128 + 64 * wj + 32 * j + lr] = acc[i][j][r];
      }
    }
    {
      float s = 0.f;
      _Pragma("unroll") for (int i = 0; i < 16; ++i) s += sred[i * 256 + tid];
      const int dir = tid >> 7, dk = tid & 127;
      P.nvec[((size_t)(dir * 8 + bh) * NCH + n) * 128 + dk] = s;
    }
  }
}

DI void phase_mscan(const Params& P, int bid, int nblk) {
  constexpr int SB = 13;
  for (int gt = bid * NT + otid(); gt < 16 * 2048 + 256; gt += nblk * NT) {
    if (gt < 16 * 2048) {
      const int seq = gt >> 11, e = gt & 2047, dir = seq >> 3;
      float C[8];
      _Pragma("unroll") for (int j = 0; j < 8; ++j) C[j] = 0.f;
      float m = 0.f;
      for (int sb = 0; sb < NCH; sb += SB) {
        f32x4 u0[SB], u1[SB]; float gg[SB], aa[SB];
        _Pragma("unroll") for (int k = 0; k < SB; ++k) {
          const int n = dir == 0 ? sb + k : NCH - 1 - sb - k;
          const size_t item = (size_t)seq * NCH + n;
          const float* up = P.U + item * 16384 + e * 8;
          u0[k] = *(const f32x4*)up; u1[k] = *(const f32x4*)(up + 4);
          gg[k] = P.mstat[item * 4]; aa[k] = P.mstat[item * 4 + 1];
        }
        _Pragma("unroll") for (int k = 0; k < SB; ++k) {
          const int n = dir == 0 ? sb + k : NCH - 1 - sb - k;
          const size_t item = (size_t)seq * NCH + n;
          const float mn = fmaxf(gg[k] + m, aa[k]);
          const float decay = __expf(gg[k] + m - mn), f = __expf(aa[k] - mn);
          u32x4 cb; cb.x = pk2(C[0], C[1]); cb.y = pk2(C[2], C[3]); cb.z = pk2(C[4], C[5]); cb.w = pk2(C[6], C[7]);
          *(u32x4*)(P.U + item * 16384 + e * 8) = cb;
          C[0] = decay * C[0] + f * u0[k].x; C[1] = decay * C[1] + f * u0[k].y; C[2] = decay * C[2] + f * u0[k].z; C[3] = decay * C[3] + f * u0[k].w;
          C[4] = decay * C[4] + f * u1[k].x; C[5] = decay * C[5] + f * u1[k].y; C[6] = decay * C[6] + f * u1[k].z; C[7] = decay * C[7] + f * u1[k].w;
          m = mn;
        }
      }
    } else {
      const int q = gt - 16 * 2048, seq = q >> 4, e = q & 15, dir = seq >> 3;
      float nst[8];
      _Pragma("unroll") for (int j = 0; j < 8; ++j) nst[j] = 0.f;
      float m = 0.f;
      for (int sb = 0; sb < NCH; sb += SB) {
        f32x4 n0[SB], n1[SB]; float gg[SB], aa[SB];
        _Pragma("unroll") for (int k = 0; k < SB; ++k) {
          const int n = dir == 0 ? sb + k : NCH - 1 - sb - k;
          const size_t item = (size_t)seq * NCH + n;
          const float* np = P.nvec + item * 128 + e * 8;
          n0[k] = *(const f32x4*)np; n1[k] = *(const f32x4*)(np + 4);
          gg[k] = P.mstat[item * 4]; aa[k] = P.mstat[item * 4 + 1];
        }
        _Pragma("unroll") for (int k = 0; k < SB; ++k) {
          const int n = dir == 0 ? sb + k : NCH - 1 - sb - k;
          const size_t item = (size_t)seq * NCH + n;
          const float mn = fmaxf(gg[k] + m, aa[k]);
          const float decay = __expf(gg[k] + m - mn), f = __expf(aa[k] - mn);
          float* np = P.nvec + item * 128 + e * 8;
          *(f32x4*)np = mk4(nst[0], nst[1], nst[2], nst[3]); *(f32x4*)(np + 4) = mk4(nst[4], nst[5], nst[6], nst[7]);
          nst[0] = decay * nst[0] + f * n0[k].x; nst[1] = decay * nst[1] + f * n0[k].y; nst[2] = decay * nst[2] + f * n0[k].z; nst[3] = decay * nst[3] + f * n0[k].w;
          nst[4] = decay * nst[4] + f * n1[k].x; nst[5] = decay * nst[5] + f * n1[k].y; nst[6] = decay * nst[6] + f * n1[k].z; nst[7] = decay * nst[7] + f * n1[k].w;
          if (e == 0) P.mstat[item * 4 + 2] = m;
          m = mn;
        }
      }
    }
  }
}

DI void mout_item(const Params& P, int l, int it, char* smem) {
  const int tid = otid(), lane = tid & 63, w = tid >> 6, lr = lane & 31, lh = lane >> 5;
  const int bh = it / NCH, n = it % NCH, b = bh >> 2, hh = bh & 3;
  char* sK = smem;
  char* sV = smem + 32768;
  float* sb = (float*)(smem + 65536);
  float* sc = sb + 256;
  float* spm = sc + 256;
  float* snp = spm + 256;
  __syncthreads();
  {
    const int rin = lane >> 4, cpos = lane & 15;
    _Pragma("unroll") for (int i = 0; i < 16; ++i) {
      const int dir = i >> 3, R = (i & 7) * 4 + w, row = 4 * R + rin;
      const char* src = (const char*)(P.U + ((size_t)(dir * 8 + bh) * NCH + n) * 16384) + (size_t)row * 512 + (cpos ^ (row & 15)) * 32;
      __builtin_amdgcn_global_load_lds((const unsigned*)src, (lds_u32*)(smem + dir * 32768 + R * 1024), 16, 0, 0);
    }
  }
  {
    const int dir = tid >> 7, tau = tid & 127;
    const size_t base = ((size_t)dir * 8 + bh) * LPAD + 128 * n + tau;
    const float bb = P.bcum[base], li = P.ligate[base];
    sb[tid] = bb; sc[tid] = li - bb;
    snp[tid] = P.nvec[((size_t)(dir * 8 + bh) * NCH + n) * 128 + tau];
  }
  __syncthreads();
  if (w < 2) {
    const int i0 = w == 0 ? 2 * lane : 127 - 2 * lane, i1 = w == 0 ? 2 * lane + 1 : 126 - 2 * lane;
    const float e0 = sc[w * 128 + i0], e1 = sc[w * 128 + i1];
    const float p1 = fmaxf(e0, e1);
    float scan = p1;
    _Pragma("unroll") for (int d = 1; d < 64; d <<= 1) { const float tt = shfl_up_f(scan, d, lane); if (lane >= d) scan = fmaxf(scan, tt); }
    float excl = shfl_up_f(scan, 1, lane); if (lane == 0) excl = -3.0e38f;
    spm[w * 128 + i0] = fmaxf(excl, e0); spm[w * 128 + i1] = fmaxf(excl, p1);
  }
  __syncthreads();
  const int t = 32 * w + lr, p = 128 * n + t;
  bf16x8 qf[8];
  _Pragma("unroll") for (int ks = 0; ks < 8; ++ks) qf[ks] = ldfrag(P.qc + ((size_t)bh * LPAD + p) * 128 + 16 * ks + 8 * lh);
  f32x16 acc[2][4];
  float btv[2], mtv[2], den0[2];
  _Pragma("unroll") for (int dir = 0; dir < 2; ++dir) {
    const size_t item = (size_t)(dir * 8 + bh) * NCH + n;
    const float mprev = P.mstat[item * 4 + 2];
    const float bt = sb[dir * 128 + t];
    const float mt = bt + fmaxf(mprev, spm[dir * 128 + t]);
    const float inter = __expf(bt + mprev - mt);
    float qn = 0.f;
    _Pragma("unroll") for (int ks = 0; ks < 8; ++ks) {
      union { bf16x8 v; unsigned u[4]; } tt; tt.v = qf[ks];
      const float* np = snp + dir * 128 + 16 * ks + 8 * lh;
      _Pragma("unroll") for (int j = 0; j < 4; ++j) qn += bflo(tt.u[j]) * np[2 * j] + bfhi(tt.u[j]) * np[2 * j + 1];
    }
    qn = xsum32(qn);
    btv[dir] = bt; mtv[dir] = mt; den0[dir] = inter * qn;
    const char* sU = smem + dir * 32768;
    _Pragma("unroll") for (int d = 0; d < 4; ++d) {
      const int urow = 32 * d + lr;
      acc[dir][d] = zero16();
      _Pragma("unroll") for (int ks = 0; ks < 8; ++ks) acc[dir][d] = MFMA32(*(const bf16x8*)(sU + urow * 256 + (((2 * ks + lh) ^ (urow & 15)) << 4)), qf[ks], acc[dir][d]);
      _Pragma("unroll") for (int r = 0; r < 16; ++r) acc[dir][d][r] *= inter;
    }
  }
  __syncthreads();
  {
    const int rin = lane >> 4, cpos = lane & 15;
    _Pragma("unroll") for (int i = 0; i < 16; ++i) {
      const int R = i * 4 + w, row = (i < 8 ? 4 * R : 4 * (R - 32)) + rin;
      const int ce = (cpos ^ (row & 15)) * 8;
      const bf16_t* src = i < 8 ? P.kc + ((size_t)bh * LPAD + 128 * n + row) * 128 + ce : P.cvT + ((size_t)bh * 128 + row) * LPAD + 128 * n + ce;
      __builtin_amdgcn_global_load_lds((const unsigned*)src, (lds_u32*)(smem + R * 1024), 16, 0, 0);
    }
  }
  __syncthreads();
  _Pragma("unroll") for (int dir = 0; dir < 2; ++dir) {
    const float bt = btv[dir], mt = mtv[dir];
    float den = 0.f;
    const int st0 = dir == 0 ? 0 : w, st1 = dir == 0 ? w : 3;
    for (int st = st0; st <= st1; ++st) {
      f32x16 s = zero16();
      _Pragma("unroll") for (int ks = 0; ks < 8; ++ks) {
        const int krow = 32 * st + kswap(lr);
        s = MFMA32(*(const bf16x8*)(sK + krow * 256 + (((2 * ks + lh) ^ (krow & 15)) << 4)), qf[ks], s);
      }
      _Pragma("unroll") for (int r = 0; r < 16; ++r) {
        const int sidx = 32 * st + keyoff(r, lh);
        const bool ok = dir == 0 ? (sidx <= t) : (sidx >= t);
        const float dd = __expf(fminf(bt + sc[dir * 128 + sidx] - mt, 0.f));
        const float pv = ok ? s[r] * dd : 0.f;
        s[r] = pv; den += pv;
      }
      const bf16x8 p0 = packfrag(s, 0), p1 = packfrag(s, 1);
      _Pragma("unroll") for (int d = 0; d < 4; ++d) {
        const int vrow = 32 * d + lr;
        const char* vp = sV + vrow * 256;
        acc[dir][d] = MFMA32(*(const bf16x8*)(vp + (((4 * st + lh) ^ (vrow & 15)) << 4)), p0, acc[dir][d]);
        acc[dir][d] = MFMA32(*(const bf16x8*)(vp + (((4 * st + 2 + lh) ^ (vrow & 15)) << 4)), p1, acc[dir][d]);
      }
    }
    den = xsum32(den);
    den = den0[dir] + den;
    const float sca = frcp(fmaxf(fabsf(den), __expf(-mt)));
    _Pragma("unroll") for (int d = 0; d < 4; ++d) _Pragma("unroll") for (int r = 0; r < 16; ++r) acc[dir][d][r] *= sca;
  }
  float hacc[4][16];
  _Pragma("unroll") for (int d = 0; d < 4; ++d) _Pragma("unroll") for (int r = 0; r < 16; ++r) hacc[d][r] = acc[0][d][r] + acc[1][d][r];
  float s1 = 0.f;
  _Pragma("unroll") for (int d = 0; d < 4; ++d) _Pragma("unroll") for (int r = 0; r < 16; ++r) s1 += hacc[d][r];
  s1 = xsum32(s1);
  const float mu = s1 * (1.f / 128.f);
  float s2 = 0.f;
  _Pragma("unroll") for (int d = 0; d < 4; ++d) _Pragma("unroll") for (int r = 0; r < 16; ++r) { hacc[d][r] -= mu; s2 += hacc[d][r] * hacc[d][r]; }
  s2 = xsum32(s2);
  const float rs = rsqrtf(s2 * (1.f / 128.f) + LN_EPS);
  const int pos = p - MPAD;
  if (pos >= 0) {
    const size_t tok = (size_t)b * L + pos;
    _Pragma("unroll") for (int d = 0; d < 4; ++d) _Pragma("unroll") for (int rg = 0; rg < 4; ++rg) {
      const int dv = 32 * d + 8 * rg + 4 * lh;
      const int col = hh * 128 + dv;
      const u32x2 cu = *(const u32x2*)(P.co + tok * 512 + col);
      const f32x4 g4 = *(const f32x4*)(P.mlstm_g + l * 512 + col);
      const float o0 = hacc[d][4 * rg + 0] * rs * g4.x * sigmoidf_(bflo(cu.x));
      const float o1 = hacc[d][4 * rg + 1] * rs * g4.y * sigmoidf_(bfhi(cu.x));
      const float o2 = hacc[d][4 * rg + 2] * rs * g4.z * sigmoidf_(bflo(cu.y));
      const float o3 = hacc[d][4 * rg + 3] * rs * g4.w * sigmoidf_(bfhi(cu.y));
      u32x2 ou; ou.x = pk2(o0, o1); ou.y = pk2(o2, o3);
      *(u32x2*)(P.oc + tok * 512 + col) = ou;
    }
  }
}

constexpr int DA_STAGE = 32768;
constexpr float DA_THR = 8.f;
DI void dattn_issue(const Params& P, int bh, int k0, char* stage, unsigned vk, unsigned vv, int w) {
  const char* kb0 = (const char*)(P.ka + ((size_t)(bh * 2) * L + k0) * 64);
  const char* vb0 = (const char*)(P.vaT + (size_t)bh * 128 * LK + k0);
  _Pragma("unroll") for (int i = 0; i < 8; ++i) {
    const char* src = i < 4 ? kb0 + (size_t)(i >> 1) * (L * 128) + (i & 1) * 4096 + vk : vb0 + (size_t)(i - 4) * 32 * LK * 2 + vv;
    __builtin_amdgcn_global_load_lds((const unsigned*)src, (lds_u32*)(stage + (i * 4 + w) * 1024), 16, 0, 0);
  }
}
DI void dattn_merge4(f32x16 (&O)[2][4], float (&m)[2], float (&ls)[2], char* smem, int lane, int w) {
  float* xf = (float*)smem;
  for (int src = 1; src < 4; ++src) {
    __syncthreads();
    if (w == src) {
      _Pragma("unroll") for (int c = 0; c < 2; ++c) {
        _Pragma("unroll") for (int d = 0; d < 4; ++d) _Pragma("unroll") for (int r = 0; r < 16; ++r) xf[((c * 4 + d) * 16 + r) * 64 + lane] = O[c][d][r];
        xf[8192 + c * 64 + lane] = m[c]; xf[8192 + 128 + c * 64 + lane] = ls[c];
      }
    }
    __syncthreads();
    if (w == 0) {
      _Pragma("unroll") for (int c = 0; c < 2; ++c) {
        const float mb = xf[8192 + c * 64 + lane], lb = xf[8192 + 128 + c * 64 + lane];
        const float M = fmaxf(m[c], mb), fa = fexp2(m[c] - M), fb = fexp2(mb - M);
        ls[c] = ls[c] * fa + lb * fb; m[c] = M;
        _Pragma("unroll") for (int d = 0; d < 4; ++d) _Pragma("unroll") for (int r = 0; r < 16; ++r) O[c][d][r] = O[c][d][r] * fa + xf[((c * 4 + d) * 16 + r) * 64 + lane] * fb;
      }
    }
  }
}
DI void dattn_finish(const Params& P, int l, int bh, int q0, f32x16 (&O)[2][4], const float (&ls)[2], int lr, int lh) {
  const int b = bh >> 2, hh = bh & 3;
  const float lam = P.lam[l], omli = P.lam[2 + l];
  const float i0 = 1.f / ls[0], i1 = lam / ls[1];
  float ss = 0.f;
  _Pragma("unroll") for (int d = 0; d < 4; ++d) _Pragma("unroll") for (int r = 0; r < 16; ++r) { const float o = O[0][d][r] * i0 - O[1][d][r] * i1; O[0][d][r] = o; ss += o * o; }
  ss = xsum32(ss);
  const float rs = rsqrtf(ss * (1.f / 128.f) + LN_EPS);
  if (q0 + lr < L) {
    const size_t tok = (size_t)b * L + q0 + lr;
    _Pragma("unroll") for (int d = 0; d < 4; ++d) _Pragma("unroll") for (int rg = 0; rg < 4; ++rg) {
      const int dv = 32 * d + 8 * rg + 4 * lh;
      const f32x4 g4 = *(const f32x4*)(P.diff_g + l * 128 + dv);
      u32x2 ou;
      ou.x = pk2(O[0][d][4 * rg + 0] * rs * g4.x * omli, O[0][d][4 * rg + 1] * rs * g4.y * omli);
      ou.y = pk2(O[0][d][4 * rg + 2] * rs * g4.z * omli, O[0][d][4 * rg + 3] * rs * g4.w * omli);
      *(u32x2*)(P.oa + tok * 512 + hh * 128 + dv) = ou;
    }
  }
}
DI void da_softmax(f32x16& s, float& m, float& ls, f32x16 (&O)[4], bool last, int key0, int lh, bf16x8& p0, bf16x8& p1) {
  if (last) {
    asm volatile("; last key tile: mask" ::: "memory");
    _Pragma("unroll") for (int r = 0; r < 16; ++r) if (key0 + keyoff(r, lh) >= L) s[r] = -3.0e38f;
  }
  float mx = s[0];
  _Pragma("unroll") for (int r = 1; r < 16; ++r) mx = fmaxf(mx, s[r]);
  if (__any(mx - m > DA_THR)) {
    asm volatile("; rare: move the softmax reference" ::: "memory");
    const float dlt = fmaxf(xmax32(mx) - m, 0.f);
    const float al = fexp2(-dlt);
    m += dlt; ls *= al;
    _Pragma("unroll") for (int d = 0; d < 4; ++d) _Pragma("unroll") for (int r = 0; r < 16; ++r) O[d][r] *= al;
  }
  f32x2 rs2 = mk2(0.f, 0.f);
  _Pragma("unroll") for (int i = 0; i < 8; ++i) {
    f32x2 x = mk2(s[2 * i], s[2 * i + 1]) - mk2(m, m);
    x.x = fexp2(x.x); x.y = fexp2(x.y);
    s[2 * i] = x.x; s[2 * i + 1] = x.y;
    rs2 += x;
  }
  ls += rs2.x + rs2.y;
  p0 = packfrag(s, 0); p1 = packfrag(s, 1);
}
constexpr int DA_PART = 2 * 4 * 16 * 64 + 256;
DI void dattn_item(const Params& P, int l, int it, bool part, char* smem) {
  const int tid = otid(), lane = tid & 63, w = tid >> 6, lr = lane & 31, lh = lane >> 5;
  const int bh = it & 7, jq = it >> 3;
  const int q0 = part ? 8192 : jq * 128 + 32 * w;
  const int qi = min(q0 + lr, L - 1);
  constexpr int NTILE = (L + 63) / 64;
  const int t0 = part ? 2 * jq : 0, t1 = part ? (jq == 63 ? NTILE : 2 * jq + 2) : NTILE;
  bf16x8 qf[2][4];
  _Pragma("unroll") for (int c = 0; c < 2; ++c) _Pragma("unroll") for (int ks = 0; ks < 4; ++ks)
    qf[c][ks] = ldfrag(P.qa + ((size_t)(bh * 2 + c) * L + qi) * 64 + 16 * ks + 8 * lh);
  f32x16 O[2][4];
  float m[2], ls[2];
  _Pragma("unroll") for (int c = 0; c < 2; ++c) {
    f32x16 s = zero16();
    const bf16_t* kp = P.ka + ((size_t)(bh * 2 + c) * L + t0 * 64 + kswap(lr)) * 64 + 8 * lh;
    _Pragma("unroll") for (int ks = 0; ks < 4; ++ks) s = MFMA32(ldfrag(kp + 16 * ks), qf[c][ks], s);
    float mx = s[0];
    _Pragma("unroll") for (int r = 1; r < 16; ++r) mx = fmaxf(mx, s[r]);
    m[c] = xmax32(mx); ls[c] = 0.f;
    _Pragma("unroll") for (int d = 0; d < 4; ++d) O[c][d] = zero16();
  }
  const unsigned vk = (unsigned)((w * 8 + (lane >> 3)) * 128 + (((lane & 7) ^ (4 * (w & 1) + (lane >> 4))) << 4));
  const unsigned vv = (unsigned)((w * 8 + (lane >> 3)) * (LK * 2) + (((lane & 7) ^ (4 * (w & 1) + (lane >> 4))) << 4));
  __syncthreads();
  dattn_issue(P, bh, t0 * 64, smem + (t0 & 1) * DA_STAGE, vk, vv, w);
  for (int t = t0; t < t1; ++t) {
    __syncthreads();
    if (t + 1 < t1) dattn_issue(P, bh, (t + 1) * 64, smem + ((t + 1) & 1) * DA_STAGE, vk, vv, w);
    const char* st = smem + (t & 1) * DA_STAGE;
    _Pragma("unroll") for (int kb = 0; kb < 2; ++kb) {
      if (part && ((((t - t0) * 2 + kb) & 3) != w)) continue;
      bf16x8 pf[2][2];
      _Pragma("unroll") for (int c = 0; c < 2; ++c) {
        f32x16 s;
        _Pragma("unroll") for (int r = 0; r < 16; ++r) s[r] = -m[c];
        const int krow = kb * 32 + kswap(lr);
        const char* kp = st + c * 8192 + krow * 128;
        _Pragma("unroll") for (int ks = 0; ks < 4; ++ks) s = MFMA32(*(const bf16x8*)(kp + (((2 * ks + lh) ^ swz(krow)) << 4)), qf[c][ks], s);
        if (t == NTILE - 1) {
          _Pragma("unroll") for (int r = 0; r < 16; ++r) if (t * 64 + kb * 32 + keyoff(r, lh) >= L) s[r] = -3.0e38f;
        }
        float mx = s[0];
        _Pragma("unroll") for (int r = 1; r < 16; ++r) mx = fmaxf(mx, s[r]);
        if (__any(mx > DA_THR)) {
          asm volatile("; rare: move the softmax reference" ::: "memory");
          const float dlt = fmaxf(xmax32(mx), 0.f);
          const float al = fexp2(-dlt);
          m[c] += dlt; ls[c] *= al;
          _Pragma("unroll") for (int d = 0; d < 4; ++d) _Pragma("unroll") for (int r = 0; r < 16; ++r) O[c][d][r] *= al;
          _Pragma("unroll") for (int r = 0; r < 16; ++r) s[r] -= dlt;
        }
        float rsum = 0.f;
        _Pragma("unroll") for (int r = 0; r < 16; ++r) { const float pv = fexp2(s[r]); s[r] = pv; rsum += pv; }
        ls[c] += rsum;
        pf[c][0] = packfrag(s, 0); pf[c][1] = packfrag(s, 1);
      }
      _Pragma("unroll") for (int d = 0; d < 4; ++d) {
        const int vrow = 32 * d + lr;
        const char* vp = st + 16384 + vrow * 128;
        const bf16x8 v0 = *(const bf16x8*)(vp + (((kb * 4 + lh) ^ swz(vrow)) << 4));
        const bf16x8 v1 = *(const bf16x8*)(vp + (((kb * 4 + 2 + lh) ^ swz(vrow)) << 4));
        _Pragma("unroll") for (int c = 0; c < 2; ++c) { O[c][d] = MFMA32(v0, pf[c][0], O[c][d]); O[c][d] = MFMA32(v1, pf[c][1], O[c][d]); }
      }
    }
  }
  _Pragma("unroll") for (int c = 0; c < 2; ++c) ls[c] = xsum32(ls[c]);
  if (part) {
    dattn_merge4(O, m, ls, smem, lane, w);
    if (w == 0) {
      float* pb = (float*)P.merged + (size_t)it * DA_PART + lane;
      _Pragma("unroll") for (int c = 0; c < 2; ++c) {
        _Pragma("unroll") for (int d = 0; d < 4; ++d) {
          float* pp = pb + (c * 4 + d) * 1024;
          asm volatile("" : "+v"(pp));
          _Pragma("unroll") for (int r = 0; r < 16; ++r) pp[r * 64] = O[c][d][r];
        }
        pb[8192 + c * 64] = m[c]; pb[8192 + 128 + c * 64] = ls[c];
      }
    }
    return;
  }
  dattn_finish(P, l, bh, q0, O, ls, lr, lh);
}
DI void da_qk(f32x16& s, const char* st, int c, int kb, int lr, int lh, const bf16x8 (&qf)[4]) {
  s = zero16();
  const int krow = kb * 32 + kswap(lr);
  const char* kp = st + c * 8192 + krow * 128;
  _Pragma("unroll") for (int ks = 0; ks < 4; ++ks) s = MFMA32(*(const bf16x8*)(kp + (((2 * ks + lh) ^ swz(krow)) << 4)), qf[ks], s);
}
DI void dattn_item8(const Params& P, int l, int it, char* smem_wg) {
  int tid = rtid(); asm volatile("" : "+v"(tid));
  const int lane = tid & 63, w = __builtin_amdgcn_readfirstlane(tid >> 6), g = w & 3, c = w >> 2, lr = lane & 31, lh = lane >> 5;
  const int bh = it & 7, jq = it >> 3;
  const int q0 = jq * 128 + 32 * g;
  constexpr int NT8 = (L + 127) / 128;
  bf16x8 qf[4];
  _Pragma("unroll") for (int ks = 0; ks < 4; ++ks) qf[ks] = ldfrag(P.qa + ((size_t)(bh * 2 + c) * L + q0 + lr) * 64 + 16 * ks + 8 * lh);
  f32x16 O[4];
  float m, ls = 0.f;
  {
    f32x16 s = zero16();
    const bf16_t* kp = P.ka + ((size_t)(bh * 2 + c) * L + kswap(lr)) * 64 + 8 * lh;
    _Pragma("unroll") for (int ks = 0; ks < 4; ++ks) s = MFMA32(ldfrag(kp + 16 * ks), qf[ks], s);
    float mx = s[0];
    _Pragma("unroll") for (int r = 1; r < 16; ++r) mx = fmaxf(mx, s[r]);
    m = xmax32(mx);
    _Pragma("unroll") for (int d = 0; d < 4; ++d) O[d] = zero16();
  }
  const unsigned vk = (unsigned)((g * 8 + (lane >> 3)) * 128 + (((lane & 7) ^ (4 * (g & 1) + (lane >> 4))) << 4));
  const unsigned vv = (unsigned)((g * 8 + (lane >> 3)) * (LK * 2) + (((lane & 7) ^ (4 * (g & 1) + (lane >> 4))) << 4));
  constexpr int ST8 = 2 * DA_STAGE;
  __syncthreads();
  dattn_issue(P, bh, c * 64, smem_wg + c * DA_STAGE, vk, vv, g);
  for (int t = 0; t < NT8; ++t) {
    __syncthreads();
    if (t + 1 < NT8) dattn_issue(P, bh, (t + 1) * 128 + c * 64, smem_wg + ((t + 1) & 1) * ST8 + c * DA_STAGE, vk, vv, g);
    const char* stt = smem_wg + (t & 1) * ST8;
    f32x16 S[4];
    _Pragma("unroll") for (int b = 0; b < 4; ++b) da_qk(S[b], stt + (b >> 1) * DA_STAGE, c, b & 1, lr, lh, qf);
    if (t == NT8 - 1) {
      asm volatile("; last key tile: mask" ::: "memory");
      _Pragma("unroll") for (int b = 0; b < 4; ++b) _Pragma("unroll") for (int r = 0; r < 16; ++r) if (t * 128 + b * 32 + keyoff(r, lh) >= L) S[b][r] = -3.0e38f;
    }
    float mx = S[0][0];
    _Pragma("unroll") for (int b = 0; b < 4; ++b) _Pragma("unroll") for (int r = 0; r < 16; ++r) mx = fmaxf(mx, S[b][r]);
    if (__any(mx - m > DA_THR)) {
      asm volatile("; rare: move the softmax reference" ::: "memory");
      const float dlt = fmaxf(xmax32(mx) - m, 0.f);
      const float al = fexp2(-dlt);
      m += dlt; ls *= al;
      _Pragma("unroll") for (int d = 0; d < 4; ++d) _Pragma("unroll") for (int r = 0; r < 16; ++r) O[d][r] *= al;
    }
    f32x2 rs2 = mk2(0.f, 0.f);
    const f32x2 mm = mk2(m, m);
    _Pragma("unroll") for (int h2 = 0; h2 < 2; ++h2) {
      bf16x8 pf[2][2];
      _Pragma("unroll") for (int kb = 0; kb < 2; ++kb) {
        f32x16& s = S[2 * h2 + kb];
        _Pragma("unroll") for (int i = 0; i < 8; ++i) {
          f32x2 x = mk2(s[2 * i], s[2 * i + 1]) - mm;
          x.x = fexp2(x.x); x.y = fexp2(x.y);
          s[2 * i] = x.x; s[2 * i + 1] = x.y;
          rs2 += x;
        }
        pf[kb][0] = packfrag(s, 0); pf[kb][1] = packfrag(s, 1);
      }
      const char* st = stt + h2 * DA_STAGE;
      _Pragma("unroll") for (int kb = 0; kb < 2; ++kb) _Pragma("unroll") for (int d = 0; d < 4; ++d) {
        const int vrow = 32 * d + lr;
        const char* vp = st + 16384 + vrow * 128;
        const bf16x8 v0 = *(const bf16x8*)(vp + (((kb * 4 + lh) ^ swz(vrow)) << 4));
        const bf16x8 v1 = *(const bf16x8*)(vp + (((kb * 4 + 2 + lh) ^ swz(vrow)) << 4));
        O[d] = MFMA32(v0, pf[kb][0], O[d]); O[d] = MFMA32(v1, pf[kb][1], O[d]);
      }
    }
    ls += rs2.x + rs2.y;
  }
  ls = xsum32(ls);
  float* xf = (float*)smem_wg + g * 4096;
  __syncthreads();
  if (c == 1) {
    const float i1 = P.lam[l] / ls;
    _Pragma("unroll") for (int d = 0; d < 4; ++d) _Pragma("unroll") for (int r = 0; r < 16; ++r) xf[(d * 16 + r) * 64 + lane] = O[d][r] * i1;
  }
  __syncthreads();
  if (c == 0) {
    const int b = bh >> 2, hh = bh & 3;
    const float omli = P.lam[2 + l], i0 = 1.f / ls;
    float ss = 0.f;
    _Pragma("unroll") for (int d = 0; d < 4; ++d) _Pragma("unroll") for (int r = 0; r < 16; ++r) { const float o = O[d][r] * i0 - xf[(d * 16 + r) * 64 + lane]; O[d][r] = o; ss += o * o; }
    ss = xsum32(ss);
    const float rs = rsqrtf(ss * (1.f / 128.f) + LN_EPS);
    const size_t tok = (size_t)b * L + q0 + lr;
    _Pragma("unroll") for (int d = 0; d < 4; ++d) _Pragma("unroll") for (int rg = 0; rg < 4; ++rg) {
      const int dv = 32 * d + 8 * rg + 4 * lh;
      const f32x4 g4 = *(const f32x4*)(P.diff_g + l * 128 + dv);
      u32x2 ou;
      ou.x = pk2(O[d][4 * rg + 0] * rs * g4.x * omli, O[d][4 * rg + 1] * rs * g4.y * omli);
      ou.y = pk2(O[d][4 * rg + 2] * rs * g4.z * omli, O[d][4 * rg + 3] * rs * g4.w * omli);
      *(u32x2*)(P.oa + tok * 512 + hh * 128 + dv) = ou;
    }
  }
}
DI void dattn_combine(const Params& P, int l, int bh, char* smem) {
  const int tid = otid(), lane = tid & 63, w = tid >> 6, lr = lane & 31, lh = lane >> 5;
  f32x16 O[2][4];
  float m[2], ls[2];
  __syncthreads();
  for (int k = 0; k < 16; ++k) {
    const float* pb = (const float*)P.merged + (size_t)(bh + 8 * (w * 16 + k)) * DA_PART + lane;
    _Pragma("unroll") for (int c = 0; c < 2; ++c) {
      const float mb = pb[8192 + c * 64], lb = pb[8192 + 128 + c * 64];
      float fa, fb;
      if (k == 0) { m[c] = mb; ls[c] = lb; fa = 0.f; fb = 1.f; }
      else { const float M = fmaxf(m[c], mb); fa = fexp2(m[c] - M); fb = fexp2(mb - M); ls[c] = ls[c] * fa + lb * fb; m[c] = M; }
      _Pragma("unroll") for (int d = 0; d < 4; ++d) {
        const float* pp = pb + (c * 4 + d) * 1024;
        asm volatile("" : "+v"(pp));
        _Pragma("unroll") for (int r = 0; r < 16; ++r) {
          const float ov = pp[r * 64];
          O[c][d][r] = k == 0 ? ov : O[c][d][r] * fa + ov * fb;
        }
      }
    }
  }
  dattn_merge4(O, m, ls, smem, lane, w);
  if (w == 0) dattn_finish(P, l, bh, 8192, O, ls, lr, lh);
}

DI void swa_item(const Params& P, int l, int it, char* smem) {
  const int tid = otid(), lane = tid & 63, w = tid >> 6, lr = lane & 31, lh = lane >> 5;
  const int NQT = (L + 31) / 32;
  const int bk = it / NQT, qt = it % NQT, b = bk >> 1, kv = bk & 1, hq = kv * 4 + w;
  const int q0 = qt * 32;
  const int qi = min(q0 + lr, L - 1);
  bf16x8 qf[4];
  _Pragma("unroll") for (int ks = 0; ks < 4; ++ks) qf[ks] = ldfrag(P.qb + ((size_t)(b * 8 + hq) * L + qi) * 64 + 16 * ks + 8 * lh);
  f32x16 O[2]; O[0] = zero16(); O[1] = zero16();
  float m = P.sink[l * 8 + hq] * 1.44269504088896341f, ls = 1.f;
  const bf16_t* kbase = P.kb + (size_t)(b * 2 + kv) * L * 64;
  const bf16_t* vbase = P.vbT + (size_t)(b * 2 + kv) * 64 * LK;
  const int qpos = q0 + lr;
  char* wk = smem + w * 16384;
  char* wv = wk + 8192;
  bf16x8 tk[2][2][4], tv[2][2][4];
#define SWA_LDK(dst, bi_) { const int k1_ = (bi_) == 0 ? 0 : q0 - 160 + 32 * (bi_); \
    _Pragma("unroll") for (int i = 0; i < 4; ++i) { const int krow_ = min(max(k1_ + 8 * i + (lane >> 3), 0), L - 1); dst[i] = ldfrag(kbase + (size_t)krow_ * 64 + (lane & 7) * 8); } }
#define SWA_LDV(dst, bi_) { const int k0_ = (bi_) == 0 ? 0 : q0 - 160 + 32 * (bi_); const int kc0_ = min(max(k0_, 0), LK - 32); \
    _Pragma("unroll") for (int i = 0; i < 4; ++i) dst[i] = ldfrag(vbase + (size_t)(16 * i + (lane >> 2)) * LK + kc0_ + (lane & 3) * 8); }
  SWA_LDK(tk[0][0], 0) SWA_LDK(tk[0][1], 1) SWA_LDV(tv[0][0], 0) SWA_LDV(tv[0][1], 1)
  __builtin_amdgcn_sched_barrier(0);
  _Pragma("unroll") for (int pr = 0; pr < 5; ++pr) {
    const int cp = pr & 1;
    _Pragma("unroll") for (int x = 0; x < 2; ++x) _Pragma("unroll") for (int i = 0; i < 4; ++i) {
      const int r = 8 * i + (lane >> 3);
      *(bf16x8*)(wk + x * 4096 + r * 128 + ((((lane & 7)) ^ swz(r)) << 4)) = tk[cp][x][i];
      const int rv = 16 * i + (lane >> 2);
      *(bf16x8*)(wv + x * 4096 + rv * 64 + ((((lane & 3)) ^ ((rv >> 2) & 3)) << 4)) = tv[cp][x][i];
    }
    __builtin_amdgcn_sched_barrier(0);
    if (pr + 1 < 5) { SWA_LDK(tk[cp ^ 1][0], 2 * pr + 2) SWA_LDK(tk[cp ^ 1][1], 2 * pr + 3) SWA_LDV(tv[cp ^ 1][0], 2 * pr + 2) SWA_LDV(tv[cp ^ 1][1], 2 * pr + 3) }
    __builtin_amdgcn_sched_barrier(0);
    f32x16 s[2];
    _Pragma("unroll") for (int x = 0; x < 2; ++x) {
      s[x] = zero16();
      const int krow = kswap(lr);
      _Pragma("unroll") for (int ks = 0; ks < 4; ++ks) s[x] = MFMA32(*(const bf16x8*)(wk + x * 4096 + krow * 128 + (((2 * ks + lh) ^ swz(krow)) << 4)), qf[ks], s[x]);
    }
    float mx = -3.0e38f;
    _Pragma("unroll") for (int x = 0; x < 2; ++x) {
      const int bi = 2 * pr + x;
      const int k0 = bi == 0 ? 0 : q0 - 160 + 32 * bi;
      _Pragma("unroll") for (int r = 0; r < 16; ++r) {
        const int kj = k0 + keyoff(r, lh);
        bool ok;
        if (bi == 0) ok = kj < NMETA;
        else ok = kj >= NMETA && kj < L && kj >= qpos - 128 && kj <= qpos + 128;
        const float v = ok ? s[x][r] : -3.0e38f;
        s[x][r] = v; mx = fmaxf(mx, v);
      }
    }
    mx = xmax32(mx);
    const float mn = fmaxf(m, mx);
    const float al = fexp2(m - mn);
    float rsum = 0.f;
    _Pragma("unroll") for (int x = 0; x < 2; ++x) _Pragma("unroll") for (int r = 0; r < 16; ++r) { const float pv = fexp2(s[x][r] - mn); s[x][r] = pv; rsum += pv; }
    rsum = xsum32(rsum);
    ls = ls * al + rsum; m = mn;
    _Pragma("unroll") for (int d = 0; d < 2; ++d) _Pragma("unroll") for (int r = 0; r < 16; ++r) O[d][r] *= al;
    _Pragma("unroll") for (int x = 0; x < 2; ++x) {
      const bf16x8 p0 = packfrag(s[x], 0), p1 = packfrag(s[x], 1);
      _Pragma("unroll") for (int d = 0; d < 2; ++d) {
        const int vrow = 32 * d + lr;
        const char* vp = wv + x * 4096 + vrow * 64;
        const int sx = (vrow >> 2) & 3;
        O[d] = MFMA32(*(const bf16x8*)(vp + ((lh ^ sx) << 4)), p0, O[d]);
        O[d] = MFMA32(*(const bf16x8*)(vp + (((2 + lh) ^ sx) << 4)), p1, O[d]);
      }
    }
    __builtin_amdgcn_sched_barrier(0);
  }
#undef SWA_LDK
#undef SWA_LDV
  if (qpos < L) {
    const float inv = 1.f / ls;
    const size_t tok = (size_t)b * L + qpos;
    _Pragma("unroll") for (int d = 0; d < 2; ++d) _Pragma("unroll") for (int rg = 0; rg < 4; ++rg) {
      const int dv = 32 * d + 8 * rg + 4 * lh;
      u32x2 ou;
      ou.x = pk2(O[d][4 * rg + 0] * inv, O[d][4 * rg + 1] * inv);
      ou.y = pk2(O[d][4 * rg + 2] * inv, O[d][4 * rg + 3] * inv);
      *(u32x2*)(P.ob + tok * 512 + hq * 64 + dv) = ou;
    }
  }
}

constexpr int P3_MT = TP / 128, P3_NT = D / 128;
DI void tail_reduce(const f32x16& acc, char* smem_wg, int w, int lane, float (&v)[2]) {
  float* red = (float*)smem_wg;
  __syncthreads();
  _Pragma("unroll") for (int r = 0; r < 16; ++r) red[(w * 16 + r) * 64 + lane] = acc[r];
  __syncthreads();
  _Pragma("unroll") for (int j = 0; j < 2; ++j) {
    float s = 0.f;
    _Pragma("unroll") for (int x = 0; x < 8; ++x) s += red[(x * 16 + 2 * w + j) * 64 + lane];
    v[j] = s;
  }
  __syncthreads();
}
DI void p3a_tail(const Params& P, char* smem_wg, int wg) {
  int tid = rtid(); asm volatile("" : "+v"(tid));
  const int lane = tid & 63, w = tid >> 6, lr = lane & 31, lh = lane >> 5;
  const int n0 = 32 * wg, k0 = 64 * w + 8 * lh;
  f32x16 tot = zero16();
  _Pragma("unroll 1") for (int br = 0; br < 3; ++br) {
    const bf16_t* A = P.oa + ((size_t)br * TP + 16384 + lr) * 512 + k0;
    const bf16_t* B = P.w_br_t + ((size_t)br * 1024 + n0 + lr) * 512 + k0;
    f32x16 part = zero16();
    _Pragma("unroll") for (int ks = 0; ks < 4; ++ks) part = MFMA32(ldfrag(A + 16 * ks), ldfrag(B + 16 * ks), part);
    _Pragma("unroll") for (int r = 0; r < 16; ++r) tot[r] += bf2f(P.gz[(size_t)(16384 + crow(r, lh)) * 3072 + br * 1024 + n0 + lr]) * part[r];
  }
  float v[2];
  tail_reduce(tot, smem_wg, w, lane, v);
  _Pragma("unroll") for (int j = 0; j < 2; ++j) P.merged[(size_t)(16384 + crow(2 * w + j, lh)) * D + n0 + lr] = f2bf(v[j]);
}
DI void p3b_tail(const Params& P, char* smem_wg, int wg) {
  int tid = rtid(); asm volatile("" : "+v"(tid));
  const int lane = tid & 63, w = tid >> 6, lr = lane & 31, lh = lane >> 5;
  const int n0 = 32 * wg, k0 = 128 * w + 8 * lh;
  const bf16_t* A = P.merged + (size_t)(16384 + lr) * D + k0;
  const bf16_t* B = P.w_out_t + (size_t)(n0 + lr) * D + k0;
  f32x16 acc = zero16();
  _Pragma("unroll") for (int ks = 0; ks < 8; ++ks) acc = MFMA32(ldfrag(A + 16 * ks), ldfrag(B + 16 * ks), acc);
  float v[2];
  tail_reduce(acc, smem_wg, w, lane, v);
  _Pragma("unroll") for (int j = 0; j < 2; ++j) { float* hp = P.h + (size_t)(16384 + crow(2 * w + j, lh)) * D + n0 + lr; *hp = ALPHA * (*hp) + v[j]; }
}
struct SchedP3a {
  static constexpr bool GATHER = false;
  const char* A; const char* B; int G, c;
  DI bool next(int i, g8::Unit& u) const {
    const int ti = i / 3, br = i - 3 * ti; int pm, pn;
    if (!g8::grid_unit(ti, G, c, 64, 4, pm, pn)) return false;
    u.pm = pm; u.pn = pn; u.tag = br;
    u.a = A + ((size_t)br * TP + (size_t)pm * 256) * 512 * 2; u.b = B + ((size_t)br * 1024 + (size_t)pn * 256) * 512 * 2; return true;
  }
  DI void arows(const g8::Unit&, int, unsigned (&)[2]) const {}
};
struct EpiP3a {
  static constexpr bool PERM = true;
  const bf16_t* gz; bf16_t* merged;
  DI bool keep(const g8::Unit& u) const { return u.tag < 2; }
  DI void operator()(g8::f32x4 (&acc)[2][2][4][2], const g8::Unit& u, int wr, int wc, int fr, int fq) const {
    const int br = u.tag;
    const bf16_t* g0 = gz + (size_t)(u.pm * 256 + 64 * wr + fr) * 3072 + br * 1024 + u.pn * 256 + 32 * wc + 8 * fq;
    _Pragma("unroll") for (int ai = 0; ai < 2; ++ai) {
      u32x4 ga[4][2], gb[4][2];
      _Pragma("unroll") for (int m = 0; m < 4; ++m) _Pragma("unroll") for (int bj = 0; bj < 2; ++bj) ga[m][bj] = *(const u32x4*)(g0 + (size_t)(128 * ai + 16 * m) * 3072 + 128 * bj);
      if (br < 2) {
        _Pragma("unroll") for (int m = 0; m < 4; ++m) _Pragma("unroll") for (int bj = 0; bj < 2; ++bj) gb[m][bj] = *(const u32x4*)(g0 + (size_t)(128 * ai + 16 * m) * 3072 + 128 * bj + 1024);
        __builtin_amdgcn_sched_barrier(0);
        _Pragma("unroll") for (int m = 0; m < 4; ++m) _Pragma("unroll") for (int bj = 0; bj < 2; ++bj) {
          const u32x4 a = ga[m][bj], b = gb[m][bj];
          acc[ai][bj][m][0][0] *= bflo(a.x) * frcp(bflo(b.x)); acc[ai][bj][m][0][1] *= bfhi(a.x) * frcp(bfhi(b.x));
          acc[ai][bj][m][0][2] *= bflo(a.y) * frcp(bflo(b.y)); acc[ai][bj][m][0][3] *= bfhi(a.y) * frcp(bfhi(b.y));
          acc[ai][bj][m][1][0] *= bflo(a.z) * frcp(bflo(b.z)); acc[ai][bj][m][1][1] *= bfhi(a.z) * frcp(bfhi(b.z));
          acc[ai][bj][m][1][2] *= bflo(a.w) * frcp(bflo(b.w)); acc[ai][bj][m][1][3] *= bfhi(a.w) * frcp(bfhi(b.w));
        }
      } else {
        __builtin_amdgcn_sched_barrier(0);
        _Pragma("unroll") for (int m = 0; m < 4; ++m) _Pragma("unroll") for (int bj = 0; bj < 2; ++bj) {
          const u32x4 a = ga[m][bj];
          u32x4 o;
          o.x = pk2(acc[ai][bj][m][0][0] * bflo(a.x), acc[ai][bj][m][0][1] * bfhi(a.x)); o.y = pk2(acc[ai][bj][m][0][2] * bflo(a.y), acc[ai][bj][m][0][3] * bfhi(a.y));
          o.z = pk2(acc[ai][bj][m][1][0] * bflo(a.z), acc[ai][bj][m][1][1] * bfhi(a.z)); o.w = pk2(acc[ai][bj][m][1][2] * bflo(a.w), acc[ai][bj][m][1][3] * bfhi(a.w));
          *(u32x4*)(merged + (size_t)(u.pm * 256 + 128 * ai + 64 * wr + 16 * m + fr) * D + u.pn * 256 + 128 * bj + 32 * wc + 8 * fq) = o;
        }
      }
      __builtin_amdgcn_sched_barrier(0);
    }
  }
};
DI void phase_p3a(const Params& P, int l, char* smem, char* smem_wg, int bid, int nblk) {
  if ((bid >> 1) < 32) p3a_tail(P, smem_wg, bid >> 1);
  {
    SchedP3a S; S.A = (const char*)P.oa; S.B = (const char*)P.w_br_t; S.G = nblk >> 1; S.c = bid >> 1;
    EpiP3a E; E.gz = P.gz; E.merged = P.merged;
    g8::gemm_phase((g8::lds_u8*)smem_wg, 512, S, E);
  }
}
struct SchedP3b {
  static constexpr bool GATHER = false;
  const char* A; const char* B; int G, c;
  DI bool next(int i, g8::Unit& u) const { int pm, pn; if (!g8::grid_unit(i, G, c, 64, 4, pm, pn)) return false; u.pm = pm; u.pn = pn; u.tag = 0; u.a = A + (size_t)pm * 256 * D * 2; u.b = B + (size_t)pn * 256 * D * 2; return true; }
  DI void arows(const g8::Unit&, int, unsigned (&)[2]) const {}
};
struct EpiP3b {
  static constexpr bool PERM = false;
  float* h;
  DI bool keep(const g8::Unit&) const { return false; }
  DI void operator()(g8::f32x4 (&acc)[2][2][4][2], const g8::Unit& u, int wr, int wc, int fr, int fq) const {
    float* h0 = h + (size_t)(u.pm * 256 + 64 * wr + fr) * D + u.pn * 256 + 32 * wc + 4 * fq;
    _Pragma("unroll") for (int ai = 0; ai < 2; ++ai) {
      g8::f32x4 hv[4][2][2];
      _Pragma("unroll") for (int m = 0; m < 4; ++m) _Pragma("unroll") for (int bj = 0; bj < 2; ++bj) _Pragma("unroll") for (int n = 0; n < 2; ++n)
        hv[m][bj][n] = *(const g8::f32x4*)(h0 + (size_t)(128 * ai + 16 * m) * D + 128 * bj + 16 * n);
      __builtin_amdgcn_sched_barrier(0);
      _Pragma("unroll") for (int m = 0; m < 4; ++m) _Pragma("unroll") for (int bj = 0; bj < 2; ++bj) _Pragma("unroll") for (int n = 0; n < 2; ++n)
        *(g8::f32x4*)(h0 + (size_t)(128 * ai + 16 * m) * D + 128 * bj + 16 * n) = ALPHA * hv[m][bj][n] + acc[ai][bj][m][n];
      __builtin_amdgcn_sched_barrier(0);
    }
  }
};
DI void phase_p3b(const Params& P, int l, char* smem, char* smem_wg, int bid, int nblk) {
  if ((bid >> 1) < 32) p3b_tail(P, smem_wg, bid >> 1);
  {
    SchedP3b S; S.A = (const char*)P.merged; S.B = (const char*)P.w_out_t; S.G = nblk >> 1; S.c = bid >> 1;
    EpiP3b E; E.h = P.h;
    g8::gemm_phase(( g8::lds_u8*)smem_wg, D, S, E);
  }
}

typedef __attribute__((ext_vector_type(4))) float f32x4v;
DI void phase_router_prep(const Params& P, int bid, int nblk) {
  const int gtid = bid * NT + otid(), gn = nblk * NT;
  for (int i = gtid; i < 2 * 64 * 3 * 64 * 4; i += gn) {
    const int sidx = i & 3, lane = (i >> 2) & 63, n = (i >> 8) % 3, chunk = ((i >> 8) / 3) & 63, l = (i >> 8) / 192;
    const int c = 16 * chunk + 4 * (lane >> 4) + sidx, j = lane & 15;
    float wv = 0.f;
    if (n < 2) wv = P.w_re[((size_t)l * D + c) * 32 + 16 * n + j];
    else if (j < 4) wv = P.w_rg[((size_t)l * D + c) * 4 + j];
    P.rwp[i] = wv * P.ln1_g[l * D + c];
  }
  const int wv_ = gtid >> 6, lane = gtid & 63;
  if (wv_ < 2 * 36) {
    const int l = wv_ / 36, o = wv_ % 36;
    float sg = 0.f, sb = 0.f;
    for (int c = lane; c < D; c += 64) {
      const float wv = o < 32 ? P.w_re[((size_t)l * D + c) * 32 + o] : P.w_rg[((size_t)l * D + c) * 4 + o - 32];
      sg += P.ln1_g[l * D + c] * wv; sb += P.ln1_b[l * D + c] * wv;
    }
    sg = wave_sum(sg); sb = wave_sum(sb);
    if (lane == 0) { P.rgb[(l * 2 + 0) * 48 + o] = sg; P.rgb[(l * 2 + 1) * 48 + o] = sb + (o < 32 ? P.b_re[l * 32 + o] : P.b_rg[l * 4 + o - 32]); }
  }
}
DI void phase_p4(const Params& P, int l, char* smem, int bid, int nblk) {
  const int tid = otid(), lane = tid & 63, w = tid >> 6, wv = (bid * NT + tid) >> 6, nwv = (nblk * NT) >> 6;
  float* raw = (float*)smem + w * 768;
  const f32x4* wp = (const f32x4*)P.rwp + (size_t)l * 64 * 3 * 64 + lane;
  const int nrb = min(nblk, (T / 16 + 3) / 4), nwr = nrb * 4;
  for (int wt = bid < nrb ? bid * 4 + w : T / 16; wt < T / 16; wt += nwr) {
    const int t0 = wt * 16;
    f32x4v acc[3];
    _Pragma("unroll") for (int n = 0; n < 3; ++n) { acc[n][0] = 0.f; acc[n][1] = 0.f; acc[n][2] = 0.f; acc[n][3] = 0.f; }
    const float* xa = P.h + (size_t)(t0 + (lane & 15)) * D + 4 * (lane >> 4);
    f32x4 A0[4], B0[4][3], A1[4], B1[4][3];
    float s1 = 0.f, s2 = 0.f;
#define P4_LOAD(Ab, Bb, c0) _Pragma("unroll") for (int u = 0; u < 4; ++u) { Ab[u] = *(const f32x4*)(xa + 16 * ((c0) + u)); \
      _Pragma("unroll") for (int n = 0; n < 3; ++n) Bb[u][n] = wp[(((c0) + u) * 3 + n) * 64]; }
#define P4_MMA(Ab, Bb) _Pragma("unroll") for (int u = 0; u < 4; ++u) { const f32x4 a = Ab[u]; \
      s1 += (a.x + a.y) + (a.z + a.w); s2 += (a.x * a.x + a.y * a.y) + (a.z * a.z + a.w * a.w); \
      _Pragma("unroll") for (int n = 0; n < 3; ++n) acc[n] = __builtin_amdgcn_mfma_f32_16x16x4f32(a.x, Bb[u][n].x, acc[n], 0, 0, 0); \
      _Pragma("unroll") for (int n = 0; n < 3; ++n) acc[n] = __builtin_amdgcn_mfma_f32_16x16x4f32(a.y, Bb[u][n].y, acc[n], 0, 0, 0); \
      _Pragma("unroll") for (int n = 0; n < 3; ++n) acc[n] = __builtin_amdgcn_mfma_f32_16x16x4f32(a.z, Bb[u][n].z, acc[n], 0, 0, 0); \
      _Pragma("unroll") for (int n = 0; n < 3; ++n) acc[n] = __builtin_amdgcn_mfma_f32_16x16x4f32(a.w, Bb[u][n].w, acc[n], 0, 0, 0); }
    P4_LOAD(A0, B0, 0)
    _Pragma("unroll 1") for (int ch = 0; ch < 64; ch += 8) {
      P4_LOAD(A1, B1, ch + 4)
      __builtin_amdgcn_sched_barrier(0);
      P4_MMA(A0, B0)
      __builtin_amdgcn_sched_barrier(0);
      if (ch + 8 < 64) { P4_LOAD(A0, B0, ch + 8) }
      __builtin_amdgcn_sched_barrier(0);
      P4_MMA(A1, B1)
      __builtin_amdgcn_sched_barrier(0);
    }
#undef P4_LOAD
#undef P4_MMA
    s1 += sxor<16>(s1); s2 += sxor<16>(s2); s1 = xsum32(s1); s2 = xsum32(s2);
    const float mu_r = s1 * (1.f / 1024.f), rs_r = rsqrtf(fmaxf(s2 * (1.f / 1024.f) - mu_r * mu_r, 0.f) + LN_EPS);
    WT_FENCE();
    _Pragma("unroll") for (int r = 0; r < 4; ++r) {
      const int tok = 4 * (lane >> 4) + r, j = lane & 15;
      raw[tok * 40 + j] = acc[0][r]; raw[tok * 40 + 16 + j] = acc[1][r];
      if (j < 4) raw[tok * 40 + 32 + j] = acc[2][r];
    }
    if (lane < 16) { raw[640 + 2 * lane] = mu_r; raw[640 + 2 * lane + 1] = rs_r; }
    WT_FENCE();
    f32x4 gg[4], bb[4];
    _Pragma("unroll") for (int i = 0; i < 4; ++i) { gg[i] = ((const f32x4*)(P.ln1_g + l * D))[lane + 64 * i]; bb[i] = ((const f32x4*)(P.ln1_b + l * D))[lane + 64 * i]; }
    _Pragma("unroll 1") for (int q0 = 0; q0 < 16; q0 += 4) {
      f32x4 v[4][4];
      _Pragma("unroll") for (int j = 0; j < 4; ++j) _Pragma("unroll") for (int i = 0; i < 4; ++i) v[j][i] = ((const f32x4*)(P.h + (size_t)(t0 + q0 + j) * D))[lane + 64 * i];
      __builtin_amdgcn_sched_barrier(0);
      _Pragma("unroll") for (int j = 0; j < 4; ++j) {
        const float mu = raw[640 + 2 * (q0 + j)], rs = raw[640 + 2 * (q0 + j) + 1];
        _Pragma("unroll") for (int i = 0; i < 4; ++i) {
          v[j][i].x = (v[j][i].x - mu) * rs * gg[i].x + bb[i].x; v[j][i].y = (v[j][i].y - mu) * rs * gg[i].y + bb[i].y;
          v[j][i].z = (v[j][i].z - mu) * rs * gg[i].z + bb[i].z; v[j][i].w = (v[j][i].w - mu) * rs * gg[i].w + bb[i].w;
        }
        store_row(v[j], P.h + (size_t)(t0 + q0 + j) * D, P.hb + (size_t)(t0 + q0 + j) * D, lane);
      }
    }
    WT_FENCE();
    if (lane < 16) {
      const int t = t0 + lane;
      const float mu = raw[640 + 2 * lane], rs = raw[640 + 2 * lane + 1];
      const float* G = P.rgb + (l * 2) * 48; const float* Bc = G + 48;
      float gl[4];
      _Pragma("unroll") for (int g = 0; g < 4; ++g) gl[g] = rs * (raw[lane * 40 + 32 + g] - mu * G[32 + g]) + Bc[32 + g];
      int gs = 0; float gm = gl[0];
      for (int g = 1; g < 4; ++g) if (gl[g] > gm) { gm = gl[g]; gs = g; }
      float den = 0.f;
      _Pragma("unroll") for (int g = 0; g < 4; ++g) den += expf(gl[g] - gm);
      const float pg = 1.f / den;
      float el[8];
      _Pragma("unroll") for (int e = 0; e < 8; ++e) el[e] = rs * (raw[lane * 40 + gs * 8 + e] - mu * G[gs * 8 + e]) + Bc[gs * 8 + e];
      int i1 = 0; float v1 = el[0];
      for (int e = 1; e < 8; ++e) if (el[e] > v1) { v1 = el[e]; i1 = e; }
      int i2 = -1; float v2 = -3.0e38f;
      _Pragma("unroll") for (int e = 0; e < 8; ++e) if (e != i1 && el[e] > v2) { v2 = el[e]; i2 = e; }
      if (i2 < 0) i2 = (i1 + 1) & 7;
      const float ex = expf(v2 - v1);
      const float w1 = pg / (1.f + ex), w2 = pg * ex / (1.f + ex);
      const int e1 = gs * 8 + i1, e2 = gs * 8 + i2;
      const int r1 = atomicAdd(P.counts + e1 * CSTR, 1), r2 = atomicAdd(P.counts + e2 * CSTR, 1);
      P.tok_slot[2 * t] = e1 * CAP + r1; P.tok_slot[2 * t + 1] = e2 * CAP + r2;
      P.tok_w[2 * t] = w1; P.tok_w[2 * t + 1] = w2;
      P.slot_tok[(size_t)e1 * CAP + r1] = t; P.slot_tok[(size_t)e2 * CAP + r2] = t;
    }
  }
}

DI bool moe_unit(const int* counts, int i, int G, int c, int& e, int& mi, int& pn, int& cnt, int& hs) {
  int tot = 0;
  for (int x = 0; x < NEXP; ++x) tot += (counts[x * CSTR] + 255) >> 8;
  const int U = tot * 4, g = i * G + c;
  if (g >= U) return false;
  const int q = U / 8, r = U % 8, xcd = g % 8, off = g / 8;
  const int idx = (xcd < r ? xcd * (q + 1) : r * (q + 1) + (xcd - r) * q) + off;
  const int mt = idx >> 2; pn = idx & 3;
  int acc = 0; e = 0; mi = 0; cnt = 0; hs = 0;
  for (int x = 0; x < NEXP; ++x) {
    const int cx = counts[x * CSTR], n = (cx + 255) >> 8;
    if (mt < acc + n) { e = x; mi = mt - acc; cnt = cx; hs = acc * 256; return true; }
    acc += n;
  }
  return false;
}
constexpr int MOE_TAB = 131072 + 512, MOE_MAXU = 8;
DI void moe_table(const int* counts, int G, int c, char* smem_wg) {
  const int tid = rtid();
  __syncthreads();
  if (tid < MOE_MAXU) {
    int e = 0, mi = 0, pn = 0, cnt = 0, hs = 0;
    const bool ok = moe_unit(counts, tid, G, c, e, mi, pn, cnt, hs);
    int* tb = (int*)(smem_wg + MOE_TAB) + tid * 8;
    tb[0] = ok ? 1 : 0; tb[1] = e; tb[2] = mi; tb[3] = pn; tb[4] = cnt; tb[5] = hs;
  }
  __syncthreads();
}
DI bool moe_next(int i, int& e, int& mi, int& pn, int& cnt, int& hs) {
  if (i >= MOE_MAXU) return false;
  const LAS_I* tb = (const LAS_I*)(size_t)(MOE_TAB + i * 32);
  const int ok = __builtin_amdgcn_readfirstlane(tb[0]);
  e = __builtin_amdgcn_readfirstlane(tb[1]); mi = __builtin_amdgcn_readfirstlane(tb[2]); pn = __builtin_amdgcn_readfirstlane(tb[3]);
  cnt = __builtin_amdgcn_readfirstlane(tb[4]); hs = __builtin_amdgcn_readfirstlane(tb[5]);
  return ok != 0;
}
struct SchedP5a {
  static constexpr bool GATHER = true;
  const int* counts; const int* slot_tok; const char* hb; const char* w; int G, c;
  DI bool next(int i, g8::Unit& u) const {
    int e, mi, pn, cnt, hs;
    if (!moe_next(i, e, mi, pn, cnt, hs)) return false;
    u.pm = hs + mi * 256; u.pn = pn; u.tag = e; u.x0 = e * CAP + mi * 256; u.x1 = cnt - mi * 256;
    u.a = hb; u.b = w + ((size_t)e * 1024 + (size_t)pn * 256) * D * 2; return true;
  }
  DI void arows(const g8::Unit& u, int R0, unsigned (&pk)[2]) const {
    const int* st = slot_tok + u.x0; const int lim = u.x1 - 1;
    const int t0 = st[min(R0, lim)], t1 = st[min(R0 + 64, lim)], t2 = st[min(R0 + 128, lim)], t3 = st[min(R0 + 192, lim)];
    pk[0] = (unsigned)t0 | ((unsigned)t1 << 16); pk[1] = (unsigned)t2 | ((unsigned)t3 << 16);
  }
};
struct EpiP5a {
  static constexpr bool PERM = true;
  bf16_t* H;
  DI bool keep(const g8::Unit&) const { return false; }
  DI void operator()(g8::f32x4 (&acc)[2][2][4][2], const g8::Unit& u, int wr, int wc, int fr, int fq) const {
    _Pragma("unroll") for (int ai = 0; ai < 2; ++ai) _Pragma("unroll") for (int m = 0; m < 4; ++m) {
      bf16_t* rowp = H + (size_t)(u.pm + 128 * ai + 64 * wr + 16 * m + fr) * 512 + u.pn * 128 + 16 * wc + 4 * fq;
      _Pragma("unroll") for (int bj = 0; bj < 2; ++bj) {
        const g8::f32x4 g = acc[ai][bj][m][0], up = acc[ai][bj][m][1];
        u32x2 o; o.x = pk2(g[0] * sigmoidf_(g[0]) * up[0], g[1] * sigmoidf_(g[1]) * up[1]); o.y = pk2(g[2] * sigmoidf_(g[2]) * up[2], g[3] * sigmoidf_(g[3]) * up[3]);
        *(u32x2*)(rowp + 64 * bj) = o;
      }
    }
  }
};
DI void phase_p5a(const Params& P, int l, char* smem_wg, int bid, int nblk) {
  SchedP5a S; S.counts = P.counts; S.slot_tok = P.slot_tok; S.hb = (const char*)P.hb; S.w = (const char*)P.w_gu_t; S.G = nblk >> 1; S.c = bid >> 1;
  EpiP5a E; E.H = P.H;
  moe_table(P.counts, S.G, S.c, smem_wg);
  g8::gemm_phase((g8::lds_u8*)smem_wg, D, S, E);
}
struct SchedP5b {
  static constexpr bool GATHER = false;
  const int* counts; const char* H; const char* w; int G, c;
  DI bool next(int i, g8::Unit& u) const {
    int e, mi, pn, cnt, hs;
    if (!moe_next(i, e, mi, pn, cnt, hs)) return false;
    u.pm = hs + mi * 256; u.pn = pn; u.tag = e; u.x0 = 0; u.x1 = 0;
    u.a = H + (size_t)u.pm * 512 * 2; u.b = w + ((size_t)e * 1024 + (size_t)pn * 256) * 512 * 2; return true;
  }
  DI void arows(const g8::Unit&, int, unsigned (&)[2]) const {}
};
struct EpiP5b {
  static constexpr bool PERM = true;
  bf16_t* ys;
  DI bool keep(const g8::Unit&) const { return false; }
  DI void operator()(g8::f32x4 (&acc)[2][2][4][2], const g8::Unit& u, int wr, int wc, int fr, int fq) const {
    _Pragma("unroll") for (int ai = 0; ai < 2; ++ai) _Pragma("unroll") for (int m = 0; m < 4; ++m) {
      bf16_t* rowp = ys + (size_t)(u.pm + 128 * ai + 64 * wr + 16 * m + fr) * D + u.pn * 256 + 32 * wc + 8 * fq;
      _Pragma("unroll") for (int bj = 0; bj < 2; ++bj) {
        const g8::f32x4 a = acc[ai][bj][m][0], b = acc[ai][bj][m][1];
        u32x4 o; o.x = pk2(a[0], a[1]); o.y = pk2(a[2], a[3]); o.z = pk2(b[0], b[1]); o.w = pk2(b[2], b[3]);
        *(u32x4*)(rowp + 128 * bj) = o;
      }
    }
  }
};
DI void phase_p5b(const Params& P, int l, char* smem_wg, int bid, int nblk) {
  SchedP5b S; S.counts = P.counts; S.H = (const char*)P.H; S.w = (const char*)P.w_dn_t; S.G = nblk >> 1; S.c = bid >> 1;
  EpiP5b E; E.ys = P.ys;
  moe_table(P.counts, S.G, S.c, smem_wg);
  g8::gemm_phase((g8::lds_u8*)smem_wg, 512, S, E);
}
DI void phase_p6(const Params& P, int l, char* smem, int bid, int nblk) {
  const int tid = otid(), lane = tid & 63, wv = (bid * NT + tid) >> 6, nwv = (nblk * NT) >> 6;
  int* shs = (int*)smem;
  __syncthreads();
  if (tid == 0) { int hs = 0; for (int x = 0; x < NEXP; ++x) { shs[x] = hs; hs += ((P.counts[x * CSTR] + 255) >> 8) * 256; } }
  __syncthreads();
  int ns1 = 0, ns2 = 0; float nw1 = 0.f, nw2 = 0.f;
  if (wv < T) { ns1 = P.tok_slot[2 * wv]; ns2 = P.tok_slot[2 * wv + 1]; nw1 = P.tok_w[2 * wv]; nw2 = P.tok_w[2 * wv + 1]; }
  for (int t = wv; t < T; t += nwv) {
    const int s1 = ns1, s2 = ns2;
    const float w1 = nw1, w2 = nw2;
    { const int tn = min(t + nwv, T - 1); ns1 = P.tok_slot[2 * tn]; ns2 = P.tok_slot[2 * tn + 1]; nw1 = P.tok_w[2 * tn]; nw2 = P.tok_w[2 * tn + 1]; }
    const bf16_t* y1 = P.ys + (size_t)(shs[s1 / CAP] + s1 % CAP) * D;
    const bf16_t* y2 = P.ys + (size_t)(shs[s2 / CAP] + s2 % CAP) * D;
    f32x4 v[4];
    _Pragma("unroll") for (int i = 0; i < 4; ++i) {
      const f32x4 hv = ((const f32x4*)(P.h + (size_t)t * D))[lane + 64 * i];
      const u32x2 a = ((const u32x2*)y1)[lane + 64 * i], c = ((const u32x2*)y2)[lane + 64 * i];
      v[i].x = ALPHA * hv.x + (bflo(a.x) * w1 + bflo(c.x) * w2); v[i].y = ALPHA * hv.y + (bfhi(a.x) * w1 + bfhi(c.x) * w2);
      v[i].z = ALPHA * hv.z + (bflo(a.y) * w1 + bflo(c.y) * w2); v[i].w = ALPHA * hv.w + (bfhi(a.y) * w1 + bfhi(c.y) * w2);
    }
    ln16(v, P.ln2_g + l * D, P.ln2_b + l * D, lane);
    if (l == 1) {
      const int b = t >= L ? 1 : 0, pos = t - b * L;
      if (pos >= NMETA) store_row(v, P.out + ((size_t)b * SEQ + pos - NMETA) * D, nullptr, lane);
    } else store_row(v, P.h + (size_t)t * D, P.hb + (size_t)t * D, lane);
  }
}

#define XB_TMO      128
#define XB_XCNT(j)  (256  + 64 * (j))
#define XB_XSUB(j)  (1280 + 64 * (j))
#define XB_XGEN(j)  (2304 + 64 * (j))
#define XB_TOP      3328
#define XB_TOPGEN   3392
#define XCD_BAR_WORDS 3456
#define XB_SPIN_CAP (1u << 20)
#define LAS __attribute__((address_space(3)))
DI unsigned xb_ld(unsigned* p) { return __hip_atomic_load(p, __ATOMIC_RELAXED, __HIP_MEMORY_SCOPE_AGENT); }
DI unsigned xb_add(unsigned* p, unsigned v) { return __hip_atomic_fetch_add(p, v, __ATOMIC_RELAXED, __HIP_MEMORY_SCOPE_AGENT); }
DI unsigned xb_xcc_id() { return (unsigned)__builtin_amdgcn_s_getreg((3 << 11) | 20) & 0xFu; }
#define XB_SPIN(cond, bar) do { unsigned _sp = 0; while (cond) { __builtin_amdgcn_s_sleep(1); \
    if ((++_sp & 255u) == 0u) { if (xb_ld(&(bar)[XB_TMO])) break; if (_sp > XB_SPIN_CAP) { atomicAdd(&(bar)[XB_TMO], 1u); break; } } } } while (0)
struct XcdBarrier { unsigned* bar; unsigned x; volatile LAS unsigned* st; };
DI XcdBarrier xcd_barrier_post(unsigned* bar, volatile LAS unsigned* st) {
  XcdBarrier b; b.bar = bar; b.x = xb_xcc_id(); b.st = st;
  if (rtid() == 0) (void)xb_add(&bar[XB_XCNT(b.x)], 1u);
  return b;
}
DI void xcd_barrier_complete(unsigned* bar, unsigned x, unsigned& nloc, unsigned& nx) {
  const unsigned G = gridDim.x * gridDim.y * gridDim.z;
  unsigned sum, cnt, mine, sp = 0u;
  for (;;) {
    sum = 0u; cnt = 0u; mine = 0u;
    _Pragma("unroll") for (unsigned j = 0; j < 16; ++j) { const unsigned c = xb_ld(&bar[XB_XCNT(j)]); sum += c; cnt += (c > 0u) ? 1u : 0u; mine = (j == x) ? c : mine; }
    if (sum == G) break;
    __builtin_amdgcn_s_sleep(1);
    if ((++sp & 255u) == 0u) { if (xb_ld(&bar[XB_TMO])) break; if (sp > XB_SPIN_CAP) { atomicAdd(&bar[XB_TMO], 1u); break; } }
  }
  nloc = mine > 0u ? mine : 1u; nx = cnt > 0u ? cnt : 1u;
}
DI void xcd_barrier(const XcdBarrier& b) {
  asm volatile("s_waitcnt vmcnt(0)" ::: "memory");
  __syncthreads();
  if (rtid() == 0) {
    unsigned* bar = b.bar; unsigned bx = b.x;
    asm volatile("" : "+s"(bar), "+s"(bx));
    __builtin_amdgcn_s_waitcnt(0);
    unsigned nloc = b.st[0], nx = b.st[1];
    if (nloc == 0u) { xcd_barrier_complete(bar, bx, nloc, nx); b.st[0] = nloc; b.st[1] = nx; }
    const unsigned old = xb_add(&bar[XB_XSUB(bx)], 1u);
    const unsigned gen = old / nloc;
    if (old + 1u == (gen + 1u) * nloc) {
      __builtin_amdgcn_fence(__ATOMIC_RELEASE, "agent");
      asm volatile("s_waitcnt vmcnt(0)" ::: "memory");
      const unsigned og = xb_add(&bar[XB_TOP], 1u);
      const unsigned tg = og / nx;
      if (og + 1u == (tg + 1u) * nx) xb_add(&bar[XB_TOPGEN], 1u);
      else XB_SPIN(xb_ld(&bar[XB_TOPGEN]) == tg, bar);
      __builtin_amdgcn_fence(__ATOMIC_ACQUIRE, "agent");
      xb_add(&bar[XB_XGEN(bx)], 1u);
      asm volatile("s_waitcnt vmcnt(0)" ::: "memory");
    } else {
      XB_SPIN(xb_ld(&bar[XB_XGEN(bx)]) == gen, bar);
      __builtin_amdgcn_fence(__ATOMIC_ACQUIRE, "agent");
      asm volatile("s_waitcnt vmcnt(0)" ::: "memory");
    }
  }
  __syncthreads();
}

constexpr size_t al256(size_t v) { return (v + 255) & ~(size_t)255; }
struct WsLayout {
  size_t bar, ctl, h, hb, w_in_t, w_br_t, w_out_t, cs, rwp, rgb, lam, counts, tok_slot, tok_w, slot_tok, mstat, nvec, wgt, bcum, ligate;
  size_t qa, ka, vaT, qb, kb, vbT, cq, ck, cvT, co, cg, gz, qc, kc, kcT, U, end_mixer;
  size_t w_gu_t, w_dn_t, H, ys, end_moe, need;
};
constexpr WsLayout make_layout() {
  WsLayout w{}; size_t off = 0;
#define TAKE(f, bytes) w.f = off; off = al256(off + (size_t)(bytes));
  TAKE(bar, XCD_BAR_WORDS * 4) TAKE(ctl, 4096)
  TAKE(h, (size_t)TP * D * 4) TAKE(hb, (size_t)TP * D * 2) TAKE(w_in_t, (size_t)DINP * D * 2) TAKE(w_br_t, (size_t)3 * 1024 * 512 * 2) TAKE(w_out_t, (size_t)D * D * 2)
  TAKE(cs, (size_t)L * 32 * 8) TAKE(rwp, (size_t)2 * 64 * 3 * 64 * 4 * 4) TAKE(rgb, 2 * 2 * 48 * 4) TAKE(lam, 256) TAKE(counts, NEXP * CSTR * 4) TAKE(tok_slot, (size_t)T * 2 * 4) TAKE(tok_w, (size_t)T * 2 * 4) TAKE(slot_tok, (size_t)NEXP * CAP * 4)
  TAKE(mstat, (size_t)16 * NCH * 4 * 4) TAKE(nvec, (size_t)16 * NCH * 128 * 4) TAKE(wgt, (size_t)16 * LPAD * 4) TAKE(bcum, (size_t)16 * LPAD * 4) TAKE(ligate, (size_t)16 * LPAD * 4)
  const size_t scratch0 = off;
  TAKE(qa, (size_t)NB * 4 * 2 * L * 64 * 2) TAKE(ka, (size_t)NB * 4 * 2 * L * 64 * 2 + 4096) TAKE(vaT, (size_t)NB * 4 * 128 * LK * 2)
  TAKE(qb, (size_t)NB * 8 * L * 64 * 2) TAKE(kb, (size_t)NB * 2 * L * 64 * 2 + 4096) TAKE(vbT, (size_t)NB * 2 * 64 * LK * 2)
  TAKE(cq, (size_t)TP * 512 * 2) TAKE(ck, (size_t)TP * 512 * 2) TAKE(cvT, (size_t)8 * 128 * LPAD * 2) TAKE(co, (size_t)TP * 512 * 2) TAKE(cg, (size_t)TP * 16 * 4)
  TAKE(gz, (size_t)TP * 3072 * 2) TAKE(qc, (size_t)8 * LPAD * 128 * 2) TAKE(kc, (size_t)8 * LPAD * 128 * 2) TAKE(kcT, (size_t)8 * 128 * LPAD * 2) TAKE(U, (size_t)16 * NCH * 16384 * 4)
  w.end_mixer = off;
  off = scratch0;
  TAKE(w_gu_t, (size_t)NEXP * 1024 * 1024 * 2) TAKE(w_dn_t, (size_t)NEXP * 1024 * 512 * 2) TAKE(H, (size_t)HROWS * 512 * 2) TAKE(ys, (size_t)HROWS * D * 2)
  w.end_moe = off;
#undef TAKE
  w.need = w.end_mixer > w.end_moe ? w.end_mixer : w.end_moe;
  return w;
}
constexpr WsLayout WL = make_layout();
static_assert(WL.need <= (size_t)552 * 1000 * 1000, "workspace");

struct SchedP1 {
  static constexpr bool GATHER = false;
  const char* hb; const char* w; int G, c;
  DI bool next(int i, g8::Unit& u) const {
    const int Lq = i * G + c; int pm, pn;
    if (Lq < 65 * 25) { g8::grid_lin(Lq, 65, 25, pm, pn); u.tag = 0; u.a = hb + (size_t)pm * 256 * D * 2; u.b = w + (size_t)pn * 256 * D * 2; }
    else if (Lq < 65 * 25 + 5 * 65) { g8::grid_lin(Lq - 65 * 25, 5, 65, pm, pn); u.tag = 1; u.a = w + (size_t)(6400 + pm * 256) * D * 2; u.b = hb + (size_t)pn * 256 * D * 2; }
    else return false;
    u.pm = pm; u.pn = pn; return true;
  }
  DI void arows(const g8::Unit&, int, unsigned (&)[2]) const {}
};
DI u32x4 pack8(const g8::f32x4& a, const g8::f32x4& b) { u32x4 o; o.x = pk2(a[0], a[1]); o.y = pk2(a[2], a[3]); o.z = pk2(b[0], b[1]); o.w = pk2(b[2], b[3]); return o; }
struct EpiP1 {
  static constexpr bool PERM = true;
  char* ws;
  DI bool keep(const g8::Unit&) const { return false; }
  DI void operator()(g8::f32x4 (&acc)[2][2][4][2], const g8::Unit& u, int wr, int wc, int fr, int fq) const {
    char* wb = ws; asm volatile("" : "+s"(wb));
    if (u.tag == 0) {
      const int r0 = u.pm * 256 + 64 * wr + fr;
      _Pragma("unroll") for (int bj = 0; bj < 2; ++bj) {
        const int c0 = u.pn * 256 + 128 * bj + 32 * wc;
        const int c = c0 + 8 * fq;
        if (c0 < 1664) {
          const int u64 = c0 >> 6, q = ((c0 >> 5) & 1) * 4 + fq;
          bf16_t* base; int nh, uu; float sc;
          if (u64 < 8) { base = (bf16_t*)(wb + WL.qa); nh = 8; uu = u64; sc = QSCALE; }
          else if (u64 < 16) { base = (bf16_t*)(wb + WL.ka); nh = 8; uu = u64 - 8; sc = 1.f; }
          else if (u64 < 24) { base = (bf16_t*)(wb + WL.qb); nh = 8; uu = u64 - 16; sc = QSCALE; }
          else { base = (bf16_t*)(wb + WL.kb); nh = 2; uu = u64 - 24; sc = 1.f; }
          const f32x2* cs = (const f32x2*)(wb + WL.cs);
          _Pragma("unroll") for (int ai = 0; ai < 2; ++ai) {
            g8::f32x4 c01[4], c23[4];
            _Pragma("unroll") for (int m = 0; m < 4; ++m) {
              const int t = r0 + 128 * ai + 16 * m, tt = min(t, T - 1), b = tt >= L ? 1 : 0, pos = tt - b * L;
              const g8::f32x4* cp = (const g8::f32x4*)(cs + (size_t)pos * 32 + 4 * q);
              c01[m] = cp[0]; c23[m] = cp[1];
            }
            __builtin_amdgcn_sched_barrier(0);
            _Pragma("unroll") for (int m = 0; m < 4; ++m) {
              const int t = r0 + 128 * ai + 16 * m, tt = min(t, T - 1), b = tt >= L ? 1 : 0, pos = tt - b * L;
              const g8::f32x4 x1 = acc[ai][bj][m][0], x2 = acc[ai][bj][m][1];
              g8::f32x4 o1, o2;
              o1[0] = (x1[0] * c01[m][0] - x2[0] * c01[m][1]) * sc; o2[0] = (x2[0] * c01[m][0] + x1[0] * c01[m][1]) * sc;
              o1[1] = (x1[1] * c01[m][2] - x2[1] * c01[m][3]) * sc; o2[1] = (x2[1] * c01[m][2] + x1[1] * c01[m][3]) * sc;
              o1[2] = (x1[2] * c23[m][0] - x2[2] * c23[m][1]) * sc; o2[2] = (x2[2] * c23[m][0] + x1[2] * c23[m][1]) * sc;
              o1[3] = (x1[3] * c23[m][2] - x2[3] * c23[m][3]) * sc; o2[3] = (x2[3] * c23[m][2] + x1[3] * c23[m][3]) * sc;
              if (t < T) *(u32x4*)(base + ((size_t)(b * nh + uu) * L + pos) * 64 + 8 * q) = pack8(o1, o2);
            }
            __builtin_amdgcn_sched_barrier(0);
          }
        } else if (c0 < 6272) {
          bf16_t* dst0; int stride; bool sig = false;
          if (c0 < 2176) { dst0 = (bf16_t*)(wb + WL.cq) + (c - 1664); stride = 512; }
          else if (c0 < 2688) { dst0 = (bf16_t*)(wb + WL.ck) + (c - 2176); stride = 512; }
          else if (c0 < 3200) { dst0 = (bf16_t*)(wb + WL.co) + (c - 2688); stride = 512; }
          else { dst0 = (bf16_t*)(wb + WL.gz) + (c - 3200); stride = 3072; sig = true; }
          _Pragma("unroll") for (int ai = 0; ai < 2; ++ai) _Pragma("unroll") for (int m = 0; m < 4; ++m) {
            const int t = r0 + 128 * ai + 16 * m;
            g8::f32x4 v0 = acc[ai][bj][m][0], v1 = acc[ai][bj][m][1];
            if (sig) { _Pragma("unroll") for (int e = 0; e < 4; ++e) { v0[e] = fmaxf(sigmoidf_(v0[e]), 1e-12f); v1[e] = fmaxf(sigmoidf_(v1[e]), 1e-12f); } }
            if (t < T) *(u32x4*)(dst0 + (size_t)t * stride) = pack8(v0, v1);
          }
        } else if (c0 == 6272) {
          if (fq < 2) {
            float* cg = (float*)(wb + WL.cg);
            _Pragma("unroll") for (int ai = 0; ai < 2; ++ai) _Pragma("unroll") for (int m = 0; m < 4; ++m) {
              const int t = r0 + 128 * ai + 16 * m;
              if (t < T) { g8::f32x4* d = (g8::f32x4*)(cg + (size_t)t * 16 + 8 * fq); d[0] = acc[ai][bj][m][0]; d[1] = acc[ai][bj][m][1]; }
            }
          }
        }
      }
    } else {
      const int chb0 = u.pm * 256 + 64 * wr;
      _Pragma("unroll") for (int ai = 0; ai < 2; ++ai) _Pragma("unroll") for (int m = 0; m < 4; ++m) {
        const int chb = chb0 + 128 * ai + 16 * m;
        if (chb < 1152) {
          const int ch = chb + fr; bf16_t* rp; size_t bs;
          if (chb < 512) { rp = (bf16_t*)(wb + WL.vaT) + (size_t)ch * LK; bs = (size_t)512 * LK; }
          else if (chb < 640) { rp = (bf16_t*)(wb + WL.vbT) + (size_t)(ch - 512) * LK; bs = (size_t)128 * LK; }
          else { rp = (bf16_t*)(wb + WL.cvT) + (size_t)(ch - 640) * LPAD + MPAD; bs = (size_t)512 * LPAD; }
          _Pragma("unroll") for (int bj = 0; bj < 2; ++bj) {
            const int t0 = u.pn * 256 + 128 * bj + 32 * wc + 8 * fq;
            if (t0 < T) { const int b = t0 >= L ? 1 : 0, pos0 = t0 - b * L; *(u32x4*)(rp + b * bs + pos0) = pack8(acc[ai][bj][m][0], acc[ai][bj][m][1]); }
          }
        }
      }
    }
  }
};
DI void phase_p1(const Params& P, int l, char* smem_wg, int bid, int nblk) {
  SchedP1 S; S.hb = (const char*)P.hb; S.w = (const char*)P.w_in_t; S.G = nblk >> 1; S.c = bid >> 1;
  EpiP1 E; E.ws = (char*)P.h - WL.h;
  g8::gemm_phase((g8::lds_u8*)smem_wg, D, S, E);
}

struct KArgs { const float* in[28]; float* out; char* ws; };
typedef const __attribute__((address_space(4))) KArgs* KAP;
DI Params make_params(KAP k) {
  Params P;
  P.x = k->in[0]; P.meta = k->in[1]; P.ln_in_g = k->in[2]; P.ln_in_b = k->in[3]; P.w_in = k->in[4]; P.conv_w = k->in[5]; P.conv_b = k->in[6]; P.gate_b = k->in[7];
  P.lam_q1 = k->in[8]; P.lam_k1 = k->in[9]; P.lam_q2 = k->in[10]; P.lam_k2 = k->in[11]; P.diff_g = k->in[12]; P.sink = k->in[13]; P.mlstm_g = k->in[14];
  P.w_branch = k->in[15]; P.w_out = k->in[16]; P.ln1_g = k->in[17]; P.ln1_b = k->in[18]; P.ln2_g = k->in[19]; P.ln2_b = k->in[20]; P.w_rg = k->in[21]; P.b_rg = k->in[22];
  P.w_re = k->in[23]; P.b_re = k->in[24]; P.w_gate = k->in[25]; P.w_up = k->in[26]; P.w_down = k->in[27];
  P.out = k->out;
  char* ws = k->ws;
  P.h = (float*)(ws + WL.h); P.hb = (bf16_t*)(ws + WL.hb); P.w_in_t = (bf16_t*)(ws + WL.w_in_t); P.w_br_t = (bf16_t*)(ws + WL.w_br_t); P.w_out_t = (bf16_t*)(ws + WL.w_out_t);
  P.cs = (f32x2*)(ws + WL.cs); P.lam = (float*)(ws + WL.lam); P.ctl = (unsigned*)(ws + WL.ctl); P.rwp = (float*)(ws + WL.rwp); P.rgb = (float*)(ws + WL.rgb); P.counts = (int*)(ws + WL.counts); P.tok_slot = (int*)(ws + WL.tok_slot); P.tok_w = (float*)(ws + WL.tok_w);
  P.slot_tok = (int*)(ws + WL.slot_tok); P.mstat = (float*)(ws + WL.mstat); P.nvec = (float*)(ws + WL.nvec); P.wgt = (float*)(ws + WL.wgt); P.bcum = (float*)(ws + WL.bcum);
  P.ligate = (float*)(ws + WL.ligate);
  P.qa = (bf16_t*)(ws + WL.qa); P.ka = (bf16_t*)(ws + WL.ka); P.vaT = (bf16_t*)(ws + WL.vaT); P.qb = (bf16_t*)(ws + WL.qb); P.kb = (bf16_t*)(ws + WL.kb); P.vbT = (bf16_t*)(ws + WL.vbT);
  P.cq = (bf16_t*)(ws + WL.cq); P.ck = (bf16_t*)(ws + WL.ck); P.merged = P.cq; P.cvT = (bf16_t*)(ws + WL.cvT); P.co = (bf16_t*)(ws + WL.co); P.cg = (float*)(ws + WL.cg);
  P.gz = (bf16_t*)(ws + WL.gz); P.qc = (bf16_t*)(ws + WL.qc); P.kc = (bf16_t*)(ws + WL.kc); P.kcT = (bf16_t*)(ws + WL.kcT); P.U = (float*)(ws + WL.U);
  P.w_gu_t = (bf16_t*)(ws + WL.w_gu_t); P.w_dn_t = (bf16_t*)(ws + WL.w_dn_t); P.H = (bf16_t*)(ws + WL.H); P.ys = (bf16_t*)(ws + WL.ys);
  P.oa = (bf16_t*)k->out; P.ob = P.oa + (size_t)TP * 512; P.oc = P.ob + (size_t)TP * 512;
  return P;
}

constexpr int SMEM_BYTES = 2 * DA_STAGE + 4096 + 256;
constexpr int WG_LDS = 2 * SMEM_BYTES + 64 + 256;
static_assert(WIDTAB_OFF == 2 * SMEM_BYTES + 64, "wave-slot table offset");
#define PH(...) { KAP k_ = ka; int bid = bid0, nblk = nblk0; asm volatile("" : "+s"(k_), "+s"(bid), "+s"(nblk)); const Params P = make_params(k_); __VA_ARGS__; }
__global__ void __launch_bounds__(512, 2) mega(KArgs kargs) {
  extern __shared__ __attribute__((aligned(16))) char smem_wg[];
  (void)kargs;
  const KAP ka = (KAP)__builtin_amdgcn_kernarg_segment_ptr();
  {
    const unsigned hw = (unsigned)__builtin_amdgcn_s_getreg((5 << 11) | 4) & 63u;
    *(volatile LAS int*)(size_t)(WIDTAB_OFF + 4 * hw) = (int)(threadIdx.x >> 6);
  }
  __syncthreads();
  const int half = __builtin_amdgcn_readfirstlane(rtid() >> 8);
  char* smem = smem_wg + half * SMEM_BYTES;
  const int bid0 = 2 * blockIdx.x + half, nblk0 = 2 * gridDim.x;
  volatile LAS unsigned* st = (volatile LAS unsigned*)(smem_wg + 2 * SMEM_BYTES);
  volatile LAS int* wgq = (volatile LAS int*)(smem_wg + 2 * SMEM_BYTES + 16);
  if (rtid() == 0) { st[0] = 0u; st[1] = 0u; }
  __syncthreads();
  const XcdBarrier xb = xcd_barrier_post((unsigned*)(ka->ws + WL.bar), st);

  PH(phase_prologue(P, bid, nblk))
  PH(phase_router_prep(P, bid, nblk))
  PH(phase_wconv_small(P, 0, smem, bid, nblk))
  xcd_barrier(xb);
  auto layer = [&](const int l) __attribute__((always_inline)) {
    PH(phase_zero_pads(P, bid, nblk))
    PH(phase_p1(P, l, smem_wg, bid, nblk))
    xcd_barrier(xb);
    PH(phase_mprep(P, l, smem, bid, nblk))
    xcd_barrier(xb);
    for (int it = bid0; it < 512; it += nblk0) PH(dattn_item(P, l, it, true, smem))
    PH(phase_mscan(P, bid, nblk))
    xcd_barrier(xb);
    {
      for (int it = (int)blockIdx.x; it < 512; it += (int)gridDim.x) PH(dattn_item8(P, l, it, smem_wg))
      unsigned* qctr = (unsigned*)(ka->ws + WL.ctl) + (l * 8 + 5) * 16;
      const int NP = 4 + 4 * NCH + 2 * 257;
      for (;;) {
        __syncthreads();
        if (rtid() == 0) wgq[0] = (int)xb_add(qctr, 1u);
        __syncthreads();
        const int pr = wgq[0];
        if (pr >= NP) break;
        if (pr < 4) PH(dattn_combine(P, l, 2 * pr + half, smem))
        else if (pr < 4 + 4 * NCH) PH(mout_item(P, l, 2 * (pr - 4) + half, smem))
        else PH(swa_item(P, l, 2 * (pr - 4 - 4 * NCH) + half, smem))
      }
    }
    xcd_barrier(xb);
    PH(phase_p3a(P, l, smem, smem_wg, bid, nblk))
    xcd_barrier(xb);
    PH(phase_p3b(P, l, smem, smem_wg, bid, nblk))
    xcd_barrier(xb);
    PH(phase_p4(P, l, smem, bid, nblk))
    PH(phase_wconv_experts(P, l, smem, half, wgq))
    xcd_barrier(xb);
    PH(phase_p5a(P, l, smem_wg, bid, nblk))
    xcd_barrier(xb);
    PH(phase_p5b(P, l, smem_wg, bid, nblk))
    xcd_barrier(xb);
    PH(phase_p6(P, l, smem, bid, nblk))
    if (l == 0) PH(phase_wconv_small(P, 1, smem, bid, nblk))
    xcd_barrier(xb);
  };
  layer(0);
  layer(1);
}

extern "C" void kernel_launch(void* const* d_in, const int* in_sizes, int n_in, void* d_out, int out_size, void* d_ws, size_t ws_size, hipStream_t stream) {
  (void)in_sizes; (void)n_in; (void)out_size;
  if (WL.need > ws_size) return;
  KArgs a{};
  for (int i = 0; i < 28; ++i) a.in[i] = (const float*)d_in[i];
  a.out = (float*)d_out; a.ws = (char*)d_ws;
  static int grid = 0;
  if (!grid) {
    int dev = 0, cus = 0, per_cu = 0;
    (void)hipGetDevice(&dev);
    (void)hipDeviceGetAttribute(&cus, hipDeviceAttributeMultiprocessorCount, dev);
    (void)hipFuncSetAttribute((const void*)mega, hipFuncAttributeMaxDynamicSharedMemorySize, WG_LDS);
    (void)hipOccupancyMaxActiveBlocksPerMultiprocessor(&per_cu, (const void*)mega, 512, WG_LDS);
    if (per_cu > 1) per_cu = 1;
    if (per_cu < 1) per_cu = 1;
    grid = cus * per_cu;
  }
  (void)hipMemsetAsync((char*)d_ws + WL.bar, 0, WL.h - WL.bar, stream);
  hipLaunchKernelGGL(mega, dim3(grid), dim3(512), WG_LDS, stream, a);
}
```

```cpp
#include <hip/hip_runtime.h>
#include <stdint.h>

#define DI __device__ __forceinline__
typedef unsigned short bf16_t;
typedef __attribute__((ext_vector_type(8))) short bf16x8;
typedef __attribute__((ext_vector_type(16))) float f32x16;
typedef __attribute__((ext_vector_type(2))) float f32x2;
typedef __attribute__((ext_vector_type(4))) float f32x4;
typedef __attribute__((ext_vector_type(4))) unsigned u32x4;
typedef __attribute__((ext_vector_type(2))) unsigned u32x2;
typedef __attribute__((ext_vector_type(2))) __bf16 bf16x2v;
#define MFMA32(a, b, c) __builtin_amdgcn_mfma_f32_32x32x16_bf16((a), (b), (c), 0, 0, 0)

constexpr int NB = 2, SEQ = 8192, NMETA = 16, L = 8208, T = NB * L, TP = 16512, D = 1024;
constexpr int DIN = 7440, DINP = 7680;
constexpr int LPAD = 8320, NCH = 65, MPAD = 112, LK = 8256;
constexpr int NEXP = 32, CAP = 2 * T, HROWS = 2 * T + NEXP * 256;
constexpr int NT = 256;
constexpr int CSTR = 64;
constexpr float LN_EPS = 1e-5f;
constexpr float NEGF = -1e30f;
constexpr int SMEM_TQ = 65536 + 4096 + 64;
constexpr float ALPHA = 1.41421356237309515f;
constexpr float QSCALE = 0.125f * 1.44269504088896341f;

DI f32x4 mk4(float a, float b, float c, float d) { f32x4 v = {a, b, c, d}; return v; }
DI f32x2 mk2(float a, float b) { f32x2 v = {a, b}; return v; }
DI unsigned pk2(float a, float b) { f32x2 v = {a, b}; bf16x2v r = __builtin_convertvector(v, bf16x2v); return __builtin_bit_cast(unsigned, r); }
DI bf16_t f2bf(float a) { return (bf16_t)(pk2(a, 0.f) & 0xffffu); }
DI float bf2f(bf16_t b) { return __uint_as_float(((unsigned)b) << 16); }
DI float bflo(unsigned u) { return __uint_as_float(u << 16); }
DI float bfhi(unsigned u) { return __uint_as_float(u & 0xffff0000u); }
typedef __attribute__((address_space(3))) int LAS_I;
constexpr int WIDTAB_OFF = 2 * (2 * 32768 + 4096 + 256) + 64;
DI int rtid() {
  const unsigned hw = (unsigned)__builtin_amdgcn_s_getreg((5 << 11) | 4) & 63u;
  const int wid = *(volatile __attribute__((address_space(3))) int*)(size_t)(WIDTAB_OFF + 4 * hw);
  return wid * 64 + (int)__builtin_amdgcn_mbcnt_hi(~0u, __builtin_amdgcn_mbcnt_lo(~0u, 0u));
}
DI int otid() { int t = rtid() & 255; asm volatile("" : "+v"(t)); return t; }
DI int crow(int r, int h) { return (r & 3) + 8 * (r >> 2) + 4 * h; }
DI int keyoff(int r, int h) { return (r & 7) + 8 * h + 16 * (r >> 3); }
DI int swz(int row) { return (row >> 1) & 7; }
DI int kswap(int r) { return (r & 0x13) | ((r & 4) << 1) | ((r & 8) >> 1); }
template <int O> DI float sxor(float v) { return __builtin_bit_cast(float, __builtin_amdgcn_ds_swizzle(__builtin_bit_cast(int, v), 0x1f | (O << 10))); }
DI float sx32(float v) {
  int ln = (int)__builtin_amdgcn_mbcnt_hi(~0u, __builtin_amdgcn_mbcnt_lo(~0u, 0u)); asm volatile("" : "+v"(ln));
  return __builtin_bit_cast(float, __builtin_amdgcn_ds_bpermute((ln ^ 32) << 2, __builtin_bit_cast(int, v)));
}
DI float xsum32(float v) { return v + sx32(v); }
DI float xmax32(float v) { return fmaxf(v, sx32(v)); }
DI float wave_sum(float v) { v = xsum32(v); v += sxor<16>(v); v += sxor<8>(v); v += sxor<4>(v); v += sxor<2>(v); v += sxor<1>(v); return v; }
DI float wave_max(float v) { v = xmax32(v); v = fmaxf(v, sxor<16>(v)); v = fmaxf(v, sxor<8>(v)); v = fmaxf(v, sxor<4>(v)); v = fmaxf(v, sxor<2>(v)); v = fmaxf(v, sxor<1>(v)); return v; }
DI float fexp2(float x) { return __builtin_amdgcn_exp2f(x); }
DI float frcp(float x) { return __builtin_amdgcn_rcpf(x); }
DI float shfl_up_f(float v, int d, int lane) { return __builtin_bit_cast(float, __builtin_amdgcn_ds_bpermute(((lane - d) & 63) << 2, __builtin_bit_cast(int, v))); }
DI float sigmoidf_(float x) { return frcp(1.f + __expf(-x)); }
DI bf16x8 ldfrag(const bf16_t* p) { return *(const bf16x8*)p; }
DI f32x16 zero16() { f32x16 z; _Pragma("unroll") for (int i = 0; i < 16; ++i) z[i] = 0.f; return z; }
DI bf16x8 packfrag(const f32x16& x, int s) {
  union { unsigned u[4]; bf16x8 v; } t;
  t.u[0] = pk2(x[8 * s + 0], x[8 * s + 1]); t.u[1] = pk2(x[8 * s + 2], x[8 * s + 3]);
  t.u[2] = pk2(x[8 * s + 4], x[8 * s + 5]); t.u[3] = pk2(x[8 * s + 6], x[8 * s + 7]);
  return t.v;
}

struct Params {
  const float *x, *meta, *ln_in_g, *ln_in_b, *w_in, *conv_w, *conv_b, *gate_b, *lam_q1, *lam_k1, *lam_q2, *lam_k2;
  const float *diff_g, *sink, *mlstm_g, *w_branch, *w_out, *ln1_g, *ln1_b, *ln2_g, *ln2_b, *w_rg, *b_rg, *w_re, *b_re;
  const float *w_gate, *w_up, *w_down;
  float* out;
  float* h; bf16_t* hb; bf16_t *w_in_t, *w_br_t, *w_out_t; f32x2* cs; float* lam; unsigned* ctl; float* rwp; float* rgb;
  int* counts; int* tok_slot; float* tok_w; int* slot_tok;
  float* mstat;
  float* nvec;
  float* wgt;
  float* bcum;
  float* ligate;
  bf16_t *qa, *ka, *vaT, *qb, *kb, *vbT, *cq, *ck, *cvT, *co, *gz, *qc, *kc, *kcT, *merged;
  float* cg; float* U;
  bf16_t *oa, *ob, *oc;
  bf16_t *w_gu_t, *w_dn_t, *H, *ys;
};

typedef __attribute__((address_space(3))) unsigned lds_u32;
DI void gemm_issue(const bf16_t* (&arow)[4], const bf16_t* (&brow)[4], int koff, char* st, int w) {
  _Pragma("unroll") for (int i = 0; i < 4; ++i) {
    __builtin_amdgcn_global_load_lds((const unsigned*)(arow[i] + koff), (lds_u32*)(st + (4 * i + w) * 1024), 16, 0, 0);
    __builtin_amdgcn_global_load_lds((const unsigned*)(brow[i] + koff), (lds_u32*)(st + 16384 + (4 * i + w) * 1024), 16, 0, 0);
  }
}
DI void gemm_tile(const bf16_t* (&arow)[4], const bf16_t* (&brow)[4], int K, char* smem, f32x16 (&acc)[2][2], int rows = 128) {
  const int tid = otid(), lane = tid & 63, w = tid >> 6, wm = w >> 1, wn = w & 1;
  const int lr = lane & 31, lh = lane >> 5;
  const int cs = ((lane & 7) ^ (4 * (w & 1) + (lane >> 4))) * 8;
  const int nkt = K >> 6;
  const int myrows = rows - wm * 64;
  __syncthreads();
  gemm_issue(arow, brow, cs, smem, w);
  for (int kt = 0; kt < nkt; ++kt) {
    __syncthreads();
    if (kt + 1 < nkt) gemm_issue(arow, brow, (kt + 1) * 64 + cs, smem + ((kt + 1) & 1) * 32768, w);
    const char* sA = smem + (kt & 1) * 32768; const char* sB = sA + 16384;
    if (myrows > 32) {
      bf16x8 a[4][2], b[4][2];
      _Pragma("unroll") for (int ks = 0; ks < 4; ++ks) {
        const int ch = 2 * ks + lh;
        _Pragma("unroll") for (int i = 0; i < 2; ++i) {
          const int rowa = wm * 64 + 32 * i + lr;
          a[ks][i] = *(const bf16x8*)(sA + rowa * 128 + ((ch ^ swz(rowa)) << 4));
          const int rowb = wn * 64 + 32 * i + lr;
          b[ks][i] = *(const bf16x8*)(sB + rowb * 128 + ((ch ^ swz(rowb)) << 4));
        }
      }
      _Pragma("unroll") for (int ks = 0; ks < 4; ++ks)
        _Pragma("unroll") for (int i = 0; i < 2; ++i)
          _Pragma("unroll") for (int j = 0; j < 2; ++j) acc[i][j] = MFMA32(a[ks][i], b[ks][j], acc[i][j]);
    } else if (myrows > 0) {
      _Pragma("unroll") for (int ks = 0; ks < 4; ++ks) {
        const int ch = 2 * ks + lh;
        const int rowa = wm * 64 + lr;
        const bf16x8 a0 = *(const bf16x8*)(sA + rowa * 128 + ((ch ^ swz(rowa)) << 4));
        _Pragma("unroll") for (int j = 0; j < 2; ++j) {
          const int rowb = wn * 64 + 32 * j + lr;
          acc[0][j] = MFMA32(a0, *(const bf16x8*)(sB + rowb * 128 + ((ch ^ swz(rowb)) << 4)), acc[0][j]);
        }
      }
    }
  }
  __syncthreads();
}


namespace g8 {
typedef __attribute__((address_space(3))) unsigned char lds_u8;
typedef float f32x4 __attribute__((ext_vector_type(4)));
constexpr int BK = 64, HALF = 128, HTB = HALF * BK * 2, STAGE_BYTES = 8 * HTB;
DI int lds_byte(int r, int c) { const int st = (r >> 4) * 2 + (c >> 5), rr = r & 15, cc = c & 31, ob = rr * 64 + cc * 2; return st * 1024 + (ob ^ (((ob >> 9) & 1) << 5)); }
DI void stage_rc(int b, int& R, int& C) { const int st = b / 1024, sb = b % 1024, swz = sb ^ (((sb >> 9) & 1) << 5); R = (st >> 1) * 16 + swz / 64; C = (st & 1) * 32 + (swz % 64) / 2; }
DI int perm32(int rho) { const int n = rho >> 4, i = rho & 15; return 8 * (i >> 2) + 4 * n + (i & 3); }
struct Unit { const char* a; const char* b; int pm, pn, tag, x0, x1; };
template <class Epi, class Sched>
DI void gemm_phase(lds_u8* lds, int K, const Sched& S, const Epi& E) {
  int tid = rtid(); asm volatile("" : "+v"(tid));
  const int wid = __builtin_amdgcn_readfirstlane(tid >> 6), lane = tid & 63, wr = wid >> 2, wc = wid & 3, fr = lane & 15, fq = lane >> 4;
  const int nt = K / BK;
  int R[2], C[2]; unsigned voffB[2];
  _Pragma("unroll") for (int i = 0; i < 2; ++i) { stage_rc(tid * 16 + i * 8192, R[i], C[i]); const int Rb = Epi::PERM ? ((R[i] & ~31) + perm32(R[i] & 31)) : R[i]; voffB[i] = (unsigned)(Rb * K + C[i]) * 2u; }
  const size_t kstep = (size_t)(BK * 2), hstep = (size_t)HALF * K * 2;
  const unsigned ldsw = (unsigned)wid * 1024u;
  const int aoff = lds_byte(wr * 64 + fr, fq * 8), boff = lds_byte(wc * 32 + fr, fq * 8);
#define G8_SA(b, h) (((b) * 2 + (h)) * HTB)
#define G8_SB(b, h) ((4 + (b) * 2 + (h)) * HTB)
#define G8_STAGE(bufoff, gbase, voff) do { _Pragma("unroll") for (int _i = 0; _i < 2; ++_i) \
    __builtin_amdgcn_global_load_lds((const unsigned*)((const char*)(gbase) + (voff)[_i]), (lds_u32*)(lds + (bufoff) + ldsw + _i * 8192), 16, 0, 0); } while (0)
#define G8_LDA(dst, b, h) do { _Pragma("unroll") for (int m = 0; m < 4; ++m) _Pragma("unroll") for (int k = 0; k < 2; ++k) dst[m][k] = *(const __attribute__((address_space(3))) bf16x8*)(lds + G8_SA(b, h) + aoff + m * 2048 + k * 1024); } while (0)
#define G8_LDB(dst, b, h) do { _Pragma("unroll") for (int n = 0; n < 2; ++n) _Pragma("unroll") for (int k = 0; k < 2; ++k) dst[n][k] = *(const __attribute__((address_space(3))) bf16x8*)(lds + G8_SB(b, h) + boff + n * 2048 + k * 1024); } while (0)
#define G8_MMA(ai, bj, At, Bt) do { __builtin_amdgcn_s_setprio(1); _Pragma("unroll") for (int m = 0; m < 4; ++m) _Pragma("unroll") for (int n = 0; n < 2; ++n) _Pragma("unroll") for (int k = 0; k < 2; ++k) \
    acc[ai][bj][m][n] = __builtin_amdgcn_mfma_f32_16x16x32_bf16(Bt[n][k], At[m][k], acc[ai][bj][m][n], 0, 0, 0); __builtin_amdgcn_s_setprio(0); } while (0)
#define G8_WAIT_V(n) asm volatile("s_waitcnt vmcnt(" #n ")" ::: "memory")
#define G8_WAIT_L(n) asm volatile("s_waitcnt lgkmcnt(" #n ")" ::: "memory")
#define G8_BAR __builtin_amdgcn_s_barrier()
#define G8_SCHED __builtin_amdgcn_sched_barrier(0)
  Unit cur, nxt; int ui = 0;
  if (!S.next(0, cur)) return;
  f32x4 acc[2][2][4][2];
  _Pragma("unroll") for (int a = 0; a < 2; ++a) _Pragma("unroll") for (int b = 0; b < 2; ++b) _Pragma("unroll") for (int m = 0; m < 4; ++m) _Pragma("unroll") for (int n = 0; n < 2; ++n) acc[a][b][m][n] = (f32x4){0.f, 0.f, 0.f, 0.f};
  bf16x8 At[4][2], B0[2][2], B1[2][2];
  constexpr bool GA = Sched::GATHER;
  unsigned voffA[2]; unsigned cpk[2], npk[2];
  _Pragma("unroll") for (int i = 0; i < 2; ++i) voffA[i] = (unsigned)(R[i] * K + C[i]) * 2u;
  const unsigned gc2 = (unsigned)C[0] * 2u, gk2 = (unsigned)K * 2u;
  if (GA) S.arows(cur, R[0], cpk);
#define G8_STAGE_G(bufoff, base, pk) do { const unsigned _v[2] = { ((pk) & 0xffffu) * gk2 + gc2, ((pk) >> 16) * gk2 + gc2 }; G8_STAGE(bufoff, base, _v); } while (0)
#define G8_STAGE_A(bufoff, base, h, nx) do { if (GA) { if (nx) G8_STAGE_G(bufoff, base, npk[h]); else G8_STAGE_G(bufoff, base, cpk[h]); } else G8_STAGE(bufoff, (base) + (h) * hstep, voffA); } while (0)
  const char* cA = cur.a; const char* cB = cur.b;
  G8_STAGE(G8_SB(0, 0), cB, voffB); G8_STAGE_A(G8_SA(0, 0), cA, 0, false); G8_STAGE(G8_SB(0, 1), cB + hstep, voffB); G8_STAGE_A(G8_SA(0, 1), cA, 1, false);
  if (wr == 1) G8_BAR;
  G8_WAIT_V(4); G8_BAR;
  G8_STAGE(G8_SB(1, 0), cB + kstep, voffB); G8_STAGE_A(G8_SA(1, 0), cA + kstep, 0, false); G8_STAGE(G8_SB(1, 1), cB + hstep + kstep, voffB);
  G8_WAIT_V(6); G8_BAR;
  for (;;) {
    const bool has_next = S.next(ui + 1, nxt);
    const char* nA = has_next ? nxt.a : cA; const char* nB = has_next ? nxt.b : cB;
    if (GA) { if (has_next) S.arows(nxt, R[0], npk); else { npk[0] = cpk[0]; npk[1] = cpk[1]; } }
    for (int t = 0; t < nt; t += 2) {
      const bool last = (t == nt - 2);
      const char* a1 = cA + (size_t)(t + 1) * kstep;
      const char* a2 = last ? nA : cA + (size_t)(t + 2) * kstep; const char* b2 = last ? nB : cB + (size_t)(t + 2) * kstep;
      const char* a3 = a2 + kstep; const char* b3 = b2 + kstep;
      G8_LDB(B0, 0, 0); G8_SCHED; G8_LDA(At, 0, 0); G8_STAGE_A(G8_SA(1, 1), a1, 1, false);
      G8_WAIT_L(8); G8_BAR; G8_WAIT_L(0); G8_MMA(0, 0, At, B0); G8_BAR; G8_SCHED;
      G8_LDB(B1, 0, 1); G8_STAGE(G8_SB(0, 0), b2, voffB);
      G8_BAR; G8_WAIT_L(0); G8_MMA(0, 1, At, B1); G8_BAR;
      G8_LDA(At, 0, 1); G8_STAGE_A(G8_SA(0, 0), a2, 0, last);
      G8_BAR; G8_WAIT_L(0); G8_MMA(1, 0, At, B0); G8_BAR; G8_SCHED;
      G8_STAGE(G8_SB(0, 1), b2 + hstep, voffB);
      G8_WAIT_V(6); G8_BAR; G8_MMA(1, 1, At, B1); G8_BAR;
      G8_LDB(B0, 1, 0); G8_SCHED; G8_LDA(At, 1, 0); G8_STAGE_A(G8_SA(0, 1), a2, 1, last);
      G8_WAIT_L(8); G8_BAR; G8_WAIT_L(0); G8_MMA(0, 0, At, B0); G8_BAR; G8_SCHED;
      G8_LDB(B1, 1, 1); G8_STAGE(G8_SB(1, 0), b3, voffB);
      G8_BAR; G8_WAIT_L(0); G8_MMA(0, 1, At, B1); G8_BAR;
      G8_LDA(At, 1, 1); G8_STAGE_A(G8_SA(1, 0), a3, 0, last);
      G8_BAR; G8_WAIT_L(0); G8_MMA(1, 0, At, B0); G8_BAR; G8_SCHED;
      G8_STAGE(G8_SB(1, 1), b3 + hstep, voffB);
      G8_WAIT_V(6); G8_BAR; G8_MMA(1, 1, At, B1); G8_BAR;
    }
    E(acc, cur, wr, wc, fr, fq);
    if (!has_next) break;
    if (!E.keep(cur)) { _Pragma("unroll") for (int a = 0; a < 2; ++a) _Pragma("unroll") for (int b = 0; b < 2; ++b) _Pragma("unroll") for (int m = 0; m < 4; ++m) _Pragma("unroll") for (int n = 0; n < 2; ++n) acc[a][b][m][n] = (f32x4){0.f, 0.f, 0.f, 0.f}; }
    cur = nxt; cA = nA; cB = nB; ++ui;
    if (GA) { cpk[0] = npk[0]; cpk[1] = npk[1]; }
  }
  G8_WAIT_V(0);
  if (wr == 0) G8_BAR;
  G8_BAR;
#undef G8_SA
#undef G8_SB
#undef G8_STAGE
#undef G8_STAGE_A
#undef G8_STAGE_G
#undef G8_LDA
#undef G8_LDB
#undef G8_MMA
#undef G8_WAIT_V
#undef G8_WAIT_L
#undef G8_BAR
#undef G8_SCHED
}
DI void dense_arows(int K, int R0, int R1, int C0, int C1, unsigned (&vo)[2][2]) {
  vo[0][0] = (unsigned)(R0 * K + C0) * 2u; vo[0][1] = (unsigned)(R1 * K + C1) * 2u;
  vo[1][0] = (unsigned)((128 + R0) * K + C0) * 2u; vo[1][1] = (unsigned)((128 + R1) * K + C1) * 2u;
}
DI void grid_lin(int wgid, int nM, int nN, int& pm, int& pn) {
  const int nwg = nM * nN;
  { const int q = nwg / 8, r = nwg % 8, xcd = wgid % 8, off = wgid / 8; wgid = (xcd < r ? xcd * (q + 1) : r * (q + 1) + (xcd - r) * q) + off; }
  const int nig = 8 * nN, gid = wgid / nig, fm = gid * 8, gsz = (nM - fm) < 8 ? (nM - fm) : 8;
  pm = fm + ((wgid % nig) % gsz); pn = (wgid % nig) / gsz;
}
DI bool grid_unit(int i, int G, int c, int nM, int nN, int& pm, int& pn) {
  const int nwg = nM * nN; const long Lq = (long)i * G + c; if (Lq >= nwg) return false;
  int wgid = (int)Lq; { const int q = nwg / 8, r = nwg % 8, xcd = wgid % 8, off = wgid / 8; wgid = (xcd < r ? xcd * (q + 1) : r * (q + 1) + (xcd - r) * q) + off; }
  const int nig = 8 * nN, gid = wgid / nig, fm = gid * 8, gsz = (nM - fm) < 8 ? (nM - fm) : 8;
  pm = fm + ((wgid % nig) % gsz); pn = (wgid % nig) / gsz; return true;
}
}

DI int ropep(int x) { const int d = x & 63; return (x & ~63) + 8 * ((d & 31) >> 2) + 4 * (d >> 5) + (d & 3); }
DI int wmap(int mode, int n) {
  if (mode == 1) {
    if (n < 512) return ropep(n);
    if (n < 1024) return 512 + ropep(n - 512);
    if (n < 1536) return 6400 + (n - 1024);
    if (n < 2048) return 1024 + ropep(n - 1536);
    if (n < 2176) return 1536 + ropep(n - 2048);
    if (n < 2304) return 6400 + 512 + (n - 2176);
    if (n < 2816) return 1664 + (n - 2304);
    if (n < 3328) return 2176 + (n - 2816);
    if (n < 3840) return 6400 + 640 + (n - 3328);
    if (n < 4352) return 2688 + (n - 3840);
    if (n < 4368) return 6272 + (n - 4352);
    return 3200 + (n - 4368);
  }
  if (mode == 2) return 8 * (n >> 2) + (n & 3);
  if (mode == 3) return 8 * (n >> 2) + 4 + (n & 3);
  return n;
}
struct CvJob { const float* src; bf16_t* dst; int K, N, mode, tk, tn; };
DI void cv_load(const CvJob& j, int tid, f32x4 (&v)[4]) {
  const int kk = tid >> 4, c4 = tid & 15, n = j.tn * 64 + 4 * c4;
  _Pragma("unroll") for (int i = 0; i < 4; ++i) {
    v[i] = mk4(0.f, 0.f, 0.f, 0.f);
    if (n < j.N) v[i] = *(const f32x4*)(j.src + (size_t)(j.tk * 64 + kk + 16 * i) * j.N + n);
  }
}
DI void cv_finish(const CvJob& j, int tid, const f32x4 (&v)[4], char* smem) {
  bf16_t* sT = (bf16_t*)smem;
  const int kk = tid >> 4, c4 = tid & 15;
  __syncthreads();
  _Pragma("unroll") for (int i = 0; i < 4; ++i) {
    const int k = kk + 16 * i;
    sT[(4 * c4 + 0) * 72 + k] = f2bf(v[i].x); sT[(4 * c4 + 1) * 72 + k] = f2bf(v[i].y);
    sT[(4 * c4 + 2) * 72 + k] = f2bf(v[i].z); sT[(4 * c4 + 3) * 72 + k] = f2bf(v[i].w);
  }
  __syncthreads();
  const int nn = tid >> 2, kc = tid & 3;
  const int ng = j.tn * 64 + nn;
  if (ng < j.N) {
    const u32x4 v0 = *(const u32x4*)(sT + nn * 72 + 16 * kc);
    const u32x4 v1 = *(const u32x4*)(sT + nn * 72 + 16 * kc + 8);
    bf16_t* d = j.dst + (size_t)wmap(j.mode, ng) * j.K + j.tk * 64 + 16 * kc;
    *(u32x4*)d = v0; *(u32x4*)(d + 8) = v1;
  }
}

constexpr int WS_TILES_IN = 16 * 117, WS_TILES_BR = 3 * 8 * 16, WS_TILES_OUT = 16 * 16;
constexpr int WS_TILES = WS_TILES_IN + WS_TILES_BR + WS_TILES_OUT;
DI CvJob ws_job(const Params& P, int l, int it) {
  CvJob j;
  if (it < WS_TILES_IN) { j.src = P.w_in + (size_t)l * D * DIN; j.K = D; j.N = DIN; j.dst = P.w_in_t; j.mode = 1; j.tk = it / 117; j.tn = it % 117; }
  else if (it < WS_TILES_IN + WS_TILES_BR) {
    const int q = it - WS_TILES_IN, i = q / 128, r = q % 128;
    j.src = P.w_branch + ((size_t)l * 3 + i) * 512 * 1024; j.K = 512; j.N = 1024; j.dst = P.w_br_t + (size_t)i * 1024 * 512; j.mode = 0; j.tk = r / 16; j.tn = r % 16;
  } else {
    const int q = it - WS_TILES_IN - WS_TILES_BR;
    j.src = P.w_out + (size_t)l * D * D; j.K = D; j.N = D; j.dst = P.w_out_t; j.mode = 0; j.tk = q / 16; j.tn = q % 16;
  }
  return j;
}
DI void phase_wconv_small(const Params& P, int l, char* smem, int bid, int nblk) {
  const int tid = otid();
  if (bid >= WS_TILES) return;
  CvJob j = ws_job(P, l, bid); f32x4 v[4];
  cv_load(j, tid, v);
  for (int it = bid; it < WS_TILES; it += nblk) {
    CvJob jn = j; f32x4 vn[4];
    _Pragma("unroll") for (int i = 0; i < 4; ++i) vn[i] = v[i];
    if (it + nblk < WS_TILES) { jn = ws_job(P, l, it + nblk); cv_load(jn, tid, vn); }
    cv_finish(j, tid, v, smem);
    j = jn;
    _Pragma("unroll") for (int i = 0; i < 4; ++i) v[i] = vn[i];
  }
}
constexpr int WE_TILES = NEXP * 384;
DI CvJob we_job(const Params& P, int l, int it) {
  const int e = it / 384, q = it % 384, which = q / 128, r = q % 128;
  const size_t eo = (size_t)l * NEXP + e;
  CvJob j;
  if (which == 0) { j.src = P.w_gate + eo * 1024 * 512; j.K = 1024; j.N = 512; j.dst = P.w_gu_t + (size_t)e * 1024 * 1024; j.mode = 2; j.tk = r / 8; j.tn = r % 8; }
  else if (which == 1) { j.src = P.w_up + eo * 1024 * 512; j.K = 1024; j.N = 512; j.dst = P.w_gu_t + (size_t)e * 1024 * 1024; j.mode = 3; j.tk = r / 8; j.tn = r % 8; }
  else { j.src = P.w_down + eo * 512 * 1024; j.K = 512; j.N = 1024; j.dst = P.w_dn_t + (size_t)e * 1024 * 512; j.mode = 0; j.tk = r / 16; j.tn = r % 16; }
  return j;
}
DI void phase_wconv_experts(const Params& P, int l, char* smem, int half, volatile __attribute__((address_space(3))) int* wgslot) {
  unsigned* ctr = P.ctl + (l * 8 + 6) * 16;
  const int tid = otid();
  for (;;) {
    __syncthreads();
    if (rtid() == 0) wgslot[0] = (int)__hip_atomic_fetch_add(ctr, 2u, __ATOMIC_RELAXED, __HIP_MEMORY_SCOPE_AGENT);
    __syncthreads();
    const int c0 = (wgslot[0] + half) * 8;
    if (c0 >= WE_TILES) break;
    CvJob j = we_job(P, l, c0); f32x4 v[4];
    cv_load(j, tid, v);
    for (int it = c0; it < c0 + 8; ++it) {
      CvJob jn = j; f32x4 vn[4];
      _Pragma("unroll") for (int i = 0; i < 4; ++i) vn[i] = v[i];
      if (it + 1 < c0 + 8) { jn = we_job(P, l, it + 1); cv_load(jn, tid, vn); }
      cv_finish(j, tid, v, smem);
      j = jn;
      _Pragma("unroll") for (int i = 0; i < 4; ++i) v[i] = vn[i];
    }
  }
}

DI void ln16(f32x4 (&v)[4], const float* g, const float* b, int lane) {
  float s = 0.f;
  _Pragma("unroll") for (int i = 0; i < 4; ++i) s += v[i].x + v[i].y + v[i].z + v[i].w;
  const float mu = wave_sum(s) * (1.f / 1024.f);
  float q = 0.f;
  _Pragma("unroll") for (int i = 0; i < 4; ++i) { v[i].x -= mu; v[i].y -= mu; v[i].z -= mu; v[i].w -= mu; q += v[i].x * v[i].x + v[i].y * v[i].y + v[i].z * v[i].z + v[i].w * v[i].w; }
  const float rs = rsqrtf(wave_sum(q) * (1.f / 1024.f) + LN_EPS);
  _Pragma("unroll") for (int i = 0; i < 4; ++i) {
    const f32x4 gg = ((const f32x4*)g)[lane + 64 * i], bb = ((const f32x4*)b)[lane + 64 * i];
    v[i].x = v[i].x * rs * gg.x + bb.x; v[i].y = v[i].y * rs * gg.y + bb.y; v[i].z = v[i].z * rs * gg.z + bb.z; v[i].w = v[i].w * rs * gg.w + bb.w;
  }
}
DI void store_row(const f32x4 (&v)[4], float* hf, bf16_t* hbf, int lane) {
  _Pragma("unroll") for (int i = 0; i < 4; ++i) {
    if (hf) ((f32x4*)hf)[lane + 64 * i] = v[i];
    if (hbf) { u32x2 u; u.x = pk2(v[i].x, v[i].y); u.y = pk2(v[i].z, v[i].w); ((u32x2*)hbf)[lane + 64 * i] = u; }
  }
}

DI void phase_prologue(const Params& P, int bid, int nblk) {
  const int tid = otid(), gtid = bid * NT + tid, gn = nblk * NT;
  for (int i = gtid; i < L * 32; i += gn) {
    const int pos = i >> 5, f = i & 31;
    const float e = (float)(2 * f) / 64.0f;
    const float pw = (float)pow(10000.0, (double)e);
    const float inv = 1.0f / pw;
    const float ang = (float)pos * inv;
    P.cs[i] = mk2((float)cos((double)ang), (float)sin((double)ang));
  }
  if (gtid < 2) {
    const int l = gtid;
    float s1 = 0.f, s2 = 0.f;
    for (int i = 0; i < 64; ++i) { s1 += P.lam_q1[l * 64 + i] * P.lam_k1[l * 64 + i]; s2 += P.lam_q2[l * 64 + i] * P.lam_k2[l * 64 + i]; }
    const float li = (float)(0.8 - 0.6 * exp(-0.3 * (double)l));
    P.lam[l] = expf(s1) - expf(s2) + li;
    P.lam[2 + l] = (float)(1.0 - (0.8 - 0.6 * exp(-0.3 * (double)l)));
  }
  const int lane = tid & 63, wv = (bid * NT + tid) >> 6, nwv = (nblk * NT) >> 6;
  for (int t = wv; t < T; t += nwv) {
    const int b = t >= L ? 1 : 0, pos = t - b * L;
    const float* src = pos < NMETA ? P.meta + (size_t)pos * D : P.x + ((size_t)b * SEQ + (pos - NMETA)) * D;
    f32x4 v[4];
    _Pragma("unroll") for (int i = 0; i < 4; ++i) v[i] = ((const f32x4*)src)[lane + 64 * i];
    ln16(v, P.ln_in_g, P.ln_in_b, lane);
    store_row(v, P.h + (size_t)t * D, P.hb + (size_t)t * D, lane);
  }
}
DI void phase_zero_pads(const Params& P, int bid, int nblk) {
  const int gtid = bid * NT + otid(), gn = nblk * NT;
  for (int i = gtid; i < 8 * 128 * (LK - L); i += gn) { const int r = i / (LK - L), cidx = i % (LK - L); P.vaT[(size_t)r * LK + L + cidx] = 0; }
  for (int i = gtid; i < 4 * 64 * (LK - L); i += gn) { const int r = i / (LK - L), cidx = i % (LK - L); P.vbT[(size_t)r * LK + L + cidx] = 0; }
  for (int i = gtid; i < 8 * 128 * MPAD; i += gn) { const int r = i / MPAD, cidx = i % MPAD; P.cvT[(size_t)r * LPAD + cidx] = 0; }
  for (int i = gtid; i < 8 * MPAD * 128; i += gn) { const int bh = i / (MPAD * 128), r = i % (MPAD * 128); P.qc[(size_t)bh * LPAD * 128 + r] = 0; P.kc[(size_t)bh * LPAD * 128 + r] = 0; }
  if (gtid < NEXP) P.counts[gtid * CSTR] = 0;
}

constexpr int P1_MT = TP / 128, P1_NT = DINP / 128;
#define WT_FENCE() asm volatile("s_waitcnt lgkmcnt(0)" ::: "memory")
DI void p1_epilogue(const Params& P, int m0, int n0, f32x16 (&acc)[2][2], char* smem) {
  const int tid = otid(), lane = tid & 63, w = tid >> 6, wm = w >> 1, wn = w & 1, lr = lane & 31, lh = lane >> 5;
  const int nw = n0 + wn * 64;
  bf16_t* wt = (bf16_t*)(smem + w * 9216);
  const int mw = m0 + wm * 64;
  int seg;
  if (nw < 512) seg = 0; else if (nw < 1024) seg = 1; else if (nw < 1536) seg = 2; else if (nw < 2048) seg = 3; else if (nw < 2176) seg = 4;
  else if (nw < 2304) seg = 5; else if (nw < 2816) seg = 6; else if (nw < 3328) seg = 7; else if (nw < 3840) seg = 8; else if (nw < 4352) seg = 9;
  else if (nw < 7424) seg = 10; else seg = 11;
  if (seg == 11) {
    _Pragma("unroll") for (int i = 0; i < 2; ++i) _Pragma("unroll") for (int r = 0; r < 16; ++r) {
      const int t = mw + 32 * i + crow(r, lh);
      const int cn = nw + lr - 7424;
      if (t < T && cn < 16) P.cg[(size_t)t * 16 + cn] = acc[i][0][r];
    }
    return;
  }
  if (seg == 0 || seg == 1 || seg == 3 || seg == 4) {
    _Pragma("unroll") for (int i = 0; i < 2; ++i) _Pragma("unroll") for (int r = 0; r < 16; ++r) {
      const int row = 32 * i + crow(r, lh);
      const int t = min(mw + row, T - 1);
      const int pos = t >= L ? t - L : t;
      const f32x2 csv = P.cs[pos * 32 + lr];
      const float x1 = acc[i][0][r], x2 = acc[i][1][r];
      float o1 = x1 * csv.x - x2 * csv.y, o2 = x2 * csv.x + x1 * csv.y;
      if (seg == 0 || seg == 3) { o1 *= QSCALE; o2 *= QSCALE; }
      wt[row * 72 + lr] = f2bf(o1); wt[row * 72 + 32 + lr] = f2bf(o2);
    }
  } else if (seg == 2 || seg == 5 || seg == 8) {
    _Pragma("unroll") for (int i = 0; i < 2; ++i) _Pragma("unroll") for (int j = 0; j < 2; ++j) _Pragma("unroll") for (int rg = 0; rg < 4; ++rg) {
      u32x2 u; u.x = pk2(acc[i][j][4 * rg], acc[i][j][4 * rg + 1]); u.y = pk2(acc[i][j][4 * rg + 2], acc[i][j][4 * rg + 3]);
      *(u32x2*)(wt + (32 * j + lr) * 72 + 32 * i + 8 * rg + 4 * lh) = u;
    }
  } else if (seg == 10) {
    _Pragma("unroll") for (int i = 0; i < 2; ++i) _Pragma("unroll") for (int j = 0; j < 2; ++j) _Pragma("unroll") for (int r = 0; r < 16; ++r)
      wt[(32 * i + crow(r, lh)) * 72 + 32 * j + lr] = f2bf(fmaxf(sigmoidf_(acc[i][j][r]), 1e-12f));
  } else {
    _Pragma("unroll") for (int i = 0; i < 2; ++i) _Pragma("unroll") for (int j = 0; j < 2; ++j) _Pragma("unroll") for (int r = 0; r < 16; ++r)
      wt[(32 * i + crow(r, lh)) * 72 + 32 * j + lr] = f2bf(acc[i][j][r]);
  }
  WT_FENCE();
  _Pragma("unroll") for (int it = 0; it < 8; ++it) {
    const int id = it * 64 + lane, row = id >> 3, ch = id & 7;
    const u32x4 v = *(const u32x4*)(wt + row * 72 + ch * 8);
    if (seg == 2 || seg == 5 || seg == 8) {
      const int t0 = mw + ch * 8;
      if (t0 < T) {
        const int b = t0 >= L ? 1 : 0, pos0 = t0 - b * L;
        bf16_t* dst;
        if (seg == 2) { const int cc = nw - 1024 + row; dst = P.vaT + ((size_t)(b * 4 + (cc >> 7)) * 128 + (cc & 127)) * LK + pos0; }
        else if (seg == 5) { const int cc = nw - 2176 + row; dst = P.vbT + ((size_t)(b * 2 + (cc >> 6)) * 64 + (cc & 63)) * LK + pos0; }
        else { const int cc = nw - 3328 + row; dst = P.cvT + ((size_t)(b * 4 + (cc >> 7)) * 128 + (cc & 127)) * LPAD + MPAD + pos0; }
        *(u32x4*)dst = v;
      }
    } else {
      const int t = mw + row;
      if (t < T) {
        const int b = t >= L ? 1 : 0, pos = t - b * L;
        bf16_t* dst;
        if (seg == 0) { const int u = nw >> 6; dst = P.qa + ((size_t)((b * 4 + (u >> 1)) * 2 + (u & 1)) * L + pos) * 64; }
        else if (seg == 1) { const int u = (nw - 512) >> 6; dst = P.ka + ((size_t)((b * 4 + (u >> 1)) * 2 + (u & 1)) * L + pos) * 64; }
        else if (seg == 3) { const int hq = (nw - 1536) >> 6; dst = P.qb + ((size_t)(b * 8 + hq) * L + pos) * 64; }
        else if (seg == 4) { const int kv = (nw - 2048) >> 6; dst = P.kb + ((size_t)(b * 2 + kv) * L + pos) * 64; }
        else if (seg == 6) dst = P.cq + (size_t)t * 512 + nw - 2304;
        else if (seg == 7) dst = P.ck + (size_t)t * 512 + nw - 2816;
        else if (seg == 9) dst = P.co + (size_t)t * 512 + nw - 3840;
        else dst = P.gz + (size_t)t * 3072 + nw - 4352;
        *(u32x4*)(dst + ch * 8) = v;
      }
    }
  }
}
DI float logsigmoidf_(float x) { return fminf(x, 0.f) - log1pf(__expf(-fabsf(x))); }
DI void phase_mprep(const Params& P, int l, char* smem, int bid, int nblk) {
  const int tid = otid();
  float* sli = (float*)smem;
  float* slf = sli + 256;
  float* sb = slf + 256;
  float* sw = sb + 256;
  float* sred = sw + 256;
  float* sst = sred + 16 * 256;
  for (int it = bid; it < 8 * NCH; it += nblk) {
    const int bh = it < 8 * (NCH - 1) ? it / (NCH - 1) : it - 8 * (NCH - 1), n = it < 8 * (NCH - 1) ? 1 + it % (NCH - 1) : 0, b = bh >> 2, hh = bh & 3;
    __syncthreads();
    if (tid < 128) {
      const int p = 128 * n + tid, pos = p - MPAD;
      float lif = NEGF, lff = 0.f, lib = NEGF, lfb = 0.f;
      if (pos >= 0) {
        const float* g = P.cg + (size_t)(b * L + pos) * 16;
        const float* gb = P.gate_b + l * 16;
        lif = g[0 + hh] + gb[0 + hh]; lff = logsigmoidf_(g[4 + hh] + gb[4 + hh]);
        lib = g[8 + hh] + gb[8 + hh]; lfb = logsigmoidf_(g[12 + hh] + gb[12 + hh]);
      }
      sli[tid] = lif; sli[128 + tid] = lib; slf[tid] = lff; slf[128 + tid] = lfb;
    }
    __syncthreads();
    if (tid < 128) {
      const int t2 = otid(), wd = t2 >> 6, ln = t2 & 63;
      const int i0 = wd == 0 ? 2 * ln : 127 - 2 * ln, i1 = wd == 0 ? 2 * ln + 1 : 126 - 2 * ln;
      const float e0 = slf[wd * 128 + i0], e1 = slf[wd * 128 + i1];
      float scan = e0 + e1;
      _Pragma("unroll") for (int d = 1; d < 64; d <<= 1) { const float tt = shfl_up_f(scan, d, ln); if (ln >= d) scan += tt; }
      float excl = shfl_up_f(scan, 1, ln); if (ln == 0) excl = 0.f;
      sb[wd * 128 + i0] = excl + e0; sb[wd * 128 + i1] = excl + e0 + e1;
    }
    __syncthreads();
    if (tid < 128) {
      const int dir = tid >> 6, lane = tid & 63;
      const float g = dir == 0 ? sb[127] : sb[128];
      const float a0 = g - sb[dir * 128 + lane] + sli[dir * 128 + lane];
      const float a1 = g - sb[dir * 128 + lane + 64] + sli[dir * 128 + lane + 64];
      const float am = wave_max(fmaxf(a0, a1));
      const float w0 = __expf(a0 - am), w1 = __expf(a1 - am);
      sw[dir * 128 + lane] = w0; sw[dir * 128 + lane + 64] = w1;
      const size_t base = ((size_t)dir * 8 + bh) * LPAD + 128 * n;
      P.wgt[base + lane] = w0; P.wgt[base + lane + 64] = w1;
      P.bcum[base + lane] = sb[dir * 128 + lane]; P.bcum[base + lane + 64] = sb[dir * 128 + lane + 64];
      P.ligate[base + lane] = sli[dir * 128 + lane]; P.ligate[base + lane + 64] = sli[dir * 128 + lane + 64];
      if (lane == 0) { float* ms = P.mstat + ((size_t)(dir * 8 + bh) * NCH + n) * 4; ms[0] = g; ms[1] = am; }
    }
    __syncthreads();
    bf16_t* skT = (bf16_t*)(smem + 32768);
    if (n == 0) { for (int i = tid; i < 128 * MPAD; i += NT) skT[(i / MPAD) * 136 + (i % MPAD)] = 0; }
    const int tid3 = otid();
    const int dg = tid3 & 15, tl = tid3 >> 4;
    float nf[8], nbk[8];
    _Pragma("unroll") for (int j = 0; j < 8; ++j) { nf[j] = 0.f; nbk[j] = 0.f; }
    const int ch = hh * 128 + dg * 8;
    float cw[2][3][8], cb[2][8];
    _Pragma("unroll") for (int j = 0; j < 8; ++j) {
      _Pragma("unroll") for (int ww = 0; ww < 3; ++ww) { cw[0][ww][j] = P.conv_w[((size_t)l * 3 + ww) * 1024 + ch + j]; cw[1][ww][j] = P.conv_w[((size_t)l * 3 + ww) * 1024 + 512 + ch + j]; }
      cb[0][j] = P.conv_b[l * 1024 + ch + j]; cb[1][j] = P.conv_b[l * 1024 + 512 + ch + j];
    }
    _Pragma("unroll 1") for (int hb4 = 0; hb4 < 8; hb4 += 4) {
      u32x4 uq[4][3], uk[4][3];
      _Pragma("unroll") for (int i4 = 0; i4 < 4; ++i4) {
        const int pos = 128 * n + tl + 16 * (hb4 + i4) - MPAD;
        _Pragma("unroll") for (int ww = 0; ww < 3; ++ww) {
          const int pp = min(max(pos + ww - 1, 0), L - 1);
          uq[i4][ww] = *(const u32x4*)(P.cq + (size_t)(b * L + pp) * 512 + ch);
          uk[i4][ww] = *(const u32x4*)(P.ck + (size_t)(b * L + pp) * 512 + ch);
        }
      }
      __builtin_amdgcn_sched_barrier(0);
      _Pragma("unroll") for (int i4 = 0; i4 < 4; ++i4) {
        const int tau = tl + 16 * (hb4 + i4), p = 128 * n + tau, pos = p - MPAD;
        float q[8], k[8];
        _Pragma("unroll") for (int j = 0; j < 8; ++j) { q[j] = cb[0][j]; k[j] = cb[1][j]; }
        _Pragma("unroll") for (int ww = 0; ww < 3; ++ww) {
          const int pp = pos + ww - 1;
          const float vm = (pp >= 0 && pp < L) ? 1.f : 0.f;
          const unsigned aq[4] = {uq[i4][ww].x, uq[i4][ww].y, uq[i4][ww].z, uq[i4][ww].w}, ak[4] = {uk[i4][ww].x, uk[i4][ww].y, uk[i4][ww].z, uk[i4][ww].w};
          _Pragma("unroll") for (int j = 0; j < 4; ++j) {
            q[2 * j] += bflo(aq[j]) * (cw[0][ww][2 * j] * vm); q[2 * j + 1] += bfhi(aq[j]) * (cw[0][ww][2 * j + 1] * vm);
            k[2 * j] += bflo(ak[j]) * (cw[1][ww][2 * j] * vm); k[2 * j + 1] += bfhi(ak[j]) * (cw[1][ww][2 * j + 1] * vm);
          }
        }
        const float wf = sw[tau], wb = sw[128 + tau];
        _Pragma("unroll") for (int j = 0; j < 8; ++j) {
          q[j] = q[j] * sigmoidf_(q[j]);
          k[j] = k[j] * sigmoidf_(k[j]) * 0.08838834764831845f;
          nf[j] += wf * k[j]; nbk[j] += wb * k[j];
        }
        if (pos >= 0) {
          u32x4 oq, ok;
          oq.x = pk2(q[0], q[1]); oq.y = pk2(q[2], q[3]); oq.z = pk2(q[4], q[5]); oq.w = pk2(q[6], q[7]);
          ok.x = pk2(k[0], k[1]); ok.y = pk2(k[2], k[3]); ok.z = pk2(k[4], k[5]); ok.w = pk2(k[6], k[7]);
          *(u32x4*)(P.qc + ((size_t)bh * LPAD + p) * 128 + dg * 8) = oq;
          *(u32x4*)(P.kc + ((size_t)bh * LPAD + p) * 128 + dg * 8) = ok;
          _Pragma("unroll") for (int j = 0; j < 8; ++j) skT[(dg * 8 + j) * 136 + tau] = f2bf(k[j]);
        }
      }
    }
    _Pragma("unroll") for (int j = 0; j < 8; ++j) { sred[tl * 256 + dg * 8 + j] = nf[j]; sred[tl * 256 + 128 + dg * 8 + j] = nbk[j]; }
    __syncthreads();
    {
      const int tid2 = otid();
      const int lane = tid2 & 63, w = tid2 >> 6, wi = w >> 1, wj = w & 1, lr = lane & 31, lh = lane >> 5;
      unsigned vo = (unsigned)((bh * 128 + 64 * wi + lr) * LPAD + 128 * n + 8 * lh);
      asm volatile("" : "+v"(vo));
      _Pragma("unroll 1") for (int dir = 0; dir < 2; ++dir) {
        f32x16 acc[2][2];
        _Pragma("unroll") for (int i = 0; i < 2; ++i) _Pragma("unroll") for (int j = 0; j < 2; ++j) acc[i][j] = zero16();
        unsigned koff = (unsigned)((64 * wj + lr) * 136 + 8 * lh);
        asm volatile("" : "+v"(koff));
        _Pragma("unroll") for (int ks = 0; ks < 8; ++ks) {
          if (n == 0 && ks < 7) continue;
          const int tau = 16 * ks + 8 * lh;
          const f32x4 w0 = *(const f32x4*)(sw + dir * 128 + tau), w1 = *(const f32x4*)(sw + dir * 128 + tau + 4);
          bf16x8 bq[2];
          _Pragma("unroll") for (int i = 0; i < 2; ++i) {
            const u32x4 kr = *(const u32x4*)(skT + koff + (32 * i) * 136 + 16 * ks);
            union { unsigned u[4]; bf16x8 v; } tt;
            tt.u[0] = pk2(bflo(kr.x) * w0.x, bfhi(kr.x) * w0.y); tt.u[1] = pk2(bflo(kr.y) * w0.z, bfhi(kr.y) * w0.w);
            tt.u[2] = pk2(bflo(kr.z) * w1.x, bfhi(kr.z) * w1.y); tt.u[3] = pk2(bflo(kr.w) * w1.z, bfhi(kr.w) * w1.w);
            bq[i] = tt.v;
          }
          bf16x8 af[2];
          _Pragma("unroll") for (int i = 0; i < 2; ++i) af[i] = ldfrag(P.cvT + vo + (unsigned)(32 * i) * LPAD + 16 * ks);
          _Pragma("unroll") for (int i = 0; i < 2; ++i) _Pragma("unroll") for (int j = 0; j < 2; ++j) acc[i][j] = MFMA32(af[i], bq[j], acc[i][j]);
        }
        float* U = P.U + ((size_t)(dir * 8 + bh) * NCH + n) * 16384;
        _Pragma("unroll") for (int i = 0; i < 2; ++i) _Pragma("unroll") for (int j = 0; j < 2; ++j) _Pragma("unroll") for (int r = 0; r < 16; ++r)
          U[(64 * wi + 32 * i + crow(r, lh)) * 128 + 64 * wj + 32 * j + lr] = acc[i][j][r];
      }
    }
    {
      float s = 0.f;
      _Pragma("unroll") for (int i = 0; i < 16; ++i) s += sred[i * 256 + tid];
      const int dir = tid >> 7, dk = tid & 127;
      P.nvec[((size_t)(dir * 8 + bh) * NCH + n) * 128 + dk] = s;
    }
  }
}

DI void phase_mscan(const Params& P, int bid, int nblk) {
  constexpr int SB = 13;
  for (int gt = bid * NT + otid(); gt < 16 * 2048 + 256; gt += nblk * NT) {
    if (gt < 16 * 2048) {
      const int seq = gt >> 11, e = gt & 2047, dir = seq >> 3;
      float C[8];
      _Pragma("unroll") for (int j = 0; j < 8; ++j) C[j] = 0.f;
      float m = 0.f;
      for (int sb = 0; sb < NCH; sb += SB) {
        f32x4 u0[SB], u1[SB]; float gg[SB], aa[SB];
        _Pragma("unroll") for (int k = 0; k < SB; ++k) {
          const int n = dir == 0 ? sb + k : NCH - 1 - sb - k;
          const size_t item = (size_t)seq * NCH + n;
          const float* up = P.U + item * 16384 + e * 8;
          u0[k] = *(const f32x4*)up; u1[k] = *(const f32x4*)(up + 4);
          gg[k] = P.mstat[item * 4]; aa[k] = P.mstat[item * 4 + 1];
        }
        _Pragma("unroll") for (int k = 0; k < SB; ++k) {
          const int n = dir == 0 ? sb + k : NCH - 1 - sb - k;
          const size_t item = (size_t)seq * NCH + n;
          const float mn = fmaxf(gg[k] + m, aa[k]);
          const float decay = __expf(gg[k] + m - mn), f = __expf(aa[k] - mn);
          u32x4 cb; cb.x = pk2(C[0], C[1]); cb.y = pk2(C[2], C[3]); cb.z = pk2(C[4], C[5]); cb.w = pk2(C[6], C[7]);
          *(u32x4*)(P.U + item * 16384 + e * 8) = cb;
          C[0] = decay * C[0] + f * u0[k].x; C[1] = decay * C[1] + f * u0[k].y; C[2] = decay * C[2] + f * u0[k].z; C[3] = decay * C[3] + f * u0[k].w;
          C[4] = decay * C[4] + f * u1[k].x; C[5] = decay * C[5] + f * u1[k].y; C[6] = decay * C[6] + f * u1[k].z; C[7] = decay * C[7] + f * u1[k].w;
          m = mn;
        }
      }
    } else {
      const int q = gt - 16 * 2048, seq = q >> 4, e = q & 15, dir = seq >> 3;
      float nst[8];
      _Pragma("unroll") for (int j = 0; j < 8; ++j) nst[j] = 0.f;
      float m = 0.f;
      for (int sb = 0; sb < NCH; sb += SB) {
        f32x4 n0[SB], n1[SB]; float gg[SB], aa[SB];
        _Pragma("unroll") for (int k = 0; k < SB; ++k) {
          const int n = dir == 0 ? sb + k : NCH - 1 - sb - k;
          const size_t item = (size_t)seq * NCH + n;
          const float* np = P.nvec + item * 128 + e * 8;
          n0[k] = *(const f32x4*)np; n1[k] = *(const f32x4*)(np + 4);
          gg[k] = P.mstat[item * 4]; aa[k] = P.mstat[item * 4 + 1];
        }
        _Pragma("unroll") for (int k = 0; k < SB; ++k) {
          const int n = dir == 0 ? sb + k : NCH - 1 - sb - k;
          const size_t item = (size_t)seq * NCH + n;
          const float mn = fmaxf(gg[k] + m, aa[k]);
          const float decay = __expf(gg[k] + m - mn), f = __expf(aa[k] - mn);
          float* np = P.nvec + item * 128 + e * 8;
          *(f32x4*)np = mk4(nst[0], nst[1], nst[2], nst[3]); *(f32x4*)(np + 4) = mk4(nst[4], nst[5], nst[6], nst[7]);
          nst[0] = decay * nst[0] + f * n0[k].x; nst[1] = decay * nst[1] + f * n0[k].y; nst[2] = decay * nst[2] + f * n0[k].z; nst[3] = decay * nst[3] + f * n0[k].w;
          nst[4] = decay * nst[4] + f * n1[k].x; nst[5] = decay * nst[5] + f * n1[k].y; nst[6] = decay * nst[6] + f * n1[k].z; nst[7] = decay * nst[7] + f * n1[k].w;
          if (e == 0) P.mstat[item * 4 + 2] = m;
          m = mn;
        }
      }
    }
  }
}

DI void mout_item(const Params& P, int l, int it, char* smem) {
  const int tid = otid(), lane = tid & 63, w = tid >> 6, lr = lane & 31, lh = lane >> 5;
  const int bh = it / NCH, n = it % NCH, b = bh >> 2, hh = bh & 3;
  char* sK = smem;
  char* sV = smem + 32768;
  float* sb = (float*)(smem + 65536);
  float* sc = sb + 256;
  float* spm = sc + 256;
  float* snp = spm + 256;
  __syncthreads();
  {
    const int rin = lane >> 4, cpos = lane & 15;
    _Pragma("unroll") for (int i = 0; i < 16; ++i) {
      const int dir = i >> 3, R = (i & 7) * 4 + w, row = 4 * R + rin;
      const char* src = (const char*)(P.U + ((size_t)(dir * 8 + bh) * NCH + n) * 16384) + (size_t)row * 512 + (cpos ^ (row & 15)) * 32;
      __builtin_amdgcn_global_load_lds((const unsigned*)src, (lds_u32*)(smem + dir * 32768 + R * 1024), 16, 0, 0);
    }
  }
  {
    const int dir = tid >> 7, tau = tid & 127;
    const size_t base = ((size_t)dir * 8 + bh) * LPAD + 128 * n + tau;
    const float bb = P.bcum[base], li = P.ligate[base];
    sb[tid] = bb; sc[tid] = li - bb;
    snp[tid] = P.nvec[((size_t)(dir * 8 + bh) * NCH + n) * 128 + tau];
  }
  __syncthreads();
  if (w < 2) {
    const int i0 = w == 0 ? 2 * lane : 127 - 2 * lane, i1 = w == 0 ? 2 * lane + 1 : 126 - 2 * lane;
    const float e0 = sc[w * 128 + i0], e1 = sc[w * 128 + i1];
    const float p1 = fmaxf(e0, e1);
    float scan = p1;
    _Pragma("unroll") for (int d = 1; d < 64; d <<= 1) { const float tt = shfl_up_f(scan, d, lane); if (lane >= d) scan = fmaxf(scan, tt); }
    float excl = shfl_up_f(scan, 1, lane); if (lane == 0) excl = -3.0e38f;
    spm[w * 128 + i0] = fmaxf(excl, e0); spm[w * 128 + i1] = fmaxf(excl, p1);
  }
  __syncthreads();
  const int t = 32 * w + lr, p = 128 * n + t;
  bf16x8 qf[8];
  _Pragma("unroll") for (int ks = 0; ks < 8; ++ks) qf[ks] = ldfrag(P.qc + ((size_t)bh * LPAD + p) * 128 + 16 * ks + 8 * lh);
  f32x16 acc[2][4];
  float btv[2], mtv[2], den0[2];
  _Pragma("unroll") for (int dir = 0; dir < 2; ++dir) {
    const size_t item = (size_t)(dir * 8 + bh) * NCH + n;
    const float mprev = P.mstat[item * 4 + 2];
    const float bt = sb[dir * 128 + t];
    const float mt = bt + fmaxf(mprev, spm[dir * 128 + t]);
    const float inter = __expf(bt + mprev - mt);
    float qn = 0.f;
    _Pragma("unroll") for (int ks = 0; ks < 8; ++ks) {
      union { bf16x8 v; unsigned u[4]; } tt; tt.v = qf[ks];
      const float* np = snp + dir * 128 + 16 * ks + 8 * lh;
      _Pragma("unroll") for (int j = 0; j < 4; ++j) qn += bflo(tt.u[j]) * np[2 * j] + bfhi(tt.u[j]) * np[2 * j + 1];
    }
    qn = xsum32(qn);
    btv[dir] = bt; mtv[dir] = mt; den0[dir] = inter * qn;
    const char* sU = smem + dir * 32768;
    _Pragma("unroll") for (int d = 0; d < 4; ++d) {
      const int urow = 32 * d + lr;
      acc[dir][d] = zero16();
      _Pragma("unroll") for (int ks = 0; ks < 8; ++ks) acc[dir][d] = MFMA32(*(const bf16x8*)(sU + urow * 256 + (((2 * ks + lh) ^ (urow & 15)) << 4)), qf[ks], acc[dir][d]);
      _Pragma("unroll") for (int r = 0; r < 16; ++r) acc[dir][d][r] *= inter;
    }
  }
  __syncthreads();
  {
    const int rin = lane >> 4, cpos = lane & 15;
    _Pragma("unroll") for (int i = 0; i < 16; ++i) {
      const int R = i * 4 + w, row = (i < 8 ? 4 * R : 4 * (R - 32)) + rin;
      const int ce = (cpos ^ (row & 15)) * 8;
      const bf16_t* src = i < 8 ? P.kc + ((size_t)bh * LPAD + 128 * n + row) * 128 + ce : P.cvT + ((size_t)bh * 128 + row) * LPAD + 128 * n + ce;
      __builtin_amdgcn_global_load_lds((const unsigned*)src, (lds_u32*)(smem + R * 1024), 16, 0, 0);
    }
  }
  __syncthreads();
  _Pragma("unroll") for (int dir = 0; dir < 2; ++dir) {
    const float bt = btv[dir], mt = mtv[dir];
    float den = 0.f;
    const int st0 = dir == 0 ? 0 : w, st1 = dir == 0 ? w : 3;
    for (int st = st0; st <= st1; ++st) {
      f32x16 s = zero16();
      _Pragma("unroll") for (int ks = 0; ks < 8; ++ks) {
        const int krow = 32 * st + kswap(lr);
        s = MFMA32(*(const bf16x8*)(sK + krow * 256 + (((2 * ks + lh) ^ (krow & 15)) << 4)), qf[ks], s);
      }
      _Pragma("unroll") for (int r = 0; r < 16; ++r) {
        const int sidx = 32 * st + keyoff(r, lh);
        const bool ok = dir == 0 ? (sidx <= t) : (sidx >= t);
        const float dd = __expf(fminf(bt + sc[dir * 128 + sidx] - mt, 0.f));
        const float pv = ok ? s[r] * dd : 0.f;
        s[r] = pv; den += pv;
      }
      const bf16x8 p0 = packfrag(s, 0), p1 = packfrag(s, 1);
      _Pragma("unroll") for (int d = 0; d < 4; ++d) {
        const int vrow = 32 * d + lr;
        const char* vp = sV + vrow * 256;
        acc[dir][d] = MFMA32(*(const bf16x8*)(vp + (((4 * st + lh) ^ (vrow & 15)) << 4)), p0, acc[dir][d]);
        acc[dir][d] = MFMA32(*(const bf16x8*)(vp + (((4 * st + 2 + lh) ^ (vrow & 15)) << 4)), p1, acc[dir][d]);
      }
    }
    den = xsum32(den);
    den = den0[dir] + den;
    const float sca = frcp(fmaxf(fabsf(den), __expf(-mt)));
    _Pragma("unroll") for (int d = 0; d < 4; ++d) _Pragma("unroll") for (int r = 0; r < 16; ++r) acc[dir][d][r] *= sca;
  }
  float hacc[4][16];
  _Pragma("unroll") for (int d = 0; d < 4; ++d) _Pragma("unroll") for (int r = 0; r < 16; ++r) hacc[d][r] = acc[0][d][r] + acc[1][d][r];
  float s1 = 0.f;
  _Pragma("unroll") for (int d = 0; d < 4; ++d) _Pragma("unroll") for (int r = 0; r < 16; ++r) s1 += hacc[d][r];
  s1 = xsum32(s1);
  const float mu = s1 * (1.f / 128.f);
  float s2 = 0.f;
  _Pragma("unroll") for (int d = 0; d < 4; ++d) _Pragma("unroll") for (int r = 0; r < 16; ++r) { hacc[d][r] -= mu; s2 += hacc[d][r] * hacc[d][r]; }
  s2 = xsum32(s2);
  const float rs = rsqrtf(s2 * (1.f / 128.f) + LN_EPS);
  const int pos = p - MPAD;
  if (pos >= 0) {
    const size_t tok = (size_t)b * L + pos;
    _Pragma("unroll") for (int d = 0; d < 4; ++d) _Pragma("unroll") for (int rg = 0; rg < 4; ++rg) {
      const int dv = 32 * d + 8 * rg + 4 * lh;
      const int col = hh * 128 + dv;
      const u32x2 cu = *(const u32x2*)(P.co + tok * 512 + col);
      const f32x4 g4 = *(const f32x4*)(P.mlstm_g + l * 512 + col);
      const float o0 = hacc[d][4 * rg + 0] * rs * g4.x * sigmoidf_(bflo(cu.x));
      const float o1 = hacc[d][4 * rg + 1] * rs * g4.y * sigmoidf_(bfhi(cu.x));
      const float o2 = hacc[d][4 * rg + 2] * rs * g4.z * sigmoidf_(bflo(cu.y));
      const float o3 = hacc[d][4 * rg + 3] * rs * g4.w * sigmoidf_(bfhi(cu.y));
      u32x2 ou; ou.x = pk2(o0, o1); ou.y = pk2(o2, o3);
      *(u32x2*)(P.oc + tok * 512 + col) = ou;
    }
  }
}

constexpr int DA_STAGE = 32768;
constexpr float DA_THR = 8.f;
DI void dattn_issue(const Params& P, int bh, int k0, char* stage, unsigned vk, unsigned vv, int w) {
  const char* kb0 = (const char*)(P.ka + ((size_t)(bh * 2) * L + k0) * 64);
  const char* vb0 = (const char*)(P.vaT + (size_t)bh * 128 * LK + k0);
  _Pragma("unroll") for (int i = 0; i < 8; ++i) {
    const char* src = i < 4 ? kb0 + (size_t)(i >> 1) * (L * 128) + (i & 1) * 4096 + vk : vb0 + (size_t)(i - 4) * 32 * LK * 2 + vv;
    __builtin_amdgcn_global_load_lds((const unsigned*)src, (lds_u32*)(stage + (i * 4 + w) * 1024), 16, 0, 0);
  }
}
DI void dattn_merge4(f32x16 (&O)[2][4], float (&m)[2], float (&ls)[2], char* smem, int lane, int w) {
  float* xf = (float*)smem;
  for (int src = 1; src < 4; ++src) {
    __syncthreads();
    if (w == src) {
      _Pragma("unroll") for (int c = 0; c < 2; ++c) {
        _Pragma("unroll") for (int d = 0; d < 4; ++d) _Pragma("unroll") for (int r = 0; r < 16; ++r) xf[((c * 4 + d) * 16 + r) * 64 + lane] = O[c][d][r];
        xf[8192 + c * 64 + lane] = m[c]; xf[8192 + 128 + c * 64 + lane] = ls[c];
      }
    }
    __syncthreads();
    if (w == 0) {
      _Pragma("unroll") for (int c = 0; c < 2; ++c) {
        const float mb = xf[8192 + c * 64 + lane], lb = xf[8192 + 128 + c * 64 + lane];
        const float M = fmaxf(m[c], mb), fa = fexp2(m[c] - M), fb = fexp2(mb - M);
        ls[c] = ls[c] * fa + lb * fb; m[c] = M;
        _Pragma("unroll") for (int d = 0; d < 4; ++d) _Pragma("unroll") for (int r = 0; r < 16; ++r) O[c][d][r] = O[c][d][r] * fa + xf[((c * 4 + d) * 16 + r) * 64 + lane] * fb;
      }
    }
  }
}
DI void dattn_finish(const Params& P, int l, int bh, int q0, f32x16 (&O)[2][4], const float (&ls)[2], int lr, int lh) {
  const int b = bh >> 2, hh = bh & 3;
  const float lam = P.lam[l], omli = P.lam[2 + l];
  const float i0 = 1.f / ls[0], i1 = lam / ls[1];
  float ss = 0.f;
  _Pragma("unroll") for (int d = 0; d < 4; ++d) _Pragma("unroll") for (int r = 0; r < 16; ++r) { const float o = O[0][d][r] * i0 - O[1][d][r] * i1; O[0][d][r] = o; ss += o * o; }
  ss = xsum32(ss);
  const float rs = rsqrtf(ss * (1.f / 128.f) + LN_EPS);
  if (q0 + lr < L) {
    const size_t tok = (size_t)b * L + q0 + lr;
    _Pragma("unroll") for (int d = 0; d < 4; ++d) _Pragma("unroll") for (int rg = 0; rg < 4; ++rg) {
      const int dv = 32 * d + 8 * rg + 4 * lh;
      const f32x4 g4 = *(const f32x4*)(P.diff_g + l * 128 + dv);
      u32x2 ou;
      ou.x = pk2(O[0][d][4 * rg + 0] * rs * g4.x * omli, O[0][d][4 * rg + 1] * rs * g4.y * omli);
      ou.y = pk2(O[0][d][4 * rg + 2] * rs * g4.z * omli, O[0][d][4 * rg + 3] * rs * g4.w * omli);
      *(u32x2*)(P.oa + tok * 512 + hh * 128 + dv) = ou;
    }
  }
}
DI void da_softmax(f32x16& s, float& m, float& ls, f32x16 (&O)[4], bool last, int key0, int lh, bf16x8& p0, bf16x8& p1) {
  if (last) {
    asm volatile("; last key tile: mask" ::: "memory");
    _Pragma("unroll") for (int r = 0; r < 16; ++r) if (key0 + keyoff(r, lh) >= L) s[r] = -3.0e38f;
  }
  float mx = s[0];
  _Pragma("unroll") for (int r = 1; r < 16; ++r) mx = fmaxf(mx, s[r]);
  if (__any(mx - m > DA_THR)) {
    asm volatile("; rare: move the softmax reference" ::: "memory");
    const float dlt = fmaxf(xmax32(mx) - m, 0.f);
    const float al = fexp2(-dlt);
    m += dlt; ls *= al;
    _Pragma("unroll") for (int d = 0; d < 4; ++d) _Pragma("unroll") for (int r = 0; r < 16; ++r) O[d][r] *= al;
  }
  f32x2 rs2 = mk2(0.f, 0.f);
  _Pragma("unroll") for (int i = 0; i < 8; ++i) {
    f32x2 x = mk2(s[2 * i], s[2 * i + 1]) - mk2(m, m);
    x.x = fexp2(x.x); x.y = fexp2(x.y);
    s[2 * i] = x.x; s[2 * i + 1] = x.y;
    rs2 += x;
  }
  ls += rs2.x + rs2.y;
  p0 = packfrag(s, 0); p1 = packfrag(s, 1);
}
constexpr int DA_PART = 2 * 4 * 16 * 64 + 256;
DI void dattn_item(const Params& P, int l, int it, bool part, char* smem) {
  const int tid = otid(), lane = tid & 63, w = tid >> 6, lr = lane & 31, lh = lane >> 5;
  const int bh = it & 7, jq = it >> 3;
  const int q0 = part ? 8192 : jq * 128 + 32 * w;
  const int qi = min(q0 + lr, L - 1);
  constexpr int NTILE = (L + 63) / 64;
  const int t0 = part ? 2 * jq : 0, t1 = part ? (jq == 63 ? NTILE : 2 * jq + 2) : NTILE;
  bf16x8 qf[2][4];
  _Pragma("unroll") for (int c = 0; c < 2; ++c) _Pragma("unroll") for (int ks = 0; ks < 4; ++ks)
    qf[c][ks] = ldfrag(P.qa + ((size_t)(bh * 2 + c) * L + qi) * 64 + 16 * ks + 8 * lh);
  f32x16 O[2][4];
  float m[2], ls[2];
  _Pragma("unroll") for (int c = 0; c < 2; ++c) {
    f32x16 s = zero16();
    const bf16_t* kp = P.ka + ((size_t)(bh * 2 + c) * L + t0 * 64 + kswap(lr)) * 64 + 8 * lh;
    _Pragma("unroll") for (int ks = 0; ks < 4; ++ks) s = MFMA32(ldfrag(kp + 16 * ks), qf[c][ks], s);
    float mx = s[0];
    _Pragma("unroll") for (int r = 1; r < 16; ++r) mx = fmaxf(mx, s[r]);
    m[c] = xmax32(mx); ls[c] = 0.f;
    _Pragma("unroll") for (int d = 0; d < 4; ++d) O[c][d] = zero16();
  }
  const unsigned vk = (unsigned)((w * 8 + (lane >> 3)) * 128 + (((lane & 7) ^ (4 * (w & 1) + (lane >> 4))) << 4));
  const unsigned vv = (unsigned)((w * 8 + (lane >> 3)) * (LK * 2) + (((lane & 7) ^ (4 * (w & 1) + (lane >> 4))) << 4));
  __syncthreads();
  dattn_issue(P, bh, t0 * 64, smem + (t0 & 1) * DA_STAGE, vk, vv, w);
  for (int t = t0; t < t1; ++t) {
    __syncthreads();
    if (t + 1 < t1) dattn_issue(P, bh, (t + 1) * 64, smem + ((t + 1) & 1) * DA_STAGE, vk, vv, w);
    const char* st = smem + (t & 1) * DA_STAGE;
    _Pragma("unroll") for (int kb = 0; kb < 2; ++kb) {
      if (part && ((((t - t0) * 2 + kb) & 3) != w)) continue;
      bf16x8 pf[2][2];
      _Pragma("unroll") for (int c = 0; c < 2; ++c) {
        f32x16 s;
        _Pragma("unroll") for (int r = 0; r < 16; ++r) s[r] = -m[c];
        const int krow = kb * 32 + kswap(lr);
        const char* kp = st + c * 8192 + krow * 128;
        _Pragma("unroll") for (int ks = 0; ks < 4; ++ks) s = MFMA32(*(const bf16x8*)(kp + (((2 * ks + lh) ^ swz(krow)) << 4)), qf[c][ks], s);
        if (t == NTILE - 1) {
          _Pragma("unroll") for (int r = 0; r < 16; ++r) if (t * 64 + kb * 32 + keyoff(r, lh) >= L) s[r] = -3.0e38f;
        }
        float mx = s[0];
        _Pragma("unroll") for (int r = 1; r < 16; ++r) mx = fmaxf(mx, s[r]);
        if (__any(mx > DA_THR)) {
          asm volatile("; rare: move the softmax reference" ::: "memory");
          const float dlt = fmaxf(xmax32(mx), 0.f);
          const float al = fexp2(-dlt);
          m[c] += dlt; ls[c] *= al;
          _Pragma("unroll") for (int d = 0; d < 4; ++d) _Pragma("unroll") for (int r = 0; r < 16; ++r) O[c][d][r] *= al;
          _Pragma("unroll") for (int r = 0; r < 16; ++r) s[r] -= dlt;
        }
        float rsum = 0.f;
        _Pragma("unroll") for (int r = 0; r < 16; ++r) { const float pv = fexp2(s[r]); s[r] = pv; rsum += pv; }
        ls[c] += rsum;
        pf[c][0] = packfrag(s, 0); pf[c][1] = packfrag(s, 1);
      }
      _Pragma("unroll") for (int d = 0; d < 4; ++d) {
        const int vrow = 32 * d + lr;
        const char* vp = st + 16384 + vrow * 128;
        const bf16x8 v0 = *(const bf16x8*)(vp + (((kb * 4 + lh) ^ swz(vrow)) << 4));
        const bf16x8 v1 = *(const bf16x8*)(vp + (((kb * 4 + 2 + lh) ^ swz(vrow)) << 4));
        _Pragma("unroll") for (int c = 0; c < 2; ++c) { O[c][d] = MFMA32(v0, pf[c][0], O[c][d]); O[c][d] = MFMA32(v1, pf[c][1], O[c][d]); }
      }
    }
  }
  _Pragma("unroll") for (int c = 0; c < 2; ++c) ls[c] = xsum32(ls[c]);
  if (part) {
    dattn_merge4(O, m, ls, smem, lane, w);
    if (w == 0) {
      float* pb = (float*)P.merged + (size_t)it * DA_PART + lane;
      _Pragma("unroll") for (int c = 0; c < 2; ++c) {
        _Pragma("unroll") for (int d = 0; d < 4; ++d) {
          float* pp = pb + (c * 4 + d) * 1024;
          asm volatile("" : "+v"(pp));
          _Pragma("unroll") for (int r = 0; r < 16; ++r) pp[r * 64] = O[c][d][r];
        }
        pb[8192 + c * 64] = m[c]; pb[8192 + 128 + c * 64] = ls[c];
      }
    }
    return;
  }
  dattn_finish(P, l, bh, q0, O, ls, lr, lh);
}
DI void da_qk(f32x16& s, const char* st, int c, int kb, int lr, int lh, const bf16x8 (&qf)[4]) {
  s = zero16();
  const int krow = kb * 32 + kswap(lr);
  const char* kp = st + c * 8192 + krow * 128;
  _Pragma("unroll") for (int ks = 0; ks < 4; ++ks) s = MFMA32(*(const bf16x8*)(kp + (((2 * ks + lh) ^ swz(krow)) << 4)), qf[ks], s);
}
DI void dattn_item8(const Params& P, int l, int it, char* smem_wg) {
  int tid = rtid(); asm volatile("" : "+v"(tid));
  const int lane = tid & 63, w = __builtin_amdgcn_readfirstlane(tid >> 6), g = w & 3, c = w >> 2, lr = lane & 31, lh = lane >> 5;
  const int bh = it & 7, jq = it >> 3;
  const int q0 = jq * 128 + 32 * g;
  constexpr int NT8 = (L + 127) / 128;
  bf16x8 qf[4];
  _Pragma("unroll") for (int ks = 0; ks < 4; ++ks) qf[ks] = ldfrag(P.qa + ((size_t)(bh * 2 + c) * L + q0 + lr) * 64 + 16 * ks + 8 * lh);
  f32x16 O[4];
  float m, ls = 0.f;
  {
    f32x16 s = zero16();
    const bf16_t* kp = P.ka + ((size_t)(bh * 2 + c) * L + kswap(lr)) * 64 + 8 * lh;
    _Pragma("unroll") for (int ks = 0; ks < 4; ++ks) s = MFMA32(ldfrag(kp + 16 * ks), qf[ks], s);
    float mx = s[0];
    _Pragma("unroll") for (int r = 1; r < 16; ++r) mx = fmaxf(mx, s[r]);
    m = xmax32(mx);
    _Pragma("unroll") for (int d = 0; d < 4; ++d) O[d] = zero16();
  }
  const unsigned vk = (unsigned)((g * 8 + (lane >> 3)) * 128 + (((lane & 7) ^ (4 * (g & 1) + (lane >> 4))) << 4));
  const unsigned vv = (unsigned)((g * 8 + (lane >> 3)) * (LK * 2) + (((lane & 7) ^ (4 * (g & 1) + (lane >> 4))) << 4));
  constexpr int ST8 = 2 * DA_STAGE;
  __syncthreads();
  dattn_issue(P, bh, c * 64, smem_wg + c * DA_STAGE, vk, vv, g);
  for (int t = 0; t < NT8; ++t) {
    __syncthreads();
    if (t + 1 < NT8) dattn_issue(P, bh, (t + 1) * 128 + c * 64, smem_wg + ((t + 1) & 1) * ST8 + c * DA_STAGE, vk, vv, g);
    const char* stt = smem_wg + (t & 1) * ST8;
    f32x16 S[4];
    _Pragma("unroll") for (int b = 0; b < 4; ++b) da_qk(S[b], stt + (b >> 1) * DA_STAGE, c, b & 1, lr, lh, qf);
    if (t == NT8 - 1) {
      asm volatile("; last key tile: mask" ::: "memory");
      _Pragma("unroll") for (int b = 0; b < 4; ++b) _Pragma("unroll") for (int r = 0; r < 16; ++r) if (t * 128 + b * 32 + keyoff(r, lh) >= L) S[b][r] = -3.0e38f;
    }
    float mx = S[0][0];
    _Pragma("unroll") for (int b = 0; b < 4; ++b) _Pragma("unroll") for (int r = 0; r < 16; ++r) mx = fmaxf(mx, S[b][r]);
    if (__any(mx - m > DA_THR)) {
      asm volatile("; rare: move the softmax reference" ::: "memory");
      const float dlt = fmaxf(xmax32(mx) - m, 0.f);
      const float al = fexp2(-dlt);
      m += dlt; ls *= al;
      _Pragma("unroll") for (int d = 0; d < 4; ++d) _Pragma("unroll") for (int r = 0; r < 16; ++r) O[d][r] *= al;
    }
    f32x2 rs2 = mk2(0.f, 0.f);
    const f32x2 mm = mk2(m, m);
    _Pragma("unroll") for (int h2 = 0; h2 < 2; ++h2) {
      bf16x8 pf[2][2];
      _Pragma("unroll") for (int kb = 0; kb < 2; ++kb) {
        f32x16& s = S[2 * h2 + kb];
        _Pragma("unroll") for (int i = 0; i < 8; ++i) {
          f32x2 x = mk2(s[2 * i], s[2 * i + 1]) - mm;
          x.x = fexp2(x.x); x.y = fexp2(x.y);
          s[2 * i] = x.x; s[2 * i + 1] = x.y;
          rs2 += x;
        }
        pf[kb][0] = packfrag(s, 0); pf[kb][1] = packfrag(s, 1);
      }
      const char* st = stt + h2 * DA_STAGE;
      _Pragma("unroll") for (int kb = 0; kb < 2; ++kb) _Pragma("unroll") for (int d = 0; d < 4; ++d) {
        const int vrow = 32 * d + lr;
        const char* vp = st + 16384 + vrow * 128;
        const bf16x8 v0 = *(const bf16x8*)(vp + (((kb * 4 + lh) ^ swz(vrow)) << 4));
        const bf16x8 v1 = *(const bf16x8*)(vp + (((kb * 4 + 2 + lh) ^ swz(vrow)) << 4));
        O[d] = MFMA32(v0, pf[kb][0], O[d]); O[d] = MFMA32(v1, pf[kb][1], O[d]);
      }
    }
    ls += rs2.x + rs2.y;
  }
  ls = xsum32(ls);
  float* xf = (float*)smem_wg + g * 4096;
  __syncthreads();
  if (c == 1) {
    const float i1 = P.lam[l] / ls;
    _Pragma("unroll") for (int d = 0; d < 4; ++d) _Pragma("unroll") for (int r = 0; r < 16; ++r) xf[(d * 16 + r) * 64 + lane] = O[d][r] * i1;
  }
  __syncthreads();
  if (c == 0) {
    const int b = bh >> 2, hh = bh & 3;
    const float omli = P.lam[2 + l], i0 = 1.f / ls;
    float ss = 0.f;
    _Pragma("unroll") for (int d = 0; d < 4; ++d) _Pragma("unroll") for (int r = 0; r < 16; ++r) { const float o = O[d][r] * i0 - xf[(d * 16 + r) * 64 + lane]; O[d][r] = o; ss += o * o; }
    ss = xsum32(ss);
    const float rs = rsqrtf(ss * (1.f / 128.f) + LN_EPS);
    const size_t tok = (size_t)b * L + q0 + lr;
    _Pragma("unroll") for (int d = 0; d < 4; ++d) _Pragma("unroll") for (int rg = 0; rg < 4; ++rg) {
      const int dv = 32 * d + 8 * rg + 4 * lh;
      const f32x4 g4 = *(const f32x4*)(P.diff_g + l * 128 + dv);
      u32x2 ou;
      ou.x = pk2(O[d][4 * rg + 0] * rs * g4.x * omli, O[d][4 * rg + 1] * rs * g4.y * omli);
      ou.y = pk2(O[d][4 * rg + 2] * rs * g4.z * omli, O[d][4 * rg + 3] * rs * g4.w * omli);
      *(u32x2*)(P.oa + tok * 512 + hh * 128 + dv) = ou;
    }
  }
}
DI void dattn_item16(const Params& P, int l, int it, char* smem_wg) {
  int tid = rtid(); asm volatile("" : "+v"(tid));
  const int lane = tid & 63, w = __builtin_amdgcn_readfirstlane(tid >> 6), w4 = w & 3, ih = w >> 2, lr = lane & 31, lh = lane >> 5;
  const int bh = it & 7, jq = it >> 3;
  const int q0 = jq * 256 + 32 * w;
  constexpr int NTILE = (L + 63) / 64;
  bf16x8 qf[2][4];
  _Pragma("unroll") for (int c = 0; c < 2; ++c) _Pragma("unroll") for (int ks = 0; ks < 4; ++ks)
    qf[c][ks] = ldfrag(P.qa + ((size_t)(bh * 2 + c) * L + q0 + lr) * 64 + 16 * ks + 8 * lh);
  f32x16 O[2][4];
  float m[2], ls[2];
  _Pragma("unroll") for (int c = 0; c < 2; ++c) {
    f32x16 s = zero16();
    const bf16_t* kp = P.ka + ((size_t)(bh * 2 + c) * L + kswap(lr)) * 64 + 8 * lh;
    _Pragma("unroll") for (int ks = 0; ks < 4; ++ks) s = MFMA32(ldfrag(kp + 16 * ks), qf[c][ks], s);
    float mx = s[0];
    _Pragma("unroll") for (int r = 1; r < 16; ++r) mx = fmaxf(mx, s[r]);
    m[c] = xmax32(mx); ls[c] = 0.f;
    _Pragma("unroll") for (int d = 0; d < 4; ++d) O[c][d] = zero16();
  }
  const unsigned sw16 = (unsigned)(((lane & 7) ^ (4 * (w4 & 1) + (lane >> 4))) << 4);
  const char* gsrc = ih == 0 ? (const char*)(P.ka + (size_t)(bh * 2) * L * 64) + (size_t)(w4 * 8 + (lane >> 3)) * 128 + sw16
                             : (const char*)(P.vaT + (size_t)bh * 128 * LK) + (size_t)(w4 * 8 + (lane >> 3)) * (LK * 2) + sw16;
#define DA16_ISSUE(t_, st_) _Pragma("unroll") for (int i_ = 0; i_ < 4; ++i_) { \
    const char* src_ = ih == 0 ? gsrc + (size_t)(t_) * (64 * 128) + (size_t)(i_ >> 1) * (L * 128) + (i_ & 1) * 4096 : gsrc + (size_t)(t_) * 128 + (size_t)i_ * 32 * LK * 2; \
    __builtin_amdgcn_global_load_lds((const unsigned*)src_, (lds_u32*)(smem_wg + (st_) * DA_STAGE + ((ih * 4 + i_) * 4 + w4) * 1024), 16, 0, 0); }
  __syncthreads();
  DA16_ISSUE(0, 0)
  for (int t = 0; t < NTILE; ++t) {
    __syncthreads();
    if (t + 1 < NTILE) { DA16_ISSUE(t + 1, (t + 1) & 1) }
    const char* st = smem_wg + (t & 1) * DA_STAGE;
    _Pragma("unroll") for (int kb = 0; kb < 2; ++kb) {
      bf16x8 pf[2][2];
      _Pragma("unroll") for (int c = 0; c < 2; ++c) {
        f32x16 s;
        _Pragma("unroll") for (int r = 0; r < 16; ++r) s[r] = -m[c];
        const int krow = kb * 32 + kswap(lr);
        const char* kp = st + c * 8192 + krow * 128;
        _Pragma("unroll") for (int ks = 0; ks < 4; ++ks) s = MFMA32(*(const bf16x8*)(kp + (((2 * ks + lh) ^ swz(krow)) << 4)), qf[c][ks], s);
        if (t == NTILE - 1) {
          _Pragma("unroll") for (int r = 0; r < 16; ++r) if (t * 64 + kb * 32 + keyoff(r, lh) >= L) s[r] = -3.0e38f;
        }
        float mx = s[0];
        _Pragma("unroll") for (int r = 1; r < 16; ++r) mx = fmaxf(mx, s[r]);
        if (__any(mx > DA_THR)) {
          asm volatile("; rare: move the softmax reference" ::: "memory");
          const float dlt = fmaxf(xmax32(mx), 0.f);
          const float al = fexp2(-dlt);
          m[c] += dlt; ls[c] *= al;
          _Pragma("unroll") for (int d = 0; d < 4; ++d) _Pragma("unroll") for (int r = 0; r < 16; ++r) O[c][d][r] *= al;
          _Pragma("unroll") for (int r = 0; r < 16; ++r) s[r] -= dlt;
        }
        float rsum = 0.f;
        _Pragma("unroll") for (int r = 0; r < 16; ++r) { const float pv = fexp2(s[r]); s[r] = pv; rsum += pv; }
        ls[c] += rsum;
        pf[c][0] = packfrag(s, 0); pf[c][1] = packfrag(s, 1);
      }
      _Pragma("unroll") for (int d = 0; d < 4; ++d) {
        const int vrow = 32 * d + lr;
        const char* vp = st + 16384 + vrow * 128;
        const bf16x8 v0 = *(const bf16x8*)(vp + (((kb * 4 + lh) ^ swz(vrow)) << 4));
        const bf16x8 v1 = *(const bf16x8*)(vp + (((kb * 4 + 2 + lh) ^ swz(vrow)) << 4));
        _Pragma("unroll") for (int c = 0; c < 2; ++c) { O[c][d] = MFMA32(v0, pf[c][0], O[c][d]); O[c][d] = MFMA32(v1, pf[c][1], O[c][d]); }
      }
    }
  }
#undef DA16_ISSUE
  _Pragma("unroll") for (int c = 0; c < 2; ++c) ls[c] = xsum32(ls[c]);
  dattn_finish(P, l, bh, q0, O, ls, lr, lh);
}
DI void dattn_combine(const Params& P, int l, int bh, char* smem) {
  const int tid = otid(), lane = tid & 63, w = tid >> 6, lr = lane & 31, lh = lane >> 5;
  f32x16 O[2][4];
  float m[2], ls[2];
  __syncthreads();
  for (int k = 0; k < 16; ++k) {
    const float* pb = (const float*)P.merged + (size_t)(bh + 8 * (w * 16 + k)) * DA_PART + lane;
    _Pragma("unroll") for (int c = 0; c < 2; ++c) {
      const float mb = pb[8192 + c * 64], lb = pb[8192 + 128 + c * 64];
      float fa, fb;
      if (k == 0) { m[c] = mb; ls[c] = lb; fa = 0.f; fb = 1.f; }
      else { const float M = fmaxf(m[c], mb); fa = fexp2(m[c] - M); fb = fexp2(mb - M); ls[c] = ls[c] * fa + lb * fb; m[c] = M; }
      _Pragma("unroll") for (int d = 0; d < 4; ++d) {
        const float* pp = pb + (c * 4 + d) * 1024;
        asm volatile("" : "+v"(pp));
        _Pragma("unroll") for (int r = 0; r < 16; ++r) {
          const float ov = pp[r * 64];
          O[c][d][r] = k == 0 ? ov : O[c][d][r] * fa + ov * fb;
        }
      }
    }
  }
  dattn_merge4(O, m, ls, smem, lane, w);
  if (w == 0) dattn_finish(P, l, bh, 8192, O, ls, lr, lh);
}

DI void swa_item(const Params& P, int l, int it, char* smem) {
  const int tid = otid(), lane = tid & 63, w = tid >> 6, lr = lane & 31, lh = lane >> 5;
  const int NQT = (L + 31) / 32;
  const int bk = it / NQT, qt = it % NQT, b = bk >> 1, kv = bk & 1, hq = kv * 4 + w;
  const int q0 = qt * 32;
  const int qi = min(q0 + lr, L - 1);
  bf16x8 qf[4];
  _Pragma("unroll") for (int ks = 0; ks < 4; ++ks) qf[ks] = ldfrag(P.qb + ((size_t)(b * 8 + hq) * L + qi) * 64 + 16 * ks + 8 * lh);
  f32x16 O[2]; O[0] = zero16(); O[1] = zero16();
  float m = P.sink[l * 8 + hq] * 1.44269504088896341f, ls = 1.f;
  const bf16_t* kbase = P.kb + (size_t)(b * 2 + kv) * L * 64;
  const bf16_t* vbase = P.vbT + (size_t)(b * 2 + kv) * 64 * LK;
  const int qpos = q0 + lr;
  char* wk = smem + w * 16384;
  char* wv = wk + 8192;
  bf16x8 tk[2][2][4], tv[2][2][4];
#define SWA_LDK(dst, bi_) { const int k1_ = (bi_) == 0 ? 0 : q0 - 160 + 32 * (bi_); \
    _Pragma("unroll") for (int i = 0; i < 4; ++i) { const int krow_ = min(max(k1_ + 8 * i + (lane >> 3), 0), L - 1); dst[i] = ldfrag(kbase + (size_t)krow_ * 64 + (lane & 7) * 8); } }
#define SWA_LDV(dst, bi_) { const int k0_ = (bi_) == 0 ? 0 : q0 - 160 + 32 * (bi_); const int kc0_ = min(max(k0_, 0), LK - 32); \
    _Pragma("unroll") for (int i = 0; i < 4; ++i) dst[i] = ldfrag(vbase + (size_t)(16 * i + (lane >> 2)) * LK + kc0_ + (lane & 3) * 8); }
  SWA_LDK(tk[0][0], 0) SWA_LDK(tk[0][1], 1) SWA_LDV(tv[0][0], 0) SWA_LDV(tv[0][1], 1)
  __builtin_amdgcn_sched_barrier(0);
  _Pragma("unroll") for (int pr = 0; pr < 5; ++pr) {
    const int cp = pr & 1;
    _Pragma("unroll") for (int x = 0; x < 2; ++x) _Pragma("unroll") for (int i = 0; i < 4; ++i) {
      const int r = 8 * i + (lane >> 3);
      *(bf16x8*)(wk + x * 4096 + r * 128 + ((((lane & 7)) ^ swz(r)) << 4)) = tk[cp][x][i];
      const int rv = 16 * i + (lane >> 2);
      *(bf16x8*)(wv + x * 4096 + rv * 64 + ((((lane & 3)) ^ ((rv >> 2) & 3)) << 4)) = tv[cp][x][i];
    }
    __builtin_amdgcn_sched_barrier(0);
    if (pr + 1 < 5) { SWA_LDK(tk[cp ^ 1][0], 2 * pr + 2) SWA_LDK(tk[cp ^ 1][1], 2 * pr + 3) SWA_LDV(tv[cp ^ 1][0], 2 * pr + 2) SWA_LDV(tv[cp ^ 1][1], 2 * pr + 3) }
    __builtin_amdgcn_sched_barrier(0);
    f32x16 s[2];
    _Pragma("unroll") for (int x = 0; x < 2; ++x) {
      s[x] = zero16();
      const int krow = kswap(lr);
      _Pragma("unroll") for (int ks = 0; ks < 4; ++ks) s[x] = MFMA32(*(const bf16x8*)(wk + x * 4096 + krow * 128 + (((2 * ks + lh) ^ swz(krow)) << 4)), qf[ks], s[x]);
    }
    float mx = -3.0e38f;
    _Pragma("unroll") for (int x = 0; x < 2; ++x) {
      const int bi = 2 * pr + x;
      const int k0 = bi == 0 ? 0 : q0 - 160 + 32 * bi;
      _Pragma("unroll") for (int r = 0; r < 16; ++r) {
        const int kj = k0 + keyoff(r, lh);
        bool ok;
        if (bi == 0) ok = kj < NMETA;
        else ok = kj >= NMETA && kj < L && kj >= qpos - 128 && kj <= qpos + 128;
        const float v = ok ? s[x][r] : -3.0e38f;
        s[x][r] = v; mx = fmaxf(mx, v);
      }
    }
    mx = xmax32(mx);
    const float mn = fmaxf(m, mx);
    const float al = fexp2(m - mn);
    float rsum = 0.f;
    _Pragma("unroll") for (int x = 0; x < 2; ++x) _Pragma("unroll") for (int r = 0; r < 16; ++r) { const float pv = fexp2(s[x][r] - mn); s[x][r] = pv; rsum += pv; }
    rsum = xsum32(rsum);
    ls = ls * al + rsum; m = mn;
    _Pragma("unroll") for (int d = 0; d < 2; ++d) _Pragma("unroll") for (int r = 0; r < 16; ++r) O[d][r] *= al;
    _Pragma("unroll") for (int x = 0; x < 2; ++x) {
      const bf16x8 p0 = packfrag(s[x], 0), p1 = packfrag(s[x], 1);
      _Pragma("unroll") for (int d = 0; d < 2; ++d) {
        const int vrow = 32 * d + lr;
        const char* vp = wv + x * 4096 + vrow * 64;
        const int sx = (vrow >> 2) & 3;
        O[d] = MFMA32(*(const bf16x8*)(vp + ((lh ^ sx) << 4)), p0, O[d]);
        O[d] = MFMA32(*(const bf16x8*)(vp + (((2 + lh) ^ sx) << 4)), p1, O[d]);
      }
    }
    __builtin_amdgcn_sched_barrier(0);
  }
#undef SWA_LDK
#undef SWA_LDV
  if (qpos < L) {
    const float inv = 1.f / ls;
    const size_t tok = (size_t)b * L + qpos;
    _Pragma("unroll") for (int d = 0; d < 2; ++d) _Pragma("unroll") for (int rg = 0; rg < 4; ++rg) {
      const int dv = 32 * d + 8 * rg + 4 * lh;
      u32x2 ou;
      ou.x = pk2(O[d][4 * rg + 0] * inv, O[d][4 * rg + 1] * inv);
      ou.y = pk2(O[d][4 * rg + 2] * inv, O[d][4 * rg + 3] * inv);
      *(u32x2*)(P.ob + tok * 512 + hq * 64 + dv) = ou;
    }
  }
}

constexpr int P3_MT = TP / 128, P3_NT = D / 128;
DI void tail_reduce(const f32x16& acc, char* smem_wg, int w, int lane, float (&v)[2]) {
  float* red = (float*)smem_wg;
  __syncthreads();
  _Pragma("unroll") for (int r = 0; r < 16; ++r) red[(w * 16 + r) * 64 + lane] = acc[r];
  __syncthreads();
  _Pragma("unroll") for (int j = 0; j < 2; ++j) {
    float s = 0.f;
    _Pragma("unroll") for (int x = 0; x < 8; ++x) s += red[(x * 16 + 2 * w + j) * 64 + lane];
    v[j] = s;
  }
  __syncthreads();
}
DI void p3a_tail(const Params& P, char* smem_wg, int wg) {
  int tid = rtid(); asm volatile("" : "+v"(tid));
  const int lane = tid & 63, w = tid >> 6, lr = lane & 31, lh = lane >> 5;
  const int n0 = 32 * wg, k0 = 64 * w + 8 * lh;
  f32x16 tot = zero16();
  _Pragma("unroll 1") for (int br = 0; br < 3; ++br) {
    const bf16_t* A = P.oa + ((size_t)br * TP + 16384 + lr) * 512 + k0;
    const bf16_t* B = P.w_br_t + ((size_t)br * 1024 + n0 + lr) * 512 + k0;
    f32x16 part = zero16();
    _Pragma("unroll") for (int ks = 0; ks < 4; ++ks) part = MFMA32(ldfrag(A + 16 * ks), ldfrag(B + 16 * ks), part);
    _Pragma("unroll") for (int r = 0; r < 16; ++r) tot[r] += bf2f(P.gz[(size_t)(16384 + crow(r, lh)) * 3072 + br * 1024 + n0 + lr]) * part[r];
  }
  float v[2];
  tail_reduce(tot, smem_wg, w, lane, v);
  _Pragma("unroll") for (int j = 0; j < 2; ++j) P.merged[(size_t)(16384 + crow(2 * w + j, lh)) * D + n0 + lr] = f2bf(v[j]);
}
DI void p3b_tail(const Params& P, char* smem_wg, int wg) {
  int tid = rtid(); asm volatile("" : "+v"(tid));
  const int lane = tid & 63, w = tid >> 6, lr = lane & 31, lh = lane >> 5;
  const int n0 = 32 * wg, k0 = 128 * w + 8 * lh;
  const bf16_t* A = P.merged + (size_t)(16384 + lr) * D + k0;
  const bf16_t* B = P.w_out_t + (size_t)(n0 + lr) * D + k0;
  f32x16 acc = zero16();
  _Pragma("unroll") for (int ks = 0; ks < 8; ++ks) acc = MFMA32(ldfrag(A + 16 * ks), ldfrag(B + 16 * ks), acc);
  float v[2];
  tail_reduce(acc, smem_wg, w, lane, v);
  _Pragma("unroll") for (int j = 0; j < 2; ++j) { float* hp = P.h + (size_t)(16384 + crow(2 * w + j, lh)) * D + n0 + lr; *hp = ALPHA * (*hp) + v[j]; }
}
struct SchedP3a {
  static constexpr bool GATHER = false;
  const char* A; const char* B; int G, c;
  DI bool next(int i, g8::Unit& u) const {
    const int ti = i / 3, br = i - 3 * ti; int pm, pn;
    if (!g8::grid_unit(ti, G, c, 64, 4, pm, pn)) return false;
    u.pm = pm; u.pn = pn; u.tag = br;
    u.a = A + ((size_t)br * TP + (size_t)pm * 256) * 512 * 2; u.b = B + ((size_t)br * 1024 + (size_t)pn * 256) * 512 * 2; return true;
  }
  DI void arows(const g8::Unit&, int, unsigned (&)[2]) const {}
};
struct EpiP3a {
  static constexpr bool PERM = true;
  const bf16_t* gz; bf16_t* merged;
  DI bool keep(const g8::Unit& u) const { return u.tag < 2; }
  DI void operator()(g8::f32x4 (&acc)[2][2][4][2], const g8::Unit& u, int wr, int wc, int fr, int fq) const {
    const int br = u.tag;
    const bf16_t* g0 = gz + (size_t)(u.pm * 256 + 64 * wr + fr) * 3072 + br * 1024 + u.pn * 256 + 32 * wc + 8 * fq;
    _Pragma("unroll") for (int ai = 0; ai < 2; ++ai) {
      u32x4 ga[4][2], gb[4][2];
      _Pragma("unroll") for (int m = 0; m < 4; ++m) _Pragma("unroll") for (int bj = 0; bj < 2; ++bj) ga[m][bj] = *(const u32x4*)(g0 + (size_t)(128 * ai + 16 * m) * 3072 + 128 * bj);
      if (br < 2) {
        _Pragma("unroll") for (int m = 0; m < 4; ++m) _Pragma("unroll") for (int bj = 0; bj < 2; ++bj) gb[m][bj] = *(const u32x4*)(g0 + (size_t)(128 * ai + 16 * m) * 3072 + 128 * bj + 1024);
        __builtin_amdgcn_sched_barrier(0);
        _Pragma("unroll") for (int m = 0; m < 4; ++m) _Pragma("unroll") for (int bj = 0; bj < 2; ++bj) {
          const u32x4 a = ga[m][bj], b = gb[m][bj];
          acc[ai][bj][m][0][0] *= bflo(a.x) * frcp(bflo(b.x)); acc[ai][bj][m][0][1] *= bfhi(a.x) * frcp(bfhi(b.x));
          acc[ai][bj][m][0][2] *= bflo(a.y) * frcp(bflo(b.y)); acc[ai][bj][m][0][3] *= bfhi(a.y) * frcp(bfhi(b.y));
          acc[ai][bj][m][1][0] *= bflo(a.z) * frcp(bflo(b.z)); acc[ai][bj][m][1][1] *= bfhi(a.z) * frcp(bfhi(b.z));
          acc[ai][bj][m][1][2] *= bflo(a.w) * frcp(bflo(b.w)); acc[ai][bj][m][1][3] *= bfhi(a.w) * frcp(bfhi(b.w));
        }
      } else {
        __builtin_amdgcn_sched_barrier(0);
        _Pragma("unroll") for (int m = 0; m < 4; ++m) _Pragma("unroll") for (int bj = 0; bj < 2; ++bj) {
          const u32x4 a = ga[m][bj];
          u32x4 o;
          o.x = pk2(acc[ai][bj][m][0][0] * bflo(a.x), acc[ai][bj][m][0][1] * bfhi(a.x)); o.y = pk2(acc[ai][bj][m][0][2] * bflo(a.y), acc[ai][bj][m][0][3] * bfhi(a.y));
          o.z = pk2(acc[ai][bj][m][1][0] * bflo(a.z), acc[ai][bj][m][1][1] * bfhi(a.z)); o.w = pk2(acc[ai][bj][m][1][2] * bflo(a.w), acc[ai][bj][m][1][3] * bfhi(a.w));
          *(u32x4*)(merged + (size_t)(u.pm * 256 + 128 * ai + 64 * wr + 16 * m + fr) * D + u.pn * 256 + 128 * bj + 32 * wc + 8 * fq) = o;
        }
      }
      __builtin_amdgcn_sched_barrier(0);
    }
  }
};
DI void phase_p3a(const Params& P, int l, char* smem, char* smem_wg, int bid, int nblk) {
  if ((bid >> 1) < 32) p3a_tail(P, smem_wg, bid >> 1);
  {
    SchedP3a S; S.A = (const char*)P.oa; S.B = (const char*)P.w_br_t; S.G = nblk >> 1; S.c = bid >> 1;
    EpiP3a E; E.gz = P.gz; E.merged = P.merged;
    g8::gemm_phase((g8::lds_u8*)smem_wg, 512, S, E);
  }
}
struct SchedP3b {
  static constexpr bool GATHER = false;
  const char* A; const char* B; int G, c;
  DI bool next(int i, g8::Unit& u) const { int pm, pn; if (!g8::grid_unit(i, G, c, 64, 4, pm, pn)) return false; u.pm = pm; u.pn = pn; u.tag = 0; u.a = A + (size_t)pm * 256 * D * 2; u.b = B + (size_t)pn * 256 * D * 2; return true; }
  DI void arows(const g8::Unit&, int, unsigned (&)[2]) const {}
};
struct EpiP3b {
  static constexpr bool PERM = false;
  float* h;
  DI bool keep(const g8::Unit&) const { return false; }
  DI void operator()(g8::f32x4 (&acc)[2][2][4][2], const g8::Unit& u, int wr, int wc, int fr, int fq) const {
    float* h0 = h + (size_t)(u.pm * 256 + 64 * wr + fr) * D + u.pn * 256 + 32 * wc + 4 * fq;
    _Pragma("unroll") for (int ai = 0; ai < 2; ++ai) {
      g8::f32x4 hv[4][2][2];
      _Pragma("unroll") for (int m = 0; m < 4; ++m) _Pragma("unroll") for (int bj = 0; bj < 2; ++bj) _Pragma("unroll") for (int n = 0; n < 2; ++n)
        hv[m][bj][n] = *(const g8::f32x4*)(h0 + (size_t)(128 * ai + 16 * m) * D + 128 * bj + 16 * n);
      __builtin_amdgcn_sched_barrier(0);
      _Pragma("unroll") for (int m = 0; m < 4; ++m) _Pragma("unroll") for (int bj = 0; bj < 2; ++bj) _Pragma("unroll") for (int n = 0; n < 2; ++n)
        *(g8::f32x4*)(h0 + (size_t)(128 * ai + 16 * m) * D + 128 * bj + 16 * n) = ALPHA * hv[m][bj][n] + acc[ai][bj][m][n];
      __builtin_amdgcn_sched_barrier(0);
    }
  }
};
DI void phase_p3b(const Params& P, int l, char* smem, char* smem_wg, int bid, int nblk) {
  if ((bid >> 1) < 32) p3b_tail(P, smem_wg, bid >> 1);
  {
    SchedP3b S; S.A = (const char*)P.merged; S.B = (const char*)P.w_out_t; S.G = nblk >> 1; S.c = bid >> 1;
    EpiP3b E; E.h = P.h;
    g8::gemm_phase(( g8::lds_u8*)smem_wg, D, S, E);
  }
}

typedef __attribute__((ext_vector_type(4))) float f32x4v;
DI void phase_router_prep(const Params& P, int bid, int nblk) {
  const int gtid = bid * NT + otid(), gn = nblk * NT;
  for (int i = gtid; i < 2 * 64 * 3 * 64 * 4; i += gn) {
    const int sidx = i & 3, lane = (i >> 2) & 63, n = (i >> 8) % 3, chunk = ((i >> 8) / 3) & 63, l = (i >> 8) / 192;
    const int c = 16 * chunk + 4 * (lane >> 4) + sidx, j = lane & 15;
    float wv = 0.f;
    if (n < 2) wv = P.w_re[((size_t)l * D + c) * 32 + 16 * n + j];
    else if (j < 4) wv = P.w_rg[((size_t)l * D + c) * 4 + j];
    P.rwp[i] = wv * P.ln1_g[l * D + c];
  }
  const int wv_ = gtid >> 6, lane = gtid & 63;
  if (wv_ < 2 * 36) {
    const int l = wv_ / 36, o = wv_ % 36;
    float sg = 0.f, sb = 0.f;
    for (int c = lane; c < D; c += 64) {
      const float wv = o < 32 ? P.w_re[((size_t)l * D + c) * 32 + o] : P.w_rg[((size_t)l * D + c) * 4 + o - 32];
      sg += P.ln1_g[l * D + c] * wv; sb += P.ln1_b[l * D + c] * wv;
    }
    sg = wave_sum(sg); sb = wave_sum(sb);
    if (lane == 0) { P.rgb[(l * 2 + 0) * 48 + o] = sg; P.rgb[(l * 2 + 1) * 48 + o] = sb + (o < 32 ? P.b_re[l * 32 + o] : P.b_rg[l * 4 + o - 32]); }
  }
}
DI void phase_p4(const Params& P, int l, char* smem, int bid, int nblk) {
  const int tid = otid(), lane = tid & 63, w = tid >> 6, wv = (bid * NT + tid) >> 6, nwv = (nblk * NT) >> 6;
  float* raw = (float*)smem + w * 768;
  const f32x4* wp = (const f32x4*)P.rwp + (size_t)l * 64 * 3 * 64 + lane;
  const int nrb = min(nblk, (T / 16 + 3) / 4), nwr = nrb * 4;
  for (int wt = bid < nrb ? bid * 4 + w : T / 16; wt < T / 16; wt += nwr) {
    const int t0 = wt * 16;
    f32x4v acc[3];
    _Pragma("unroll") for (int n = 0; n < 3; ++n) { acc[n][0] = 0.f; acc[n][1] = 0.f; acc[n][2] = 0.f; acc[n][3] = 0.f; }
    const float* xa = P.h + (size_t)(t0 + (lane & 15)) * D + 4 * (lane >> 4);
    f32x4 A0[4], B0[4][3], A1[4], B1[4][3];
    float s1 = 0.f, s2 = 0.f;
#define P4_LOAD(Ab, Bb, c0) _Pragma("unroll") for (int u = 0; u < 4; ++u) { Ab[u] = *(const f32x4*)(xa + 16 * ((c0) + u)); \
      _Pragma("unroll") for (int n = 0; n < 3; ++n) Bb[u][n] = wp[(((c0) + u) * 3 + n) * 64]; }
#define P4_MMA(Ab, Bb) _Pragma("unroll") for (int u = 0; u < 4; ++u) { const f32x4 a = Ab[u]; \
      s1 += (a.x + a.y) + (a.z + a.w); s2 += (a.x * a.x + a.y * a.y) + (a.z * a.z + a.w * a.w); \
      _Pragma("unroll") for (int n = 0; n < 3; ++n) acc[n] = __builtin_amdgcn_mfma_f32_16x16x4f32(a.x, Bb[u][n].x, acc[n], 0, 0, 0); \
      _Pragma("unroll") for (int n = 0; n < 3; ++n) acc[n] = __builtin_amdgcn_mfma_f32_16x16x4f32(a.y, Bb[u][n].y, acc[n], 0, 0, 0); \
      _Pragma("unroll") for (int n = 0; n < 3; ++n) acc[n] = __builtin_amdgcn_mfma_f32_16x16x4f32(a.z, Bb[u][n].z, acc[n], 0, 0, 0); \
      _Pragma("unroll") for (int n = 0; n < 3; ++n) acc[n] = __builtin_amdgcn_mfma_f32_16x16x4f32(a.w, Bb[u][n].w, acc[n], 0, 0, 0); }
    P4_LOAD(A0, B0, 0)
    _Pragma("unroll 1") for (int ch = 0; ch < 64; ch += 8) {
      P4_LOAD(A1, B1, ch + 4)
      __builtin_amdgcn_sched_barrier(0);
      P4_MMA(A0, B0)
      __builtin_amdgcn_sched_barrier(0);
      if (ch + 8 < 64) { P4_LOAD(A0, B0, ch + 8) }
      __builtin_amdgcn_sched_barrier(0);
      P4_MMA(A1, B1)
      __builtin_amdgcn_sched_barrier(0);
    }
#undef P4_LOAD
#undef P4_MMA
    s1 += sxor<16>(s1); s2 += sxor<16>(s2); s1 = xsum32(s1); s2 = xsum32(s2);
    const float mu_r = s1 * (1.f / 1024.f), rs_r = rsqrtf(fmaxf(s2 * (1.f / 1024.f) - mu_r * mu_r, 0.f) + LN_EPS);
    WT_FENCE();
    _Pragma("unroll") for (int r = 0; r < 4; ++r) {
      const int tok = 4 * (lane >> 4) + r, j = lane & 15;
      raw[tok * 40 + j] = acc[0][r]; raw[tok * 40 + 16 + j] = acc[1][r];
      if (j < 4) raw[tok * 40 + 32 + j] = acc[2][r];
    }
    if (lane < 16) { raw[640 + 2 * lane] = mu_r; raw[640 + 2 * lane + 1] = rs_r; }
    WT_FENCE();
    f32x4 gg[4], bb[4];
    _Pragma("unroll") for (int i = 0; i < 4; ++i) { gg[i] = ((const f32x4*)(P.ln1_g + l * D))[lane + 64 * i]; bb[i] = ((const f32x4*)(P.ln1_b + l * D))[lane + 64 * i]; }
    _Pragma("unroll 1") for (int q0 = 0; q0 < 16; q0 += 4) {
      f32x4 v[4][4];
      _Pragma("unroll") for (int j = 0; j < 4; ++j) _Pragma("unroll") for (int i = 0; i < 4; ++i) v[j][i] = ((const f32x4*)(P.h + (size_t)(t0 + q0 + j) * D))[lane + 64 * i];
      __builtin_amdgcn_sched_barrier(0);
      _Pragma("unroll") for (int j = 0; j < 4; ++j) {
        const float mu = raw[640 + 2 * (q0 + j)], rs = raw[640 + 2 * (q0 + j) + 1];
        _Pragma("unroll") for (int i = 0; i < 4; ++i) {
          v[j][i].x = (v[j][i].x - mu) * rs * gg[i].x + bb[i].x; v[j][i].y = (v[j][i].y - mu) * rs * gg[i].y + bb[i].y;
          v[j][i].z = (v[j][i].z - mu) * rs * gg[i].z + bb[i].z; v[j][i].w = (v[j][i].w - mu) * rs * gg[i].w + bb[i].w;
        }
        store_row(v[j], P.h + (size_t)(t0 + q0 + j) * D, P.hb + (size_t)(t0 + q0 + j) * D, lane);
      }
    }
    WT_FENCE();
    if (lane < 16) {
      const int t = t0 + lane;
      const float mu = raw[640 + 2 * lane], rs = raw[640 + 2 * lane + 1];
      const float* G = P.rgb + (l * 2) * 48; const float* Bc = G + 48;
      float gl[4];
      _Pragma("unroll") for (int g = 0; g < 4; ++g) gl[g] = rs * (raw[lane * 40 + 32 + g] - mu * G[32 + g]) + Bc[32 + g];
      int gs = 0; float gm = gl[0];
      for (int g = 1; g < 4; ++g) if (gl[g] > gm) { gm = gl[g]; gs = g; }
      float den = 0.f;
      _Pragma("unroll") for (int g = 0; g < 4; ++g) den += expf(gl[g] - gm);
      const float pg = 1.f / den;
      float el[8];
      _Pragma("unroll") for (int e = 0; e < 8; ++e) el[e] = rs * (raw[lane * 40 + gs * 8 + e] - mu * G[gs * 8 + e]) + Bc[gs * 8 + e];
      int i1 = 0; float v1 = el[0];
      for (int e = 1; e < 8; ++e) if (el[e] > v1) { v1 = el[e]; i1 = e; }
      int i2 = -1; float v2 = -3.0e38f;
      _Pragma("unroll") for (int e = 0; e < 8; ++e) if (e != i1 && el[e] > v2) { v2 = el[e]; i2 = e; }
      if (i2 < 0) i2 = (i1 + 1) & 7;
      const float ex = expf(v2 - v1);
      const float w1 = pg / (1.f + ex), w2 = pg * ex / (1.f + ex);
      const int e1 = gs * 8 + i1, e2 = gs * 8 + i2;
      const int r1 = atomicAdd(P.counts + e1 * CSTR, 1), r2 = atomicAdd(P.counts + e2 * CSTR, 1);
      P.tok_slot[2 * t] = e1 * CAP + r1; P.tok_slot[2 * t + 1] = e2 * CAP + r2;
      P.tok_w[2 * t] = w1; P.tok_w[2 * t + 1] = w2;
      P.slot_tok[(size_t)e1 * CAP + r1] = t; P.slot_tok[(size_t)e2 * CAP + r2] = t;
    }
  }
}

DI bool moe_unit(const int* counts, int i, int G, int c, int& e, int& mi, int& pn, int& cnt, int& hs) {
  int tot = 0;
  for (int x = 0; x < NEXP; ++x) tot += (counts[x * CSTR] + 255) >> 8;
  const int U = tot * 4, g = i * G + c;
  if (g >= U) return false;
  const int q = U / 8, r = U % 8, xcd = g % 8, off = g / 8;
  const int idx = (xcd < r ? xcd * (q + 1) : r * (q + 1) + (xcd - r) * q) + off;
  const int mt = idx >> 2; pn = idx & 3;
  int acc = 0; e = 0; mi = 0; cnt = 0; hs = 0;
  for (int x = 0; x < NEXP; ++x) {
    const int cx = counts[x * CSTR], n = (cx + 255) >> 8;
    if (mt < acc + n) { e = x; mi = mt - acc; cnt = cx; hs = acc * 256; return true; }
    acc += n;
  }
  return false;
}
constexpr int MOE_TAB = 131072 + 512, MOE_MAXU = 8;
DI void moe_table(const int* counts, int G, int c, char* smem_wg) {
  const int tid = rtid();
  __syncthreads();
  if (tid < MOE_MAXU) {
    int e = 0, mi = 0, pn = 0, cnt = 0, hs = 0;
    const bool ok = moe_unit(counts, tid, G, c, e, mi, pn, cnt, hs);
    int* tb = (int*)(smem_wg + MOE_TAB) + tid * 8;
    tb[0] = ok ? 1 : 0; tb[1] = e; tb[2] = mi; tb[3] = pn; tb[4] = cnt; tb[5] = hs;
  }
  __syncthreads();
}
DI bool moe_next(int i, int& e, int& mi, int& pn, int& cnt, int& hs) {
  if (i >= MOE_MAXU) return false;
  const LAS_I* tb = (const LAS_I*)(size_t)(MOE_TAB + i * 32);
  const int ok = __builtin_amdgcn_readfirstlane(tb[0]);
  e = __builtin_amdgcn_readfirstlane(tb[1]); mi = __builtin_amdgcn_readfirstlane(tb[2]); pn = __builtin_amdgcn_readfirstlane(tb[3]);
  cnt = __builtin_amdgcn_readfirstlane(tb[4]); hs = __builtin_amdgcn_readfirstlane(tb[5]);
  return ok != 0;
}
struct SchedP5a {
  static constexpr bool GATHER = true;
  const int* counts; const int* slot_tok; const char* hb; const char* w; int G, c;
  DI bool next(int i, g8::Unit& u) const {
    int e, mi, pn, cnt, hs;
    if (!moe_next(i, e, mi, pn, cnt, hs)) return false;
    u.pm = hs + mi * 256; u.pn = pn; u.tag = e; u.x0 = e * CAP + mi * 256; u.x1 = cnt - mi * 256;
    u.a = hb; u.b = w + ((size_t)e * 1024 + (size_t)pn * 256) * D * 2; return true;
  }
  DI void arows(const g8::Unit& u, int R0, unsigned (&pk)[2]) const {
    const int* st = slot_tok + u.x0; const int lim = u.x1 - 1;
    const int t0 = st[min(R0, lim)], t1 = st[min(R0 + 64, lim)], t2 = st[min(R0 + 128, lim)], t3 = st[min(R0 + 192, lim)];
    pk[0] = (unsigned)t0 | ((unsigned)t1 << 16); pk[1] = (unsigned)t2 | ((unsigned)t3 << 16);
  }
};
struct EpiP5a {
  static constexpr bool PERM = true;
  bf16_t* H;
  DI bool keep(const g8::Unit&) const { return false; }
  DI void operator()(g8::f32x4 (&acc)[2][2][4][2], const g8::Unit& u, int wr, int wc, int fr, int fq) const {
    _Pragma("unroll") for (int ai = 0; ai < 2; ++ai) _Pragma("unroll") for (int m = 0; m < 4; ++m) {
      bf16_t* rowp = H + (size_t)(u.pm + 128 * ai + 64 * wr + 16 * m + fr) * 512 + u.pn * 128 + 16 * wc + 4 * fq;
      _Pragma("unroll") for (int bj = 0; bj < 2; ++bj) {
        const g8::f32x4 g = acc[ai][bj][m][0], up = acc[ai][bj][m][1];
        u32x2 o; o.x = pk2(g[0] * sigmoidf_(g[0]) * up[0], g[1] * sigmoidf_(g[1]) * up[1]); o.y = pk2(g[2] * sigmoidf_(g[2]) * up[2], g[3] * sigmoidf_(g[3]) * up[3]);
        *(u32x2*)(rowp + 64 * bj) = o;
      }
    }
  }
};
DI void phase_p5a(const Params& P, int l, char* smem_wg, int bid, int nblk) {
  SchedP5a S; S.counts = P.counts; S.slot_tok = P.slot_tok; S.hb = (const char*)P.hb; S.w = (const char*)P.w_gu_t; S.G = nblk >> 1; S.c = bid >> 1;
  EpiP5a E; E.H = P.H;
  moe_table(P.counts, S.G, S.c, smem_wg);
  g8::gemm_phase((g8::lds_u8*)smem_wg, D, S, E);
}
struct SchedP5b {
  static constexpr bool GATHER = false;
  const int* counts; const char* H; const char* w; int G, c;
  DI bool next(int i, g8::Unit& u) const {
    int e, mi, pn, cnt, hs;
    if (!moe_next(i, e, mi, pn, cnt, hs)) return false;
    u.pm = hs + mi * 256; u.pn = pn; u.tag = e; u.x0 = 0; u.x1 = 0;
    u.a = H + (size_t)u.pm * 512 * 2; u.b = w + ((size_t)e * 1024 + (size_t)pn * 256) * 512 * 2; return true;
  }
  DI void arows(const g8::Unit&, int, unsigned (&)[2]) const {}
};
struct EpiP5b {
  static constexpr bool PERM = true;
  bf16_t* ys;
  DI bool keep(const g8::Unit&) const { return false; }
  DI void operator()(g8::f32x4 (&acc)[2][2][4][2], const g8::Unit& u, int wr, int wc, int fr, int fq) const {
    _Pragma("unroll") for (int ai = 0; ai < 2; ++ai) _Pragma("unroll") for (int m = 0; m < 4; ++m) {
      bf16_t* rowp = ys + (size_t)(u.pm + 128 * ai + 64 * wr + 16 * m + fr) * D + u.pn * 256 + 32 * wc + 8 * fq;
      _Pragma("unroll") for (int bj = 0; bj < 2; ++bj) {
        const g8::f32x4 a = acc[ai][bj][m][0], b = acc[ai][bj][m][1];
        u32x4 o; o.x = pk2(a[0], a[1]); o.y = pk2(a[2], a[3]); o.z = pk2(b[0], b[1]); o.w = pk2(b[2], b[3]);
        *(u32x4*)(rowp + 128 * bj) = o;
      }
    }
  }
};
DI void phase_p5b(const Params& P, int l, char* smem_wg, int bid, int nblk) {
  SchedP5b S; S.counts = P.counts; S.H = (const char*)P.H; S.w = (const char*)P.w_dn_t; S.G = nblk >> 1; S.c = bid >> 1;
  EpiP5b E; E.ys = P.ys;
  moe_table(P.counts, S.G, S.c, smem_wg);
  g8::gemm_phase((g8::lds_u8*)smem_wg, 512, S, E);
}
DI void phase_p6(const Params& P, int l, char* smem, int bid, int nblk) {
  const int tid = otid(), lane = tid & 63, wv = (bid * NT + tid) >> 6, nwv = (nblk * NT) >> 6;
  int* shs = (int*)smem;
  __syncthreads();
  if (tid == 0) { int hs = 0; for (int x = 0; x < NEXP; ++x) { shs[x] = hs; hs += ((P.counts[x * CSTR] + 255) >> 8) * 256; } }
  __syncthreads();
  int ns1 = 0, ns2 = 0; float nw1 = 0.f, nw2 = 0.f;
  if (wv < T) { ns1 = P.tok_slot[2 * wv]; ns2 = P.tok_slot[2 * wv + 1]; nw1 = P.tok_w[2 * wv]; nw2 = P.tok_w[2 * wv + 1]; }
  for (int t = wv; t < T; t += nwv) {
    const int s1 = ns1, s2 = ns2;
    const float w1 = nw1, w2 = nw2;
    { const int tn = min(t + nwv, T - 1); ns1 = P.tok_slot[2 * tn]; ns2 = P.tok_slot[2 * tn + 1]; nw1 = P.tok_w[2 * tn]; nw2 = P.tok_w[2 * tn + 1]; }
    const bf16_t* y1 = P.ys + (size_t)(shs[s1 / CAP] + s1 % CAP) * D;
    const bf16_t* y2 = P.ys + (size_t)(shs[s2 / CAP] + s2 % CAP) * D;
    f32x4 v[4];
    _Pragma("unroll") for (int i = 0; i < 4; ++i) {
      const f32x4 hv = ((const f32x4*)(P.h + (size_t)t * D))[lane + 64 * i];
      const u32x2 a = ((const u32x2*)y1)[lane + 64 * i], c = ((const u32x2*)y2)[lane + 64 * i];
      v[i].x = ALPHA * hv.x + (bflo(a.x) * w1 + bflo(c.x) * w2); v[i].y = ALPHA * hv.y + (bfhi(a.x) * w1 + bfhi(c.x) * w2);
      v[i].z = ALPHA * hv.z + (bflo(a.y) * w1 + bflo(c.y) * w2); v[i].w = ALPHA * hv.w + (bfhi(a.y) * w1 + bfhi(c.y) * w2);
    }
    ln16(v, P.ln2_g + l * D, P.ln2_b + l * D, lane);
    if (l == 1) {
      const int b = t >= L ? 1 : 0, pos = t - b * L;
      if (pos >= NMETA) store_row(v, P.out + ((size_t)b * SEQ + pos - NMETA) * D, nullptr, lane);
    } else store_row(v, P.h + (size_t)t * D, P.hb + (size_t)t * D, lane);
  }
}

#define XB_TMO      128
#define XB_XCNT(j)  (256  + 64 * (j))
#define XB_XSUB(j)  (1280 + 64 * (j))
#define XB_XGEN(j)  (2304 + 64 * (j))
#define XB_TOP      3328
#define XB_TOPGEN   3392
#define XCD_BAR_WORDS 3456
#define XB_SPIN_CAP (1u << 20)
#define LAS __attribute__((address_space(3)))
DI unsigned xb_ld(unsigned* p) { return __hip_atomic_load(p, __ATOMIC_RELAXED, __HIP_MEMORY_SCOPE_AGENT); }
DI unsigned xb_add(unsigned* p, unsigned v) { return __hip_atomic_fetch_add(p, v, __ATOMIC_RELAXED, __HIP_MEMORY_SCOPE_AGENT); }
DI unsigned xb_xcc_id() { return (unsigned)__builtin_amdgcn_s_getreg((3 << 11) | 20) & 0xFu; }
#define XB_SPIN(cond, bar) do { unsigned _sp = 0; while (cond) { __builtin_amdgcn_s_sleep(1); \
    if ((++_sp & 255u) == 0u) { if (xb_ld(&(bar)[XB_TMO])) break; if (_sp > XB_SPIN_CAP) { atomicAdd(&(bar)[XB_TMO], 1u); break; } } } } while (0)
struct XcdBarrier { unsigned* bar; unsigned x; volatile LAS unsigned* st; };
DI XcdBarrier xcd_barrier_post(unsigned* bar, volatile LAS unsigned* st) {
  XcdBarrier b; b.bar = bar; b.x = xb_xcc_id(); b.st = st;
  if (rtid() == 0) (void)xb_add(&bar[XB_XCNT(b.x)], 1u);
  return b;
}
DI void xcd_barrier_complete(unsigned* bar, unsigned x, unsigned& nloc, unsigned& nx) {
  const unsigned G = gridDim.x * gridDim.y * gridDim.z;
  unsigned sum, cnt, mine, sp = 0u;
  for (;;) {
    sum = 0u; cnt = 0u; mine = 0u;
    _Pragma("unroll") for (unsigned j = 0; j < 16; ++j) { const unsigned c = xb_ld(&bar[XB_XCNT(j)]); sum += c; cnt += (c > 0u) ? 1u : 0u; mine = (j == x) ? c : mine; }
    if (sum == G) break;
    __builtin_amdgcn_s_sleep(1);
    if ((++sp & 255u) == 0u) { if (xb_ld(&bar[XB_TMO])) break; if (sp > XB_SPIN_CAP) { atomicAdd(&bar[XB_TMO], 1u); break; } }
  }
  nloc = mine > 0u ? mine : 1u; nx = cnt > 0u ? cnt : 1u;
}
DI void xcd_barrier(const XcdBarrier& b) {
  asm volatile("s_waitcnt vmcnt(0)" ::: "memory");
  __syncthreads();
  if (rtid() == 0) {
    unsigned* bar = b.bar; unsigned bx = b.x;
    asm volatile("" : "+s"(bar), "+s"(bx));
    __builtin_amdgcn_s_waitcnt(0);
    unsigned nloc = b.st[0], nx = b.st[1];
    if (nloc == 0u) { xcd_barrier_complete(bar, bx, nloc, nx); b.st[0] = nloc; b.st[1] = nx; }
    const unsigned old = xb_add(&bar[XB_XSUB(bx)], 1u);
    const unsigned gen = old / nloc;
    if (old + 1u == (gen + 1u) * nloc) {
      __builtin_amdgcn_fence(__ATOMIC_RELEASE, "agent");
      asm volatile("s_waitcnt vmcnt(0)" ::: "memory");
      const unsigned og = xb_add(&bar[XB_TOP], 1u);
      const unsigned tg = og / nx;
      if (og + 1u == (tg + 1u) * nx) xb_add(&bar[XB_TOPGEN], 1u);
      else XB_SPIN(xb_ld(&bar[XB_TOPGEN]) == tg, bar);
      __builtin_amdgcn_fence(__ATOMIC_ACQUIRE, "agent");
      xb_add(&bar[XB_XGEN(bx)], 1u);
      asm volatile("s_waitcnt vmcnt(0)" ::: "memory");
    } else {
      XB_SPIN(xb_ld(&bar[XB_XGEN(bx)]) == gen, bar);
      __builtin_amdgcn_fence(__ATOMIC_ACQUIRE, "agent");
      asm volatile("s_waitcnt vmcnt(0)" ::: "memory");
    }
  }
  __syncthreads();
}

constexpr size_t al256(size_t v) { return (v + 255) & ~(size_t)255; }
struct WsLayout {
  size_t bar, ctl, h, hb, w_in_t, w_br_t, w_out_t, cs, rwp, rgb, lam, counts, tok_slot, tok_w, slot_tok, mstat, nvec, wgt, bcum, ligate;
  size_t qa, ka, vaT, qb, kb, vbT, cq, ck, cvT, co, cg, gz, qc, kc, kcT, U, end_mixer;
  size_t w_gu_t, w_dn_t, H, ys, end_moe, need;
};
constexpr WsLayout make_layout() {
  WsLayout w{}; size_t off = 0;
#define TAKE(f, bytes) w.f = off; off = al256(off + (size_t)(bytes));
  TAKE(bar, XCD_BAR_WORDS * 4) TAKE(ctl, 4096)
  TAKE(h, (size_t)TP * D * 4) TAKE(hb, (size_t)TP * D * 2) TAKE(w_in_t, (size_t)DINP * D * 2) TAKE(w_br_t, (size_t)3 * 1024 * 512 * 2) TAKE(w_out_t, (size_t)D * D * 2)
  TAKE(cs, (size_t)L * 32 * 8) TAKE(rwp, (size_t)2 * 64 * 3 * 64 * 4 * 4) TAKE(rgb, 2 * 2 * 48 * 4) TAKE(lam, 256) TAKE(counts, NEXP * CSTR * 4) TAKE(tok_slot, (size_t)T * 2 * 4) TAKE(tok_w, (size_t)T * 2 * 4) TAKE(slot_tok, (size_t)NEXP * CAP * 4)
  TAKE(mstat, (size_t)16 * NCH * 4 * 4) TAKE(nvec, (size_t)16 * NCH * 128 * 4) TAKE(wgt, (size_t)16 * LPAD * 4) TAKE(bcum, (size_t)16 * LPAD * 4) TAKE(ligate, (size_t)16 * LPAD * 4)
  const size_t scratch0 = off;
  TAKE(qa, (size_t)NB * 4 * 2 * L * 64 * 2) TAKE(ka, (size_t)NB * 4 * 2 * L * 64 * 2 + 4096) TAKE(vaT, (size_t)NB * 4 * 128 * LK * 2)
  TAKE(qb, (size_t)NB * 8 * L * 64 * 2) TAKE(kb, (size_t)NB * 2 * L * 64 * 2 + 4096) TAKE(vbT, (size_t)NB * 2 * 64 * LK * 2)
  TAKE(cq, (size_t)TP * 512 * 2) TAKE(ck, (size_t)TP * 512 * 2) TAKE(cvT, (size_t)8 * 128 * LPAD * 2) TAKE(co, (size_t)TP * 512 * 2) TAKE(cg, (size_t)TP * 16 * 4)
  TAKE(gz, (size_t)TP * 3072 * 2) TAKE(qc, (size_t)8 * LPAD * 128 * 2) TAKE(kc, (size_t)8 * LPAD * 128 * 2) TAKE(kcT, (size_t)8 * 128 * LPAD * 2) TAKE(U, (size_t)16 * NCH * 16384 * 4)
  w.end_mixer = off;
  off = scratch0;
  TAKE(w_gu_t, (size_t)NEXP * 1024 * 1024 * 2) TAKE(w_dn_t, (size_t)NEXP * 1024 * 512 * 2) TAKE(H, (size_t)HROWS * 512 * 2) TAKE(ys, (size_t)HROWS * D * 2)
  w.end_moe = off;
#undef TAKE
  w.need = w.end_mixer > w.end_moe ? w.end_mixer : w.end_moe;
  return w;
}
constexpr WsLayout WL = make_layout();
static_assert(WL.need <= (size_t)552 * 1000 * 1000, "workspace");

struct SchedP1 {
  static constexpr bool GATHER = false;
  const char* hb; const char* w; int G, c;
  DI bool next(int i, g8::Unit& u) const {
    const int Lq = i * G + c; int pm, pn;
    if (Lq < 65 * 25) { g8::grid_lin(Lq, 65, 25, pm, pn); u.tag = 0; u.a = hb + (size_t)pm * 256 * D * 2; u.b = w + (size_t)pn * 256 * D * 2; }
    else if (Lq < 65 * 25 + 5 * 65) { g8::grid_lin(Lq - 65 * 25, 5, 65, pm, pn); u.tag = 1; u.a = w + (size_t)(6400 + pm * 256) * D * 2; u.b = hb + (size_t)pn * 256 * D * 2; }
    else return false;
    u.pm = pm; u.pn = pn; return true;
  }
  DI void arows(const g8::Unit&, int, unsigned (&)[2]) const {}
};
DI u32x4 pack8(const g8::f32x4& a, const g8::f32x4& b) { u32x4 o; o.x = pk2(a[0], a[1]); o.y = pk2(a[2], a[3]); o.z = pk2(b[0], b[1]); o.w = pk2(b[2], b[3]); return o; }
struct EpiP1 {
  static constexpr bool PERM = true;
  char* ws;
  DI bool keep(const g8::Unit&) const { return false; }
  DI void operator()(g8::f32x4 (&acc)[2][2][4][2], const g8::Unit& u, int wr, int wc, int fr, int fq) const {
    char* wb = ws; asm volatile("" : "+s"(wb));
    if (u.tag == 0) {
      const int r0 = u.pm * 256 + 64 * wr + fr;
      _Pragma("unroll") for (int bj = 0; bj < 2; ++bj) {
        const int c0 = u.pn * 256 + 128 * bj + 32 * wc;
        const int c = c0 + 8 * fq;
        if (c0 < 1664) {
          const int u64 = c0 >> 6, q = ((c0 >> 5) & 1) * 4 + fq;
          bf16_t* base; int nh, uu; float sc;
          if (u64 < 8) { base = (bf16_t*)(wb + WL.qa); nh = 8; uu = u64; sc = QSCALE; }
          else if (u64 < 16) { base = (bf16_t*)(wb + WL.ka); nh = 8; uu = u64 - 8; sc = 1.f; }
          else if (u64 < 24) { base = (bf16_t*)(wb + WL.qb); nh = 8; uu = u64 - 16; sc = QSCALE; }
          else { base = (bf16_t*)(wb + WL.kb); nh = 2; uu = u64 - 24; sc = 1.f; }
          const f32x2* cs = (const f32x2*)(wb + WL.cs);
          _Pragma("unroll") for (int ai = 0; ai < 2; ++ai) {
            g8::f32x4 c01[4], c23[4];
            _Pragma("unroll") for (int m = 0; m < 4; ++m) {
              const int t = r0 + 128 * ai + 16 * m, tt = min(t, T - 1), b = tt >= L ? 1 : 0, pos = tt - b * L;
              const g8::f32x4* cp = (const g8::f32x4*)(cs + (size_t)pos * 32 + 4 * q);
              c01[m] = cp[0]; c23[m] = cp[1];
            }
            __builtin_amdgcn_sched_barrier(0);
            _Pragma("unroll") for (int m = 0; m < 4; ++m) {
              const int t = r0 + 128 * ai + 16 * m, tt = min(t, T - 1), b = tt >= L ? 1 : 0, pos = tt - b * L;
              const g8::f32x4 x1 = acc[ai][bj][m][0], x2 = acc[ai][bj][m][1];
              g8::f32x4 o1, o2;
              o1[0] = (x1[0] * c01[m][0] - x2[0] * c01[m][1]) * sc; o2[0] = (x2[0] * c01[m][0] + x1[0] * c01[m][1]) * sc;
              o1[1] = (x1[1] * c01[m][2] - x2[1] * c01[m][3]) * sc; o2[1] = (x2[1] * c01[m][2] + x1[1] * c01[m][3]) * sc;
              o1[2] = (x1[2] * c23[m][0] - x2[2] * c23[m][1]) * sc; o2[2] = (x2[2] * c23[m][0] + x1[2] * c23[m][1]) * sc;
              o1[3] = (x1[3] * c23[m][2] - x2[3] * c23[m][3]) * sc; o2[3] = (x2[3] * c23[m][2] + x1[3] * c23[m][3]) * sc;
              if (t < T) *(u32x4*)(base + ((size_t)(b * nh + uu) * L + pos) * 64 + 8 * q) = pack8(o1, o2);
            }
            __builtin_amdgcn_sched_barrier(0);
          }
        } else if (c0 < 6272) {
          bf16_t* dst0; int stride; bool sig = false;
          if (c0 < 2176) { dst0 = (bf16_t*)(wb + WL.cq) + (c - 1664); stride = 512; }
          else if (c0 < 2688) { dst0 = (bf16_t*)(wb + WL.ck) + (c - 2176); stride = 512; }
          else if (c0 < 3200) { dst0 = (bf16_t*)(wb + WL.co) + (c - 2688); stride = 512; }
          else { dst0 = (bf16_t*)(wb + WL.gz) + (c - 3200); stride = 3072; sig = true; }
          _Pragma("unroll") for (int ai = 0; ai < 2; ++ai) _Pragma("unroll") for (int m = 0; m < 4; ++m) {
            const int t = r0 + 128 * ai + 16 * m;
            g8::f32x4 v0 = acc[ai][bj][m][0], v1 = acc[ai][bj][m][1];
            if (sig) { _Pragma("unroll") for (int e = 0; e < 4; ++e) { v0[e] = fmaxf(sigmoidf_(v0[e]), 1e-12f); v1[e] = fmaxf(sigmoidf_(v1[e]), 1e-12f); } }
            if (t < T) *(u32x4*)(dst0 + (size_t)t * stride) = pack8(v0, v1);
          }
        } else if (c0 == 6272) {
          if (fq < 2) {
            float* cg = (float*)(wb + WL.cg);
            _Pragma("unroll") for (int ai = 0; ai < 2; ++ai) _Pragma("unroll") for (int m = 0; m < 4; ++m) {
              const int t = r0 + 128 * ai + 16 * m;
              if (t < T) { g8::f32x4* d = (g8::f32x4*)(cg + (size_t)t * 16 + 8 * fq); d[0] = acc[ai][bj][m][0]; d[1] = acc[ai][bj][m][1]; }
            }
          }
        }
      }
    } else {
      const int chb0 = u.pm * 256 + 64 * wr;
      _Pragma("unroll") for (int ai = 0; ai < 2; ++ai) _Pragma("unroll") for (int m = 0; m < 4; ++m) {
        const int chb = chb0 + 128 * ai + 16 * m;
        if (chb < 1152) {
          const int ch = chb + fr; bf16_t* rp; size_t bs;
          if (chb < 512) { rp = (bf16_t*)(wb + WL.vaT) + (size_t)ch * LK; bs = (size_t)512 * LK; }
          else if (chb < 640) { rp = (bf16_t*)(wb + WL.vbT) + (size_t)(ch - 512) * LK; bs = (size_t)128 * LK; }
          else { rp = (bf16_t*)(wb + WL.cvT) + (size_t)(ch - 640) * LPAD + MPAD; bs = (size_t)512 * LPAD; }
          _Pragma("unroll") for (int bj = 0; bj < 2; ++bj) {
            const int t0 = u.pn * 256 + 128 * bj + 32 * wc + 8 * fq;
            if (t0 < T) { const int b = t0 >= L ? 1 : 0, pos0 = t0 - b * L; *(u32x4*)(rp + b * bs + pos0) = pack8(acc[ai][bj][m][0], acc[ai][bj][m][1]); }
          }
        }
      }
    }
  }
};
DI void phase_p1(const Params& P, int l, char* smem_wg, int bid, int nblk) {
  SchedP1 S; S.hb = (const char*)P.hb; S.w = (const char*)P.w_in_t; S.G = nblk >> 1; S.c = bid >> 1;
  EpiP1 E; E.ws = (char*)P.h - WL.h;
  g8::gemm_phase((g8::lds_u8*)smem_wg, D, S, E);
}

struct KArgs { const float* in[28]; float* out; char* ws; };
typedef const __attribute__((address_space(4))) KArgs* KAP;
DI Params make_params(KAP k) {
  Params P;
  P.x = k->in[0]; P.meta = k->in[1]; P.ln_in_g = k->in[2]; P.ln_in_b = k->in[3]; P.w_in = k->in[4]; P.conv_w = k->in[5]; P.conv_b = k->in[6]; P.gate_b = k->in[7];
  P.lam_q1 = k->in[8]; P.lam_k1 = k->in[9]; P.lam_q2 = k->in[10]; P.lam_k2 = k->in[11]; P.diff_g = k->in[12]; P.sink = k->in[13]; P.mlstm_g = k->in[14];
  P.w_branch = k->in[15]; P.w_out = k->in[16]; P.ln1_g = k->in[17]; P.ln1_b = k->in[18]; P.ln2_g = k->in[19]; P.ln2_b = k->in[20]; P.w_rg = k->in[21]; P.b_rg = k->in[22];
  P.w_re = k->in[23]; P.b_re = k->in[24]; P.w_gate = k->in[25]; P.w_up = k->in[26]; P.w_down = k->in[27];
  P.out = k->out;
  char* ws = k->ws;
  P.h = (float*)(ws + WL.h); P.hb = (bf16_t*)(ws + WL.hb); P.w_in_t = (bf16_t*)(ws + WL.w_in_t); P.w_br_t = (bf16_t*)(ws + WL.w_br_t); P.w_out_t = (bf16_t*)(ws + WL.w_out_t);
  P.cs = (f32x2*)(ws + WL.cs); P.lam = (float*)(ws + WL.lam); P.ctl = (unsigned*)(ws + WL.ctl); P.rwp = (float*)(ws + WL.rwp); P.rgb = (float*)(ws + WL.rgb); P.counts = (int*)(ws + WL.counts); P.tok_slot = (int*)(ws + WL.tok_slot); P.tok_w = (float*)(ws + WL.tok_w);
  P.slot_tok = (int*)(ws + WL.slot_tok); P.mstat = (float*)(ws + WL.mstat); P.nvec = (float*)(ws + WL.nvec); P.wgt = (float*)(ws + WL.wgt); P.bcum = (float*)(ws + WL.bcum);
  P.ligate = (float*)(ws + WL.ligate);
  P.qa = (bf16_t*)(ws + WL.qa); P.ka = (bf16_t*)(ws + WL.ka); P.vaT = (bf16_t*)(ws + WL.vaT); P.qb = (bf16_t*)(ws + WL.qb); P.kb = (bf16_t*)(ws + WL.kb); P.vbT = (bf16_t*)(ws + WL.vbT);
  P.cq = (bf16_t*)(ws + WL.cq); P.ck = (bf16_t*)(ws + WL.ck); P.merged = P.cq; P.cvT = (bf16_t*)(ws + WL.cvT); P.co = (bf16_t*)(ws + WL.co); P.cg = (float*)(ws + WL.cg);
  P.gz = (bf16_t*)(ws + WL.gz); P.qc = (bf16_t*)(ws + WL.qc); P.kc = (bf16_t*)(ws + WL.kc); P.kcT = (bf16_t*)(ws + WL.kcT); P.U = (float*)(ws + WL.U);
  P.w_gu_t = (bf16_t*)(ws + WL.w_gu_t); P.w_dn_t = (bf16_t*)(ws + WL.w_dn_t); P.H = (bf16_t*)(ws + WL.H); P.ys = (bf16_t*)(ws + WL.ys);
  P.oa = (bf16_t*)k->out; P.ob = P.oa + (size_t)TP * 512; P.oc = P.ob + (size_t)TP * 512;
  return P;
}

constexpr int SMEM_BYTES = 2 * DA_STAGE + 4096 + 256;
constexpr int WG_LDS = 2 * SMEM_BYTES + 64 + 256;
static_assert(WIDTAB_OFF == 2 * SMEM_BYTES + 64, "wave-slot table offset");
#define PH(...) { KAP k_ = ka; int bid = bid0, nblk = nblk0; asm volatile("" : "+s"(k_), "+s"(bid), "+s"(nblk)); const Params P = make_params(k_); __VA_ARGS__; }
__global__ void __launch_bounds__(512, 2) mega(KArgs kargs) {
  extern __shared__ __attribute__((aligned(16))) char smem_wg[];
  (void)kargs;
  const KAP ka = (KAP)__builtin_amdgcn_kernarg_segment_ptr();
  {
    const unsigned hw = (unsigned)__builtin_amdgcn_s_getreg((5 << 11) | 4) & 63u;
    *(volatile LAS int*)(size_t)(WIDTAB_OFF + 4 * hw) = (int)(threadIdx.x >> 6);
  }
  __syncthreads();
  const int half = __builtin_amdgcn_readfirstlane(rtid() >> 8);
  char* smem = smem_wg + half * SMEM_BYTES;
  const int bid0 = 2 * blockIdx.x + half, nblk0 = 2 * gridDim.x;
  volatile LAS unsigned* st = (volatile LAS unsigned*)(smem_wg + 2 * SMEM_BYTES);
  volatile LAS int* wgq = (volatile LAS int*)(smem_wg + 2 * SMEM_BYTES + 16);
  if (rtid() == 0) { st[0] = 0u; st[1] = 0u; }
  __syncthreads();
  const XcdBarrier xb = xcd_barrier_post((unsigned*)(ka->ws + WL.bar), st);

  PH(phase_prologue(P, bid, nblk))
  PH(phase_router_prep(P, bid, nblk))
  PH(phase_wconv_small(P, 0, smem, bid, nblk))
  xcd_barrier(xb);
  auto layer = [&](const int l) __attribute__((always_inline)) {
    PH(phase_zero_pads(P, bid, nblk))
    PH(phase_p1(P, l, smem_wg, bid, nblk))
    xcd_barrier(xb);
    PH(phase_mprep(P, l, smem, bid, nblk))
    xcd_barrier(xb);
    for (int it = bid0; it < 512; it += nblk0) PH(dattn_item(P, l, it, true, smem))
    PH(phase_mscan(P, bid, nblk))
    xcd_barrier(xb);
    {
      for (int it = (int)blockIdx.x; it < 256; it += (int)gridDim.x) PH(dattn_item16(P, l, it, smem_wg))
      unsigned* qctr = (unsigned*)(ka->ws + WL.ctl) + (l * 8 + 5) * 16;
      const int NP = 4 + 4 * NCH + 2 * 257;
      for (;;) {
        __syncthreads();
        if (rtid() == 0) wgq[0] = (int)xb_add(qctr, 1u);
        __syncthreads();
        const int pr = wgq[0];
        if (pr >= NP) break;
        if (pr < 4) PH(dattn_combine(P, l, 2 * pr + half, smem))
        else if (pr < 4 + 4 * NCH) PH(mout_item(P, l, 2 * (pr - 4) + half, smem))
        else PH(swa_item(P, l, 2 * (pr - 4 - 4 * NCH) + half, smem))
      }
    }
    xcd_barrier(xb);
    PH(phase_p3a(P, l, smem, smem_wg, bid, nblk))
    xcd_barrier(xb);
    PH(phase_p3b(P, l, smem, smem_wg, bid, nblk))
    xcd_barrier(xb);
    PH(phase_p4(P, l, smem, bid, nblk))
    PH(phase_wconv_experts(P, l, smem, half, wgq))
    xcd_barrier(xb);
    PH(phase_p5a(P, l, smem_wg, bid, nblk))
    xcd_barrier(xb);
    PH(phase_p5b(P, l, smem_wg, bid, nblk))
    xcd_barrier(xb);
    PH(phase_p6(P, l, smem, bid, nblk))
    if (l == 0) PH(phase_wconv_small(P, 1, smem, bid, nblk))
    xcd_barrier(xb);
  };
  layer(0);
  layer(1);
}

extern "C" void kernel_launch(void* const* d_in, const int* in_sizes, int n_in, void* d_out, int out_size, void* d_ws, size_t ws_size, hipStream_t stream) {
  (void)in_sizes; (void)n_in; (void)out_size;
  if (WL.need > ws_size) return;
  KArgs a{};
  for (int i = 0; i < 28; ++i) a.in[i] = (const float*)d_in[i];
  a.out = (float*)d_out; a.ws = (char*)d_ws;
  static int grid = 0;
  if (!grid) {
    int dev = 0, cus = 0, per_cu = 0;
    (void)hipGetDevice(&dev);
    (void)hipDeviceGetAttribute(&cus, hipDeviceAttributeMultiprocessorCount, dev);
    (void)hipFuncSetAttribute((const void*)mega, hipFuncAttributeMaxDynamicSharedMemorySize, WG_LDS);
    (void)hipOccupancyMaxActiveBlocksPerMultiprocessor(&per_cu, (const void*)mega, 512, WG_LDS);
    if (per_cu > 1) per_cu = 1;
    if (per_cu < 1) per_cu = 1;
    grid = cus * per_cu;
  }
  (void)hipMemsetAsync((char*)d_ws + WL.bar, 0, WL.h - WL.bar, stream);
  hipLaunchKernelGGL(mega, dim3(grid), dim3(512), WG_LDS, stream, a);
}
```

```cpp
#include <hip/hip_runtime.h>
#include <stdint.h>

#define DI __device__ __forceinline__
typedef unsigned short bf16_t;
typedef __attribute__((ext_vector_type(8))) short bf16x8;
typedef __attribute__((ext_vector_type(16))) float f32x16;
typedef __attribute__((ext_vector_type(2))) float f32x2;
typedef __attribute__((ext_vector_type(4))) float f32x4;
typedef __attribute__((ext_vector_type(4))) unsigned u32x4;
typedef __attribute__((ext_vector_type(2))) unsigned u32x2;
typedef __attribute__((ext_vector_type(2))) __bf16 bf16x2v;
#define MFMA32(a, b, c) __builtin_amdgcn_mfma_f32_32x32x16_bf16((a), (b), (c), 0, 0, 0)

constexpr int NB = 2, SEQ = 8192, NMETA = 16, L = 8208, T = NB * L, TP = 16512, D = 1024;
constexpr int DIN = 7440, DINP = 7680;
constexpr int LPAD = 8320, NCH = 65, MPAD = 112, LK = 8256;
constexpr int NEXP = 32, CAP = 2 * T, HROWS = 2 * T + NEXP * 256;
constexpr int NT = 256;
constexpr int CSTR = 64;
constexpr float LN_EPS = 1e-5f;
constexpr float NEGF = -1e30f;
constexpr int SMEM_TQ = 65536 + 4096 + 64;
constexpr float ALPHA = 1.41421356237309515f;
constexpr float QSCALE = 0.125f * 1.44269504088896341f;

DI f32x4 mk4(float a, float b, float c, float d) { f32x4 v = {a, b, c, d}; return v; }
DI f32x2 mk2(float a, float b) { f32x2 v = {a, b}; return v; }
DI unsigned pk2(float a, float b) { f32x2 v = {a, b}; bf16x2v r = __builtin_convertvector(v, bf16x2v); return __builtin_bit_cast(unsigned, r); }
DI bf16_t f2bf(float a) { return (bf16_t)(pk2(a, 0.f) & 0xffffu); }
DI float bf2f(bf16_t b) { return __uint_as_float(((unsigned)b) << 16); }
DI float bflo(unsigned u) { return __uint_as_float(u << 16); }
DI float bfhi(unsigned u) { return __uint_as_float(u & 0xffff0000u); }
typedef __attribute__((address_space(3))) int LAS_I;
constexpr int WIDTAB_OFF = 2 * (2 * 32768 + 4096 + 256) + 64;
DI int rtid() {
  const unsigned hw = (unsigned)__builtin_amdgcn_s_getreg((5 << 11) | 4) & 63u;
  const int wid = *(volatile __attribute__((address_space(3))) int*)(size_t)(WIDTAB_OFF + 4 * hw);
  return wid * 64 + (int)__builtin_amdgcn_mbcnt_hi(~0u, __builtin_amdgcn_mbcnt_lo(~0u, 0u));
}
DI int otid() { int t = rtid() & 255; asm volatile("" : "+v"(t)); return t; }
DI int crow(int r, int h) { return (r & 3) + 8 * (r >> 2) + 4 * h; }
DI int keyoff(int r, int h) { return (r & 7) + 8 * h + 16 * (r >> 3); }
DI int swz(int row) { return (row >> 1) & 7; }
DI int kswap(int r) { return (r & 0x13) | ((r & 4) << 1) | ((r & 8) >> 1); }
template <int O> DI float sxor(float v) { return __builtin_bit_cast(float, __builtin_amdgcn_ds_swizzle(__builtin_bit_cast(int, v), 0x1f | (O << 10))); }
DI float sx32(float v) {
  int ln = (int)__builtin_amdgcn_mbcnt_hi(~0u, __builtin_amdgcn_mbcnt_lo(~0u, 0u)); asm volatile("" : "+v"(ln));
  return __builtin_bit_cast(float, __builtin_amdgcn_ds_bpermute((ln ^ 32) << 2, __builtin_bit_cast(int, v)));
}
DI float xsum32(float v) { return v + sx32(v); }
DI float xmax32(float v) { return fmaxf(v, sx32(v)); }
DI float wave_sum(float v) { v = xsum32(v); v += sxor<16>(v); v += sxor<8>(v); v += sxor<4>(v); v += sxor<2>(v); v += sxor<1>(v); return v; }
DI float wave_max(float v) { v = xmax32(v); v = fmaxf(v, sxor<16>(v)); v = fmaxf(v, sxor<8>(v)); v = fmaxf(v, sxor<4>(v)); v = fmaxf(v, sxor<2>(v)); v = fmaxf(v, sxor<1>(v)); return v; }
DI float fexp2(float x) { return __builtin_amdgcn_exp2f(x); }
DI float frcp(float x) { return __builtin_amdgcn_rcpf(x); }
DI float shfl_up_f(float v, int d, int lane) { return __builtin_bit_cast(float, __builtin_amdgcn_ds_bpermute(((lane - d) & 63) << 2, __builtin_bit_cast(int, v))); }
DI float sigmoidf_(float x) { return frcp(1.f + __expf(-x)); }
DI bf16x8 ldfrag(const bf16_t* p) { return *(const bf16x8*)p; }
DI f32x16 zero16() { f32x16 z; _Pragma("unroll") for (int i = 0; i < 16; ++i) z[i] = 0.f; return z; }
DI bf16x8 packfrag(const f32x16& x, int s) {
  union { unsigned u[4]; bf16x8 v; } t;
  t.u[0] = pk2(x[8 * s + 0], x[8 * s + 1]); t.u[1] = pk2(x[8 * s + 2], x[8 * s + 3]);
  t.u[2] = pk2(x[8 * s + 4], x[8 * s + 5]); t.u[3] = pk2(x[8 * s + 6], x[8 * s + 7]);
  return t.v;
}

struct Params {
  const float *x, *meta, *ln_in_g, *ln_in_b, *w_in, *conv_w, *conv_b, *gate_b, *lam_q1, *lam_k1, *lam_q2, *lam_k2;
  const float *diff_g, *sink, *mlstm_g, *w_branch, *w_out, *ln1_g, *ln1_b, *ln2_g, *ln2_b, *w_rg, *b_rg, *w_re, *b_re;
  const float *w_gate, *w_up, *w_down;
  float* out;
  float* h; bf16_t* hb; bf16_t *w_in_t, *w_br_t, *w_out_t; f32x2* cs; float* lam; unsigned* ctl; float* rwp; float* rgb;
  int* counts; int* tok_slot; float* tok_w; int* slot_tok;
  float* mstat;
  float* nvec;
  float* wgt;
  float* bcum;
  float* ligate;
  bf16_t *qa, *ka, *vaT, *qb, *kb, *vbT, *cq, *ck, *cvT, *co, *gz, *qc, *kc, *kcT, *merged;
  float* cg; float* U;
  bf16_t *oa, *ob, *oc;
  bf16_t *w_gu_t, *w_dn_t, *H, *ys;
};

typedef __attribute__((address_space(3))) unsigned lds_u32;
DI void gemm_issue(const bf16_t* (&arow)[4], const bf16_t* (&brow)[4], int koff, char* st, int w) {
  _Pragma("unroll") for (int i = 0; i < 4; ++i) {
    __builtin_amdgcn_global_load_lds((const unsigned*)(arow[i] + koff), (lds_u32*)(st + (4 * i + w) * 1024), 16, 0, 0);
    __builtin_amdgcn_global_load_lds((const unsigned*)(brow[i] + koff), (lds_u32*)(st + 16384 + (4 * i + w) * 1024), 16, 0, 0);
  }
}
DI void gemm_tile(const bf16_t* (&arow)[4], const bf16_t* (&brow)[4], int K, char* smem, f32x16 (&acc)[2][2], int rows = 128) {
  const int tid = otid(), lane = tid & 63, w = tid >> 6, wm = w >> 1, wn = w & 1;
  const int lr = lane & 31, lh = lane >> 5;
  const int cs = ((lane & 7) ^ (4 * (w & 1) + (lane >> 4))) * 8;
  const int nkt = K >> 6;
  const int myrows = rows - wm * 64;
  __syncthreads();
  gemm_issue(arow, brow, cs, smem, w);
  for (int kt = 0; kt < nkt; ++kt) {
    __syncthreads();
    if (kt + 1 < nkt) gemm_issue(arow, brow, (kt + 1) * 64 + cs, smem + ((kt + 1) & 1) * 32768, w);
    const char* sA = smem + (kt & 1) * 32768; const char* sB = sA + 16384;
    if (myrows > 32) {
      bf16x8 a[4][2], b[4][2];
      _Pragma("unroll") for (int ks = 0; ks < 4; ++ks) {
        const int ch = 2 * ks + lh;
        _Pragma("unroll") for (int i = 0; i < 2; ++i) {
          const int rowa = wm * 64 + 32 * i + lr;
          a[ks][i] = *(const bf16x8*)(sA + rowa * 128 + ((ch ^ swz(rowa)) << 4));
          const int rowb = wn * 64 + 32 * i + lr;
          b[ks][i] = *(const bf16x8*)(sB + rowb * 128 + ((ch ^ swz(rowb)) << 4));
        }
      }
      _Pragma("unroll") for (int ks = 0; ks < 4; ++ks)
        _Pragma("unroll") for (int i = 0; i < 2; ++i)
          _Pragma("unroll") for (int j = 0; j < 2; ++j) acc[i][j] = MFMA32(a[ks][i], b[ks][j], acc[i][j]);
    } else if (myrows > 0) {
      _Pragma("unroll") for (int ks = 0; ks < 4; ++ks) {
        const int ch = 2 * ks + lh;
        const int rowa = wm * 64 + lr;
        const bf16x8 a0 = *(const bf16x8*)(sA + rowa * 128 + ((ch ^ swz(rowa)) << 4));
        _Pragma("unroll") for (int j = 0; j < 2; ++j) {
          const int rowb = wn * 64 + 32 * j + lr;
          acc[0][j] = MFMA32(a0, *(const bf16x8*)(sB + rowb * 128 + ((ch ^ swz(rowb)) << 4)), acc[0][j]);
        }
      }
    }
  }
  __syncthreads();
}


namespace g8 {
typedef __attribute__((address_space(3))) unsigned char lds_u8;
typedef float f32x4 __attribute__((ext_vector_type(4)));
constexpr int BK = 64, HALF = 128, HTB = HALF * BK * 2, STAGE_BYTES = 8 * HTB;
DI int lds_byte(int r, int c) { const int st = (r >> 4) * 2 + (c >> 5), rr = r & 15, cc = c & 31, ob = rr * 64 + cc * 2; return st * 1024 + (ob ^ (((ob >> 9) & 1) << 5)); }
DI void stage_rc(int b, int& R, int& C) { const int st = b / 1024, sb = b % 1024, swz = sb ^ (((sb >> 9) & 1) << 5); R = (st >> 1) * 16 + swz / 64; C = (st & 1) * 32 + (swz % 64) / 2; }
DI int perm32(int rho) { const int n = rho >> 4, i = rho & 15; return 8 * (i >> 2) + 4 * n + (i & 3); }
struct Unit { const char* a; const char* b; int pm, pn, tag, x0, x1; };
template <class Epi, class Sched>
DI void gemm_phase(lds_u8* lds, int K, const Sched& S, const Epi& E) {
  int tid = rtid(); asm volatile("" : "+v"(tid));
  const int wid = __builtin_amdgcn_readfirstlane(tid >> 6), lane = tid & 63, wr = wid >> 2, wc = wid & 3, fr = lane & 15, fq = lane >> 4;
  const int nt = K / BK;
  int R[2], C[2]; unsigned voffB[2];
  _Pragma("unroll") for (int i = 0; i < 2; ++i) { stage_rc(tid * 16 + i * 8192, R[i], C[i]); const int Rb = Epi::PERM ? ((R[i] & ~31) + perm32(R[i] & 31)) : R[i]; voffB[i] = (unsigned)(Rb * K + C[i]) * 2u; }
  const size_t kstep = (size_t)(BK * 2), hstep = (size_t)HALF * K * 2;
  const unsigned ldsw = (unsigned)wid * 1024u;
  const int aoff = lds_byte(wr * 64 + fr, fq * 8), boff = lds_byte(wc * 32 + fr, fq * 8);
#define G8_SA(b, h) (((b) * 2 + (h)) * HTB)
#define G8_SB(b, h) ((4 + (b) * 2 + (h)) * HTB)
#define G8_STAGE(bufoff, gbase, voff) do { _Pragma("unroll") for (int _i = 0; _i < 2; ++_i) \
    __builtin_amdgcn_global_load_lds((const unsigned*)((const char*)(gbase) + (voff)[_i]), (lds_u32*)(lds + (bufoff) + ldsw + _i * 8192), 16, 0, 0); } while (0)
#define G8_LDA(dst, b, h) do { _Pragma("unroll") for (int m = 0; m < 4; ++m) _Pragma("unroll") for (int k = 0; k < 2; ++k) dst[m][k] = *(const __attribute__((address_space(3))) bf16x8*)(lds + G8_SA(b, h) + aoff + m * 2048 + k * 1024); } while (0)
#define G8_LDB(dst, b, h) do { _Pragma("unroll") for (int n = 0; n < 2; ++n) _Pragma("unroll") for (int k = 0; k < 2; ++k) dst[n][k] = *(const __attribute__((address_space(3))) bf16x8*)(lds + G8_SB(b, h) + boff + n * 2048 + k * 1024); } while (0)
#define G8_MMA(ai, bj, At, Bt) do { __builtin_amdgcn_s_setprio(1); _Pragma("unroll") for (int m = 0; m < 4; ++m) _Pragma("unroll") for (int n = 0; n < 2; ++n) _Pragma("unroll") for (int k = 0; k < 2; ++k) \
    acc[ai][bj][m][n] = __builtin_amdgcn_mfma_f32_16x16x32_bf16(Bt[n][k], At[m][k], acc[ai][bj][m][n], 0, 0, 0); __builtin_amdgcn_s_setprio(0); } while (0)
#define G8_WAIT_V(n) asm volatile("s_waitcnt vmcnt(" #n ")" ::: "memory")
#define G8_WAIT_L(n) asm volatile("s_waitcnt lgkmcnt(" #n ")" ::: "memory")
#define G8_BAR __builtin_amdgcn_s_barrier()
#define G8_SCHED __builtin_amdgcn_sched_barrier(0)
  Unit cur, nxt; int ui = 0;
  if (!S.next(0, cur)) return;
  f32x4 acc[2][2][4][2];
  _Pragma("unroll") for (int a = 0; a < 2; ++a) _Pragma("unroll") for (int b = 0; b < 2; ++b) _Pragma("unroll") for (int m = 0; m < 4; ++m) _Pragma("unroll") for (int n = 0; n < 2; ++n) acc[a][b][m][n] = (f32x4){0.f, 0.f, 0.f, 0.f};
  bf16x8 At[4][2], B0[2][2], B1[2][2];
  constexpr bool GA = Sched::GATHER;
  unsigned voffA[2]; unsigned cpk[2], npk[2];
  _Pragma("unroll") for (int i = 0; i < 2; ++i) voffA[i] = (unsigned)(R[i] * K + C[i]) * 2u;
  const unsigned gc2 = (unsigned)C[0] * 2u, gk2 = (unsigned)K * 2u;
  if (GA) S.arows(cur, R[0], cpk);
#define G8_STAGE_G(bufoff, base, pk) do { const unsigned _v[2] = { ((pk) & 0xffffu) * gk2 + gc2, ((pk) >> 16) * gk2 + gc2 }; G8_STAGE(bufoff, base, _v); } while (0)
#define G8_STAGE_A(bufoff, base, h, nx) do { if (GA) { if (nx) G8_STAGE_G(bufoff, base, npk[h]); else G8_STAGE_G(bufoff, base, cpk[h]); } else G8_STAGE(bufoff, (base) + (h) * hstep, voffA); } while (0)
  const char* cA = cur.a; const char* cB = cur.b;
  G8_STAGE(G8_SB(0, 0), cB, voffB); G8_STAGE_A(G8_SA(0, 0), cA, 0, false); G8_STAGE(G8_SB(0, 1), cB + hstep, voffB); G8_STAGE_A(G8_SA(0, 1), cA, 1, false);
  if (wr == 1) G8_BAR;
  G8_WAIT_V(4); G8_BAR;
  G8_STAGE(G8_SB(1, 0), cB + kstep, voffB); G8_STAGE_A(G8_SA(1, 0), cA + kstep, 0, false); G8_STAGE(G8_SB(1, 1), cB + hstep + kstep, voffB);
  G8_WAIT_V(6); G8_BAR;
  for (;;) {
    const bool has_next = S.next(ui + 1, nxt);
    const char* nA = has_next ? nxt.a : cA; const char* nB = has_next ? nxt.b : cB;
    if (GA) { if (has_next) S.arows(nxt, R[0], npk); else { npk[0] = cpk[0]; npk[1] = cpk[1]; } }
    for (int t = 0; t < nt; t += 2) {
      const bool last = (t == nt - 2);
      const char* a1 = cA + (size_t)(t + 1) * kstep;
      const char* a2 = last ? nA : cA + (size_t)(t + 2) * kstep; const char* b2 = last ? nB : cB + (size_t)(t + 2) * kstep;
      const char* a3 = a2 + kstep; const char* b3 = b2 + kstep;
      G8_LDB(B0, 0, 0); G8_SCHED; G8_LDA(At, 0, 0); G8_STAGE_A(G8_SA(1, 1), a1, 1, false);
      G8_WAIT_L(8); G8_BAR; G8_WAIT_L(0); G8_MMA(0, 0, At, B0); G8_BAR; G8_SCHED;
      G8_LDB(B1, 0, 1); G8_STAGE(G8_SB(0, 0), b2, voffB);
      G8_BAR; G8_WAIT_L(0); G8_MMA(0, 1, At, B1); G8_BAR;
      G8_LDA(At, 0, 1); G8_STAGE_A(G8_SA(0, 0), a2, 0, last);
      G8_BAR; G8_WAIT_L(0); G8_MMA(1, 0, At, B0); G8_BAR; G8_SCHED;
      G8_STAGE(G8_SB(0, 1), b2 + hstep, voffB);
      G8_WAIT_V(6); G8_BAR; G8_MMA(1, 1, At, B1); G8_BAR;
      G8_LDB(B0, 1, 0); G8_SCHED; G8_LDA(At, 1, 0); G8_STAGE_A(G8_SA(0, 1), a2, 1, last);
      G8_WAIT_L(8); G8_BAR; G8_WAIT_L(0); G8_MMA(0, 0, At, B0); G8_BAR; G8_SCHED;
      G8_LDB(B1, 1, 1); G8_STAGE(G8_SB(1, 0), b3, voffB);
      G8_BAR; G8_WAIT_L(0); G8_MMA(0, 1, At, B1); G8_BAR;
      G8_LDA(At, 1, 1); G8_STAGE_A(G8_SA(1, 0), a3, 0, last);
      G8_BAR; G8_WAIT_L(0); G8_MMA(1, 0, At, B0); G8_BAR; G8_SCHED;
      G8_STAGE(G8_SB(1, 1), b3 + hstep, voffB);
      G8_WAIT_V(6); G8_BAR; G8_MMA(1, 1, At, B1); G8_BAR;
    }
    E(acc, cur, wr, wc, fr, fq);
    if (!has_next) break;
    if (!E.keep(cur)) { _Pragma("unroll") for (int a = 0; a < 2; ++a) _Pragma("unroll") for (int b = 0; b < 2; ++b) _Pragma("unroll") for (int m = 0; m < 4; ++m) _Pragma("unroll") for (int n = 0; n < 2; ++n) acc[a][b][m][n] = (f32x4){0.f, 0.f, 0.f, 0.f}; }
    cur = nxt; cA = nA; cB = nB; ++ui;
    if (GA) { cpk[0] = npk[0]; cpk[1] = npk[1]; }
  }
  G8_WAIT_V(0);
  if (wr == 0) G8_BAR;
  G8_BAR;
#undef G8_SA
#undef G8_SB
#undef G8_STAGE
#undef G8_STAGE_A
#undef G8_STAGE_G
#undef G8_LDA
#undef G8_LDB
#undef G8_MMA
#undef G8_WAIT_V
#undef G8_WAIT_L
#undef G8_BAR
#undef G8_SCHED
}
DI void dense_arows(int K, int R0, int R1, int C0, int C1, unsigned (&vo)[2][2]) {
  vo[0][0] = (unsigned)(R0 * K + C0) * 2u; vo[0][1] = (unsigned)(R1 * K + C1) * 2u;
  vo[1][0] = (unsigned)((128 + R0) * K + C0) * 2u; vo[1][1] = (unsigned)((128 + R1) * K + C1) * 2u;
}
DI void grid_lin(int wgid, int nM, int nN, int& pm, int& pn) {
  const int nwg = nM * nN;
  { const int q = nwg / 8, r = nwg % 8, xcd = wgid % 8, off = wgid / 8; wgid = (xcd < r ? xcd * (q + 1) : r * (q + 1) + (xcd - r) * q) + off; }
  const int nig = 8 * nN, gid = wgid / nig, fm = gid * 8, gsz = (nM - fm) < 8 ? (nM - fm) : 8;
  pm = fm + ((wgid % nig) % gsz); pn = (wgid % nig) / gsz;
}
DI bool grid_unit(int i, int G, int c, int nM, int nN, int& pm, int& pn) {
  const int nwg = nM * nN; const long Lq = (long)i * G + c; if (Lq >= nwg) return false;
  int wgid = (int)Lq; { const int q = nwg / 8, r = nwg % 8, xcd = wgid % 8, off = wgid / 8; wgid = (xcd < r ? xcd * (q + 1) : r * (q + 1) + (xcd - r) * q) + off; }
  const int nig = 8 * nN, gid = wgid / nig, fm = gid * 8, gsz = (nM - fm) < 8 ? (nM - fm) : 8;
  pm = fm + ((wgid % nig) % gsz); pn = (wgid % nig) / gsz; return true;
}
}

DI int ropep(int x) { const int d = x & 63; return (x & ~63) + 8 * ((d & 31) >> 2) + 4 * (d >> 5) + (d & 3); }
DI int wmap(int mode, int n) {
  if (mode == 1) {
    if (n < 512) return ropep(n);
    if (n < 1024) return 512 + ropep(n - 512);
    if (n < 1536) return 6400 + (n - 1024);
    if (n < 2048) return 1024 + ropep(n - 1536);
    if (n < 2176) return 1536 + ropep(n - 2048);
    if (n < 2304) return 6400 + 512 + (n - 2176);
    if (n < 2816) return 1664 + (n - 2304);
    if (n < 3328) return 2176 + (n - 2816);
    if (n < 3840) return 6400 + 640 + (n - 3328);
    if (n < 4352) return 2688 + (n - 3840);
    if (n < 4368) return 6272 + (n - 4352);
    return 3200 + (n - 4368);
  }
  if (mode == 2) return 8 * (n >> 2) + (n & 3);
  if (mode == 3) return 8 * (n >> 2) + 4 + (n & 3);
  return n;
}
struct CvJob { const float* src; bf16_t* dst; int K, N, mode, tk, tn; };
DI void cv_load(const CvJob& j, int tid, f32x4 (&v)[4]) {
  const int kk = tid >> 4, c4 = tid & 15, n = j.tn * 64 + 4 * c4;
  _Pragma("unroll") for (int i = 0; i < 4; ++i) {
    v[i] = mk4(0.f, 0.f, 0.f, 0.f);
    if (n < j.N) v[i] = *(const f32x4*)(j.src + (size_t)(j.tk * 64 + kk + 16 * i) * j.N + n);
  }
}
DI void cv_finish(const CvJob& j, int tid, const f32x4 (&v)[4], char* smem) {
  bf16_t* sT = (bf16_t*)smem;
  const int kk = tid >> 4, c4 = tid & 15;
  __syncthreads();
  _Pragma("unroll") for (int i = 0; i < 4; ++i) {
    const int k = kk + 16 * i;
    sT[(4 * c4 + 0) * 72 + k] = f2bf(v[i].x); sT[(4 * c4 + 1) * 72 + k] = f2bf(v[i].y);
    sT[(4 * c4 + 2) * 72 + k] = f2bf(v[i].z); sT[(4 * c4 + 3) * 72 + k] = f2bf(v[i].w);
  }
  __syncthreads();
  const int nn = tid >> 2, kc = tid & 3;
  const int ng = j.tn * 64 + nn;
  if (ng < j.N) {
    const u32x4 v0 = *(const u32x4*)(sT + nn * 72 + 16 * kc);
    const u32x4 v1 = *(const u32x4*)(sT + nn * 72 + 16 * kc + 8);
    bf16_t* d = j.dst + (size_t)wmap(j.mode, ng) * j.K + j.tk * 64 + 16 * kc;
    *(u32x4*)d = v0; *(u32x4*)(d + 8) = v1;
  }
}

constexpr int WS_TILES_IN = 16 * 117, WS_TILES_BR = 3 * 8 * 16, WS_TILES_OUT = 16 * 16;
constexpr int WS_TILES = WS_TILES_IN + WS_TILES_BR + WS_TILES_OUT;
DI CvJob ws_job(const Params& P, int l, int it) {
  CvJob j;
  if (it < WS_TILES_IN) { j.src = P.w_in + (size_t)l * D * DIN; j.K = D; j.N = DIN; j.dst = P.w_in_t; j.mode = 1; j.tk = it / 117; j.tn = it % 117; }
  else if (it < WS_TILES_IN + WS_TILES_BR) {
    const int q = it - WS_TILES_IN, i = q / 128, r = q % 128;
    j.src = P.w_branch + ((size_t)l * 3 + i) * 512 * 1024; j.K = 512; j.N = 1024; j.dst = P.w_br_t + (size_t)i * 1024 * 512; j.mode = 0; j.tk = r / 16; j.tn = r % 16;
  } else {
    const int q = it - WS_TILES_IN - WS_TILES_BR;
    j.src = P.w_out + (size_t)l * D * D; j.K = D; j.N = D; j.dst = P.w_out_t; j.mode = 0; j.tk = q / 16; j.tn = q % 16;
  }
  return j;
}
DI void phase_wconv_small(const Params& P, int l, char* smem, int bid, int nblk) {
  const int tid = otid();
  if (bid >= WS_TILES) return;
  CvJob j = ws_job(P, l, bid); f32x4 v[4];
  cv_load(j, tid, v);
  for (int it = bid; it < WS_TILES; it += nblk) {
    CvJob jn = j; f32x4 vn[4];
    _Pragma("unroll") for (int i = 0; i < 4; ++i) vn[i] = v[i];
    if (it + nblk < WS_TILES) { jn = ws_job(P, l, it + nblk); cv_load(jn, tid, vn); }
    cv_finish(j, tid, v, smem);
    j = jn;
    _Pragma("unroll") for (int i = 0; i < 4; ++i) v[i] = vn[i];
  }
}
constexpr int WE_TILES = NEXP * 384;
DI CvJob we_job(const Params& P, int l, int it) {
  const int e = it / 384, q = it % 384, which = q / 128, r = q % 128;
  const size_t eo = (size_t)l * NEXP + e;
  CvJob j;
  if (which == 0) { j.src = P.w_gate + eo * 1024 * 512; j.K = 1024; j.N = 512; j.dst = P.w_gu_t + (size_t)e * 1024 * 1024; j.mode = 2; j.tk = r / 8; j.tn = r % 8; }
  else if (which == 1) { j.src = P.w_up + eo * 1024 * 512; j.K = 1024; j.N = 512; j.dst = P.w_gu_t + (size_t)e * 1024 * 1024; j.mode = 3; j.tk = r / 8; j.tn = r % 8; }
  else { j.src = P.w_down + eo * 512 * 1024; j.K = 512; j.N = 1024; j.dst = P.w_dn_t + (size_t)e * 1024 * 512; j.mode = 0; j.tk = r / 16; j.tn = r % 16; }
  return j;
}
DI void phase_wconv_experts(const Params& P, int l, char* smem, int half, volatile __attribute__((address_space(3))) int* wgslot) {
  unsigned* ctr = P.ctl + (l * 8 + 6) * 16;
  const int tid = otid();
  for (;;) {
    __syncthreads();
    if (rtid() == 0) wgslot[0] = (int)__hip_atomic_fetch_add(ctr, 2u, __ATOMIC_RELAXED, __HIP_MEMORY_SCOPE_AGENT);
    __syncthreads();
    const int c0 = (wgslot[0] + half) * 8;
    if (c0 >= WE_TILES) break;
    CvJob j = we_job(P, l, c0); f32x4 v[4];
    cv_load(j, tid, v);
    for (int it = c0; it < c0 + 8; ++it) {
      CvJob jn = j; f32x4 vn[4];
      _Pragma("unroll") for (int i = 0; i < 4; ++i) vn[i] = v[i];
      if (it + 1 < c0 + 8) { jn = we_job(P, l, it + 1); cv_load(jn, tid, vn); }
      cv_finish(j, tid, v, smem);
      j = jn;
      _Pragma("unroll") for (int i = 0; i < 4; ++i) v[i] = vn[i];
    }
  }
}

DI void ln16(f32x4 (&v)[4], const float* g, const float* b, int lane) {
  float s = 0.f;
  _Pragma("unroll") for (int i = 0; i < 4; ++i) s += v[i].x + v[i].y + v[i].z + v[i].w;
  const float mu = wave_sum(s) * (1.f / 1024.f);
  float q = 0.f;
  _Pragma("unroll") for (int i = 0; i < 4; ++i) { v[i].x -= mu; v[i].y -= mu; v[i].z -= mu; v[i].w -= mu; q += v[i].x * v[i].x + v[i].y * v[i].y + v[i].z * v[i].z + v[i].w * v[i].w; }
  const float rs = rsqrtf(wave_sum(q) * (1.f / 1024.f) + LN_EPS);
  _Pragma("unroll") for (int i = 0; i < 4; ++i) {
    const f32x4 gg = ((const f32x4*)g)[lane + 64 * i], bb = ((const f32x4*)b)[lane + 64 * i];
    v[i].x = v[i].x * rs * gg.x + bb.x; v[i].y = v[i].y * rs * gg.y + bb.y; v[i].z = v[i].z * rs * gg.z + bb.z; v[i].w = v[i].w * rs * gg.w + bb.w;
  }
}
DI void store_row(const f32x4 (&v)[4], float* hf, bf16_t* hbf, int lane) {
  _Pragma("unroll") for (int i = 0; i < 4; ++i) {
    if (hf) ((f32x4*)hf)[lane + 64 * i] = v[i];
    if (hbf) { u32x2 u; u.x = pk2(v[i].x, v[i].y); u.y = pk2(v[i].z, v[i].w); ((u32x2*)hbf)[lane + 64 * i] = u; }
  }
}

DI void phase_prologue(const Params& P, int bid, int nblk) {
  const int tid = otid(), gtid = bid * NT + tid, gn = nblk * NT;
  for (int i = gtid; i < L * 32; i += gn) {
    const int pos = i >> 5, f = i & 31;
    const float e = (float)(2 * f) / 64.0f;
    const float pw = (float)pow(10000.0, (double)e);
    const float inv = 1.0f / pw;
    const float ang = (float)pos * inv;
    P.cs[i] = mk2((float)cos((double)ang), (float)sin((double)ang));
  }
  if (gtid < 2) {
    const int l = gtid;
    float s1 = 0.f, s2 = 0.f;
    for (int i = 0; i < 64; ++i) { s1 += P.lam_q1[l * 64 + i] * P.lam_k1[l * 64 + i]; s2 += P.lam_q2[l * 64 + i] * P.lam_k2[l * 64 + i]; }
    const float li = (float)(0.8 - 0.6 * exp(-0.3 * (double)l));
    P.lam[l] = expf(s1) - expf(s2) + li;
    P.lam[2 + l] = (float)(1.0 - (0.8 - 0.6 * exp(-0.3 * (double)l)));
  }
  const int lane = tid & 63, wv = (bid * NT + tid) >> 6, nwv = (nblk * NT) >> 6;
  for (int t = wv; t < T; t += nwv) {
    const int b = t >= L ? 1 : 0, pos = t - b * L;
    const float* src = pos < NMETA ? P.meta + (size_t)pos * D : P.x + ((size_t)b * SEQ + (pos - NMETA)) * D;
    f32x4 v[4];
    _Pragma("unroll") for (int i = 0; i < 4; ++i) v[i] = ((const f32x4*)src)[lane + 64 * i];
    ln16(v, P.ln_in_g, P.ln_in_b, lane);
    store_row(v, P.h + (size_t)t * D, P.hb + (size_t)t * D, lane);
  }
}
DI void phase_zero_pads(const Params& P, int bid, int nblk) {
  const int gtid = bid * NT + otid(), gn = nblk * NT;
  for (int i = gtid; i < 8 * 128 * (LK - L); i += gn) { const int r = i / (LK - L), cidx = i % (LK - L); P.vaT[(size_t)r * LK + L + cidx] = 0; }
  for (int i = gtid; i < 4 * 64 * (LK - L); i += gn) { const int r = i / (LK - L), cidx = i % (LK - L); P.vbT[(size_t)r * LK + L + cidx] = 0; }
  for (int i = gtid; i < 8 * 128 * MPAD; i += gn) { const int r = i / MPAD, cidx = i % MPAD; P.cvT[(size_t)r * LPAD + cidx] = 0; }
  for (int i = gtid; i < 8 * MPAD * 128; i += gn) { const int bh = i / (MPAD * 128), r = i % (MPAD * 128); P.qc[(size_t)bh * LPAD * 128 + r] = 0; P.kc[(size_t)bh * LPAD * 128 + r] = 0; }
  if (gtid < NEXP) P.counts[gtid * CSTR] = 0;
}

constexpr int P1_MT = TP / 128, P1_NT = DINP / 128;
#define WT_FENCE() asm volatile("s_waitcnt lgkmcnt(0)" ::: "memory")
DI void p1_epilogue(const Params& P, int m0, int n0, f32x16 (&acc)[2][2], char* smem) {
  const int tid = otid(), lane = tid & 63, w = tid >> 6, wm = w >> 1, wn = w & 1, lr = lane & 31, lh = lane >> 5;
  const int nw = n0 + wn * 64;
  bf16_t* wt = (bf16_t*)(smem + w * 9216);
  const int mw = m0 + wm * 64;
  int seg;
  if (nw < 512) seg = 0; else if (nw < 1024) seg = 1; else if (nw < 1536) seg = 2; else if (nw < 2048) seg = 3; else if (nw < 2176) seg = 4;
  else if (nw < 2304) seg = 5; else if (nw < 2816) seg = 6; else if (nw < 3328) seg = 7; else if (nw < 3840) seg = 8; else if (nw < 4352) seg = 9;
  else if (nw < 7424) seg = 10; else seg = 11;
  if (seg == 11) {
    _Pragma("unroll") for (int i = 0; i < 2; ++i) _Pragma("unroll") for (int r = 0; r < 16; ++r) {
      const int t = mw + 32 * i + crow(r, lh);
      const int cn = nw + lr - 7424;
      if (t < T && cn < 16) P.cg[(size_t)t * 16 + cn] = acc[i][0][r];
    }
    return;
  }
  if (seg == 0 || seg == 1 || seg == 3 || seg == 4) {
    _Pragma("unroll") for (int i = 0; i < 2; ++i) _Pragma("unroll") for (int r = 0; r < 16; ++r) {
      const int row = 32 * i + crow(r, lh);
      const int t = min(mw + row, T - 1);
      const int pos = t >= L ? t - L : t;
      const f32x2 csv = P.cs[pos * 32 + lr];
      const float x1 = acc[i][0][r], x2 = acc[i][1][r];
      float o1 = x1 * csv.x - x2 * csv.y, o2 = x2 * csv.x + x1 * csv.y;
      if (seg == 0 || seg == 3) { o1 *= QSCALE; o2 *= QSCALE; }
      wt[row * 72 + lr] = f2bf(o1); wt[row * 72 + 32 + lr] = f2bf(o2);
    }
  } else if (seg == 2 || seg == 5 || seg == 8) {
    _Pragma("unroll") for (int i = 0; i < 2; ++i) _Pragma("unroll") for (int j = 0; j < 2; ++j) _Pragma("unroll") for (int rg = 0; rg < 4; ++rg) {
      u32x2 u; u.x = pk2(acc[i][j][4 * rg], acc[i][j][4 * rg + 1]); u.y = pk2(acc[i][j][4 * rg + 2], acc[i][j][4 * rg + 3]);
      *(u32x2*)(wt + (32 * j + lr) * 72 + 32 * i + 8 * rg + 4 * lh) = u;
    }
  } else if (seg == 10) {
    _Pragma("unroll") for (int i = 0; i < 2; ++i) _Pragma("unroll") for (int j = 0; j < 2; ++j) _Pragma("unroll") for (int r = 0; r < 16; ++r)
      wt[(32 * i + crow(r, lh)) * 72 + 32 * j + lr] = f2bf(fmaxf(sigmoidf_(acc[i][j][r]), 1e-12f));
  } else {
    _Pragma("unroll") for (int i = 0; i < 2; ++i) _Pragma("unroll") for (int j = 0; j < 2; ++j) _Pragma("unroll") for (int r = 0; r < 16; ++r)
      wt[(32 * i + crow(r, lh)) * 72 + 32 * j + lr] = f2bf(acc[i][j][r]);
  }
  WT_FENCE();
  _Pragma("unroll") for (int it = 0; it < 8; ++it) {
    const int id = it * 64 + lane, row = id >> 3, ch = id & 7;
    const u32x4 v = *(const u32x4*)(wt + row * 72 + ch * 8);
    if (seg == 2 || seg == 5 || seg == 8) {
      const int t0 = mw + ch * 8;
      if (t0 < T) {
        const int b = t0 >= L ? 1 : 0, pos0 = t0 - b * L;
        bf16_t* dst;
        if (seg == 2) { const int cc = nw - 1024 + row; dst = P.vaT + ((size_t)(b * 4 + (cc >> 7)) * 128 + (cc & 127)) * LK + pos0; }
        else if (seg == 5) { const int cc = nw - 2176 + row; dst = P.vbT + ((size_t)(b * 2 + (cc >> 6)) * 64 + (cc & 63)) * LK + pos0; }
        else { const int cc = nw - 3328 + row; dst = P.cvT + ((size_t)(b * 4 + (cc >> 7)) * 128 + (cc & 127)) * LPAD + MPAD + pos0; }
        *(u32x4*)dst = v;
      }
    } else {
      const int t = mw + row;
      if (t < T) {
        const int b = t >= L ? 1 : 0, pos = t - b * L;
        bf16_t* dst;
        if (seg == 0) { const int u = nw >> 6; dst = P.qa + ((size_t)((b * 4 + (u >> 1)) * 2 + (u & 1)) * L + pos) * 64; }
        else if (seg == 1) { const int u = (nw - 512) >> 6; dst = P.ka + ((size_t)((b * 4 + (u >> 1)) * 2 + (u & 1)) * L + pos) * 64; }
        else if (seg == 3) { const int hq = (nw - 1536) >> 6; dst = P.qb + ((size_t)(b * 8 + hq) * L + pos) * 64; }
        else if (seg == 4) { const int kv = (nw - 2048) >> 6; dst = P.kb + ((size_t)(b * 2 + kv) * L + pos) * 64; }
        else if (seg == 6) dst = P.cq + (size_t)t * 512 + nw - 2304;
        else if (seg == 7) dst = P.ck + (size_t)t * 512 + nw - 2816;
        else if (seg == 9) dst = P.co + (size_t)t * 512 + nw - 3840;
        else dst = P.gz + (size_t)t * 3072 + nw - 4352;
        *(u32x4*)(dst + ch * 8) = v;
      }
    }
  }
}
DI float logsigmoidf_(float x) { return fminf(x, 0.f) - log1pf(__expf(-fabsf(x))); }
DI void phase_mprep(const Params& P, int l, char* smem, int bid, int nblk) {
  const int tid = otid();
  float* sli = (float*)smem;
  float* slf = sli + 256;
  float* sb = slf + 256;
  float* sw = sb + 256;
  float* sred = sw + 256;
  float* sst = sred + 16 * 256;
  for (int it = bid; it < 8 * NCH; it += nblk) {
    const int bh = it < 8 * (NCH - 1) ? it / (NCH - 1) : it - 8 * (NCH - 1), n = it < 8 * (NCH - 1) ? 1 + it % (NCH - 1) : 0, b = bh >> 2, hh = bh & 3;
    __syncthreads();
    if (tid < 128) {
      const int p = 128 * n + tid, pos = p - MPAD;
      float lif = NEGF, lff = 0.f, lib = NEGF, lfb = 0.f;
      if (pos >= 0) {
        const float* g = P.cg + (size_t)(b * L + pos) * 16;
        const float* gb = P.gate_b + l * 16;
        lif = g[0 + hh] + gb[0 + hh]; lff = logsigmoidf_(g[4 + hh] + gb[4 + hh]);
        lib = g[8 + hh] + gb[8 + hh]; lfb = logsigmoidf_(g[12 + hh] + gb[12 + hh]);
      }
      sli[tid] = lif; sli[128 + tid] = lib; slf[tid] = lff; slf[128 + tid] = lfb;
    }
    __syncthreads();
    if (tid < 128) {
      const int t2 = otid(), wd = t2 >> 6, ln = t2 & 63;
      const int i0 = wd == 0 ? 2 * ln : 127 - 2 * ln, i1 = wd == 0 ? 2 * ln + 1 : 126 - 2 * ln;
      const float e0 = slf[wd * 128 + i0], e1 = slf[wd * 128 + i1];
      float scan = e0 + e1;
      _Pragma("unroll") for (int d = 1; d < 64; d <<= 1) { const float tt = shfl_up_f(scan, d, ln); if (ln >= d) scan += tt; }
      float excl = shfl_up_f(scan, 1, ln); if (ln == 0) excl = 0.f;
      sb[wd * 128 + i0] = excl + e0; sb[wd * 128 + i1] = excl + e0 + e1;
    }
    __syncthreads();
    if (tid < 128) {
      const int dir = tid >> 6, lane = tid & 63;
      const float g = dir == 0 ? sb[127] : sb[128];
      const float a0 = g - sb[dir * 128 + lane] + sli[dir * 128 + lane];
      const float a1 = g - sb[dir * 128 + lane + 64] + sli[dir * 128 + lane + 64];
      const float am = wave_max(fmaxf(a0, a1));
      const float w0 = __expf(a0 - am), w1 = __expf(a1 - am);
      sw[dir * 128 + lane] = w0; sw[dir * 128 + lane + 64] = w1;
      const size_t base = ((size_t)dir * 8 + bh) * LPAD + 128 * n;
      P.wgt[base + lane] = w0; P.wgt[base + lane + 64] = w1;
      P.bcum[base + lane] = sb[dir * 128 + lane]; P.bcum[base + lane + 64] = sb[dir * 128 + lane + 64];
      P.ligate[base + lane] = sli[dir * 128 + lane]; P.ligate[base + lane + 64] = sli[dir * 128 + lane + 64];
      if (lane == 0) { float* ms = P.mstat + ((size_t)(dir * 8 + bh) * NCH + n) * 4; ms[0] = g; ms[1] = am; }
    }
    __syncthreads();
    bf16_t* skT = (bf16_t*)(smem + 32768);
    if (n == 0) { for (int i = tid; i < 128 * MPAD; i += NT) skT[(i / MPAD) * 136 + (i % MPAD)] = 0; }
    const int tid3 = otid();
    const int dg = tid3 & 15, tl = tid3 >> 4;
    float nf[8], nbk[8];
    _Pragma("unroll") for (int j = 0; j < 8; ++j) { nf[j] = 0.f; nbk[j] = 0.f; }
    const int ch = hh * 128 + dg * 8;
    float cw[2][3][8], cb[2][8];
    _Pragma("unroll") for (int j = 0; j < 8; ++j) {
      _Pragma("unroll") for (int ww = 0; ww < 3; ++ww) { cw[0][ww][j] = P.conv_w[((size_t)l * 3 + ww) * 1024 + ch + j]; cw[1][ww][j] = P.conv_w[((size_t)l * 3 + ww) * 1024 + 512 + ch + j]; }
      cb[0][j] = P.conv_b[l * 1024 + ch + j]; cb[1][j] = P.conv_b[l * 1024 + 512 + ch + j];
    }
    _Pragma("unroll 1") for (int hb4 = 0; hb4 < 8; hb4 += 4) {
      u32x4 uq[4][3], uk[4][3];
      _Pragma("unroll") for (int i4 = 0; i4 < 4; ++i4) {
        const int pos = 128 * n + tl + 16 * (hb4 + i4) - MPAD;
        _Pragma("unroll") for (int ww = 0; ww < 3; ++ww) {
          const int pp = min(max(pos + ww - 1, 0), L - 1);
          uq[i4][ww] = *(const u32x4*)(P.cq + (size_t)(b * L + pp) * 512 + ch);
          uk[i4][ww] = *(const u32x4*)(P.ck + (size_t)(b * L + pp) * 512 + ch);
        }
      }
      __builtin_amdgcn_sched_barrier(0);
      _Pragma("unroll") for (int i4 = 0; i4 < 4; ++i4) {
        const int tau = tl + 16 * (hb4 + i4), p = 128 * n + tau, pos = p - MPAD;
        float q[8], k[8];
        _Pragma("unroll") for (int j = 0; j < 8; ++j) { q[j] = cb[0][j]; k[j] = cb[1][j]; }
        _Pragma("unroll") for (int ww = 0; ww < 3; ++ww) {
          const int pp = pos + ww - 1;
          const float vm = (pp >= 0 && pp < L) ? 1.f : 0.f;
          const unsigned aq[4] = {uq[i4][ww].x, uq[i4][ww].y, uq[i4][ww].z, uq[i4][ww].w}, ak[4] = {uk[i4][ww].x, uk[i4][ww].y, uk[i4][ww].z, uk[i4][ww].w};
          _Pragma("unroll") for (int j = 0; j < 4; ++j) {
            q[2 * j] += bflo(aq[j]) * (cw[0][ww][2 * j] * vm); q[2 * j + 1] += bfhi(aq[j]) * (cw[0][ww][2 * j + 1] * vm);
            k[2 * j] += bflo(ak[j]) * (cw[1][ww][2 * j] * vm); k[2 * j + 1] += bfhi(ak[j]) * (cw[1][ww][2 * j + 1] * vm);
          }
        }
        const float wf = sw[tau], wb = sw[128 + tau];
        _Pragma("unroll") for (int j = 0; j < 8; ++j) {
          q[j] = q[j] * sigmoidf_(q[j]);
          k[j] = k[j] * sigmoidf_(k[j]) * 0.08838834764831845f;
          nf[j] += wf * k[j]; nbk[j] += wb * k[j];
        }
        if (pos >= 0) {
          u32x4 oq, ok;
          oq.x = pk2(q[0], q[1]); oq.y = pk2(q[2], q[3]); oq.z = pk2(q[4], q[5]); oq.w = pk2(q[6], q[7]);
          ok.x = pk2(k[0], k[1]); ok.y = pk2(k[2], k[3]); ok.z = pk2(k[4], k[5]); ok.w = pk2(k[6], k[7]);
          *(u32x4*)(P.qc + ((size_t)bh * LPAD + p) * 128 + dg * 8) = oq;
          *(u32x4*)(P.kc + ((size_t)bh * LPAD + p) * 128 + dg * 8) = ok;
          _Pragma("unroll") for (int j = 0; j < 8; ++j) skT[(dg * 8 + j) * 136 + tau] = f2bf(k[j]);
        }
      }
    }
    _Pragma("unroll") for (int j = 0; j < 8; ++j) { sred[tl * 256 + dg * 8 + j] = nf[j]; sred[tl * 256 + 128 + dg * 8 + j] = nbk[j]; }
    __syncthreads();
    {
      const int tid2 = otid();
      const int lane = tid2 & 63, w = tid2 >> 6, wi = w >> 1, wj = w & 1, lr = lane & 31, lh = lane >> 5;
      unsigned vo = (unsigned)((bh * 128 + 64 * wi + lr) * LPAD + 128 * n + 8 * lh);
      asm volatile("" : "+v"(vo));
      _Pragma("unroll 1") for (int dir = 0; dir < 2; ++dir) {
        f32x16 acc[2][2];
        _Pragma("unroll") for (int i = 0; i < 2; ++i) _Pragma("unroll") for (int j = 0; j < 2; ++j) acc[i][j] = zero16();
        unsigned koff = (unsigned)((64 * wj + lr) * 136 + 8 * lh);
        asm volatile("" : "+v"(koff));
        _Pragma("unroll") for (int ks = 0; ks < 8; ++ks) {
          if (n == 0 && ks < 7) continue;
          const int tau = 16 * ks + 8 * lh;
          const f32x4 w0 = *(const f32x4*)(sw + dir * 128 + tau), w1 = *(const f32x4*)(sw + dir * 128 + tau + 4);
          bf16x8 bq[2];
          _Pragma("unroll") for (int i = 0; i < 2; ++i) {
            const u32x4 kr = *(const u32x4*)(skT + koff + (32 * i) * 136 + 16 * ks);
            union { unsigned u[4]; bf16x8 v; } tt;
            tt.u[0] = pk2(bflo(kr.x) * w0.x, bfhi(kr.x) * w0.y); tt.u[1] = pk2(bflo(kr.y) * w0.z, bfhi(kr.y) * w0.w);
            tt.u[2] = pk2(bflo(kr.z) * w1.x, bfhi(kr.z) * w1.y); tt.u[3] = pk2(bflo(kr.w) * w1.z, bfhi(kr.w) * w1.w);
            bq[i] = tt.v;
          }
          bf16x8 af[2];
          _Pragma("unroll") for (int i = 0; i < 2; ++i) af[i] = ldfrag(P.cvT + vo + (unsigned)(32 * i) * LPAD + 16 * ks);
          _Pragma("unroll") for (int i = 0; i < 2; ++i) _Pragma("unroll") for (int j = 0; j < 2; ++j) acc[i][j] = MFMA32(af[i], bq[j], acc[i][j]);
        }
        float* U = P.U + ((size_t)(dir * 8 + bh) * NCH + n) * 16384;
        _Pragma("unroll") for (int i = 0; i < 2; ++i) _Pragma("unroll") for (int j = 0; j < 2; ++j) _Pragma("unroll") for (int r = 0; r < 16; ++r)
          U[(64 * wi + 32 * i + crow(r, lh)) * 128 + 64 * wj + 32 * j + lr] = acc[i][j][r];
      }
    }
    {
      float s = 0.f;
      _Pragma("unroll") for (int i = 0; i < 16; ++i) s += sred[i * 256 + tid];
      const int dir = tid >> 7, dk = tid & 127;
      P.nvec[((size_t)(dir * 8 + bh) * NCH + n) * 128 + dk] = s;
    }
  }
}

DI void phase_mscan(const Params& P, int bid, int nblk) {
  constexpr int SB = 13;
  for (int gt = bid * NT + otid(); gt < 16 * 2048 + 256; gt += nblk * NT) {
    if (gt < 16 * 2048) {
      const int seq = gt >> 11, e = gt & 2047, dir = seq >> 3;
      float C[8];
      _Pragma("unroll") for (int j = 0; j < 8; ++j) C[j] = 0.f;
      float m = 0.f;
      for (int sb = 0; sb < NCH; sb += SB) {
        f32x4 u0[SB], u1[SB]; float gg[SB], aa[SB];
        _Pragma("unroll") for (int k = 0; k < SB; ++k) {
          const int n = dir == 0 ? sb + k : NCH - 1 - sb - k;
          const size_t item = (size_t)seq * NCH + n;
          const float* up = P.U + item * 16384 + e * 8;
          u0[k] = *(const f32x4*)up; u1[k] = *(const f32x4*)(up + 4);
          gg[k] = P.mstat[item * 4]; aa[k] = P.mstat[item * 4 + 1];
        }
        _Pragma("unroll") for (int k = 0; k < SB; ++k) {
          const int n = dir == 0 ? sb + k : NCH - 1 - sb - k;
          const size_t item = (size_t)seq * NCH + n;
          const float mn = fmaxf(gg[k] + m, aa[k]);
          const float decay = __expf(gg[k] + m - mn), f = __expf(aa[k] - mn);
          u32x4 cb; cb.x = pk2(C[0], C[1]); cb.y = pk2(C[2], C[3]); cb.z = pk2(C[4], C[5]); cb.w = pk2(C[6], C[7]);
          *(u32x4*)(P.U + item * 16384 + e * 8) = cb;
          C[0] = decay * C[0] + f * u0[k].x; C[1] = decay * C[1] + f * u0[k].y; C[2] = decay * C[2] + f * u0[k].z; C[3] = decay * C[3] + f * u0[k].w;
          C[4] = decay * C[4] + f * u1[k].x; C[5] = decay * C[5] + f * u1[k].y; C[6] = decay * C[6] + f * u1[k].z; C[7] = decay * C[7] + f * u1[k].w;
          m = mn;
        }
      }
    } else {
      const int q = gt - 16 * 2048, seq = q >> 4, e = q & 15, dir = seq >> 3;
      float nst[8];
      _Pragma("unroll") for (int j = 0; j < 8; ++j) nst[j] = 0.f;
      float m = 0.f;
      for (int sb = 0; sb < NCH; sb += SB) {
        f32x4 n0[SB], n1[SB]; float gg[SB], aa[SB];
        _Pragma("unroll") for (int k = 0; k < SB; ++k) {
          const int n = dir == 0 ? sb + k : NCH - 1 - sb - k;
          const size_t item = (size_t)seq * NCH + n;
          const float* np = P.nvec + item * 128 + e * 8;
          n0[k] = *(const f32x4*)np; n1[k] = *(const f32x4*)(np + 4);
          gg[k] = P.mstat[item * 4]; aa[k] = P.mstat[item * 4 + 1];
        }
        _Pragma("unroll") for (int k = 0; k < SB; ++k) {
          const int n = dir == 0 ? sb + k : NCH - 1 - sb - k;
          const size_t item = (size_t)seq * NCH + n;
          const float mn = fmaxf(gg[k] + m, aa[k]);
          const float decay = __expf(gg[k] + m - mn), f = __expf(aa[k] - mn);
          float* np = P.nvec + item * 128 + e * 8;
          *(f32x4*)np = mk4(nst[0], nst[1], nst[2], nst[3]); *(f32x4*)(np + 4) = mk4(nst[4], nst[5], nst[6], nst[7]);
          nst[0] = decay * nst[0] + f * n0[k].x; nst[1] = decay * nst[1] + f * n0[k].y; nst[2] = decay * nst[2] + f * n0[k].z; nst[3] = decay * nst[3] + f * n0[k].w;
          nst[4] = decay * nst[4] + f * n1[k].x; nst[5] = decay * nst[5] + f * n1[k].y; nst[6] = decay * nst[6] + f * n1[k].z; nst[7] = decay * nst[7] + f * n1[k].w;
          if (e == 0) P.mstat[item * 4 + 2] = m;
          m = mn;
        }
      }
    }
  }
}

DI void mout_item(const Params& P, int l, int it, char* smem) {
  const int tid = otid(), lane = tid & 63, w = tid >> 6, lr = lane & 31, lh = lane >> 5;
  const int bh = it / NCH, n = it % NCH, b = bh >> 2, hh = bh & 3;
  char* sK = smem;
  char* sV = smem + 32768;
  float* sb = (float*)(smem + 65536);
  float* sc = sb + 256;
  float* spm = sc + 256;
  float* snp = spm + 256;
  __syncthreads();
  {
    const int rin = lane >> 4, cpos = lane & 15;
    _Pragma("unroll") for (int i = 0; i < 16; ++i) {
      const int dir = i >> 3, R = (i & 7) * 4 + w, row = 4 * R + rin;
      const char* src = (const char*)(P.U + ((size_t)(dir * 8 + bh) * NCH + n) * 16384) + (size_t)row * 512 + (cpos ^ (row & 15)) * 32;
      __builtin_amdgcn_global_load_lds((const unsigned*)src, (lds_u32*)(smem + dir * 32768 + R * 1024), 16, 0, 0);
    }
  }
  {
    const int dir = tid >> 7, tau = tid & 127;
    const size_t base = ((size_t)dir * 8 + bh) * LPAD + 128 * n + tau;
    const float bb = P.bcum[base], li = P.ligate[base];
    sb[tid] = bb; sc[tid] = li - bb;
    snp[tid] = P.nvec[((size_t)(dir * 8 + bh) * NCH + n) * 128 + tau];
  }
  __syncthreads();
  if (w < 2) {
    const int i0 = w == 0 ? 2 * lane : 127 - 2 * lane, i1 = w == 0 ? 2 * lane + 1 : 126 - 2 * lane;
    const float e0 = sc[w * 128 + i0], e1 = sc[w * 128 + i1];
    const float p1 = fmaxf(e0, e1);
    float scan = p1;
    _Pragma("unroll") for (int d = 1; d < 64; d <<= 1) { const float tt = shfl_up_f(scan, d, lane); if (lane >= d) scan = fmaxf(scan, tt); }
    float excl = shfl_up_f(scan, 1, lane); if (lane == 0) excl = -3.0e38f;
    spm[w * 128 + i0] = fmaxf(excl, e0); spm[w * 128 + i1] = fmaxf(excl, p1);
  }
  __syncthreads();
  const int t = 32 * w + lr, p = 128 * n + t;
  bf16x8 qf[8];
  _Pragma("unroll") for (int ks = 0; ks < 8; ++ks) qf[ks] = ldfrag(P.qc + ((size_t)bh * LPAD + p) * 128 + 16 * ks + 8 * lh);
  f32x16 acc[2][4];
  float btv[2], mtv[2], den0[2];
  _Pragma("unroll") for (int dir = 0; dir < 2; ++dir) {
    const size_t item = (size_t)(dir * 8 + bh) * NCH + n;
    const float mprev = P.mstat[item * 4 + 2];
    const float bt = sb[dir * 128 + t];
    const float mt = bt + fmaxf(mprev, spm[dir * 128 + t]);
    const float inter = __expf(bt + mprev - mt);
    float qn = 0.f;
    _Pragma("unroll") for (int ks = 0; ks < 8; ++ks) {
      union { bf16x8 v; unsigned u[4]; } tt; tt.v = qf[ks];
      const float* np = snp + dir * 128 + 16 * ks + 8 * lh;
      _Pragma("unroll") for (int j = 0; j < 4; ++j) qn += bflo(tt.u[j]) * np[2 * j] + bfhi(tt.u[j]) * np[2 * j + 1];
    }
    qn = xsum32(qn);
    btv[dir] = bt; mtv[dir] = mt; den0[dir] = inter * qn;
    const char* sU = smem + dir * 32768;
    _Pragma("unroll") for (int d = 0; d < 4; ++d) {
      const int urow = 32 * d + lr;
      acc[dir][d] = zero16();
      _Pragma("unroll") for (int ks = 0; ks < 8; ++ks) acc[dir][d] = MFMA32(*(const bf16x8*)(sU + urow * 256 + (((2 * ks + lh) ^ (urow & 15)) << 4)), qf[ks], acc[dir][d]);
      _Pragma("unroll") for (int r = 0; r < 16; ++r) acc[dir][d][r] *= inter;
    }
  }
  __syncthreads();
  {
    const int rin = lane >> 4, cpos = lane & 15;
    _Pragma("unroll") for (int i = 0; i < 16; ++i) {
      const int R = i * 4 + w, row = (i < 8 ? 4 * R : 4 * (R - 32)) + rin;
      const int ce = (cpos ^ (row & 15)) * 8;
      const bf16_t* src = i < 8 ? P.kc + ((size_t)bh * LPAD + 128 * n + row) * 128 + ce : P.cvT + ((size_t)bh * 128 + row) * LPAD + 128 * n + ce;
      __builtin_amdgcn_global_load_lds((const unsigned*)src, (lds_u32*)(smem + R * 1024), 16, 0, 0);
    }
  }
  __syncthreads();
  _Pragma("unroll") for (int dir = 0; dir < 2; ++dir) {
    const float bt = btv[dir], mt = mtv[dir];
    float den = 0.f;
    const int st0 = dir == 0 ? 0 : w, st1 = dir == 0 ? w : 3;
    for (int st = st0; st <= st1; ++st) {
      f32x16 s = zero16();
      _Pragma("unroll") for (int ks = 0; ks < 8; ++ks) {
        const int krow = 32 * st + kswap(lr);
        s = MFMA32(*(const bf16x8*)(sK + krow * 256 + (((2 * ks + lh) ^ (krow & 15)) << 4)), qf[ks], s);
      }
      _Pragma("unroll") for (int r = 0; r < 16; ++r) {
        const int sidx = 32 * st + keyoff(r, lh);
        const bool ok = dir == 0 ? (sidx <= t) : (sidx >= t);
        const float dd = __expf(fminf(bt + sc[dir * 128 + sidx] - mt, 0.f));
        const float pv = ok ? s[r] * dd : 0.f;
        s[r] = pv; den += pv;
      }
      const bf16x8 p0 = packfrag(s, 0), p1 = packfrag(s, 1);
      _Pragma("unroll") for (int d = 0; d < 4; ++d) {
        const int vrow = 32 * d + lr;
        const char* vp = sV + vrow * 256;
        acc[dir][d] = MFMA32(*(const bf16x8*)(vp + (((4 * st + lh) ^ (vrow & 15)) << 4)), p0, acc[dir][d]);
        acc[dir][d] = MFMA32(*(const bf16x8*)(vp + (((4 * st + 2 + lh) ^ (vrow & 15)) << 4)), p1, acc[dir][d]);
      }
    }
    den = xsum32(den);
    den = den0[dir] + den;
    const float sca = frcp(fmaxf(fabsf(den), __expf(-mt)));
    _Pragma("unroll") for (int d = 0; d < 4; ++d) _Pragma("unroll") for (int r = 0; r < 16; ++r) acc[dir][d][r] *= sca;
  }
  float hacc[4][16];
  _Pragma("unroll") for (int d = 0; d < 4; ++d) _Pragma("unroll") for (int r = 0; r < 16; ++r) hacc[d][r] = acc[0][d][r] + acc[1][d][r];
  float s1 = 0.f;
  _Pragma("unroll") for (int d = 0; d < 4; ++d) _Pragma("unroll") for (int r = 0; r < 16; ++r) s1 += hacc[d][r];
  s1 = xsum32(s1);
  const float mu = s1 * (1.f / 128.f);
  float s2 = 0.f;
  _Pragma("unroll") for (int d = 0; d < 4; ++d) _Pragma("unroll") for (int r = 0; r < 16; ++r) { hacc[d][r] -= mu; s2 += hacc[d][r] * hacc[d][r]; }
  s2 = xsum32(s2);
  const float rs = rsqrtf(s2 * (1.f / 128.f) + LN_EPS);
  const int pos = p - MPAD;
  if (pos >= 0) {
    const size_t tok = (size_t)b * L + pos;
    _Pragma("unroll") for (int d = 0; d < 4; ++d) _Pragma("unroll") for (int rg = 0; rg < 4; ++rg) {
      const int dv = 32 * d + 8 * rg + 4 * lh;
      const int col = hh * 128 + dv;
      const u32x2 cu = *(const u32x2*)(P.co + tok * 512 + col);
      const f32x4 g4 = *(const f32x4*)(P.mlstm_g + l * 512 + col);
      const float o0 = hacc[d][4 * rg + 0] * rs * g4.x * sigmoidf_(bflo(cu.x));
      const float o1 = hacc[d][4 * rg + 1] * rs * g4.y * sigmoidf_(bfhi(cu.x));
      const float o2 = hacc[d][4 * rg + 2] * rs * g4.z * sigmoidf_(bflo(cu.y));
      const float o3 = hacc[d][4 * rg + 3] * rs * g4.w * sigmoidf_(bfhi(cu.y));
      u32x2 ou; ou.x = pk2(o0, o1); ou.y = pk2(o2, o3);
      *(u32x2*)(P.oc + tok * 512 + col) = ou;
    }
  }
}

constexpr int DA_STAGE = 32768;
constexpr float DA_THR = 8.f;
DI void dattn_issue(const Params& P, int bh, int k0, char* stage, unsigned vk, unsigned vv, int w) {
  const char* kb0 = (const char*)(P.ka + ((size_t)(bh * 2) * L + k0) * 64);
  const char* vb0 = (const char*)(P.vaT + (size_t)bh * 128 * LK + k0);
  _Pragma("unroll") for (int i = 0; i < 8; ++i) {
    const char* src = i < 4 ? kb0 + (size_t)(i >> 1) * (L * 128) + (i & 1) * 4096 + vk : vb0 + (size_t)(i - 4) * 32 * LK * 2 + vv;
    __builtin_amdgcn_global_load_lds((const unsigned*)src, (lds_u32*)(stage + (i * 4 + w) * 1024), 16, 0, 0);
  }
}
DI void dattn_merge4(f32x16 (&O)[2][4], float (&m)[2], float (&ls)[2], char* smem, int lane, int w) {
  float* xf = (float*)smem;
  for (int src = 1; src < 4; ++src) {
    __syncthreads();
    if (w == src) {
      _Pragma("unroll") for (int c = 0; c < 2; ++c) {
        _Pragma("unroll") for (int d = 0; d < 4; ++d) _Pragma("unroll") for (int r = 0; r < 16; ++r) xf[((c * 4 + d) * 16 + r) * 64 + lane] = O[c][d][r];
        xf[8192 + c * 64 + lane] = m[c]; xf[8192 + 128 + c * 64 + lane] = ls[c];
      }
    }
    __syncthreads();
    if (w == 0) {
      _Pragma("unroll") for (int c = 0; c < 2; ++c) {
        const float mb = xf[8192 + c * 64 + lane], lb = xf[8192 + 128 + c * 64 + lane];
        const float M = fmaxf(m[c], mb), fa = fexp2(m[c] - M), fb = fexp2(mb - M);
        ls[c] = ls[c] * fa + lb * fb; m[c] = M;
        _Pragma("unroll") for (int d = 0; d < 4; ++d) _Pragma("unroll") for (int r = 0; r < 16; ++r) O[c][d][r] = O[c][d][r] * fa + xf[((c * 4 + d) * 16 + r) * 64 + lane] * fb;
      }
    }
  }
}
DI void dattn_finish(const Params& P, int l, int bh, int q0, f32x16 (&O)[2][4], const float (&ls)[2], int lr, int lh) {
  const int b = bh >> 2, hh = bh & 3;
  const float lam = P.lam[l], omli = P.lam[2 + l];
  const float i0 = 1.f / ls[0], i1 = lam / ls[1];
  float ss = 0.f;
  _Pragma("unroll") for (int d = 0; d < 4; ++d) _Pragma("unroll") for (int r = 0; r < 16; ++r) { const float o = O[0][d][r] * i0 - O[1][d][r] * i1; O[0][d][r] = o; ss += o * o; }
  ss = xsum32(ss);
  const float rs = rsqrtf(ss * (1.f / 128.f) + LN_EPS);
  if (q0 + lr < L) {
    const size_t tok = (size_t)b * L + q0 + lr;
    _Pragma("unroll") for (int d = 0; d < 4; ++d) _Pragma("unroll") for (int rg = 0; rg < 4; ++rg) {
      const int dv = 32 * d + 8 * rg + 4 * lh;
      const f32x4 g4 = *(const f32x4*)(P.diff_g + l * 128 + dv);
      u32x2 ou;
      ou.x = pk2(O[0][d][4 * rg + 0] * rs * g4.x * omli, O[0][d][4 * rg + 1] * rs * g4.y * omli);
      ou.y = pk2(O[0][d][4 * rg + 2] * rs * g4.z * omli, O[0][d][4 * rg + 3] * rs * g4.w * omli);
      *(u32x2*)(P.oa + tok * 512 + hh * 128 + dv) = ou;
    }
  }
}
DI void da_softmax(f32x16& s, float& m, float& ls, f32x16 (&O)[4], bool last, int key0, int lh, bf16x8& p0, bf16x8& p1) {
  if (last) {
    asm volatile("; last key tile: mask" ::: "memory");
    _Pragma("unroll") for (int r = 0; r < 16; ++r) if (key0 + keyoff(r, lh) >= L) s[r] = -3.0e38f;
  }
  float mx = s[0];
  _Pragma("unroll") for (int r = 1; r < 16; ++r) mx = fmaxf(mx, s[r]);
  if (__any(mx - m > DA_THR)) {
    asm volatile("; rare: move the softmax reference" ::: "memory");
    const float dlt = fmaxf(xmax32(mx) - m, 0.f);
    const float al = fexp2(-dlt);
    m += dlt; ls *= al;
    _Pragma("unroll") for (int d = 0; d < 4; ++d) _Pragma("unroll") for (int r = 0; r < 16; ++r) O[d][r] *= al;
  }
  f32x2 rs2 = mk2(0.f, 0.f);
  _Pragma("unroll") for (int i = 0; i < 8; ++i) {
    f32x2 x = mk2(s[2 * i], s[2 * i + 1]) - mk2(m, m);
    x.x = fexp2(x.x); x.y = fexp2(x.y);
    s[2 * i] = x.x; s[2 * i + 1] = x.y;
    rs2 += x;
  }
  ls += rs2.x + rs2.y;
  p0 = packfrag(s, 0); p1 = packfrag(s, 1);
}
constexpr int DA_PART = 2 * 4 * 16 * 64 + 256;
DI void dattn_item(const Params& P, int l, int it, bool part, char* smem) {
  const int tid = otid(), lane = tid & 63, w = tid >> 6, lr = lane & 31, lh = lane >> 5;
  const int bh = it & 7, jq = it >> 3;
  const int q0 = part ? 8192 : jq * 128 + 32 * w;
  const int qi = min(q0 + lr, L - 1);
  constexpr int NTILE = (L + 63) / 64;
  const int t0 = part ? 2 * jq : 0, t1 = part ? (jq == 63 ? NTILE : 2 * jq + 2) : NTILE;
  bf16x8 qf[2][4];
  _Pragma("unroll") for (int c = 0; c < 2; ++c) _Pragma("unroll") for (int ks = 0; ks < 4; ++ks)
    qf[c][ks] = ldfrag(P.qa + ((size_t)(bh * 2 + c) * L + qi) * 64 + 16 * ks + 8 * lh);
  f32x16 O[2][4];
  float m[2], ls[2];
  _Pragma("unroll") for (int c = 0; c < 2; ++c) {
    f32x16 s = zero16();
    const bf16_t* kp = P.ka + ((size_t)(bh * 2 + c) * L + t0 * 64 + kswap(lr)) * 64 + 8 * lh;
    _Pragma("unroll") for (int ks = 0; ks < 4; ++ks) s = MFMA32(ldfrag(kp + 16 * ks), qf[c][ks], s);
    float mx = s[0];
    _Pragma("unroll") for (int r = 1; r < 16; ++r) mx = fmaxf(mx, s[r]);
    m[c] = xmax32(mx); ls[c] = 0.f;
    _Pragma("unroll") for (int d = 0; d < 4; ++d) O[c][d] = zero16();
  }
  const unsigned vk = (unsigned)((w * 8 + (lane >> 3)) * 128 + (((lane & 7) ^ (4 * (w & 1) + (lane >> 4))) << 4));
  const unsigned vv = (unsigned)((w * 8 + (lane >> 3)) * (LK * 2) + (((lane & 7) ^ (4 * (w & 1) + (lane >> 4))) << 4));
  __syncthreads();
  dattn_issue(P, bh, t0 * 64, smem + (t0 & 1) * DA_STAGE, vk, vv, w);
  for (int t = t0; t < t1; ++t) {
    __syncthreads();
    if (t + 1 < t1) dattn_issue(P, bh, (t + 1) * 64, smem + ((t + 1) & 1) * DA_STAGE, vk, vv, w);
    const char* st = smem + (t & 1) * DA_STAGE;
    _Pragma("unroll") for (int kb = 0; kb < 2; ++kb) {
      if (part && ((((t - t0) * 2 + kb) & 3) != w)) continue;
      bf16x8 pf[2][2];
      _Pragma("unroll") for (int c = 0; c < 2; ++c) {
        f32x16 s;
        _Pragma("unroll") for (int r = 0; r < 16; ++r) s[r] = -m[c];
        const int krow = kb * 32 + kswap(lr);
        const char* kp = st + c * 8192 + krow * 128;
        _Pragma("unroll") for (int ks = 0; ks < 4; ++ks) s = MFMA32(*(const bf16x8*)(kp + (((2 * ks + lh) ^ swz(krow)) << 4)), qf[c][ks], s);
        if (t == NTILE - 1) {
          _Pragma("unroll") for (int r = 0; r < 16; ++r) if (t * 64 + kb * 32 + keyoff(r, lh) >= L) s[r] = -3.0e38f;
        }
        float mx = s[0];
        _Pragma("unroll") for (int r = 1; r < 16; ++r) mx = fmaxf(mx, s[r]);
        if (__any(mx > DA_THR)) {
          asm volatile("; rare: move the softmax reference" ::: "memory");
          const float dlt = fmaxf(xmax32(mx), 0.f);
          const float al = fexp2(-dlt);
          m[c] += dlt; ls[c] *= al;
          _Pragma("unroll") for (int d = 0; d < 4; ++d) _Pragma("unroll") for (int r = 0; r < 16; ++r) O[c][d][r] *= al;
          _Pragma("unroll") for (int r = 0; r < 16; ++r) s[r] -= dlt;
        }
        float rsum = 0.f;
        _Pragma("unroll") for (int r = 0; r < 16; ++r) { const float pv = fexp2(s[r]); s[r] = pv; rsum += pv; }
        ls[c] += rsum;
        pf[c][0] = packfrag(s, 0); pf[c][1] = packfrag(s, 1);
      }
      _Pragma("unroll") for (int d = 0; d < 4; ++d) {
        const int vrow = 32 * d + lr;
        const char* vp = st + 16384 + vrow * 128;
        const bf16x8 v0 = *(const bf16x8*)(vp + (((kb * 4 + lh) ^ swz(vrow)) << 4));
        const bf16x8 v1 = *(const bf16x8*)(vp + (((kb * 4 + 2 + lh) ^ swz(vrow)) << 4));
        _Pragma("unroll") for (int c = 0; c < 2; ++c) { O[c][d] = MFMA32(v0, pf[c][0], O[c][d]); O[c][d] = MFMA32(v1, pf[c][1], O[c][d]); }
      }
    }
  }
  _Pragma("unroll") for (int c = 0; c < 2; ++c) ls[c] = xsum32(ls[c]);
  if (part) {
    dattn_merge4(O, m, ls, smem, lane, w);
    if (w == 0) {
      float* pb = (float*)P.merged + (size_t)it * DA_PART + lane;
      _Pragma("unroll") for (int c = 0; c < 2; ++c) {
        _Pragma("unroll") for (int d = 0; d < 4; ++d) {
          float* pp = pb + (c * 4 + d) * 1024;
          asm volatile("" : "+v"(pp));
          _Pragma("unroll") for (int r = 0; r < 16; ++r) pp[r * 64] = O[c][d][r];
        }
        pb[8192 + c * 64] = m[c]; pb[8192 + 128 + c * 64] = ls[c];
      }
    }
    return;
  }
  dattn_finish(P, l, bh, q0, O, ls, lr, lh);
}
DI void da_qk(f32x16& s, const char* st, int c, int kb, int lr, int lh, const bf16x8 (&qf)[4]) {
  s = zero16();
  const int krow = kb * 32 + kswap(lr);
  const char* kp = st + c * 8192 + krow * 128;
  _Pragma("unroll") for (int ks = 0; ks < 4; ++ks) s = MFMA32(*(const bf16x8*)(kp + (((2 * ks + lh) ^ swz(krow)) << 4)), qf[ks], s);
}
DI void dattn_item8(const Params& P, int l, int it, char* smem_wg) {
  int tid = rtid(); asm volatile("" : "+v"(tid));
  const int lane = tid & 63, w = __builtin_amdgcn_readfirstlane(tid >> 6), g = w & 3, c = w >> 2, lr = lane & 31, lh = lane >> 5;
  const int bh = it & 7, jq = it >> 3;
  const int q0 = jq * 128 + 32 * g;
  constexpr int NT8 = (L + 127) / 128;
  bf16x8 qf[4];
  _Pragma("unroll") for (int ks = 0; ks < 4; ++ks) qf[ks] = ldfrag(P.qa + ((size_t)(bh * 2 + c) * L + q0 + lr) * 64 + 16 * ks + 8 * lh);
  f32x16 O[4];
  float m, ls = 0.f;
  {
    f32x16 s = zero16();
    const bf16_t* kp = P.ka + ((size_t)(bh * 2 + c) * L + kswap(lr)) * 64 + 8 * lh;
    _Pragma("unroll") for (int ks = 0; ks < 4; ++ks) s = MFMA32(ldfrag(kp + 16 * ks), qf[ks], s);
    float mx = s[0];
    _Pragma("unroll") for (int r = 1; r < 16; ++r) mx = fmaxf(mx, s[r]);
    m = xmax32(mx);
    _Pragma("unroll") for (int d = 0; d < 4; ++d) O[d] = zero16();
  }
  const unsigned vk = (unsigned)((g * 8 + (lane >> 3)) * 128 + (((lane & 7) ^ (4 * (g & 1) + (lane >> 4))) << 4));
  const unsigned vv = (unsigned)((g * 8 + (lane >> 3)) * (LK * 2) + (((lane & 7) ^ (4 * (g & 1) + (lane >> 4))) << 4));
  constexpr int ST8 = 2 * DA_STAGE;
  __syncthreads();
  dattn_issue(P, bh, c * 64, smem_wg + c * DA_STAGE, vk, vv, g);
  for (int t = 0; t < NT8; ++t) {
    __syncthreads();
    if (t + 1 < NT8) dattn_issue(P, bh, (t + 1) * 128 + c * 64, smem_wg + ((t + 1) & 1) * ST8 + c * DA_STAGE, vk, vv, g);
    const char* stt = smem_wg + (t & 1) * ST8;
    f32x16 S[4];
    _Pragma("unroll") for (int b = 0; b < 4; ++b) da_qk(S[b], stt + (b >> 1) * DA_STAGE, c, b & 1, lr, lh, qf);
    if (t == NT8 - 1) {
      asm volatile("; last key tile: mask" ::: "memory");
      _Pragma("unroll") for (int b = 0; b < 4; ++b) _Pragma("unroll") for (int r = 0; r < 16; ++r) if (t * 128 + b * 32 + keyoff(r, lh) >= L) S[b][r] = -3.0e38f;
    }
    float mx = S[0][0];
    _Pragma("unroll") for (int b = 0; b < 4; ++b) _Pragma("unroll") for (int r = 0; r < 16; ++r) mx = fmaxf(mx, S[b][r]);
    if (__any(mx - m > DA_THR)) {
      asm volatile("; rare: move the softmax reference" ::: "memory");
      const float dlt = fmaxf(xmax32(mx) - m, 0.f);
      const float al = fexp2(-dlt);
      m += dlt; ls *= al;
      _Pragma("unroll") for (int d = 0; d < 4; ++d) _Pragma("unroll") for (int r = 0; r < 16; ++r) O[d][r] *= al;
    }
    f32x2 rs2 = mk2(0.f, 0.f);
    const f32x2 mm = mk2(m, m);
    _Pragma("unroll") for (int h2 = 0; h2 < 2; ++h2) {
      bf16x8 pf[2][2];
      _Pragma("unroll") for (int kb = 0; kb < 2; ++kb) {
        f32x16& s = S[2 * h2 + kb];
        _Pragma("unroll") for (int i = 0; i < 8; ++i) {
          f32x2 x = mk2(s[2 * i], s[2 * i + 1]) - mm;
          x.x = fexp2(x.x); x.y = fexp2(x.y);
          s[2 * i] = x.x; s[2 * i + 1] = x.y;
          rs2 += x;
        }
        pf[kb][0] = packfrag(s, 0); pf[kb][1] = packfrag(s, 1);
      }
      const char* st = stt + h2 * DA_STAGE;
      _Pragma("unroll") for (int kb = 0; kb < 2; ++kb) _Pragma("unroll") for (int d = 0; d < 4; ++d) {
        const int vrow = 32 * d + lr;
        const char* vp = st + 16384 + vrow * 128;
        const bf16x8 v0 = *(const bf16x8*)(vp + (((kb * 4 + lh) ^ swz(vrow)) << 4));
        const bf16x8 v1 = *(const bf16x8*)(vp + (((kb * 4 + 2 + lh) ^ swz(vrow)) << 4));
        O[d] = MFMA32(v0, pf[kb][0], O[d]); O[d] = MFMA32(v1, pf[kb][1], O[d]);
      }
    }
    ls += rs2.x + rs2.y;
  }
  ls = xsum32(ls);
  float* xf = (float*)smem_wg + g * 4096;
  __syncthreads();
  if (c == 1) {
    const float i1 = P.lam[l] / ls;
    _Pragma("unroll") for (int d = 0; d < 4; ++d) _Pragma("unroll") for (int r = 0; r < 16; ++r) xf[(d * 16 + r) * 64 + lane] = O[d][r] * i1;
  }
  __syncthreads();
  if (c == 0) {
    const int b = bh >> 2, hh = bh & 3;
    const float omli = P.lam[2 + l], i0 = 1.f / ls;
    float ss = 0.f;
    _Pragma("unroll") for (int d = 0; d < 4; ++d) _Pragma("unroll") for (int r = 0; r < 16; ++r) { const float o = O[d][r] * i0 - xf[(d * 16 + r) * 64 + lane]; O[d][r] = o; ss += o * o; }
    ss = xsum32(ss);
    const float rs = rsqrtf(ss * (1.f / 128.f) + LN_EPS);
    const size_t tok = (size_t)b * L + q0 + lr;
    _Pragma("unroll") for (int d = 0; d < 4; ++d) _Pragma("unroll") for (int rg = 0; rg < 4; ++rg) {
      const int dv = 32 * d + 8 * rg + 4 * lh;
      const f32x4 g4 = *(const f32x4*)(P.diff_g + l * 128 + dv);
      u32x2 ou;
      ou.x = pk2(O[d][4 * rg + 0] * rs * g4.x * omli, O[d][4 * rg + 1] * rs * g4.y * omli);
      ou.y = pk2(O[d][4 * rg + 2] * rs * g4.z * omli, O[d][4 * rg + 3] * rs * g4.w * omli);
      *(u32x2*)(P.oa + tok * 512 + hh * 128 + dv) = ou;
    }
  }
}
DI void dattn_item16(const Params& P, int l, int it, char* smem_wg) {
  int tid = rtid(); asm volatile("" : "+v"(tid));
  const int lane = tid & 63, w = __builtin_amdgcn_readfirstlane(tid >> 6), w4 = w & 3, ih = w >> 2, lr = lane & 31, lh = lane >> 5;
  const int bh = it & 7, jq = it >> 3;
  const int q0 = jq * 256 + 32 * w;
  constexpr int NTILE = (L + 63) / 64;
  bf16x8 qf[2][4];
  _Pragma("unroll") for (int c = 0; c < 2; ++c) _Pragma("unroll") for (int ks = 0; ks < 4; ++ks)
    qf[c][ks] = ldfrag(P.qa + ((size_t)(bh * 2 + c) * L + q0 + lr) * 64 + 16 * ks + 8 * lh);
  f32x16 O[2][4];
  float m[2], ls[2];
  _Pragma("unroll") for (int c = 0; c < 2; ++c) {
    f32x16 s = zero16();
    const bf16_t* kp = P.ka + ((size_t)(bh * 2 + c) * L + kswap(lr)) * 64 + 8 * lh;
    _Pragma("unroll") for (int ks = 0; ks < 4; ++ks) s = MFMA32(ldfrag(kp + 16 * ks), qf[c][ks], s);
    float mx = s[0];
    _Pragma("unroll") for (int r = 1; r < 16; ++r) mx = fmaxf(mx, s[r]);
    m[c] = xmax32(mx); ls[c] = 0.f;
    _Pragma("unroll") for (int d = 0; d < 4; ++d) O[c][d] = zero16();
  }
  const unsigned sw16 = (unsigned)(((lane & 7) ^ (4 * (w4 & 1) + (lane >> 4))) << 4);
  const char* gsrc = ih == 0 ? (const char*)(P.ka + (size_t)(bh * 2) * L * 64) + (size_t)(w4 * 8 + (lane >> 3)) * 128 + sw16
                             : (const char*)(P.vaT + (size_t)bh * 128 * LK) + (size_t)(w4 * 8 + (lane >> 3)) * (LK * 2) + sw16;
#define DA16_ISSUE(t_, st_) _Pragma("unroll") for (int i_ = 0; i_ < 4; ++i_) { \
    const char* src_ = ih == 0 ? gsrc + (size_t)(t_) * (64 * 128) + (size_t)(i_ >> 1) * (L * 128) + (i_ & 1) * 4096 : gsrc + (size_t)(t_) * 128 + (size_t)i_ * 32 * LK * 2; \
    __builtin_amdgcn_global_load_lds((const unsigned*)src_, (lds_u32*)(smem_wg + (st_) * DA_STAGE + ((ih * 4 + i_) * 4 + w4) * 1024), 16, 0, 0); }
  __syncthreads();
  DA16_ISSUE(0, 0)
  for (int t = 0; t < NTILE; ++t) {
    __syncthreads();
    if (t + 1 < NTILE) { DA16_ISSUE(t + 1, (t + 1) & 1) }
    const char* st = smem_wg + (t & 1) * DA_STAGE;
    _Pragma("unroll") for (int kb = 0; kb < 2; ++kb) {
      bf16x8 pf[2][2];
      _Pragma("unroll") for (int c = 0; c < 2; ++c) {
        f32x16 s;
        _Pragma("unroll") for (int r = 0; r < 16; ++r) s[r] = -m[c];
        const int krow = kb * 32 + kswap(lr);
        const char* kp = st + c * 8192 + krow * 128;
        _Pragma("unroll") for (int ks = 0; ks < 4; ++ks) s = MFMA32(*(const bf16x8*)(kp + (((2 * ks + lh) ^ swz(krow)) << 4)), qf[c][ks], s);
        if (t == NTILE - 1) {
          _Pragma("unroll") for (int r = 0; r < 16; ++r) if (t * 64 + kb * 32 + keyoff(r, lh) >= L) s[r] = -3.0e38f;
        }
        float mx = s[0];
        _Pragma("unroll") for (int r = 1; r < 16; ++r) mx = fmaxf(mx, s[r]);
        if (__any(mx > DA_THR)) {
          asm volatile("; rare: move the softmax reference" ::: "memory");
          const float dlt = fmaxf(xmax32(mx), 0.f);
          const float al = fexp2(-dlt);
          m[c] += dlt; ls[c] *= al;
          _Pragma("unroll") for (int d = 0; d < 4; ++d) _Pragma("unroll") for (int r = 0; r < 16; ++r) O[c][d][r] *= al;
          _Pragma("unroll") for (int r = 0; r < 16; ++r) s[r] -= dlt;
        }
        float rsum = 0.f;
        _Pragma("unroll") for (int r = 0; r < 16; ++r) { const float pv = fexp2(s[r]); s[r] = pv; rsum += pv; }
        ls[c] += rsum;
        pf[c][0] = packfrag(s, 0); pf[c][1] = packfrag(s, 1);
      }
      _Pragma("unroll") for (int d = 0; d < 4; ++d) {
        const int vrow = 32 * d + lr;
        const char* vp = st + 16384 + vrow * 128;
        const bf16x8 v0 = *(const bf16x8*)(vp + (((kb * 4 + lh) ^ swz(vrow)) << 4));
        const bf16x8 v1 = *(const bf16x8*)(vp + (((kb * 4 + 2 + lh) ^ swz(vrow)) << 4));
        _Pragma("unroll") for (int c = 0; c < 2; ++c) { O[c][d] = MFMA32(v0, pf[c][0], O[c][d]); O[c][d] = MFMA32(v1, pf[c][1], O[c][d]); }
      }
    }
  }
#undef DA16_ISSUE
  _Pragma("unroll") for (int c = 0; c < 2; ++c) ls[c] = xsum32(ls[c]);
  dattn_finish(P, l, bh, q0, O, ls, lr, lh);
}
DI void dattn_combine(const Params& P, int l, int bh, char* smem) {
  const int tid = otid(), lane = tid & 63, w = tid >> 6, lr = lane & 31, lh = lane >> 5;
  f32x16 O[2][4];
  float m[2], ls[2];
  __syncthreads();
  for (int k = 0; k < 16; ++k) {
    const float* pb = (const float*)P.merged + (size_t)(bh + 8 * (w * 16 + k)) * DA_PART + lane;
    _Pragma("unroll") for (int c = 0; c < 2; ++c) {
      const float mb = pb[8192 + c * 64], lb = pb[8192 + 128 + c * 64];
      float fa, fb;
      if (k == 0) { m[c] = mb; ls[c] = lb; fa = 0.f; fb = 1.f; }
      else { const float M = fmaxf(m[c], mb); fa = fexp2(m[c] - M); fb = fexp2(mb - M); ls[c] = ls[c] * fa + lb * fb; m[c] = M; }
      _Pragma("unroll") for (int d = 0; d < 4; ++d) {
        const float* pp = pb + (c * 4 + d) * 1024;
        asm volatile("" : "+v"(pp));
        _Pragma("unroll") for (int r = 0; r < 16; ++r) {
          const float ov = pp[r * 64];
          O[c][d][r] = k == 0 ? ov : O[c][d][r] * fa + ov * fb;
        }
      }
    }
  }
  dattn_merge4(O, m, ls, smem, lane, w);
  if (w == 0) dattn_finish(P, l, bh, 8192, O, ls, lr, lh);
}

DI void swa_item(const Params& P, int l, int it, char* smem) {
  const int tid = otid(), lane = tid & 63, w = tid >> 6, lr = lane & 31, lh = lane >> 5;
  const int NQT = (L + 31) / 32;
  const int bk = it / NQT, qt = it % NQT, b = bk >> 1, kv = bk & 1, hq = kv * 4 + w;
  const int q0 = qt * 32;
  const int qi = min(q0 + lr, L - 1);
  bf16x8 qf[4];
  _Pragma("unroll") for (int ks = 0; ks < 4; ++ks) qf[ks] = ldfrag(P.qb + ((size_t)(b * 8 + hq) * L + qi) * 64 + 16 * ks + 8 * lh);
  f32x16 O[2]; O[0] = zero16(); O[1] = zero16();
  float m = P.sink[l * 8 + hq] * 1.44269504088896341f, ls = 1.f;
  const bf16_t* kbase = P.kb + (size_t)(b * 2 + kv) * L * 64;
  const bf16_t* vbase = P.vbT + (size_t)(b * 2 + kv) * 64 * LK;
  const int qpos = q0 + lr;
  char* sK = smem;
  char* sV = smem + 5 * 4096;
  bf16x8 ta[5], tb[5];
#define SWA_LOAD(ph_) _Pragma("unroll") for (int i = 0; i < 5; ++i) { \
    { const int rr_ = 40 * w + 8 * i + (lane >> 3), bb_ = rr_ >> 5, bi_ = 5 * (ph_) + bb_; const int k1_ = bi_ == 0 ? 0 : q0 - 160 + 32 * bi_; \
      const int krow_ = min(max(k1_ + (rr_ & 31), 0), L - 1); ta[i] = ldfrag(kbase + (size_t)krow_ * 64 + (lane & 7) * 8); } \
    { const int j_ = 5 * w + i, bb_ = j_ >> 2, bi_ = 5 * (ph_) + bb_; const int k0_ = bi_ == 0 ? 0 : q0 - 160 + 32 * bi_; const int kc0_ = min(max(k0_, 0), LK - 32); \
      tb[i] = ldfrag(vbase + (size_t)(16 * (j_ & 3) + (lane >> 2)) * LK + kc0_ + (lane & 3) * 8); } }
#define SWA_STORE() _Pragma("unroll") for (int i = 0; i < 5; ++i) { \
    { const int rr_ = 40 * w + 8 * i + (lane >> 3), bb_ = rr_ >> 5, r_ = rr_ & 31; *(bf16x8*)(sK + bb_ * 4096 + r_ * 128 + (((lane & 7) ^ swz(r_)) << 4)) = ta[i]; } \
    { const int j_ = 5 * w + i, bb_ = j_ >> 2, rv_ = 16 * (j_ & 3) + (lane >> 2); *(bf16x8*)(sV + bb_ * 4096 + rv_ * 64 + (((lane & 3) ^ ((rv_ >> 2) & 3)) << 4)) = tb[i]; } }
  SWA_LOAD(0)
  __syncthreads();
  SWA_STORE()
  __syncthreads();
  SWA_LOAD(1)
  __builtin_amdgcn_sched_barrier(0);
  _Pragma("unroll") for (int ph = 0; ph < 2; ++ph) {
    if (ph == 1) { __syncthreads(); SWA_STORE() __syncthreads(); }
    _Pragma("unroll") for (int bb = 0; bb < 5; ++bb) {
      const int bi = 5 * ph + bb;
      const int k0 = bi == 0 ? 0 : q0 - 160 + 32 * bi;
      f32x16 s = zero16();
      {
        const int krow = kswap(lr);
        _Pragma("unroll") for (int ks = 0; ks < 4; ++ks) s = MFMA32(*(const bf16x8*)(sK + bb * 4096 + krow * 128 + (((2 * ks + lh) ^ swz(krow)) << 4)), qf[ks], s);
      }
      float mx = -3.0e38f;
      _Pragma("unroll") for (int r = 0; r < 16; ++r) {
        const int kj = k0 + keyoff(r, lh);
        bool ok;
        if (bi == 0) ok = kj < NMETA;
        else ok = kj >= NMETA && kj < L && kj >= qpos - 128 && kj <= qpos + 128;
        const float v = ok ? s[r] : -3.0e38f;
        s[r] = v; mx = fmaxf(mx, v);
      }
      mx = xmax32(mx);
      const float mn = fmaxf(m, mx);
      const float al = fexp2(m - mn);
      float rsum = 0.f;
      _Pragma("unroll") for (int r = 0; r < 16; ++r) { const float pv = fexp2(s[r] - mn); s[r] = pv; rsum += pv; }
      rsum = xsum32(rsum);
      ls = ls * al + rsum; m = mn;
      _Pragma("unroll") for (int d = 0; d < 2; ++d) _Pragma("unroll") for (int r = 0; r < 16; ++r) O[d][r] *= al;
      const bf16x8 p0 = packfrag(s, 0), p1 = packfrag(s, 1);
      _Pragma("unroll") for (int d = 0; d < 2; ++d) {
        const int vrow = 32 * d + lr;
        const char* vp = sV + bb * 4096 + vrow * 64;
        const int sx = (vrow >> 2) & 3;
        O[d] = MFMA32(*(const bf16x8*)(vp + ((lh ^ sx) << 4)), p0, O[d]);
        O[d] = MFMA32(*(const bf16x8*)(vp + (((2 + lh) ^ sx) << 4)), p1, O[d]);
      }
    }
  }
#undef SWA_LOAD
#undef SWA_STORE
  if (qpos < L) {
    const float inv = 1.f / ls;
    const size_t tok = (size_t)b * L + qpos;
    _Pragma("unroll") for (int d = 0; d < 2; ++d) _Pragma("unroll") for (int rg = 0; rg < 4; ++rg) {
      const int dv = 32 * d + 8 * rg + 4 * lh;
      u32x2 ou;
      ou.x = pk2(O[d][4 * rg + 0] * inv, O[d][4 * rg + 1] * inv);
      ou.y = pk2(O[d][4 * rg + 2] * inv, O[d][4 * rg + 3] * inv);
      *(u32x2*)(P.ob + tok * 512 + hq * 64 + dv) = ou;
    }
  }
}

constexpr int P3_MT = TP / 128, P3_NT = D / 128;
DI void tail_reduce(const f32x16& acc, char* smem_wg, int w, int lane, float (&v)[2]) {
  float* red = (float*)smem_wg;
  __syncthreads();
  _Pragma("unroll") for (int r = 0; r < 16; ++r) red[(w * 16 + r) * 64 + lane] = acc[r];
  __syncthreads();
  _Pragma("unroll") for (int j = 0; j < 2; ++j) {
    float s = 0.f;
    _Pragma("unroll") for (int x = 0; x < 8; ++x) s += red[(x * 16 + 2 * w + j) * 64 + lane];
    v[j] = s;
  }
  __syncthreads();
}
DI void p3a_tail(const Params& P, char* smem_wg, int wg) {
  int tid = rtid(); asm volatile("" : "+v"(tid));
  const int lane = tid & 63, w = tid >> 6, lr = lane & 31, lh = lane >> 5;
  const int n0 = 32 * wg, k0 = 64 * w + 8 * lh;
  f32x16 tot = zero16();
  _Pragma("unroll 1") for (int br = 0; br < 3; ++br) {
    const bf16_t* A = P.oa + ((size_t)br * TP + 16384 + lr) * 512 + k0;
    const bf16_t* B = P.w_br_t + ((size_t)br * 1024 + n0 + lr) * 512 + k0;
    f32x16 part = zero16();
    _Pragma("unroll") for (int ks = 0; ks < 4; ++ks) part = MFMA32(ldfrag(A + 16 * ks), ldfrag(B + 16 * ks), part);
    _Pragma("unroll") for (int r = 0; r < 16; ++r) tot[r] += bf2f(P.gz[(size_t)(16384 + crow(r, lh)) * 3072 + br * 1024 + n0 + lr]) * part[r];
  }
  float v[2];
  tail_reduce(tot, smem_wg, w, lane, v);
  _Pragma("unroll") for (int j = 0; j < 2; ++j) P.merged[(size_t)(16384 + crow(2 * w + j, lh)) * D + n0 + lr] = f2bf(v[j]);
}
DI void p3b_tail(const Params& P, char* smem_wg, int wg) {
  int tid = rtid(); asm volatile("" : "+v"(tid));
  const int lane = tid & 63, w = tid >> 6, lr = lane & 31, lh = lane >> 5;
  const int n0 = 32 * wg, k0 = 128 * w + 8 * lh;
  const bf16_t* A = P.merged + (size_t)(16384 + lr) * D + k0;
  const bf16_t* B = P.w_out_t + (size_t)(n0 + lr) * D + k0;
  f32x16 acc = zero16();
  _Pragma("unroll") for (int ks = 0; ks < 8; ++ks) acc = MFMA32(ldfrag(A + 16 * ks), ldfrag(B + 16 * ks), acc);
  float v[2];
  tail_reduce(acc, smem_wg, w, lane, v);
  _Pragma("unroll") for (int j = 0; j < 2; ++j) { float* hp = P.h + (size_t)(16384 + crow(2 * w + j, lh)) * D + n0 + lr; *hp = ALPHA * (*hp) + v[j]; }
}
struct SchedP3a {
  static constexpr bool GATHER = false;
  const char* A; const char* B; int G, c;
  DI bool next(int i, g8::Unit& u) const {
    const int ti = i / 3, br = i - 3 * ti; int pm, pn;
    if (!g8::grid_unit(ti, G, c, 64, 4, pm, pn)) return false;
    u.pm = pm; u.pn = pn; u.tag = br;
    u.a = A + ((size_t)br * TP + (size_t)pm * 256) * 512 * 2; u.b = B + ((size_t)br * 1024 + (size_t)pn * 256) * 512 * 2; return true;
  }
  DI void arows(const g8::Unit&, int, unsigned (&)[2]) const {}
};
struct EpiP3a {
  static constexpr bool PERM = true;
  const bf16_t* gz; bf16_t* merged;
  DI bool keep(const g8::Unit& u) const { return u.tag < 2; }
  DI void operator()(g8::f32x4 (&acc)[2][2][4][2], const g8::Unit& u, int wr, int wc, int fr, int fq) const {
    const int br = u.tag;
    const bf16_t* g0 = gz + (size_t)(u.pm * 256 + 64 * wr + fr) * 3072 + br * 1024 + u.pn * 256 + 32 * wc + 8 * fq;
    _Pragma("unroll") for (int ai = 0; ai < 2; ++ai) {
      u32x4 ga[4][2], gb[4][2];
      _Pragma("unroll") for (int m = 0; m < 4; ++m) _Pragma("unroll") for (int bj = 0; bj < 2; ++bj) ga[m][bj] = *(const u32x4*)(g0 + (size_t)(128 * ai + 16 * m) * 3072 + 128 * bj);
      if (br < 2) {
        _Pragma("unroll") for (int m = 0; m < 4; ++m) _Pragma("unroll") for (int bj = 0; bj < 2; ++bj) gb[m][bj] = *(const u32x4*)(g0 + (size_t)(128 * ai + 16 * m) * 3072 + 128 * bj + 1024);
        __builtin_amdgcn_sched_barrier(0);
        _Pragma("unroll") for (int m = 0; m < 4; ++m) _Pragma("unroll") for (int bj = 0; bj < 2; ++bj) {
          const u32x4 a = ga[m][bj], b = gb[m][bj];
          acc[ai][bj][m][0][0] *= bflo(a.x) * frcp(bflo(b.x)); acc[ai][bj][m][0][1] *= bfhi(a.x) * frcp(bfhi(b.x));
          acc[ai][bj][m][0][2] *= bflo(a.y) * frcp(bflo(b.y)); acc[ai][bj][m][0][3] *= bfhi(a.y) * frcp(bfhi(b.y));
          acc[ai][bj][m][1][0] *= bflo(a.z) * frcp(bflo(b.z)); acc[ai][bj][m][1][1] *= bfhi(a.z) * frcp(bfhi(b.z));
          acc[ai][bj][m][1][2] *= bflo(a.w) * frcp(bflo(b.w)); acc[ai][bj][m][1][3] *= bfhi(a.w) * frcp(bfhi(b.w));
        }
      } else {
        __builtin_amdgcn_sched_barrier(0);
        _Pragma("unroll") for (int m = 0; m < 4; ++m) _Pragma("unroll") for (int bj = 0; bj < 2; ++bj) {
          const u32x4 a = ga[m][bj];
          u32x4 o;
          o.x = pk2(acc[ai][bj][m][0][0] * bflo(a.x), acc[ai][bj][m][0][1] * bfhi(a.x)); o.y = pk2(acc[ai][bj][m][0][2] * bflo(a.y), acc[ai][bj][m][0][3] * bfhi(a.y));
          o.z = pk2(acc[ai][bj][m][1][0] * bflo(a.z), acc[ai][bj][m][1][1] * bfhi(a.z)); o.w = pk2(acc[ai][bj][m][1][2] * bflo(a.w), acc[ai][bj][m][1][3] * bfhi(a.w));
          *(u32x4*)(merged + (size_t)(u.pm * 256 + 128 * ai + 64 * wr + 16 * m + fr) * D + u.pn * 256 + 128 * bj + 32 * wc + 8 * fq) = o;
        }
      }
      __builtin_amdgcn_sched_barrier(0);
    }
  }
};
DI void phase_p3a(const Params& P, int l, char* smem, char* smem_wg, int bid, int nblk) {
  if ((bid >> 1) < 32) p3a_tail(P, smem_wg, bid >> 1);
  {
    SchedP3a S; S.A = (const char*)P.oa; S.B = (const char*)P.w_br_t; S.G = nblk >> 1; S.c = bid >> 1;
    EpiP3a E; E.gz = P.gz; E.merged = P.merged;
    g8::gemm_phase((g8::lds_u8*)smem_wg, 512, S, E);
  }
}
struct SchedP3b {
  static constexpr bool GATHER = false;
  const char* A; const char* B; int G, c;
  DI bool next(int i, g8::Unit& u) const { int pm, pn; if (!g8::grid_unit(i, G, c, 64, 4, pm, pn)) return false; u.pm = pm; u.pn = pn; u.tag = 0; u.a = A + (size_t)pm * 256 * D * 2; u.b = B + (size_t)pn * 256 * D * 2; return true; }
  DI void arows(const g8::Unit&, int, unsigned (&)[2]) const {}
};
struct EpiP3b {
  static constexpr bool PERM = false;
  float* h;
  DI bool keep(const g8::Unit&) const { return false; }
  DI void operator()(g8::f32x4 (&acc)[2][2][4][2], const g8::Unit& u, int wr, int wc, int fr, int fq) const {
    float* h0 = h + (size_t)(u.pm * 256 + 64 * wr + fr) * D + u.pn * 256 + 32 * wc + 4 * fq;
    _Pragma("unroll") for (int ai = 0; ai < 2; ++ai) {
      g8::f32x4 hv[4][2][2];
      _Pragma("unroll") for (int m = 0; m < 4; ++m) _Pragma("unroll") for (int bj = 0; bj < 2; ++bj) _Pragma("unroll") for (int n = 0; n < 2; ++n)
        hv[m][bj][n] = *(const g8::f32x4*)(h0 + (size_t)(128 * ai + 16 * m) * D + 128 * bj + 16 * n);
      __builtin_amdgcn_sched_barrier(0);
      _Pragma("unroll") for (int m = 0; m < 4; ++m) _Pragma("unroll") for (int bj = 0; bj < 2; ++bj) _Pragma("unroll") for (int n = 0; n < 2; ++n)
        *(g8::f32x4*)(h0 + (size_t)(128 * ai + 16 * m) * D + 128 * bj + 16 * n) = ALPHA * hv[m][bj][n] + acc[ai][bj][m][n];
      __builtin_amdgcn_sched_barrier(0);
    }
  }
};
DI void phase_p3b(const Params& P, int l, char* smem, char* smem_wg, int bid, int nblk) {
  if ((bid >> 1) < 32) p3b_tail(P, smem_wg, bid >> 1);
  {
    SchedP3b S; S.A = (const char*)P.merged; S.B = (const char*)P.w_out_t; S.G = nblk >> 1; S.c = bid >> 1;
    EpiP3b E; E.h = P.h;
    g8::gemm_phase(( g8::lds_u8*)smem_wg, D, S, E);
  }
}

typedef __attribute__((ext_vector_type(4))) float f32x4v;
DI void phase_router_prep(const Params& P, int bid, int nblk) {
  const int gtid = bid * NT + otid(), gn = nblk * NT;
  for (int i = gtid; i < 2 * 64 * 3 * 64 * 4; i += gn) {
    const int sidx = i & 3, lane = (i >> 2) & 63, n = (i >> 8) % 3, chunk = ((i >> 8) / 3) & 63, l = (i >> 8) / 192;
    const int c = 16 * chunk + 4 * (lane >> 4) + sidx, j = lane & 15;
    float wv = 0.f;
    if (n < 2) wv = P.w_re[((size_t)l * D + c) * 32 + 16 * n + j];
    else if (j < 4) wv = P.w_rg[((size_t)l * D + c) * 4 + j];
    P.rwp[i] = wv * P.ln1_g[l * D + c];
  }
  const int wv_ = gtid >> 6, lane = gtid & 63;
  if (wv_ < 2 * 36) {
    const int l = wv_ / 36, o = wv_ % 36;
    float sg = 0.f, sb = 0.f;
    for (int c = lane; c < D; c += 64) {
      const float wv = o < 32 ? P.w_re[((size_t)l * D + c) * 32 + o] : P.w_rg[((size_t)l * D + c) * 4 + o - 32];
      sg += P.ln1_g[l * D + c] * wv; sb += P.ln1_b[l * D + c] * wv;
    }
    sg = wave_sum(sg); sb = wave_sum(sb);
    if (lane == 0) { P.rgb[(l * 2 + 0) * 48 + o] = sg; P.rgb[(l * 2 + 1) * 48 + o] = sb + (o < 32 ? P.b_re[l * 32 + o] : P.b_rg[l * 4 + o - 32]); }
  }
}
DI void phase_p4(const Params& P, int l, char* smem, int bid, int nblk) {
  const int tid = otid(), lane = tid & 63, w = tid >> 6, wv = (bid * NT + tid) >> 6, nwv = (nblk * NT) >> 6;
  float* raw = (float*)smem + w * 768;
  const f32x4* wp = (const f32x4*)P.rwp + (size_t)l * 64 * 3 * 64 + lane;
  const int nrb = min(nblk, (T / 16 + 3) / 4), nwr = nrb * 4;
  for (int wt = bid < nrb ? bid * 4 + w : T / 16; wt < T / 16; wt += nwr) {
    const int t0 = wt * 16;
    f32x4v acc[3];
    _Pragma("unroll") for (int n = 0; n < 3; ++n) { acc[n][0] = 0.f; acc[n][1] = 0.f; acc[n][2] = 0.f; acc[n][3] = 0.f; }
    const float* xa = P.h + (size_t)(t0 + (lane & 15)) * D + 4 * (lane >> 4);
    f32x4 A0[4], B0[4][3], A1[4], B1[4][3];
    float s1 = 0.f, s2 = 0.f;
#define P4_LOAD(Ab, Bb, c0) _Pragma("unroll") for (int u = 0; u < 4; ++u) { Ab[u] = *(const f32x4*)(xa + 16 * ((c0) + u)); \
      _Pragma("unroll") for (int n = 0; n < 3; ++n) Bb[u][n] = wp[(((c0) + u) * 3 + n) * 64]; }
#define P4_MMA(Ab, Bb) _Pragma("unroll") for (int u = 0; u < 4; ++u) { const f32x4 a = Ab[u]; \
      s1 += (a.x + a.y) + (a.z + a.w); s2 += (a.x * a.x + a.y * a.y) + (a.z * a.z + a.w * a.w); \
      _Pragma("unroll") for (int n = 0; n < 3; ++n) acc[n] = __builtin_amdgcn_mfma_f32_16x16x4f32(a.x, Bb[u][n].x, acc[n], 0, 0, 0); \
      _Pragma("unroll") for (int n = 0; n < 3; ++n) acc[n] = __builtin_amdgcn_mfma_f32_16x16x4f32(a.y, Bb[u][n].y, acc[n], 0, 0, 0); \
      _Pragma("unroll") for (int n = 0; n < 3; ++n) acc[n] = __builtin_amdgcn_mfma_f32_16x16x4f32(a.z, Bb[u][n].z, acc[n], 0, 0, 0); \
      _Pragma("unroll") for (int n = 0; n < 3; ++n) acc[n] = __builtin_amdgcn_mfma_f32_16x16x4f32(a.w, Bb[u][n].w, acc[n], 0, 0, 0); }
    P4_LOAD(A0, B0, 0)
    _Pragma("unroll 1") for (int ch = 0; ch < 64; ch += 8) {
      P4_LOAD(A1, B1, ch + 4)
      __builtin_amdgcn_sched_barrier(0);
      P4_MMA(A0, B0)
      __builtin_amdgcn_sched_barrier(0);
      if (ch + 8 < 64) { P4_LOAD(A0, B0, ch + 8) }
      __builtin_amdgcn_sched_barrier(0);
      P4_MMA(A1, B1)
      __builtin_amdgcn_sched_barrier(0);
    }
#undef P4_LOAD
#undef P4_MMA
    s1 += sxor<16>(s1); s2 += sxor<16>(s2); s1 = xsum32(s1); s2 = xsum32(s2);
    const float mu_r = s1 * (1.f / 1024.f), rs_r = rsqrtf(fmaxf(s2 * (1.f / 1024.f) - mu_r * mu_r, 0.f) + LN_EPS);
    WT_FENCE();
    _Pragma("unroll") for (int r = 0; r < 4; ++r) {
      const int tok = 4 * (lane >> 4) + r, j = lane & 15;
      raw[tok * 40 + j] = acc[0][r]; raw[tok * 40 + 16 + j] = acc[1][r];
      if (j < 4) raw[tok * 40 + 32 + j] = acc[2][r];
    }
    if (lane < 16) { raw[640 + 2 * lane] = mu_r; raw[640 + 2 * lane + 1] = rs_r; }
    WT_FENCE();
    f32x4 gg[4], bb[4];
    _Pragma("unroll") for (int i = 0; i < 4; ++i) { gg[i] = ((const f32x4*)(P.ln1_g + l * D))[lane + 64 * i]; bb[i] = ((const f32x4*)(P.ln1_b + l * D))[lane + 64 * i]; }
    _Pragma("unroll 1") for (int q0 = 0; q0 < 16; q0 += 4) {
      f32x4 v[4][4];
      _Pragma("unroll") for (int j = 0; j < 4; ++j) _Pragma("unroll") for (int i = 0; i < 4; ++i) v[j][i] = ((const f32x4*)(P.h + (size_t)(t0 + q0 + j) * D))[lane + 64 * i];
      __builtin_amdgcn_sched_barrier(0);
      _Pragma("unroll") for (int j = 0; j < 4; ++j) {
        const float mu = raw[640 + 2 * (q0 + j)], rs = raw[640 + 2 * (q0 + j) + 1];
        _Pragma("unroll") for (int i = 0; i < 4; ++i) {
          v[j][i].x = (v[j][i].x - mu) * rs * gg[i].x + bb[i].x; v[j][i].y = (v[j][i].y - mu) * rs * gg[i].y + bb[i].y;
          v[j][i].z = (v[j][i].z - mu) * rs * gg[i].z + bb[i].z; v[j][i].w = (v[j][i].w - mu) * rs * gg[i].w + bb[i].w;
        }
        store_row(v[j], P.h + (size_t)(t0 + q0 + j) * D, P.hb + (size_t)(t0 + q0 + j) * D, lane);
      }
    }
    WT_FENCE();
    if (lane < 16) {
      const int t = t0 + lane;
      const float mu = raw[640 + 2 * lane], rs = raw[640 + 2 * lane + 1];
      const float* G = P.rgb + (l * 2) * 48; const float* Bc = G + 48;
      float gl[4];
      _Pragma("unroll") for (int g = 0; g < 4; ++g) gl[g] = rs * (raw[lane * 40 + 32 + g] - mu * G[32 + g]) + Bc[32 + g];
      int gs = 0; float gm = gl[0];
      for (int g = 1; g < 4; ++g) if (gl[g] > gm) { gm = gl[g]; gs = g; }
      float den = 0.f;
      _Pragma("unroll") for (int g = 0; g < 4; ++g) den += expf(gl[g] - gm);
      const float pg = 1.f / den;
      float el[8];
      _Pragma("unroll") for (int e = 0; e < 8; ++e) el[e] = rs * (raw[lane * 40 + gs * 8 + e] - mu * G[gs * 8 + e]) + Bc[gs * 8 + e];
      int i1 = 0; float v1 = el[0];
      for (int e = 1; e < 8; ++e) if (el[e] > v1) { v1 = el[e]; i1 = e; }
      int i2 = -1; float v2 = -3.0e38f;
      _Pragma("unroll") for (int e = 0; e < 8; ++e) if (e != i1 && el[e] > v2) { v2 = el[e]; i2 = e; }
      if (i2 < 0) i2 = (i1 + 1) & 7;
      const float ex = expf(v2 - v1);
      const float w1 = pg / (1.f + ex), w2 = pg * ex / (1.f + ex);
      const int e1 = gs * 8 + i1, e2 = gs * 8 + i2;
      const int r1 = atomicAdd(P.counts + e1 * CSTR, 1), r2 = atomicAdd(P.counts + e2 * CSTR, 1);
      P.tok_slot[2 * t] = e1 * CAP + r1; P.tok_slot[2 * t + 1] = e2 * CAP + r2;
      P.tok_w[2 * t] = w1; P.tok_w[2 * t + 1] = w2;
      P.slot_tok[(size_t)e1 * CAP + r1] = t; P.slot_tok[(size_t)e2 * CAP + r2] = t;
    }
  }
}

DI bool moe_unit(const int* counts, int i, int G, int c, int& e, int& mi, int& pn, int& cnt, int& hs) {
  int tot = 0;
  for (int x = 0; x < NEXP; ++x) tot += (counts[x * CSTR] + 255) >> 8;
  const int U = tot * 4, g = i * G + c;
  if (g >= U) return false;
  const int q = U / 8, r = U % 8, xcd = g % 8, off = g / 8;
  const int idx = (xcd < r ? xcd * (q + 1) : r * (q + 1) + (xcd - r) * q) + off;
  const int mt = idx >> 2; pn = idx & 3;
  int acc = 0; e = 0; mi = 0; cnt = 0; hs = 0;
  for (int x = 0; x < NEXP; ++x) {
    const int cx = counts[x * CSTR], n = (cx + 255) >> 8;
    if (mt < acc + n) { e = x; mi = mt - acc; cnt = cx; hs = acc * 256; return true; }
    acc += n;
  }
  return false;
}
constexpr int MOE_TAB = 131072 + 512, MOE_MAXU = 8;
DI void moe_table(const int* counts, int G, int c, char* smem_wg) {
  const int tid = rtid();
  __syncthreads();
  if (tid < MOE_MAXU) {
    int e = 0, mi = 0, pn = 0, cnt = 0, hs = 0;
    const bool ok = moe_unit(counts, tid, G, c, e, mi, pn, cnt, hs);
    int* tb = (int*)(smem_wg + MOE_TAB) + tid * 8;
    tb[0] = ok ? 1 : 0; tb[1] = e; tb[2] = mi; tb[3] = pn; tb[4] = cnt; tb[5] = hs;
  }
  __syncthreads();
}
DI bool moe_next(int i, int& e, int& mi, int& pn, int& cnt, int& hs) {
  if (i >= MOE_MAXU) return false;
  const LAS_I* tb = (const LAS_I*)(size_t)(MOE_TAB + i * 32);
  const int ok = __builtin_amdgcn_readfirstlane(tb[0]);
  e = __builtin_amdgcn_readfirstlane(tb[1]); mi = __builtin_amdgcn_readfirstlane(tb[2]); pn = __builtin_amdgcn_readfirstlane(tb[3]);
  cnt = __builtin_amdgcn_readfirstlane(tb[4]); hs = __builtin_amdgcn_readfirstlane(tb[5]);
  return ok != 0;
}
struct SchedP5a {
  static constexpr bool GATHER = true;
  const int* counts; const int* slot_tok; const char* hb; const char* w; int G, c;
  DI bool next(int i, g8::Unit& u) const {
    int e, mi, pn, cnt, hs;
    if (!moe_next(i, e, mi, pn, cnt, hs)) return false;
    u.pm = hs + mi * 256; u.pn = pn; u.tag = e; u.x0 = e * CAP + mi * 256; u.x1 = cnt - mi * 256;
    u.a = hb; u.b = w + ((size_t)e * 1024 + (size_t)pn * 256) * D * 2; return true;
  }
  DI void arows(const g8::Unit& u, int R0, unsigned (&pk)[2]) const {
    const int* st = slot_tok + u.x0; const int lim = u.x1 - 1;
    const int t0 = st[min(R0, lim)], t1 = st[min(R0 + 64, lim)], t2 = st[min(R0 + 128, lim)], t3 = st[min(R0 + 192, lim)];
    pk[0] = (unsigned)t0 | ((unsigned)t1 << 16); pk[1] = (unsigned)t2 | ((unsigned)t3 << 16);
  }
};
struct EpiP5a {
  static constexpr bool PERM = true;
  bf16_t* H;
  DI bool keep(const g8::Unit&) const { return false; }
  DI void operator()(g8::f32x4 (&acc)[2][2][4][2], const g8::Unit& u, int wr, int wc, int fr, int fq) const {
    _Pragma("unroll") for (int ai = 0; ai < 2; ++ai) _Pragma("unroll") for (int m = 0; m < 4; ++m) {
      bf16_t* rowp = H + (size_t)(u.pm + 128 * ai + 64 * wr + 16 * m + fr) * 512 + u.pn * 128 + 16 * wc + 4 * fq;
      _Pragma("unroll") for (int bj = 0; bj < 2; ++bj) {
        const g8::f32x4 g = acc[ai][bj][m][0], up = acc[ai][bj][m][1];
        u32x2 o; o.x = pk2(g[0] * sigmoidf_(g[0]) * up[0], g[1] * sigmoidf_(g[1]) * up[1]); o.y = pk2(g[2] * sigmoidf_(g[2]) * up[2], g[3] * sigmoidf_(g[3]) * up[3]);
        *(u32x2*)(rowp + 64 * bj) = o;
      }
    }
  }
};
DI void phase_p5a(const Params& P, int l, char* smem_wg, int bid, int nblk) {
  SchedP5a S; S.counts = P.counts; S.slot_tok = P.slot_tok; S.hb = (const char*)P.hb; S.w = (const char*)P.w_gu_t; S.G = nblk >> 1; S.c = bid >> 1;
  EpiP5a E; E.H = P.H;
  moe_table(P.counts, S.G, S.c, smem_wg);
  g8::gemm_phase((g8::lds_u8*)smem_wg, D, S, E);
}
struct SchedP5b {
  static constexpr bool GATHER = false;
  const int* counts; const char* H; const char* w; int G, c;
  DI bool next(int i, g8::Unit& u) const {
    int e, mi, pn, cnt, hs;
    if (!moe_next(i, e, mi, pn, cnt, hs)) return false;
    u.pm = hs + mi * 256; u.pn = pn; u.tag = e; u.x0 = 0; u.x1 = 0;
    u.a = H + (size_t)u.pm * 512 * 2; u.b = w + ((size_t)e * 1024 + (size_t)pn * 256) * 512 * 2; return true;
  }
  DI void arows(const g8::Unit&, int, unsigned (&)[2]) const {}
};
struct EpiP5b {
  static constexpr bool PERM = true;
  bf16_t* ys;
  DI bool keep(const g8::Unit&) const { return false; }
  DI void operator()(g8::f32x4 (&acc)[2][2][4][2], const g8::Unit& u, int wr, int wc, int fr, int fq) const {
    _Pragma("unroll") for (int ai = 0; ai < 2; ++ai) _Pragma("unroll") for (int m = 0; m < 4; ++m) {
      bf16_t* rowp = ys + (size_t)(u.pm + 128 * ai + 64 * wr + 16 * m + fr) * D + u.pn * 256 + 32 * wc + 8 * fq;
      _Pragma("unroll") for (int bj = 0; bj < 2; ++bj) {
        const g8::f32x4 a = acc[ai][bj][m][0], b = acc[ai][bj][m][1];
        u32x4 o; o.x = pk2(a[0], a[1]); o.y = pk2(a[2], a[3]); o.z = pk2(b[0], b[1]); o.w = pk2(b[2], b[3]);
        *(u32x4*)(rowp + 128 * bj) = o;
      }
    }
  }
};
DI void phase_p5b(const Params& P, int l, char* smem_wg, int bid, int nblk) {
  SchedP5b S; S.counts = P.counts; S.H = (const char*)P.H; S.w = (const char*)P.w_dn_t; S.G = nblk >> 1; S.c = bid >> 1;
  EpiP5b E; E.ys = P.ys;
  moe_table(P.counts, S.G, S.c, smem_wg);
  g8::gemm_phase((g8::lds_u8*)smem_wg, 512, S, E);
}
DI void phase_p6(const Params& P, int l, char* smem, int bid, int nblk) {
  const int tid = otid(), lane = tid & 63, wv = (bid * NT + tid) >> 6, nwv = (nblk * NT) >> 6;
  int* shs = (int*)smem;
  __syncthreads();
  if (tid == 0) { int hs = 0; for (int x = 0; x < NEXP; ++x) { shs[x] = hs; hs += ((P.counts[x * CSTR] + 255) >> 8) * 256; } }
  __syncthreads();
  int ns1 = 0, ns2 = 0; float nw1 = 0.f, nw2 = 0.f;
  if (wv < T) { ns1 = P.tok_slot[2 * wv]; ns2 = P.tok_slot[2 * wv + 1]; nw1 = P.tok_w[2 * wv]; nw2 = P.tok_w[2 * wv + 1]; }
  for (int t = wv; t < T; t += nwv) {
    const int s1 = ns1, s2 = ns2;
    const float w1 = nw1, w2 = nw2;
    { const int tn = min(t + nwv, T - 1); ns1 = P.tok_slot[2 * tn]; ns2 = P.tok_slot[2 * tn + 1]; nw1 = P.tok_w[2 * tn]; nw2 = P.tok_w[2 * tn + 1]; }
    const bf16_t* y1 = P.ys + (size_t)(shs[s1 / CAP] + s1 % CAP) * D;
    const bf16_t* y2 = P.ys + (size_t)(shs[s2 / CAP] + s2 % CAP) * D;
    f32x4 v[4];
    _Pragma("unroll") for (int i = 0; i < 4; ++i) {
      const f32x4 hv = ((const f32x4*)(P.h + (size_t)t * D))[lane + 64 * i];
      const u32x2 a = ((const u32x2*)y1)[lane + 64 * i], c = ((const u32x2*)y2)[lane + 64 * i];
      v[i].x = ALPHA * hv.x + (bflo(a.x) * w1 + bflo(c.x) * w2); v[i].y = ALPHA * hv.y + (bfhi(a.x) * w1 + bfhi(c.x) * w2);
      v[i].z = ALPHA * hv.z + (bflo(a.y) * w1 + bflo(c.y) * w2); v[i].w = ALPHA * hv.w + (bfhi(a.y) * w1 + bfhi(c.y) * w2);
    }
    ln16(v, P.ln2_g + l * D, P.ln2_b + l * D, lane);
    if (l == 1) {
      const int b = t >= L ? 1 : 0, pos = t - b * L;
      if (pos >= NMETA) store_row(v, P.out + ((size_t)b * SEQ + pos - NMETA) * D, nullptr, lane);
    } else store_row(v, P.h + (size_t)t * D, P.hb + (size_t)t * D, lane);
  }
}

#define XB_TMO      128
#define XB_XCNT(j)  (256  + 64 * (j))
#define XB_XSUB(j)  (1280 + 64 * (j))
#define XB_XGEN(j)  (2304 + 64 * (j))
#define XB_TOP      3328
#define XB_TOPGEN   3392
#define XCD_BAR_WORDS 3456
#define XB_SPIN_CAP (1u << 20)
#define LAS __attribute__((address_space(3)))
DI unsigned xb_ld(unsigned* p) { return __hip_atomic_load(p, __ATOMIC_RELAXED, __HIP_MEMORY_SCOPE_AGENT); }
DI unsigned xb_add(unsigned* p, unsigned v) { return __hip_atomic_fetch_add(p, v, __ATOMIC_RELAXED, __HIP_MEMORY_SCOPE_AGENT); }
DI unsigned xb_xcc_id() { return (unsigned)__builtin_amdgcn_s_getreg((3 << 11) | 20) & 0xFu; }
#define XB_SPIN(cond, bar) do { unsigned _sp = 0; while (cond) { __builtin_amdgcn_s_sleep(1); \
    if ((++_sp & 255u) == 0u) { if (xb_ld(&(bar)[XB_TMO])) break; if (_sp > XB_SPIN_CAP) { atomicAdd(&(bar)[XB_TMO], 1u); break; } } } } while (0)
struct XcdBarrier { unsigned* bar; unsigned x; volatile LAS unsigned* st; };
DI XcdBarrier xcd_barrier_post(unsigned* bar, volatile LAS unsigned* st) {
  XcdBarrier b; b.bar = bar; b.x = xb_xcc_id(); b.st = st;
  if (rtid() == 0) (void)xb_add(&bar[XB_XCNT(b.x)], 1u);
  return b;
}
DI void xcd_barrier_complete(unsigned* bar, unsigned x, unsigned& nloc, unsigned& nx) {
  const unsigned G = gridDim.x * gridDim.y * gridDim.z;
  unsigned sum, cnt, mine, sp = 0u;
  for (;;) {
    sum = 0u; cnt = 0u; mine = 0u;
    _Pragma("unroll") for (unsigned j = 0; j < 16; ++j) { const unsigned c = xb_ld(&bar[XB_XCNT(j)]); sum += c; cnt += (c > 0u) ? 1u : 0u; mine = (j == x) ? c : mine; }
    if (sum == G) break;
    __builtin_amdgcn_s_sleep(1);
    if ((++sp & 255u) == 0u) { if (xb_ld(&bar[XB_TMO])) break; if (sp > XB_SPIN_CAP) { atomicAdd(&bar[XB_TMO], 1u); break; } }
  }
  nloc = mine > 0u ? mine : 1u; nx = cnt > 0u ? cnt : 1u;
}
DI void xcd_barrier(const XcdBarrier& b) {
  asm volatile("s_waitcnt vmcnt(0)" ::: "memory");
  __syncthreads();
  if (rtid() == 0) {
    unsigned* bar = b.bar; unsigned bx = b.x;
    asm volatile("" : "+s"(bar), "+s"(bx));
    __builtin_amdgcn_s_waitcnt(0);
    unsigned nloc = b.st[0], nx = b.st[1];
    if (nloc == 0u) { xcd_barrier_complete(bar, bx, nloc, nx); b.st[0] = nloc; b.st[1] = nx; }
    const unsigned old = xb_add(&bar[XB_XSUB(bx)], 1u);
    const unsigned gen = old / nloc;
    if (old + 1u == (gen + 1u) * nloc) {
      __builtin_amdgcn_fence(__ATOMIC_RELEASE, "agent");
      asm volatile("s_waitcnt vmcnt(0)" ::: "memory");
      const unsigned og = xb_add(&bar[XB_TOP], 1u);
      const unsigned tg = og / nx;
      if (og + 1u == (tg + 1u) * nx) xb_add(&bar[XB_TOPGEN], 1u);
      else XB_SPIN(xb_ld(&bar[XB_TOPGEN]) == tg, bar);
      __builtin_amdgcn_fence(__ATOMIC_ACQUIRE, "agent");
      xb_add(&bar[XB_XGEN(bx)], 1u);
      asm volatile("s_waitcnt vmcnt(0)" ::: "memory");
    } else {
      XB_SPIN(xb_ld(&bar[XB_XGEN(bx)]) == gen, bar);
      __builtin_amdgcn_fence(__ATOMIC_ACQUIRE, "agent");
      asm volatile("s_waitcnt vmcnt(0)" ::: "memory");
    }
  }
  __syncthreads();
}

constexpr size_t al256(size_t v) { return (v + 255) & ~(size_t)255; }
struct WsLayout {
  size_t bar, ctl, h, hb, w_in_t, w_br_t, w_out_t, cs, rwp, rgb, lam, counts, tok_slot, tok_w, slot_tok, mstat, nvec, wgt, bcum, ligate;
  size_t qa, ka, vaT, qb, kb, vbT, cq, ck, cvT, co, cg, gz, qc, kc, kcT, U, end_mixer;
  size_t w_gu_t, w_dn_t, H, ys, end_moe, need;
};
constexpr WsLayout make_layout() {
  WsLayout w{}; size_t off = 0;
#define TAKE(f, bytes) w.f = off; off = al256(off + (size_t)(bytes));
  TAKE(bar, XCD_BAR_WORDS * 4) TAKE(ctl, 4096)
  TAKE(h, (size_t)TP * D * 4) TAKE(hb, (size_t)TP * D * 2) TAKE(w_in_t, (size_t)DINP * D * 2) TAKE(w_br_t, (size_t)3 * 1024 * 512 * 2) TAKE(w_out_t, (size_t)D * D * 2)
  TAKE(cs, (size_t)L * 32 * 8) TAKE(rwp, (size_t)2 * 64 * 3 * 64 * 4 * 4) TAKE(rgb, 2 * 2 * 48 * 4) TAKE(lam, 256) TAKE(counts, NEXP * CSTR * 4) TAKE(tok_slot, (size_t)T * 2 * 4) TAKE(tok_w, (size_t)T * 2 * 4) TAKE(slot_tok, (size_t)NEXP * CAP * 4)
  TAKE(mstat, (size_t)16 * NCH * 4 * 4) TAKE(nvec, (size_t)16 * NCH * 128 * 4) TAKE(wgt, (size_t)16 * LPAD * 4) TAKE(bcum, (size_t)16 * LPAD * 4) TAKE(ligate, (size_t)16 * LPAD * 4)
  const size_t scratch0 = off;
  TAKE(qa, (size_t)NB * 4 * 2 * L * 64 * 2) TAKE(ka, (size_t)NB * 4 * 2 * L * 64 * 2 + 4096) TAKE(vaT, (size_t)NB * 4 * 128 * LK * 2)
  TAKE(qb, (size_t)NB * 8 * L * 64 * 2) TAKE(kb, (size_t)NB * 2 * L * 64 * 2 + 4096) TAKE(vbT, (size_t)NB * 2 * 64 * LK * 2)
  TAKE(cq, (size_t)TP * 512 * 2) TAKE(ck, (size_t)TP * 512 * 2) TAKE(cvT, (size_t)8 * 128 * LPAD * 2) TAKE(co, (size_t)TP * 512 * 2) TAKE(cg, (size_t)TP * 16 * 4)
  TAKE(gz, (size_t)TP * 3072 * 2) TAKE(qc, (size_t)8 * LPAD * 128 * 2) TAKE(kc, (size_t)8 * LPAD * 128 * 2) TAKE(kcT, (size_t)8 * 128 * LPAD * 2) TAKE(U, (size_t)16 * NCH * 16384 * 4)
  w.end_mixer = off;
  off = scratch0;
  TAKE(w_gu_t, (size_t)NEXP * 1024 * 1024 * 2) TAKE(w_dn_t, (size_t)NEXP * 1024 * 512 * 2) TAKE(H, (size_t)HROWS * 512 * 2) TAKE(ys, (size_t)HROWS * D * 2)
  w.end_moe = off;
#undef TAKE
  w.need = w.end_mixer > w.end_moe ? w.end_mixer : w.end_moe;
  return w;
}
constexpr WsLayout WL = make_layout();
static_assert(WL.need <= (size_t)552 * 1000 * 1000, "workspace");

struct SchedP1 {
  static constexpr bool GATHER = false;
  const char* hb; const char* w; int G, c;
  DI bool next(int i, g8::Unit& u) const {
    const int Lq = i * G + c; int pm, pn;
    if (Lq < 65 * 25) { g8::grid_lin(Lq, 65, 25, pm, pn); u.tag = 0; u.a = hb + (size_t)pm * 256 * D * 2; u.b = w + (size_t)pn * 256 * D * 2; }
    else if (Lq < 65 * 25 + 5 * 65) { g8::grid_lin(Lq - 65 * 25, 5, 65, pm, pn); u.tag = 1; u.a = w + (size_t)(6400 + pm * 256) * D * 2; u.b = hb + (size_t)pn * 256 * D * 2; }
    else return false;
    u.pm = pm; u.pn = pn; return true;
  }
  DI void arows(const g8::Unit&, int, unsigned (&)[2]) const {}
};
DI u32x4 pack8(const g8::f32x4& a, const g8::f32x4& b) { u32x4 o; o.x = pk2(a[0], a[1]); o.y = pk2(a[2], a[3]); o.z = pk2(b[0], b[1]); o.w = pk2(b[2], b[3]); return o; }
struct EpiP1 {
  static constexpr bool PERM = true;
  char* ws;
  DI bool keep(const g8::Unit&) const { return false; }
  DI void operator()(g8::f32x4 (&acc)[2][2][4][2], const g8::Unit& u, int wr, int wc, int fr, int fq) const {
    char* wb = ws; asm volatile("" : "+s"(wb));
    if (u.tag == 0) {
      const int r0 = u.pm * 256 + 64 * wr + fr;
      _Pragma("unroll") for (int bj = 0; bj < 2; ++bj) {
        const int c0 = u.pn * 256 + 128 * bj + 32 * wc;
        const int c = c0 + 8 * fq;
        if (c0 < 1664) {
          const int u64 = c0 >> 6, q = ((c0 >> 5) & 1) * 4 + fq;
          bf16_t* base; int nh, uu; float sc;
          if (u64 < 8) { base = (bf16_t*)(wb + WL.qa); nh = 8; uu = u64; sc = QSCALE; }
          else if (u64 < 16) { base = (bf16_t*)(wb + WL.ka); nh = 8; uu = u64 - 8; sc = 1.f; }
          else if (u64 < 24) { base = (bf16_t*)(wb + WL.qb); nh = 8; uu = u64 - 16; sc = QSCALE; }
          else { base = (bf16_t*)(wb + WL.kb); nh = 2; uu = u64 - 24; sc = 1.f; }
          const f32x2* cs = (const f32x2*)(wb + WL.cs);
          _Pragma("unroll") for (int ai = 0; ai < 2; ++ai) {
            g8::f32x4 c01[4], c23[4];
            _Pragma("unroll") for (int m = 0; m < 4; ++m) {
              const int t = r0 + 128 * ai + 16 * m, tt = min(t, T - 1), b = tt >= L ? 1 : 0, pos = tt - b * L;
              const g8::f32x4* cp = (const g8::f32x4*)(cs + (size_t)pos * 32 + 4 * q);
              c01[m] = cp[0]; c23[m] = cp[1];
            }
            __builtin_amdgcn_sched_barrier(0);
            _Pragma("unroll") for (int m = 0; m < 4; ++m) {
              const int t = r0 + 128 * ai + 16 * m, tt = min(t, T - 1), b = tt >= L ? 1 : 0, pos = tt - b * L;
              const g8::f32x4 x1 = acc[ai][bj][m][0], x2 = acc[ai][bj][m][1];
              g8::f32x4 o1, o2;
              o1[0] = (x1[0] * c01[m][0] - x2[0] * c01[m][1]) * sc; o2[0] = (x2[0] * c01[m][0] + x1[0] * c01[m][1]) * sc;
              o1[1] = (x1[1] * c01[m][2] - x2[1] * c01[m][3]) * sc; o2[1] = (x2[1] * c01[m][2] + x1[1] * c01[m][3]) * sc;
              o1[2] = (x1[2] * c23[m][0] - x2[2] * c23[m][1]) * sc; o2[2] = (x2[2] * c23[m][0] + x1[2] * c23[m][1]) * sc;
              o1[3] = (x1[3] * c23[m][2] - x2[3] * c23[m][3]) * sc; o2[3] = (x2[3] * c23[m][2] + x1[3] * c23[m][3]) * sc;
              if (t < T) *(u32x4*)(base + ((size_t)(b * nh + uu) * L + pos) * 64 + 8 * q) = pack8(o1, o2);
            }
            __builtin_amdgcn_sched_barrier(0);
          }
        } else if (c0 < 6272) {
          bf16_t* dst0; int stride; bool sig = false;
          if (c0 < 2176) { dst0 = (bf16_t*)(wb + WL.cq) + (c - 1664); stride = 512; }
          else if (c0 < 2688) { dst0 = (bf16_t*)(wb + WL.ck) + (c - 2176); stride = 512; }
          else if (c0 < 3200) { dst0 = (bf16_t*)(wb + WL.co) + (c - 2688); stride = 512; }
          else { dst0 = (bf16_t*)(wb + WL.gz) + (c - 3200); stride = 3072; sig = true; }
          _Pragma("unroll") for (int ai = 0; ai < 2; ++ai) _Pragma("unroll") for (int m = 0; m < 4; ++m) {
            const int t = r0 + 128 * ai + 16 * m;
            g8::f32x4 v0 = acc[ai][bj][m][0], v1 = acc[ai][bj][m][1];
            if (sig) { _Pragma("unroll") for (int e = 0; e < 4; ++e) { v0[e] = fmaxf(sigmoidf_(v0[e]), 1e-12f); v1[e] = fmaxf(sigmoidf_(v1[e]), 1e-12f); } }
            if (t < T) *(u32x4*)(dst0 + (size_t)t * stride) = pack8(v0, v1);
          }
        } else if (c0 == 6272) {
          if (fq < 2) {
            float* cg = (float*)(wb + WL.cg);
            _Pragma("unroll") for (int ai = 0; ai < 2; ++ai) _Pragma("unroll") for (int m = 0; m < 4; ++m) {
              const int t = r0 + 128 * ai + 16 * m;
              if (t < T) { g8::f32x4* d = (g8::f32x4*)(cg + (size_t)t * 16 + 8 * fq); d[0] = acc[ai][bj][m][0]; d[1] = acc[ai][bj][m][1]; }
            }
          }
        }
      }
    } else {
      const int chb0 = u.pm * 256 + 64 * wr;
      _Pragma("unroll") for (int ai = 0; ai < 2; ++ai) _Pragma("unroll") for (int m = 0; m < 4; ++m) {
        const int chb = chb0 + 128 * ai + 16 * m;
        if (chb < 1152) {
          const int ch = chb + fr; bf16_t* rp; size_t bs;
          if (chb < 512) { rp = (bf16_t*)(wb + WL.vaT) + (size_t)ch * LK; bs = (size_t)512 * LK; }
          else if (chb < 640) { rp = (bf16_t*)(wb + WL.vbT) + (size_t)(ch - 512) * LK; bs = (size_t)128 * LK; }
          else { rp = (bf16_t*)(wb + WL.cvT) + (size_t)(ch - 640) * LPAD + MPAD; bs = (size_t)512 * LPAD; }
          _Pragma("unroll") for (int bj = 0; bj < 2; ++bj) {
            const int t0 = u.pn * 256 + 128 * bj + 32 * wc + 8 * fq;
            if (t0 < T) { const int b = t0 >= L ? 1 : 0, pos0 = t0 - b * L; *(u32x4*)(rp + b * bs + pos0) = pack8(acc[ai][bj][m][0], acc[ai][bj][m][1]); }
          }
        }
      }
    }
  }
};
DI void phase_p1(const Params& P, int l, char* smem_wg, int bid, int nblk) {
  SchedP1 S; S.hb = (const char*)P.hb; S.w = (const char*)P.w_in_t; S.G = nblk >> 1; S.c = bid >> 1;
  EpiP1 E; E.ws = (char*)P.h - WL.h;
  g8::gemm_phase((g8::lds_u8*)smem_wg, D, S, E);
}

struct KArgs { const float* in[28]; float* out; char* ws; };
typedef const __attribute__((address_space(4))) KArgs* KAP;
DI Params make_params(KAP k) {
  Params P;
  P.x = k->in[0]; P.meta = k->in[1]; P.ln_in_g = k->in[2]; P.ln_in_b = k->in[3]; P.w_in = k->in[4]; P.conv_w = k->in[5]; P.conv_b = k->in[6]; P.gate_b = k->in[7];
  P.lam_q1 = k->in[8]; P.lam_k1 = k->in[9]; P.lam_q2 = k->in[10]; P.lam_k2 = k->in[11]; P.diff_g = k->in[12]; P.sink = k->in[13]; P.mlstm_g = k->in[14];
  P.w_branch = k->in[15]; P.w_out = k->in[16]; P.ln1_g = k->in[17]; P.ln1_b = k->in[18]; P.ln2_g = k->in[19]; P.ln2_b = k->in[20]; P.w_rg = k->in[21]; P.b_rg = k->in[22];
  P.w_re = k->in[23]; P.b_re = k->in[24]; P.w_gate = k->in[25]; P.w_up = k->in[26]; P.w_down = k->in[27];
  P.out = k->out;
  char* ws = k->ws;
  P.h = (float*)(ws + WL.h); P.hb = (bf16_t*)(ws + WL.hb); P.w_in_t = (bf16_t*)(ws + WL.w_in_t); P.w_br_t = (bf16_t*)(ws + WL.w_br_t); P.w_out_t = (bf16_t*)(ws + WL.w_out_t);
  P.cs = (f32x2*)(ws + WL.cs); P.lam = (float*)(ws + WL.lam); P.ctl = (unsigned*)(ws + WL.ctl); P.rwp = (float*)(ws + WL.rwp); P.rgb = (float*)(ws + WL.rgb); P.counts = (int*)(ws + WL.counts); P.tok_slot = (int*)(ws + WL.tok_slot); P.tok_w = (float*)(ws + WL.tok_w);
  P.slot_tok = (int*)(ws + WL.slot_tok); P.mstat = (float*)(ws + WL.mstat); P.nvec = (float*)(ws + WL.nvec); P.wgt = (float*)(ws + WL.wgt); P.bcum = (float*)(ws + WL.bcum);
  P.ligate = (float*)(ws + WL.ligate);
  P.qa = (bf16_t*)(ws + WL.qa); P.ka = (bf16_t*)(ws + WL.ka); P.vaT = (bf16_t*)(ws + WL.vaT); P.qb = (bf16_t*)(ws + WL.qb); P.kb = (bf16_t*)(ws + WL.kb); P.vbT = (bf16_t*)(ws + WL.vbT);
  P.cq = (bf16_t*)(ws + WL.cq); P.ck = (bf16_t*)(ws + WL.ck); P.merged = P.cq; P.cvT = (bf16_t*)(ws + WL.cvT); P.co = (bf16_t*)(ws + WL.co); P.cg = (float*)(ws + WL.cg);
  P.gz = (bf16_t*)(ws + WL.gz); P.qc = (bf16_t*)(ws + WL.qc); P.kc = (bf16_t*)(ws + WL.kc); P.kcT = (bf16_t*)(ws + WL.kcT); P.U = (float*)(ws + WL.U);
  P.w_gu_t = (bf16_t*)(ws + WL.w_gu_t); P.w_dn_t = (bf16_t*)(ws + WL.w_dn_t); P.H = (bf16_t*)(ws + WL.H); P.ys = (bf16_t*)(ws + WL.ys);
  P.oa = (bf16_t*)k->out; P.ob = P.oa + (size_t)TP * 512; P.oc = P.ob + (size_t)TP * 512;
  return P;
}

constexpr int SMEM_BYTES = 2 * DA_STAGE + 4096 + 256;
constexpr int WG_LDS = 2 * SMEM_BYTES + 64 + 256;
static_assert(WIDTAB_OFF == 2 * SMEM_BYTES + 64, "wave-slot table offset");
#define PH(...) { KAP k_ = ka; int bid = bid0, nblk = nblk0; asm volatile("" : "+s"(k_), "+s"(bid), "+s"(nblk)); const Params P = make_params(k_); __VA_ARGS__; }
__global__ void __launch_bounds__(512, 2) mega(KArgs kargs) {
  extern __shared__ __attribute__((aligned(16))) char smem_wg[];
  (void)kargs;
  const KAP ka = (KAP)__builtin_amdgcn_kernarg_segment_ptr();
  {
    const unsigned hw = (unsigned)__builtin_amdgcn_s_getreg((5 << 11) | 4) & 63u;
    *(volatile LAS int*)(size_t)(WIDTAB_OFF + 4 * hw) = (int)(threadIdx.x >> 6);
  }
  __syncthreads();
  const int half = __builtin_amdgcn_readfirstlane(rtid() >> 8);
  char* smem = smem_wg + half * SMEM_BYTES;
  const int bid0 = 2 * blockIdx.x + half, nblk0 = 2 * gridDim.x;
  volatile LAS unsigned* st = (volatile LAS unsigned*)(smem_wg + 2 * SMEM_BYTES);
  volatile LAS int* wgq = (volatile LAS int*)(smem_wg + 2 * SMEM_BYTES + 16);
  if (rtid() == 0) { st[0] = 0u; st[1] = 0u; }
  __syncthreads();
  const XcdBarrier xb = xcd_barrier_post((unsigned*)(ka->ws + WL.bar), st);

  PH(phase_prologue(P, bid, nblk))
  PH(phase_router_prep(P, bid, nblk))
  PH(phase_wconv_small(P, 0, smem, bid, nblk))
  xcd_barrier(xb);
  auto layer = [&](const int l) __attribute__((always_inline)) {
    PH(phase_zero_pads(P, bid, nblk))
    PH(phase_p1(P, l, smem_wg, bid, nblk))
    xcd_barrier(xb);
    PH(phase_mprep(P, l, smem, bid, nblk))
    xcd_barrier(xb);
    for (int it = bid0; it < 512; it += nblk0) PH(dattn_item(P, l, it, true, smem))
    PH(phase_mscan(P, bid, nblk))
    xcd_barrier(xb);
    {
      for (int it = (int)blockIdx.x; it < 256; it += (int)gridDim.x) PH(dattn_item16(P, l, it, smem_wg))
      unsigned* qctr = (unsigned*)(ka->ws + WL.ctl) + (l * 8 + 5) * 16;
      const int NP = 4 + 4 * NCH + 2 * 257;
      for (;;) {
        __syncthreads();
        if (rtid() == 0) wgq[0] = (int)xb_add(qctr, 1u);
        __syncthreads();
        const int pr = wgq[0];
        if (pr >= NP) break;
        if (pr < 4) PH(dattn_combine(P, l, 2 * pr + half, smem))
        else if (pr < 4 + 4 * NCH) PH(mout_item(P, l, 2 * (pr - 4) + half, smem))
        else PH(swa_item(P, l, 2 * (pr - 4 - 4 * NCH) + half, smem))
      }
    }
    xcd_barrier(xb);
    PH(phase_p3a(P, l, smem, smem_wg, bid, nblk))
    xcd_barrier(xb);
    PH(phase_p3b(P, l, smem, smem_wg, bid, nblk))
    xcd_barrier(xb);
    PH(phase_p4(P, l, smem, bid, nblk))
    PH(phase_wconv_experts(P, l, smem, half, wgq))
    xcd_barrier(xb);
    PH(phase_p5a(P, l, smem_wg, bid, nblk))
    xcd_barrier(xb);
    PH(phase_p5b(P, l, smem_wg, bid, nblk))
    xcd_barrier(xb);
    PH(phase_p6(P, l, smem, bid, nblk))
    if (l == 0) PH(phase_wconv_small(P, 1, smem, bid, nblk))
    xcd_barrier(xb);
  };
  layer(0);
  layer(1);
}

extern "C" void kernel_launch(void* const* d_in, const int* in_sizes, int n_in, void* d_out, int out_size, void* d_ws, size_t ws_size, hipStream_t stream) {
  (void)in_sizes; (void)n_in; (void)out_size;
  if (WL.need > ws_size) return;
  KArgs a{};
  for (int i = 0; i < 28; ++i) a.in[i] = (const float*)d_in[i];
  a.out = (float*)d_out; a.ws = (char*)d_ws;
  static int grid = 0;
  if (!grid) {
    int dev = 0, cus = 0, per_cu = 0;
    (void)hipGetDevice(&dev);
    (void)hipDeviceGetAttribute(&cus, hipDeviceAttributeMultiprocessorCount, dev);
    (void)hipFuncSetAttribute((const void*)mega, hipFuncAttributeMaxDynamicSharedMemorySize, WG_LDS);
    (void)hipOccupancyMaxActiveBlocksPerMultiprocessor(&per_cu, (const void*)mega, 512, WG_LDS);
    if (per_cu > 1) per_cu = 1;
    if (per_cu < 1) per_cu = 1;
    grid = cus * per_cu;
  }
  (void)hipMemsetAsync((char*)d_ws + WL.bar, 0, WL.h - WL.bar, stream);
  hipLaunchKernelGGL(mega, dim3(grid), dim3(512), WG_LDS, stream, a);
}
```

```cpp
#include <hip/hip_runtime.h>
#include <stdint.h>

#define DI __device__ __forceinline__
typedef unsigned short bf16_t;
typedef __attribute__((ext_vector_type(8))) short bf16x8;
typedef __attribute__((ext_vector_type(16))) float f32x16;
typedef __attribute__((ext_vector_type(2))) float f32x2;
typedef __attribute__((ext_vector_type(4))) float f32x4;
typedef __attribute__((ext_vector_type(4))) unsigned u32x4;
typedef __attribute__((ext_vector_type(2))) unsigned u32x2;
typedef __attribute__((ext_vector_type(2))) __bf16 bf16x2v;
#define MFMA32(a, b, c) __builtin_amdgcn_mfma_f32_32x32x16_bf16((a), (b), (c), 0, 0, 0)

constexpr int NB = 2, SEQ = 8192, NMETA = 16, L = 8208, T = NB * L, TP = 16512, D = 1024;
constexpr int DIN = 7440, DINP = 7680;
constexpr int LPAD = 8320, NCH = 65, MPAD = 112, LK = 8256;
constexpr int NEXP = 32, CAP = 2 * T, HROWS = 2 * T + NEXP * 256;
constexpr int NT = 256;
constexpr int CSTR = 64;
constexpr float LN_EPS = 1e-5f;
constexpr float NEGF = -1e30f;
constexpr int SMEM_TQ = 65536 + 4096 + 64;
constexpr float ALPHA = 1.41421356237309515f;
constexpr float QSCALE = 0.125f * 1.44269504088896341f;

DI f32x4 mk4(float a, float b, float c, float d) { f32x4 v = {a, b, c, d}; return v; }
DI f32x2 mk2(float a, float b) { f32x2 v = {a, b}; return v; }
DI unsigned pk2(float a, float b) { f32x2 v = {a, b}; bf16x2v r = __builtin_convertvector(v, bf16x2v); return __builtin_bit_cast(unsigned, r); }
DI bf16_t f2bf(float a) { return (bf16_t)(pk2(a, 0.f) & 0xffffu); }
DI float bf2f(bf16_t b) { return __uint_as_float(((unsigned)b) << 16); }
DI float bflo(unsigned u) { return __uint_as_float(u << 16); }
DI float bfhi(unsigned u) { return __uint_as_float(u & 0xffff0000u); }
typedef __attribute__((address_space(3))) int LAS_I;
constexpr int WIDTAB_OFF = 2 * (2 * 32768 + 4096 + 256) + 64;
DI int rtid() {
  const unsigned hw = (unsigned)__builtin_amdgcn_s_getreg((5 << 11) | 4) & 63u;
  const int wid = *(volatile __attribute__((address_space(3))) int*)(size_t)(WIDTAB_OFF + 4 * hw);
  return wid * 64 + (int)__builtin_amdgcn_mbcnt_hi(~0u, __builtin_amdgcn_mbcnt_lo(~0u, 0u));
}
DI int otid() { int t = rtid() & 255; asm volatile("" : "+v"(t)); return t; }
DI int crow(int r, int h) { return (r & 3) + 8 * (r >> 2) + 4 * h; }
DI int keyoff(int r, int h) { return (r & 7) + 8 * h + 16 * (r >> 3); }
DI int swz(int row) { return (row >> 1) & 7; }
DI int kswap(int r) { return (r & 0x13) | ((r & 4) << 1) | ((r & 8) >> 1); }
template <int O> DI float sxor(float v) { return __builtin_bit_cast(float, __builtin_amdgcn_ds_swizzle(__builtin_bit_cast(int, v), 0x1f | (O << 10))); }
DI float sx32(float v) {
  int ln = (int)__builtin_amdgcn_mbcnt_hi(~0u, __builtin_amdgcn_mbcnt_lo(~0u, 0u)); asm volatile("" : "+v"(ln));
  return __builtin_bit_cast(float, __builtin_amdgcn_ds_bpermute((ln ^ 32) << 2, __builtin_bit_cast(int, v)));
}
DI float xsum32(float v) { return v + sx32(v); }
DI float xmax32(float v) { return fmaxf(v, sx32(v)); }
DI float wave_sum(float v) { v = xsum32(v); v += sxor<16>(v); v += sxor<8>(v); v += sxor<4>(v); v += sxor<2>(v); v += sxor<1>(v); return v; }
DI float wave_max(float v) { v = xmax32(v); v = fmaxf(v, sxor<16>(v)); v = fmaxf(v, sxor<8>(v)); v = fmaxf(v, sxor<4>(v)); v = fmaxf(v, sxor<2>(v)); v = fmaxf(v, sxor<1>(v)); return v; }
DI float fexp2(float x) { return __builtin_amdgcn_exp2f(x); }
DI float frcp(float x) { return __builtin_amdgcn_rcpf(x); }
DI float shfl_up_f(float v, int d, int lane) { return __builtin_bit_cast(float, __builtin_amdgcn_ds_bpermute(((lane - d) & 63) << 2, __builtin_bit_cast(int, v))); }
DI float sigmoidf_(float x) { return frcp(1.f + __expf(-x)); }
DI bf16x8 ldfrag(const bf16_t* p) { return *(const bf16x8*)p; }
DI f32x16 zero16() { f32x16 z; _Pragma("unroll") for (int i = 0; i < 16; ++i) z[i] = 0.f; return z; }
DI bf16x8 packfrag(const f32x16& x, int s) {
  union { unsigned u[4]; bf16x8 v; } t;
  t.u[0] = pk2(x[8 * s + 0], x[8 * s + 1]); t.u[1] = pk2(x[8 * s + 2], x[8 * s + 3]);
  t.u[2] = pk2(x[8 * s + 4], x[8 * s + 5]); t.u[3] = pk2(x[8 * s + 6], x[8 * s + 7]);
  return t.v;
}

struct Params {
  const float *x, *meta, *ln_in_g, *ln_in_b, *w_in, *conv_w, *conv_b, *gate_b, *lam_q1, *lam_k1, *lam_q2, *lam_k2;
  const float *diff_g, *sink, *mlstm_g, *w_branch, *w_out, *ln1_g, *ln1_b, *ln2_g, *ln2_b, *w_rg, *b_rg, *w_re, *b_re;
  const float *w_gate, *w_up, *w_down;
  float* out;
  float* h; bf16_t* hb; bf16_t *w_in_t, *w_br_t, *w_out_t; f32x2* cs; float* lam; unsigned* ctl; float* rwp; float* rgb;
  int* counts; int* tok_slot; float* tok_w; int* slot_tok;
  float* mstat;
  float* nvec;
  float* wgt;
  float* bcum;
  float* ligate;
  bf16_t *qa, *ka, *vaT, *qb, *kb, *vbT, *cq, *ck, *cvT, *co, *gz, *qc, *kc, *kcT, *merged;
  float* cg; float* U;
  bf16_t *oa, *ob, *oc;
  bf16_t *w_gu_t, *w_dn_t, *H, *ys;
};

typedef __attribute__((address_space(3))) unsigned lds_u32;
DI void gemm_issue(const bf16_t* (&arow)[4], const bf16_t* (&brow)[4], int koff, char* st, int w) {
  _Pragma("unroll") for (int i = 0; i < 4; ++i) {
    __builtin_amdgcn_global_load_lds((const unsigned*)(arow[i] + koff), (lds_u32*)(st + (4 * i + w) * 1024), 16, 0, 0);
    __builtin_amdgcn_global_load_lds((const unsigned*)(brow[i] + koff), (lds_u32*)(st + 16384 + (4 * i + w) * 1024), 16, 0, 0);
  }
}
DI void gemm_tile(const bf16_t* (&arow)[4], const bf16_t* (&brow)[4], int K, char* smem, f32x16 (&acc)[2][2], int rows = 128) {
  const int tid = otid(), lane = tid & 63, w = tid >> 6, wm = w >> 1, wn = w & 1;
  const int lr = lane & 31, lh = lane >> 5;
  const int cs = ((lane & 7) ^ (4 * (w & 1) + (lane >> 4))) * 8;
  const int nkt = K >> 6;
  const int myrows = rows - wm * 64;
  __syncthreads();
  gemm_issue(arow, brow, cs, smem, w);
  for (int kt = 0; kt < nkt; ++kt) {
    __syncthreads();
    if (kt + 1 < nkt) gemm_issue(arow, brow, (kt + 1) * 64 + cs, smem + ((kt + 1) & 1) * 32768, w);
    const char* sA = smem + (kt & 1) * 32768; const char* sB = sA + 16384;
    if (myrows > 32) {
      bf16x8 a[4][2], b[4][2];
      _Pragma("unroll") for (int ks = 0; ks < 4; ++ks) {
        const int ch = 2 * ks + lh;
        _Pragma("unroll") for (int i = 0; i < 2; ++i) {
          const int rowa = wm * 64 + 32 * i + lr;
          a[ks][i] = *(const bf16x8*)(sA + rowa * 128 + ((ch ^ swz(rowa)) << 4));
          const int rowb = wn * 64 + 32 * i + lr;
          b[ks][i] = *(const bf16x8*)(sB + rowb * 128 + ((ch ^ swz(rowb)) << 4));
        }
      }
      _Pragma("unroll") for (int ks = 0; ks < 4; ++ks)
        _Pragma("unroll") for (int i = 0; i < 2; ++i)
          _Pragma("unroll") for (int j = 0; j < 2; ++j) acc[i][j] = MFMA32(a[ks][i], b[ks][j], acc[i][j]);
    } else if (myrows > 0) {
      _Pragma("unroll") for (int ks = 0; ks < 4; ++ks) {
        const int ch = 2 * ks + lh;
        const int rowa = wm * 64 + lr;
        const bf16x8 a0 = *(const bf16x8*)(sA + rowa * 128 + ((ch ^ swz(rowa)) << 4));
        _Pragma("unroll") for (int j = 0; j < 2; ++j) {
          const int rowb = wn * 64 + 32 * j + lr;
          acc[0][j] = MFMA32(a0, *(const bf16x8*)(sB + rowb * 128 + ((ch ^ swz(rowb)) << 4)), acc[0][j]);
        }
      }
    }
  }
  __syncthreads();
}


namespace g8 {
typedef __attribute__((address_space(3))) unsigned char lds_u8;
typedef float f32x4 __attribute__((ext_vector_type(4)));
constexpr int BK = 64, HALF = 128, HTB = HALF * BK * 2, STAGE_BYTES = 8 * HTB;
DI int lds_byte(int r, int c) { const int st = (r >> 4) * 2 + (c >> 5), rr = r & 15, cc = c & 31, ob = rr * 64 + cc * 2; return st * 1024 + (ob ^ (((ob >> 9) & 1) << 5)); }
DI void stage_rc(int b, int& R, int& C) { const int st = b / 1024, sb = b % 1024, swz = sb ^ (((sb >> 9) & 1) << 5); R = (st >> 1) * 16 + swz / 64; C = (st & 1) * 32 + (swz % 64) / 2; }
DI int perm32(int rho) { const int n = rho >> 4, i = rho & 15; return 8 * (i >> 2) + 4 * n + (i & 3); }
struct Unit { const char* a; const char* b; int pm, pn, tag, x0, x1; };
template <class Epi, class Sched>
DI void gemm_phase(lds_u8* lds, int K, const Sched& S, const Epi& E) {
  int tid = rtid(); asm volatile("" : "+v"(tid));
  const int wid = __builtin_amdgcn_readfirstlane(tid >> 6), lane = tid & 63, wr = wid >> 2, wc = wid & 3, fr = lane & 15, fq = lane >> 4;
  const int nt = K / BK;
  int R[2], C[2]; unsigned voffB[2];
  _Pragma("unroll") for (int i = 0; i < 2; ++i) { stage_rc(tid * 16 + i * 8192, R[i], C[i]); const int Rb = Epi::PERM ? ((R[i] & ~31) + perm32(R[i] & 31)) : R[i]; voffB[i] = (unsigned)(Rb * K + C[i]) * 2u; }
  const size_t kstep = (size_t)(BK * 2), hstep = (size_t)HALF * K * 2;
  const unsigned ldsw = (unsigned)wid * 1024u;
  const int aoff = lds_byte(wr * 64 + fr, fq * 8), boff = lds_byte(wc * 32 + fr, fq * 8);
#define G8_SA(b, h) (((b) * 2 + (h)) * HTB)
#define G8_SB(b, h) ((4 + (b) * 2 + (h)) * HTB)
#define G8_STAGE(bufoff, gbase, voff) do { _Pragma("unroll") for (int _i = 0; _i < 2; ++_i) \
    __builtin_amdgcn_global_load_lds((const unsigned*)((const char*)(gbase) + (voff)[_i]), (lds_u32*)(lds + (bufoff) + ldsw + _i * 8192), 16, 0, 0); } while (0)
#define G8_LDA(dst, b, h) do { _Pragma("unroll") for (int m = 0; m < 4; ++m) _Pragma("unroll") for (int k = 0; k < 2; ++k) dst[m][k] = *(const __attribute__((address_space(3))) bf16x8*)(lds + G8_SA(b, h) + aoff + m * 2048 + k * 1024); } while (0)
#define G8_LDB(dst, b, h) do { _Pragma("unroll") for (int n = 0; n < 2; ++n) _Pragma("unroll") for (int k = 0; k < 2; ++k) dst[n][k] = *(const __attribute__((address_space(3))) bf16x8*)(lds + G8_SB(b, h) + boff + n * 2048 + k * 1024); } while (0)
#define G8_MMA(ai, bj, At, Bt) do { __builtin_amdgcn_s_setprio(1); _Pragma("unroll") for (int m = 0; m < 4; ++m) _Pragma("unroll") for (int n = 0; n < 2; ++n) _Pragma("unroll") for (int k = 0; k < 2; ++k) \
    acc[ai][bj][m][n] = __builtin_amdgcn_mfma_f32_16x16x32_bf16(Bt[n][k], At[m][k], acc[ai][bj][m][n], 0, 0, 0); __builtin_amdgcn_s_setprio(0); } while (0)
#define G8_WAIT_V(n) asm volatile("s_waitcnt vmcnt(" #n ")" ::: "memory")
#define G8_WAIT_L(n) asm volatile("s_waitcnt lgkmcnt(" #n ")" ::: "memory")
#define G8_BAR __builtin_amdgcn_s_barrier()
#define G8_SCHED __builtin_amdgcn_sched_barrier(0)
  Unit cur, nxt; int ui = 0;
  if (!S.next(0, cur)) return;
  f32x4 acc[2][2][4][2];
  _Pragma("unroll") for (int a = 0; a < 2; ++a) _Pragma("unroll") for (int b = 0; b < 2; ++b) _Pragma("unroll") for (int m = 0; m < 4; ++m) _Pragma("unroll") for (int n = 0; n < 2; ++n) acc[a][b][m][n] = (f32x4){0.f, 0.f, 0.f, 0.f};
  bf16x8 At[4][2], B0[2][2], B1[2][2];
  constexpr bool GA = Sched::GATHER;
  unsigned voffA[2]; unsigned cpk[2], npk[2];
  _Pragma("unroll") for (int i = 0; i < 2; ++i) voffA[i] = (unsigned)(R[i] * K + C[i]) * 2u;
  const unsigned gc2 = (unsigned)C[0] * 2u, gk2 = (unsigned)K * 2u;
  if (GA) S.arows(cur, R[0], cpk);
#define G8_STAGE_G(bufoff, base, pk) do { const unsigned _v[2] = { ((pk) & 0xffffu) * gk2 + gc2, ((pk) >> 16) * gk2 + gc2 }; G8_STAGE(bufoff, base, _v); } while (0)
#define G8_STAGE_A(bufoff, base, h, nx) do { if (GA) { if (nx) G8_STAGE_G(bufoff, base, npk[h]); else G8_STAGE_G(bufoff, base, cpk[h]); } else G8_STAGE(bufoff, (base) + (h) * hstep, voffA); } while (0)
  const char* cA = cur.a; const char* cB = cur.b;
  G8_STAGE(G8_SB(0, 0), cB, voffB); G8_STAGE_A(G8_SA(0, 0), cA, 0, false); G8_STAGE(G8_SB(0, 1), cB + hstep, voffB); G8_STAGE_A(G8_SA(0, 1), cA, 1, false);
  if (wr == 1) G8_BAR;
  G8_WAIT_V(4); G8_BAR;
  G8_STAGE(G8_SB(1, 0), cB + kstep, voffB); G8_STAGE_A(G8_SA(1, 0), cA + kstep, 0, false); G8_STAGE(G8_SB(1, 1), cB + hstep + kstep, voffB);
  G8_WAIT_V(6); G8_BAR;
  for (;;) {
    const bool has_next = S.next(ui + 1, nxt);
    const char* nA = has_next ? nxt.a : cA; const char* nB = has_next ? nxt.b : cB;
    if (GA) { if (has_next) S.arows(nxt, R[0], npk); else { npk[0] = cpk[0]; npk[1] = cpk[1]; } }
    for (int t = 0; t < nt; t += 2) {
      const bool last = (t == nt - 2);
      const char* a1 = cA + (size_t)(t + 1) * kstep;
      const char* a2 = last ? nA : cA + (size_t)(t + 2) * kstep; const char* b2 = last ? nB : cB + (size_t)(t + 2) * kstep;
      const char* a3 = a2 + kstep; const char* b3 = b2 + kstep;
      G8_LDB(B0, 0, 0); G8_SCHED; G8_LDA(At, 0, 0); G8_STAGE_A(G8_SA(1, 1), a1, 1, false);
      G8_WAIT_L(8); G8_BAR; G8_WAIT_L(0); G8_MMA(0, 0, At, B0); G8_BAR; G8_SCHED;
      G8_LDB(B1, 0, 1); G8_STAGE(G8_SB(0, 0), b2, voffB);
      G8_BAR; G8_WAIT_L(0); G8_MMA(0, 1, At, B1); G8_BAR;
      G8_LDA(At, 0, 1); G8_STAGE_A(G8_SA(0, 0), a2, 0, last);
      G8_BAR; G8_WAIT_L(0); G8_MMA(1, 0, At, B0); G8_BAR; G8_SCHED;
      G8_STAGE(G8_SB(0, 1), b2 + hstep, voffB);
      G8_WAIT_V(6); G8_BAR; G8_MMA(1, 1, At, B1); G8_BAR;
      G8_LDB(B0, 1, 0); G8_SCHED; G8_LDA(At, 1, 0); G8_STAGE_A(G8_SA(0, 1), a2, 1, last);
      G8_WAIT_L(8); G8_BAR; G8_WAIT_L(0); G8_MMA(0, 0, At, B0); G8_BAR; G8_SCHED;
      G8_LDB(B1, 1, 1); G8_STAGE(G8_SB(1, 0), b3, voffB);
      G8_BAR; G8_WAIT_L(0); G8_MMA(0, 1, At, B1); G8_BAR;
      G8_LDA(At, 1, 1); G8_STAGE_A(G8_SA(1, 0), a3, 0, last);
      G8_BAR; G8_WAIT_L(0); G8_MMA(1, 0, At, B0); G8_BAR; G8_SCHED;
      G8_STAGE(G8_SB(1, 1), b3 + hstep, voffB);
      G8_WAIT_V(6); G8_BAR; G8_MMA(1, 1, At, B1); G8_BAR;
    }
    E(acc, cur, wr, wc, fr, fq);
    if (!has_next) break;
    if (!E.keep(cur)) { _Pragma("unroll") for (int a = 0; a < 2; ++a) _Pragma("unroll") for (int b = 0; b < 2; ++b) _Pragma("unroll") for (int m = 0; m < 4; ++m) _Pragma("unroll") for (int n = 0; n < 2; ++n) acc[a][b][m][n] = (f32x4){0.f, 0.f, 0.f, 0.f}; }
    cur = nxt; cA = nA; cB = nB; ++ui;
    if (GA) { cpk[0] = npk[0]; cpk[1] = npk[1]; }
  }
  G8_WAIT_V(0);
  if (wr == 0) G8_BAR;
  G8_BAR;
#undef G8_SA
#undef G8_SB
#undef G8_STAGE
#undef G8_STAGE_A
#undef G8_STAGE_G
#undef G8_LDA
#undef G8_LDB
#undef G8_MMA
#undef G8_WAIT_V
#undef G8_WAIT_L
#undef G8_BAR
#undef G8_SCHED
}
DI void dense_arows(int K, int R0, int R1, int C0, int C1, unsigned (&vo)[2][2]) {
  vo[0][0] = (unsigned)(R0 * K + C0) * 2u; vo[0][1] = (unsigned)(R1 * K + C1) * 2u;
  vo[1][0] = (unsigned)((128 + R0) * K + C0) * 2u; vo[1][1] = (unsigned)((128 + R1) * K + C1) * 2u;
}
DI void grid_lin(int wgid, int nM, int nN, int& pm, int& pn) {
  const int nwg = nM * nN;
  { const int q = nwg / 8, r = nwg % 8, xcd = wgid % 8, off = wgid / 8; wgid = (xcd < r ? xcd * (q + 1) : r * (q + 1) + (xcd - r) * q) + off; }
  const int nig = 8 * nN, gid = wgid / nig, fm = gid * 8, gsz = (nM - fm) < 8 ? (nM - fm) : 8;
  pm = fm + ((wgid % nig) % gsz); pn = (wgid % nig) / gsz;
}
DI bool grid_unit(int i, int G, int c, int nM, int nN, int& pm, int& pn) {
  const int nwg = nM * nN; const long Lq = (long)i * G + c; if (Lq >= nwg) return false;
  int wgid = (int)Lq; { const int q = nwg / 8, r = nwg % 8, xcd = wgid % 8, off = wgid / 8; wgid = (xcd < r ? xcd * (q + 1) : r * (q + 1) + (xcd - r) * q) + off; }
  const int nig = 8 * nN, gid = wgid / nig, fm = gid * 8, gsz = (nM - fm) < 8 ? (nM - fm) : 8;
  pm = fm + ((wgid % nig) % gsz); pn = (wgid % nig) / gsz; return true;
}
}

DI int ropep(int x) { const int d = x & 63; return (x & ~63) + 8 * ((d & 31) >> 2) + 4 * (d >> 5) + (d & 3); }
DI int wmap(int mode, int n) {
  if (mode == 1) {
    if (n < 512) return ropep(n);
    if (n < 1024) return 512 + ropep(n - 512);
    if (n < 1536) return 6400 + (n - 1024);
    if (n < 2048) return 1024 + ropep(n - 1536);
    if (n < 2176) return 1536 + ropep(n - 2048);
    if (n < 2304) return 6400 + 512 + (n - 2176);
    if (n < 2816) return 1664 + (n - 2304);
    if (n < 3328) return 2176 + (n - 2816);
    if (n < 3840) return 6400 + 640 + (n - 3328);
    if (n < 4352) return 2688 + (n - 3840);
    if (n < 4368) return 6272 + (n - 4352);
    return 3200 + (n - 4368);
  }
  if (mode == 2) return 8 * (n >> 2) + (n & 3);
  if (mode == 3) return 8 * (n >> 2) + 4 + (n & 3);
  return n;
}
struct CvJob { const float* src; bf16_t* dst; int K, N, mode, tk, tn; };
DI void cv_load(const CvJob& j, int tid, f32x4 (&v)[4]) {
  const int kk = tid >> 4, c4 = tid & 15, n = j.tn * 64 + 4 * c4;
  _Pragma("unroll") for (int i = 0; i < 4; ++i) {
    v[i] = mk4(0.f, 0.f, 0.f, 0.f);
    if (n < j.N) v[i] = *(const f32x4*)(j.src + (size_t)(j.tk * 64 + kk + 16 * i) * j.N + n);
  }
}
DI void cv_finish(const CvJob& j, int tid, const f32x4 (&v)[4], char* smem) {
  bf16_t* sT = (bf16_t*)smem;
  const int kk = tid >> 4, c4 = tid & 15;
  __syncthreads();
  _Pragma("unroll") for (int i = 0; i < 4; ++i) {
    const int k = kk + 16 * i;
    sT[(4 * c4 + 0) * 72 + k] = f2bf(v[i].x); sT[(4 * c4 + 1) * 72 + k] = f2bf(v[i].y);
    sT[(4 * c4 + 2) * 72 + k] = f2bf(v[i].z); sT[(4 * c4 + 3) * 72 + k] = f2bf(v[i].w);
  }
  __syncthreads();
  const int nn = tid >> 2, kc = tid & 3;
  const int ng = j.tn * 64 + nn;
  if (ng < j.N) {
    const u32x4 v0 = *(const u32x4*)(sT + nn * 72 + 16 * kc);
    const u32x4 v1 = *(const u32x4*)(sT + nn * 72 + 16 * kc + 8);
    bf16_t* d = j.dst + (size_t)wmap(j.mode, ng) * j.K + j.tk * 64 + 16 * kc;
    *(u32x4*)d = v0; *(u32x4*)(d + 8) = v1;
  }
}

constexpr int WS_TILES_IN = 16 * 117, WS_TILES_BR = 3 * 8 * 16, WS_TILES_OUT = 16 * 16;
constexpr int WS_TILES = WS_TILES_IN + WS_TILES_BR + WS_TILES_OUT;
DI CvJob ws_job(const Params& P, int l, int it) {
  CvJob j;
  if (it < WS_TILES_IN) { j.src = P.w_in + (size_t)l * D * DIN; j.K = D; j.N = DIN; j.dst = P.w_in_t; j.mode = 1; j.tk = it / 117; j.tn = it % 117; }
  else if (it < WS_TILES_IN + WS_TILES_BR) {
    const int q = it - WS_TILES_IN, i = q / 128, r = q % 128;
    j.src = P.w_branch + ((size_t)l * 3 + i) * 512 * 1024; j.K = 512; j.N = 1024; j.dst = P.w_br_t + (size_t)i * 1024 * 512; j.mode = 0; j.tk = r / 16; j.tn = r % 16;
  } else {
    const int q = it - WS_TILES_IN - WS_TILES_BR;
    j.src = P.w_out + (size_t)l * D * D; j.K = D; j.N = D; j.dst = P.w_out_t; j.mode = 0; j.tk = q / 16; j.tn = q % 16;
  }
  return j;
}
DI void phase_wconv_small(const Params& P, int l, char* smem, int bid, int nblk) {
  const int tid = otid();
  if (bid >= WS_TILES) return;
  CvJob j = ws_job(P, l, bid); f32x4 v[4];
  cv_load(j, tid, v);
  for (int it = bid; it < WS_TILES; it += nblk) {
    CvJob jn = j; f32x4 vn[4];
    _Pragma("unroll") for (int i = 0; i < 4; ++i) vn[i] = v[i];
    if (it + nblk < WS_TILES) { jn = ws_job(P, l, it + nblk); cv_load(jn, tid, vn); }
    cv_finish(j, tid, v, smem);
    j = jn;
    _Pragma("unroll") for (int i = 0; i < 4; ++i) v[i] = vn[i];
  }
}
constexpr int WE_TILES = NEXP * 384;
DI CvJob we_job(const Params& P, int l, int it) {
  const int e = it / 384, q = it % 384, which = q / 128, r = q % 128;
  const size_t eo = (size_t)l * NEXP + e;
  CvJob j;
  if (which == 0) { j.src = P.w_gate + eo * 1024 * 512; j.K = 1024; j.N = 512; j.dst = P.w_gu_t + (size_t)e * 1024 * 1024; j.mode = 2; j.tk = r / 8; j.tn = r % 8; }
  else if (which == 1) { j.src = P.w_up + eo * 1024 * 512; j.K = 1024; j.N = 512; j.dst = P.w_gu_t + (size_t)e * 1024 * 1024; j.mode = 3; j.tk = r / 8; j.tn = r % 8; }
  else { j.src = P.w_down + eo * 512 * 1024; j.K = 512; j.N = 1024; j.dst = P.w_dn_t + (size_t)e * 1024 * 512; j.mode = 0; j.tk = r / 16; j.tn = r % 16; }
  return j;
}
DI void phase_wconv_experts(const Params& P, int l, char* smem, int half, volatile __attribute__((address_space(3))) int* wgslot) {
  unsigned* ctr = P.ctl + (l * 8 + 6) * 16;
  const int tid = otid();
  for (;;) {
    __syncthreads();
    if (rtid() == 0) wgslot[0] = (int)__hip_atomic_fetch_add(ctr, 2u, __ATOMIC_RELAXED, __HIP_MEMORY_SCOPE_AGENT);
    __syncthreads();
    const int c0 = (wgslot[0] + half) * 8;
    if (c0 >= WE_TILES) break;
    CvJob j = we_job(P, l, c0); f32x4 v[4];
    cv_load(j, tid, v);
    for (int it = c0; it < c0 + 8; ++it) {
      CvJob jn = j; f32x4 vn[4];
      _Pragma("unroll") for (int i = 0; i < 4; ++i) vn[i] = v[i];
      if (it + 1 < c0 + 8) { jn = we_job(P, l, it + 1); cv_load(jn, tid, vn); }
      cv_finish(j, tid, v, smem);
      j = jn;
      _Pragma("unroll") for (int i = 0; i < 4; ++i) v[i] = vn[i];
    }
  }
}

DI void ln16(f32x4 (&v)[4], const float* g, const float* b, int lane) {
  float s = 0.f;
  _Pragma("unroll") for (int i = 0; i < 4; ++i) s += v[i].x + v[i].y + v[i].z + v[i].w;
  const float mu = wave_sum(s) * (1.f / 1024.f);
  float q = 0.f;
  _Pragma("unroll") for (int i = 0; i < 4; ++i) { v[i].x -= mu; v[i].y -= mu; v[i].z -= mu; v[i].w -= mu; q += v[i].x * v[i].x + v[i].y * v[i].y + v[i].z * v[i].z + v[i].w * v[i].w; }
  const float rs = rsqrtf(wave_sum(q) * (1.f / 1024.f) + LN_EPS);
  _Pragma("unroll") for (int i = 0; i < 4; ++i) {
    const f32x4 gg = ((const f32x4*)g)[lane + 64 * i], bb = ((const f32x4*)b)[lane + 64 * i];
    v[i].x = v[i].x * rs * gg.x + bb.x; v[i].y = v[i].y * rs * gg.y + bb.y; v[i].z = v[i].z * rs * gg.z + bb.z; v[i].w = v[i].w * rs * gg.w + bb.w;
  }
}
DI void store_row(const f32x4 (&v)[4], float* hf, bf16_t* hbf, int lane) {
  _Pragma("unroll") for (int i = 0; i < 4; ++i) {
    if (hf) ((f32x4*)hf)[lane + 64 * i] = v[i];
    if (hbf) { u32x2 u; u.x = pk2(v[i].x, v[i].y); u.y = pk2(v[i].z, v[i].w); ((u32x2*)hbf)[lane + 64 * i] = u; }
  }
}

DI void phase_prologue(const Params& P, int bid, int nblk) {
  const int tid = otid(), gtid = bid * NT + tid, gn = nblk * NT;
  for (int i = gtid; i < L * 32; i += gn) {
    const int pos = i >> 5, f = i & 31;
    const float e = (float)(2 * f) / 64.0f;
    const float pw = (float)pow(10000.0, (double)e);
    const float inv = 1.0f / pw;
    const float ang = (float)pos * inv;
    P.cs[i] = mk2((float)cos((double)ang), (float)sin((double)ang));
  }
  if (gtid < 2) {
    const int l = gtid;
    float s1 = 0.f, s2 = 0.f;
    for (int i = 0; i < 64; ++i) { s1 += P.lam_q1[l * 64 + i] * P.lam_k1[l * 64 + i]; s2 += P.lam_q2[l * 64 + i] * P.lam_k2[l * 64 + i]; }
    const float li = (float)(0.8 - 0.6 * exp(-0.3 * (double)l));
    P.lam[l] = expf(s1) - expf(s2) + li;
    P.lam[2 + l] = (float)(1.0 - (0.8 - 0.6 * exp(-0.3 * (double)l)));
  }
  const int lane = tid & 63, wv = (bid * NT + tid) >> 6, nwv = (nblk * NT) >> 6;
  for (int t = wv; t < T; t += nwv) {
    const int b = t >= L ? 1 : 0, pos = t - b * L;
    const float* src = pos < NMETA ? P.meta + (size_t)pos * D : P.x + ((size_t)b * SEQ + (pos - NMETA)) * D;
    f32x4 v[4];
    _Pragma("unroll") for (int i = 0; i < 4; ++i) v[i] = ((const f32x4*)src)[lane + 64 * i];
    ln16(v, P.ln_in_g, P.ln_in_b, lane);
    store_row(v, P.h + (size_t)t * D, P.hb + (size_t)t * D, lane);
  }
}
DI void phase_zero_pads(const Params& P, int bid, int nblk) {
  const int gtid = bid * NT + otid(), gn = nblk * NT;
  for (int i = gtid; i < 8 * 128 * (LK - L); i += gn) { const int r = i / (LK - L), cidx = i % (LK - L); P.vaT[(size_t)r * LK + L + cidx] = 0; }
  for (int i = gtid; i < 4 * 64 * (LK - L); i += gn) { const int r = i / (LK - L), cidx = i % (LK - L); P.vbT[(size_t)r * LK + L + cidx] = 0; }
  for (int i = gtid; i < 8 * 128 * MPAD; i += gn) { const int r = i / MPAD, cidx = i % MPAD; P.cvT[(size_t)r * LPAD + cidx] = 0; }
  for (int i = gtid; i < 8 * MPAD * 128; i += gn) { const int bh = i / (MPAD * 128), r = i % (MPAD * 128); P.qc[(size_t)bh * LPAD * 128 + r] = 0; P.kc[(size_t)bh * LPAD * 128 + r] = 0; }
  if (gtid < NEXP) P.counts[gtid * CSTR] = 0;
}

constexpr int P1_MT = TP / 128, P1_NT = DINP / 128;
#define WT_FENCE() asm volatile("s_waitcnt lgkmcnt(0)" ::: "memory")
DI void p1_epilogue(const Params& P, int m0, int n0, f32x16 (&acc)[2][2], char* smem) {
  const int tid = otid(), lane = tid & 63, w = tid >> 6, wm = w >> 1, wn = w & 1, lr = lane & 31, lh = lane >> 5;
  const int nw = n0 + wn * 64;
  bf16_t* wt = (bf16_t*)(smem + w * 9216);
  const int mw = m0 + wm * 64;
  int seg;
  if (nw < 512) seg = 0; else if (nw < 1024) seg = 1; else if (nw < 1536) seg = 2; else if (nw < 2048) seg = 3; else if (nw < 2176) seg = 4;
  else if (nw < 2304) seg = 5; else if (nw < 2816) seg = 6; else if (nw < 3328) seg = 7; else if (nw < 3840) seg = 8; else if (nw < 4352) seg = 9;
  else if (nw < 7424) seg = 10; else seg = 11;
  if (seg == 11) {
    _Pragma("unroll") for (int i = 0; i < 2; ++i) _Pragma("unroll") for (int r = 0; r < 16; ++r) {
      const int t = mw + 32 * i + crow(r, lh);
      const int cn = nw + lr - 7424;
      if (t < T && cn < 16) P.cg[(size_t)t * 16 + cn] = acc[i][0][r];
    }
    return;
  }
  if (seg == 0 || seg == 1 || seg == 3 || seg == 4) {
    _Pragma("unroll") for (int i = 0; i < 2; ++i) _Pragma("unroll") for (int r = 0; r < 16; ++r) {
      const int row = 32 * i + crow(r, lh);
      const int t = min(mw + row, T - 1);
      const int pos = t >= L ? t - L : t;
      const f32x2 csv = P.cs[pos * 32 + lr];
      const float x1 = acc[i][0][r], x2 = acc[i][1][r];
      float o1 = x1 * csv.x - x2 * csv.y, o2 = x2 * csv.x + x1 * csv.y;
      if (seg == 0 || seg == 3) { o1 *= QSCALE; o2 *= QSCALE; }
      wt[row * 72 + lr] = f2bf(o1); wt[row * 72 + 32 + lr] = f2bf(o2);
    }
  } else if (seg == 2 || seg == 5 || seg == 8) {
    _Pragma("unroll") for (int i = 0; i < 2; ++i) _Pragma("unroll") for (int j = 0; j < 2; ++j) _Pragma("unroll") for (int rg = 0; rg < 4; ++rg) {
      u32x2 u; u.x = pk2(acc[i][j][4 * rg], acc[i][j][4 * rg + 1]); u.y = pk2(acc[i][j][4 * rg + 2], acc[i][j][4 * rg + 3]);
      *(u32x2*)(wt + (32 * j + lr) * 72 + 32 * i + 8 * rg + 4 * lh) = u;
    }
  } else if (seg == 10) {
    _Pragma("unroll") for (int i = 0; i < 2; ++i) _Pragma("unroll") for (int j = 0; j < 2; ++j) _Pragma("unroll") for (int r = 0; r < 16; ++r)
      wt[(32 * i + crow(r, lh)) * 72 + 32 * j + lr] = f2bf(fmaxf(sigmoidf_(acc[i][j][r]), 1e-12f));
  } else {
    _Pragma("unroll") for (int i = 0; i < 2; ++i) _Pragma("unroll") for (int j = 0; j < 2; ++j) _Pragma("unroll") for (int r = 0; r < 16; ++r)
      wt[(32 * i + crow(r, lh)) * 72 + 32 * j + lr] = f2bf(acc[i][j][r]);
  }
  WT_FENCE();
  _Pragma("unroll") for (int it = 0; it < 8; ++it) {
    const int id = it * 64 + lane, row = id >> 3, ch = id & 7;
    const u32x4 v = *(const u32x4*)(wt + row * 72 + ch * 8);
    if (seg == 2 || seg == 5 || seg == 8) {
      const int t0 = mw + ch * 8;
      if (t0 < T) {
        const int b = t0 >= L ? 1 : 0, pos0 = t0 - b * L;
        bf16_t* dst;
        if (seg == 2) { const int cc = nw - 1024 + row; dst = P.vaT + ((size_t)(b * 4 + (cc >> 7)) * 128 + (cc & 127)) * LK + pos0; }
        else if (seg == 5) { const int cc = nw - 2176 + row; dst = P.vbT + ((size_t)(b * 2 + (cc >> 6)) * 64 + (cc & 63)) * LK + pos0; }
        else { const int cc = nw - 3328 + row; dst = P.cvT + ((size_t)(b * 4 + (cc >> 7)) * 128 + (cc & 127)) * LPAD + MPAD + pos0; }
        *(u32x4*)dst = v;
      }
    } else {
      const int t = mw + row;
      if (t < T) {
        const int b = t >= L ? 1 : 0, pos = t - b * L;
        bf16_t* dst;
        if (seg == 0) { const int u = nw >> 6; dst = P.qa + ((size_t)((b * 4 + (u >> 1)) * 2 + (u & 1)) * L + pos) * 64; }
        else if (seg == 1) { const int u = (nw - 512) >> 6; dst = P.ka + ((size_t)((b * 4 + (u >> 1)) * 2 + (u & 1)) * L + pos) * 64; }
        else if (seg == 3) { const int hq = (nw - 1536) >> 6; dst = P.qb + ((size_t)(b * 8 + hq) * L + pos) * 64; }
        else if (seg == 4) { const int kv = (nw - 2048) >> 6; dst = P.kb + ((size_t)(b * 2 + kv) * L + pos) * 64; }
        else if (seg == 6) dst = P.cq + (size_t)t * 512 + nw - 2304;
        else if (seg == 7) dst = P.ck + (size_t)t * 512 + nw - 2816;
        else if (seg == 9) dst = P.co + (size_t)t * 512 + nw - 3840;
        else dst = P.gz + (size_t)t * 3072 + nw - 4352;
        *(u32x4*)(dst + ch * 8) = v;
      }
    }
  }
}
DI float logsigmoidf_(float x) { return fminf(x, 0.f) - log1pf(__expf(-fabsf(x))); }
DI void phase_mprep(const Params& P, int l, char* smem, int bid, int nblk) {
  const int tid = otid();
  float* sli = (float*)smem;
  float* slf = sli + 256;
  float* sb = slf + 256;
  float* sw = sb + 256;
  float* sred = sw + 256;
  float* sst = sred + 16 * 256;
  for (int it = bid; it < 8 * NCH; it += nblk) {
    const int bh = it < 8 * (NCH - 1) ? it / (NCH - 1) : it - 8 * (NCH - 1), n = it < 8 * (NCH - 1) ? 1 + it % (NCH - 1) : 0, b = bh >> 2, hh = bh & 3;
    __syncthreads();
    if (tid < 128) {
      const int p = 128 * n + tid, pos = p - MPAD;
      float lif = NEGF, lff = 0.f, lib = NEGF, lfb = 0.f;
      if (pos >= 0) {
        const float* g = P.cg + (size_t)(b * L + pos) * 16;
        const float* gb = P.gate_b + l * 16;
        lif = g[0 + hh] + gb[0 + hh]; lff = logsigmoidf_(g[4 + hh] + gb[4 + hh]);
        lib = g[8 + hh] + gb[8 + hh]; lfb = logsigmoidf_(g[12 + hh] + gb[12 + hh]);
      }
      sli[tid] = lif; sli[128 + tid] = lib; slf[tid] = lff; slf[128 + tid] = lfb;
    }
    __syncthreads();
    if (tid < 128) {
      const int t2 = otid(), wd = t2 >> 6, ln = t2 & 63;
      const int i0 = wd == 0 ? 2 * ln : 127 - 2 * ln, i1 = wd == 0 ? 2 * ln + 1 : 126 - 2 * ln;
      const float e0 = slf[wd * 128 + i0], e1 = slf[wd * 128 + i1];
      float scan = e0 + e1;
      _Pragma("unroll") for (int d = 1; d < 64; d <<= 1) { const float tt = shfl_up_f(scan, d, ln); if (ln >= d) scan += tt; }
      float excl = shfl_up_f(scan, 1, ln); if (ln == 0) excl = 0.f;
      sb[wd * 128 + i0] = excl + e0; sb[wd * 128 + i1] = excl + e0 + e1;
    }
    __syncthreads();
    if (tid < 128) {
      const int dir = tid >> 6, lane = tid & 63;
      const float g = dir == 0 ? sb[127] : sb[128];
      const float a0 = g - sb[dir * 128 + lane] + sli[dir * 128 + lane];
      const float a1 = g - sb[dir * 128 + lane + 64] + sli[dir * 128 + lane + 64];
      const float am = wave_max(fmaxf(a0, a1));
      const float w0 = __expf(a0 - am), w1 = __expf(a1 - am);
      sw[dir * 128 + lane] = w0; sw[dir * 128 + lane + 64] = w1;
      const size_t base = ((size_t)dir * 8 + bh) * LPAD + 128 * n;
      P.wgt[base + lane] = w0; P.wgt[base + lane + 64] = w1;
      P.bcum[base + lane] = sb[dir * 128 + lane]; P.bcum[base + lane + 64] = sb[dir * 128 + lane + 64];
      P.ligate[base + lane] = sli[dir * 128 + lane]; P.ligate[base + lane + 64] = sli[dir * 128 + lane + 64];
      if (lane == 0) { float* ms = P.mstat + ((size_t)(dir * 8 + bh) * NCH + n) * 4; ms[0] = g; ms[1] = am; }
    }
    __syncthreads();
    bf16_t* skT = (bf16_t*)(smem + 32768);
    if (n == 0) { for (int i = tid; i < 128 * MPAD; i += NT) skT[(i / MPAD) * 136 + (i % MPAD)] = 0; }
    const int tid3 = otid();
    const int dg = tid3 & 15, tl = tid3 >> 4;
    float nf[8], nbk[8];
    _Pragma("unroll") for (int j = 0; j < 8; ++j) { nf[j] = 0.f; nbk[j] = 0.f; }
    const int ch = hh * 128 + dg * 8;
    float cw[2][3][8], cb[2][8];
    _Pragma("unroll") for (int j = 0; j < 8; ++j) {
      _Pragma("unroll") for (int ww = 0; ww < 3; ++ww) { cw[0][ww][j] = P.conv_w[((size_t)l * 3 + ww) * 1024 + ch + j]; cw[1][ww][j] = P.conv_w[((size_t)l * 3 + ww) * 1024 + 512 + ch + j]; }
      cb[0][j] = P.conv_b[l * 1024 + ch + j]; cb[1][j] = P.conv_b[l * 1024 + 512 + ch + j];
    }
    _Pragma("unroll 1") for (int hb4 = 0; hb4 < 8; hb4 += 4) {
      u32x4 uq[4][3], uk[4][3];
      _Pragma("unroll") for (int i4 = 0; i4 < 4; ++i4) {
        const int pos = 128 * n + tl + 16 * (hb4 + i4) - MPAD;
        _Pragma("unroll") for (int ww = 0; ww < 3; ++ww) {
          const int pp = min(max(pos + ww - 1, 0), L - 1);
          uq[i4][ww] = *(const u32x4*)(P.cq + (size_t)(b * L + pp) * 512 + ch);
          uk[i4][ww] = *(const u32x4*)(P.ck + (size_t)(b * L + pp) * 512 + ch);
        }
      }
      __builtin_amdgcn_sched_barrier(0);
      _Pragma("unroll") for (int i4 = 0; i4 < 4; ++i4) {
        const int tau = tl + 16 * (hb4 + i4), p = 128 * n + tau, pos = p - MPAD;
        float q[8], k[8];
        _Pragma("unroll") for (int j = 0; j < 8; ++j) { q[j] = cb[0][j]; k[j] = cb[1][j]; }
        _Pragma("unroll") for (int ww = 0; ww < 3; ++ww) {
          const int pp = pos + ww - 1;
          const float vm = (pp >= 0 && pp < L) ? 1.f : 0.f;
          const unsigned aq[4] = {uq[i4][ww].x, uq[i4][ww].y, uq[i4][ww].z, uq[i4][ww].w}, ak[4] = {uk[i4][ww].x, uk[i4][ww].y, uk[i4][ww].z, uk[i4][ww].w};
          _Pragma("unroll") for (int j = 0; j < 4; ++j) {
            q[2 * j] += bflo(aq[j]) * (cw[0][ww][2 * j] * vm); q[2 * j + 1] += bfhi(aq[j]) * (cw[0][ww][2 * j + 1] * vm);
            k[2 * j] += bflo(ak[j]) * (cw[1][ww][2 * j] * vm); k[2 * j + 1] += bfhi(ak[j]) * (cw[1][ww][2 * j + 1] * vm);
          }
        }
        const float wf = sw[tau], wb = sw[128 + tau];
        _Pragma("unroll") for (int j = 0; j < 8; ++j) {
          q[j] = q[j] * sigmoidf_(q[j]);
          k[j] = k[j] * sigmoidf_(k[j]) * 0.08838834764831845f;
          nf[j] += wf * k[j]; nbk[j] += wb * k[j];
        }
        if (pos >= 0) {
          u32x4 oq, ok;
          oq.x = pk2(q[0], q[1]); oq.y = pk2(q[2], q[3]); oq.z = pk2(q[4], q[5]); oq.w = pk2(q[6], q[7]);
          ok.x = pk2(k[0], k[1]); ok.y = pk2(k[2], k[3]); ok.z = pk2(k[4], k[5]); ok.w = pk2(k[6], k[7]);
          *(u32x4*)(P.qc + ((size_t)bh * LPAD + p) * 128 + dg * 8) = oq;
          *(u32x4*)(P.kc + ((size_t)bh * LPAD + p) * 128 + dg * 8) = ok;
          _Pragma("unroll") for (int j = 0; j < 8; ++j) skT[(dg * 8 + j) * 136 + tau] = f2bf(k[j]);
        }
      }
    }
    _Pragma("unroll") for (int j = 0; j < 8; ++j) { sred[tl * 256 + dg * 8 + j] = nf[j]; sred[tl * 256 + 128 + dg * 8 + j] = nbk[j]; }
    __syncthreads();
    {
      const int tid2 = otid();
      const int lane = tid2 & 63, w = tid2 >> 6, wi = w >> 1, wj = w & 1, lr = lane & 31, lh = lane >> 5;
      unsigned vo = (unsigned)((bh * 128 + 64 * wi + lr) * LPAD + 128 * n + 8 * lh);
      asm volatile("" : "+v"(vo));
      _Pragma("unroll 1") for (int dir = 0; dir < 2; ++dir) {
        f32x16 acc[2][2];
        _Pragma("unroll") for (int i = 0; i < 2; ++i) _Pragma("unroll") for (int j = 0; j < 2; ++j) acc[i][j] = zero16();
        unsigned koff = (unsigned)((64 * wj + lr) * 136 + 8 * lh);
        asm volatile("" : "+v"(koff));
        _Pragma("unroll") for (int ks = 0; ks < 8; ++ks) {
          if (n == 0 && ks < 7) continue;
          const int tau = 16 * ks + 8 * lh;
          const f32x4 w0 = *(const f32x4*)(sw + dir * 128 + tau), w1 = *(const f32x4*)(sw + dir * 128 + tau + 4);
          bf16x8 bq[2];
          _Pragma("unroll") for (int i = 0; i < 2; ++i) {
            const u32x4 kr = *(const u32x4*)(skT + koff + (32 * i) * 136 + 16 * ks);
            union { unsigned u[4]; bf16x8 v; } tt;
            tt.u[0] = pk2(bflo(kr.x) * w0.x, bfhi(kr.x) * w0.y); tt.u[1] = pk2(bflo(kr.y) * w0.z, bfhi(kr.y) * w0.w);
            tt.u[2] = pk2(bflo(kr.z) * w1.x, bfhi(kr.z) * w1.y); tt.u[3] = pk2(bflo(kr.w) * w1.z, bfhi(kr.w) * w1.w);
            bq[i] = tt.v;
          }
          bf16x8 af[2];
          _Pragma("unroll") for (int i = 0; i < 2; ++i) af[i] = ldfrag(P.cvT + vo + (unsigned)(32 * i) * LPAD + 16 * ks);
          _Pragma("unroll") for (int i = 0; i < 2; ++i) _Pragma("unroll") for (int j = 0; j < 2; ++j) acc[i][j] = MFMA32(af[i], bq[j], acc[i][j]);
        }
        float* U = P.U + ((size_t)(dir * 8 + bh) * NCH + n) * 16384;
        _Pragma("unroll") for (int i = 0; i < 2; ++i) _Pragma("unroll") for (int j = 0; j < 2; ++j) _Pragma("unroll") for (int r = 0; r < 16; ++r)
          U[(64 * wi + 32 * i + crow(r, lh)) * 128 + 64 * wj + 32 * j + lr] = acc[i][j][r];
      }
    }
    {
      float s = 0.f;
      _Pragma("unroll") for (int i = 0; i < 16; ++i) s += sred[i * 256 + tid];
      const int dir = tid >> 7, dk = tid & 127;
      P.nvec[((size_t)(dir * 8 + bh) * NCH + n) * 128 + dk] = s;
    }
  }
}

DI void phase_mscan(const Params& P, int bid, int nblk) {
  for (int gt = bid * NT + otid(); gt < 16 * 4096 + 256; gt += nblk * NT) {
    if (gt < 16 * 4096) {
      const int seq = gt >> 12, e = gt & 4095, dir = seq >> 3;
      float C[4] = {0.f, 0.f, 0.f, 0.f};
      float m = 0.f;
      _Pragma("unroll") for (int hb = 0; hb < 3; ++hb) {
        constexpr int SBm = 22;
        const int sb = hb * SBm, cnt = hb < 2 ? SBm : NCH - 2 * SBm;
        f32x4 u0[SBm]; float gg[SBm], aa[SBm];
        _Pragma("unroll") for (int k = 0; k < SBm; ++k) if (k < cnt) {
          const int n = dir == 0 ? sb + k : NCH - 1 - sb - k;
          const size_t item = (size_t)seq * NCH + n;
          u0[k] = *(const f32x4*)(P.U + item * 16384 + e * 4);
          gg[k] = P.mstat[item * 4]; aa[k] = P.mstat[item * 4 + 1];
        }
        asm volatile("s_waitcnt vmcnt(0)" ::: "memory");
        _Pragma("unroll") for (int k = 0; k < SBm; ++k) if (k < cnt) {
          const int n = dir == 0 ? sb + k : NCH - 1 - sb - k;
          const size_t item = (size_t)seq * NCH + n;
          const float mn = fmaxf(gg[k] + m, aa[k]);
          const float decay = __expf(gg[k] + m - mn), f = __expf(aa[k] - mn);
          u32x2 cb; cb.x = pk2(C[0], C[1]); cb.y = pk2(C[2], C[3]);
          *(u32x2*)((char*)(P.U + item * 16384) + (size_t)(e >> 1) * 32 + (e & 1) * 8) = cb;
          C[0] = decay * C[0] + f * u0[k].x; C[1] = decay * C[1] + f * u0[k].y; C[2] = decay * C[2] + f * u0[k].z; C[3] = decay * C[3] + f * u0[k].w;
          m = mn;
        }
      }
    } else {
      constexpr int SB = 13;
      const int q = gt - 16 * 4096, seq = q >> 4, e = q & 15, dir = seq >> 3;
      float nst[8];
      _Pragma("unroll") for (int j = 0; j < 8; ++j) nst[j] = 0.f;
      float m = 0.f;
      for (int sb = 0; sb < NCH; sb += SB) {
        f32x4 n0[SB], n1[SB]; float gg[SB], aa[SB];
        _Pragma("unroll") for (int k = 0; k < SB; ++k) {
          const int n = dir == 0 ? sb + k : NCH - 1 - sb - k;
          const size_t item = (size_t)seq * NCH + n;
          const float* np = P.nvec + item * 128 + e * 8;
          n0[k] = *(const f32x4*)np; n1[k] = *(const f32x4*)(np + 4);
          gg[k] = P.mstat[item * 4]; aa[k] = P.mstat[item * 4 + 1];
        }
        _Pragma("unroll") for (int k = 0; k < SB; ++k) {
          const int n = dir == 0 ? sb + k : NCH - 1 - sb - k;
          const size_t item = (size_t)seq * NCH + n;
          const float mn = fmaxf(gg[k] + m, aa[k]);
          const float decay = __expf(gg[k] + m - mn), f = __expf(aa[k] - mn);
          float* np = P.nvec + item * 128 + e * 8;
          *(f32x4*)np = mk4(nst[0], nst[1], nst[2], nst[3]); *(f32x4*)(np + 4) = mk4(nst[4], nst[5], nst[6], nst[7]);
          nst[0] = decay * nst[0] + f * n0[k].x; nst[1] = decay * nst[1] + f * n0[k].y; nst[2] = decay * nst[2] + f * n0[k].z; nst[3] = decay * nst[3] + f * n0[k].w;
          nst[4] = decay * nst[4] + f * n1[k].x; nst[5] = decay * nst[5] + f * n1[k].y; nst[6] = decay * nst[6] + f * n1[k].z; nst[7] = decay * nst[7] + f * n1[k].w;
          if (e == 0) P.mstat[item * 4 + 2] = m;
          m = mn;
        }
      }
    }
  }
}
DI void mout_item(const Params& P, int l, int it, char* smem) {
  const int tid = otid(), lane = tid & 63, w = tid >> 6, lr = lane & 31, lh = lane >> 5;
  const int bh = it / NCH, n = it % NCH, b = bh >> 2, hh = bh & 3;
  char* sK = smem;
  char* sV = smem + 32768;
  float* sb = (float*)(smem + 65536);
  float* sc = sb + 256;
  float* spm = sc + 256;
  float* snp = spm + 256;
  __syncthreads();
  {
    const int rin = lane >> 4, cpos = lane & 15;
    _Pragma("unroll") for (int i = 0; i < 16; ++i) {
      const int dir = i >> 3, R = (i & 7) * 4 + w, row = 4 * R + rin;
      const char* src = (const char*)(P.U + ((size_t)(dir * 8 + bh) * NCH + n) * 16384) + (size_t)row * 512 + (cpos ^ (row & 15)) * 32;
      __builtin_amdgcn_global_load_lds((const unsigned*)src, (lds_u32*)(smem + dir * 32768 + R * 1024), 16, 0, 0);
    }
  }
  {
    const int dir = tid >> 7, tau = tid & 127;
    const size_t base = ((size_t)dir * 8 + bh) * LPAD + 128 * n + tau;
    const float bb = P.bcum[base], li = P.ligate[base];
    sb[tid] = bb; sc[tid] = li - bb;
    snp[tid] = P.nvec[((size_t)(dir * 8 + bh) * NCH + n) * 128 + tau];
  }
  __syncthreads();
  if (w < 2) {
    const int i0 = w == 0 ? 2 * lane : 127 - 2 * lane, i1 = w == 0 ? 2 * lane + 1 : 126 - 2 * lane;
    const float e0 = sc[w * 128 + i0], e1 = sc[w * 128 + i1];
    const float p1 = fmaxf(e0, e1);
    float scan = p1;
    _Pragma("unroll") for (int d = 1; d < 64; d <<= 1) { const float tt = shfl_up_f(scan, d, lane); if (lane >= d) scan = fmaxf(scan, tt); }
    float excl = shfl_up_f(scan, 1, lane); if (lane == 0) excl = -3.0e38f;
    spm[w * 128 + i0] = fmaxf(excl, e0); spm[w * 128 + i1] = fmaxf(excl, p1);
  }
  __syncthreads();
  const int t = 32 * w + lr, p = 128 * n + t;
  bf16x8 qf[8];
  _Pragma("unroll") for (int ks = 0; ks < 8; ++ks) qf[ks] = ldfrag(P.qc + ((size_t)bh * LPAD + p) * 128 + 16 * ks + 8 * lh);
  f32x16 acc[2][4];
  float btv[2], mtv[2], den0[2];
  _Pragma("unroll") for (int dir = 0; dir < 2; ++dir) {
    const size_t item = (size_t)(dir * 8 + bh) * NCH + n;
    const float mprev = P.mstat[item * 4 + 2];
    const float bt = sb[dir * 128 + t];
    const float mt = bt + fmaxf(mprev, spm[dir * 128 + t]);
    const float inter = __expf(bt + mprev - mt);
    float qn = 0.f;
    _Pragma("unroll") for (int ks = 0; ks < 8; ++ks) {
      union { bf16x8 v; unsigned u[4]; } tt; tt.v = qf[ks];
      const float* np = snp + dir * 128 + 16 * ks + 8 * lh;
      _Pragma("unroll") for (int j = 0; j < 4; ++j) qn += bflo(tt.u[j]) * np[2 * j] + bfhi(tt.u[j]) * np[2 * j + 1];
    }
    qn = xsum32(qn);
    btv[dir] = bt; mtv[dir] = mt; den0[dir] = inter * qn;
    const char* sU = smem + dir * 32768;
    _Pragma("unroll") for (int d = 0; d < 4; ++d) {
      const int urow = 32 * d + lr;
      acc[dir][d] = zero16();
      _Pragma("unroll") for (int ks = 0; ks < 8; ++ks) acc[dir][d] = MFMA32(*(const bf16x8*)(sU + urow * 256 + (((2 * ks + lh) ^ (urow & 15)) << 4)), qf[ks], acc[dir][d]);
      _Pragma("unroll") for (int r = 0; r < 16; ++r) acc[dir][d][r] *= inter;
    }
  }
  __syncthreads();
  {
    const int rin = lane >> 4, cpos = lane & 15;
    _Pragma("unroll") for (int i = 0; i < 16; ++i) {
      const int R = i * 4 + w, row = (i < 8 ? 4 * R : 4 * (R - 32)) + rin;
      const int ce = (cpos ^ (row & 15)) * 8;
      const bf16_t* src = i < 8 ? P.kc + ((size_t)bh * LPAD + 128 * n + row) * 128 + ce : P.cvT + ((size_t)bh * 128 + row) * LPAD + 128 * n + ce;
      __builtin_amdgcn_global_load_lds((const unsigned*)src, (lds_u32*)(smem + R * 1024), 16, 0, 0);
    }
  }
  __syncthreads();
  _Pragma("unroll") for (int dir = 0; dir < 2; ++dir) {
    const float bt = btv[dir], mt = mtv[dir];
    float den = 0.f;
    const int st0 = dir == 0 ? 0 : w, st1 = dir == 0 ? w : 3;
    for (int st = st0; st <= st1; ++st) {
      f32x16 s = zero16();
      _Pragma("unroll") for (int ks = 0; ks < 8; ++ks) {
        const int krow = 32 * st + kswap(lr);
        s = MFMA32(*(const bf16x8*)(sK + krow * 256 + (((2 * ks + lh) ^ (krow & 15)) << 4)), qf[ks], s);
      }
      _Pragma("unroll") for (int r = 0; r < 16; ++r) {
        const int sidx = 32 * st + keyoff(r, lh);
        const bool ok = dir == 0 ? (sidx <= t) : (sidx >= t);
        const float dd = __expf(fminf(bt + sc[dir * 128 + sidx] - mt, 0.f));
        const float pv = ok ? s[r] * dd : 0.f;
        s[r] = pv; den += pv;
      }
      const bf16x8 p0 = packfrag(s, 0), p1 = packfrag(s, 1);
      _Pragma("unroll") for (int d = 0; d < 4; ++d) {
        const int vrow = 32 * d + lr;
        const char* vp = sV + vrow * 256;
        acc[dir][d] = MFMA32(*(const bf16x8*)(vp + (((4 * st + lh) ^ (vrow & 15)) << 4)), p0, acc[dir][d]);
        acc[dir][d] = MFMA32(*(const bf16x8*)(vp + (((4 * st + 2 + lh) ^ (vrow & 15)) << 4)), p1, acc[dir][d]);
      }
    }
    den = xsum32(den);
    den = den0[dir] + den;
    const float sca = frcp(fmaxf(fabsf(den), __expf(-mt)));
    _Pragma("unroll") for (int d = 0; d < 4; ++d) _Pragma("unroll") for (int r = 0; r < 16; ++r) acc[dir][d][r] *= sca;
  }
  float hacc[4][16];
  _Pragma("unroll") for (int d = 0; d < 4; ++d) _Pragma("unroll") for (int r = 0; r < 16; ++r) hacc[d][r] = acc[0][d][r] + acc[1][d][r];
  float s1 = 0.f;
  _Pragma("unroll") for (int d = 0; d < 4; ++d) _Pragma("unroll") for (int r = 0; r < 16; ++r) s1 += hacc[d][r];
  s1 = xsum32(s1);
  const float mu = s1 * (1.f / 128.f);
  float s2 = 0.f;
  _Pragma("unroll") for (int d = 0; d < 4; ++d) _Pragma("unroll") for (int r = 0; r < 16; ++r) { hacc[d][r] -= mu; s2 += hacc[d][r] * hacc[d][r]; }
  s2 = xsum32(s2);
  const float rs = rsqrtf(s2 * (1.f / 128.f) + LN_EPS);
  const int pos = p - MPAD;
  if (pos >= 0) {
    const size_t tok = (size_t)b * L + pos;
    _Pragma("unroll") for (int d = 0; d < 4; ++d) _Pragma("unroll") for (int rg = 0; rg < 4; ++rg) {
      const int dv = 32 * d + 8 * rg + 4 * lh;
      const int col = hh * 128 + dv;
      const u32x2 cu = *(const u32x2*)(P.co + tok * 512 + col);
      const f32x4 g4 = *(const f32x4*)(P.mlstm_g + l * 512 + col);
      const float o0 = hacc[d][4 * rg + 0] * rs * g4.x * sigmoidf_(bflo(cu.x));
      const float o1 = hacc[d][4 * rg + 1] * rs * g4.y * sigmoidf_(bfhi(cu.x));
      const float o2 = hacc[d][4 * rg + 2] * rs * g4.z * sigmoidf_(bflo(cu.y));
      const float o3 = hacc[d][4 * rg + 3] * rs * g4.w * sigmoidf_(bfhi(cu.y));
      u32x2 ou; ou.x = pk2(o0, o1); ou.y = pk2(o2, o3);
      *(u32x2*)(P.oc + tok * 512 + col) = ou;
    }
  }
}

constexpr int DA_STAGE = 32768;
constexpr float DA_THR = 8.f;
DI void dattn_issue(const Params& P, int bh, int k0, char* stage, unsigned vk, unsigned vv, int w) {
  const char* kb0 = (const char*)(P.ka + ((size_t)(bh * 2) * L + k0) * 64);
  const char* vb0 = (const char*)(P.vaT + (size_t)bh * 128 * LK + k0);
  _Pragma("unroll") for (int i = 0; i < 8; ++i) {
    const char* src = i < 4 ? kb0 + (size_t)(i >> 1) * (L * 128) + (i & 1) * 4096 + vk : vb0 + (size_t)(i - 4) * 32 * LK * 2 + vv;
    __builtin_amdgcn_global_load_lds((const unsigned*)src, (lds_u32*)(stage + (i * 4 + w) * 1024), 16, 0, 0);
  }
}
DI void dattn_merge4(f32x16 (&O)[2][4], float (&m)[2], float (&ls)[2], char* smem, int lane, int w) {
  float* xf = (float*)smem;
  for (int src = 1; src < 4; ++src) {
    __syncthreads();
    if (w == src) {
      _Pragma("unroll") for (int c = 0; c < 2; ++c) {
        _Pragma("unroll") for (int d = 0; d < 4; ++d) _Pragma("unroll") for (int r = 0; r < 16; ++r) xf[((c * 4 + d) * 16 + r) * 64 + lane] = O[c][d][r];
        xf[8192 + c * 64 + lane] = m[c]; xf[8192 + 128 + c * 64 + lane] = ls[c];
      }
    }
    __syncthreads();
    if (w == 0) {
      _Pragma("unroll") for (int c = 0; c < 2; ++c) {
        const float mb = xf[8192 + c * 64 + lane], lb = xf[8192 + 128 + c * 64 + lane];
        const float M = fmaxf(m[c], mb), fa = fexp2(m[c] - M), fb = fexp2(mb - M);
        ls[c] = ls[c] * fa + lb * fb; m[c] = M;
        _Pragma("unroll") for (int d = 0; d < 4; ++d) _Pragma("unroll") for (int r = 0; r < 16; ++r) O[c][d][r] = O[c][d][r] * fa + xf[((c * 4 + d) * 16 + r) * 64 + lane] * fb;
      }
    }
  }
}
DI void dattn_finish(const Params& P, int l, int bh, int q0, f32x16 (&O)[2][4], const float (&ls)[2], int lr, int lh) {
  const int b = bh >> 2, hh = bh & 3;
  const float lam = P.lam[l], omli = P.lam[2 + l];
  const float i0 = 1.f / ls[0], i1 = lam / ls[1];
  float ss = 0.f;
  _Pragma("unroll") for (int d = 0; d < 4; ++d) _Pragma("unroll") for (int r = 0; r < 16; ++r) { const float o = O[0][d][r] * i0 - O[1][d][r] * i1; O[0][d][r] = o; ss += o * o; }
  ss = xsum32(ss);
  const float rs = rsqrtf(ss * (1.f / 128.f) + LN_EPS);
  if (q0 + lr < L) {
    const size_t tok = (size_t)b * L + q0 + lr;
    _Pragma("unroll") for (int d = 0; d < 4; ++d) _Pragma("unroll") for (int rg = 0; rg < 4; ++rg) {
      const int dv = 32 * d + 8 * rg + 4 * lh;
      const f32x4 g4 = *(const f32x4*)(P.diff_g + l * 128 + dv);
      u32x2 ou;
      ou.x = pk2(O[0][d][4 * rg + 0] * rs * g4.x * omli, O[0][d][4 * rg + 1] * rs * g4.y * omli);
      ou.y = pk2(O[0][d][4 * rg + 2] * rs * g4.z * omli, O[0][d][4 * rg + 3] * rs * g4.w * omli);
      *(u32x2*)(P.oa + tok * 512 + hh * 128 + dv) = ou;
    }
  }
}
DI void da_softmax(f32x16& s, float& m, float& ls, f32x16 (&O)[4], bool last, int key0, int lh, bf16x8& p0, bf16x8& p1) {
  if (last) {
    asm volatile("; last key tile: mask" ::: "memory");
    _Pragma("unroll") for (int r = 0; r < 16; ++r) if (key0 + keyoff(r, lh) >= L) s[r] = -3.0e38f;
  }
  float mx = s[0];
  _Pragma("unroll") for (int r = 1; r < 16; ++r) mx = fmaxf(mx, s[r]);
  if (__any(mx - m > DA_THR)) {
    asm volatile("; rare: move the softmax reference" ::: "memory");
    const float dlt = fmaxf(xmax32(mx) - m, 0.f);
    const float al = fexp2(-dlt);
    m += dlt; ls *= al;
    _Pragma("unroll") for (int d = 0; d < 4; ++d) _Pragma("unroll") for (int r = 0; r < 16; ++r) O[d][r] *= al;
  }
  f32x2 rs2 = mk2(0.f, 0.f);
  _Pragma("unroll") for (int i = 0; i < 8; ++i) {
    f32x2 x = mk2(s[2 * i], s[2 * i + 1]) - mk2(m, m);
    x.x = fexp2(x.x); x.y = fexp2(x.y);
    s[2 * i] = x.x; s[2 * i + 1] = x.y;
    rs2 += x;
  }
  ls += rs2.x + rs2.y;
  p0 = packfrag(s, 0); p1 = packfrag(s, 1);
}
constexpr int DA_PART = 2 * 4 * 16 * 64 + 256;
DI void dattn_item(const Params& P, int l, int it, bool part, char* smem) {
  const int tid = otid(), lane = tid & 63, w = tid >> 6, lr = lane & 31, lh = lane >> 5;
  const int bh = it & 7, jq = it >> 3;
  const int q0 = part ? 8192 : jq * 128 + 32 * w;
  const int qi = min(q0 + lr, L - 1);
  constexpr int NTILE = (L + 63) / 64;
  const int t0 = part ? 2 * jq : 0, t1 = part ? (jq == 63 ? NTILE : 2 * jq + 2) : NTILE;
  bf16x8 qf[2][4];
  _Pragma("unroll") for (int c = 0; c < 2; ++c) _Pragma("unroll") for (int ks = 0; ks < 4; ++ks)
    qf[c][ks] = ldfrag(P.qa + ((size_t)(bh * 2 + c) * L + qi) * 64 + 16 * ks + 8 * lh);
  f32x16 O[2][4];
  float m[2], ls[2];
  _Pragma("unroll") for (int c = 0; c < 2; ++c) {
    f32x16 s = zero16();
    const bf16_t* kp = P.ka + ((size_t)(bh * 2 + c) * L + t0 * 64 + kswap(lr)) * 64 + 8 * lh;
    _Pragma("unroll") for (int ks = 0; ks < 4; ++ks) s = MFMA32(ldfrag(kp + 16 * ks), qf[c][ks], s);
    float mx = s[0];
    _Pragma("unroll") for (int r = 1; r < 16; ++r) mx = fmaxf(mx, s[r]);
    m[c] = xmax32(mx); ls[c] = 0.f;
    _Pragma("unroll") for (int d = 0; d < 4; ++d) O[c][d] = zero16();
  }
  const unsigned vk = (unsigned)((w * 8 + (lane >> 3)) * 128 + (((lane & 7) ^ (4 * (w & 1) + (lane >> 4))) << 4));
  const unsigned vv = (unsigned)((w * 8 + (lane >> 3)) * (LK * 2) + (((lane & 7) ^ (4 * (w & 1) + (lane >> 4))) << 4));
  __syncthreads();
  dattn_issue(P, bh, t0 * 64, smem + (t0 & 1) * DA_STAGE, vk, vv, w);
  for (int t = t0; t < t1; ++t) {
    __syncthreads();
    if (t + 1 < t1) dattn_issue(P, bh, (t + 1) * 64, smem + ((t + 1) & 1) * DA_STAGE, vk, vv, w);
    const char* st = smem + (t & 1) * DA_STAGE;
    _Pragma("unroll") for (int kb = 0; kb < 2; ++kb) {
      if (part && ((((t - t0) * 2 + kb) & 3) != w)) continue;
      bf16x8 pf[2][2];
      _Pragma("unroll") for (int c = 0; c < 2; ++c) {
        f32x16 s;
        _Pragma("unroll") for (int r = 0; r < 16; ++r) s[r] = -m[c];
        const int krow = kb * 32 + kswap(lr);
        const char* kp = st + c * 8192 + krow * 128;
        _Pragma("unroll") for (int ks = 0; ks < 4; ++ks) s = MFMA32(*(const bf16x8*)(kp + (((2 * ks + lh) ^ swz(krow)) << 4)), qf[c][ks], s);
        if (t == NTILE - 1) {
          _Pragma("unroll") for (int r = 0; r < 16; ++r) if (t * 64 + kb * 32 + keyoff(r, lh) >= L) s[r] = -3.0e38f;
        }
        float mx = s[0];
        _Pragma("unroll") for (int r = 1; r < 16; ++r) mx = fmaxf(mx, s[r]);
        if (__any(mx > DA_THR)) {
          asm volatile("; rare: move the softmax reference" ::: "memory");
          const float dlt = fmaxf(xmax32(mx), 0.f);
          const float al = fexp2(-dlt);
          m[c] += dlt; ls[c] *= al;
          _Pragma("unroll") for (int d = 0; d < 4; ++d) _Pragma("unroll") for (int r = 0; r < 16; ++r) O[c][d][r] *= al;
          _Pragma("unroll") for (int r = 0; r < 16; ++r) s[r] -= dlt;
        }
        float rsum = 0.f;
        _Pragma("unroll") for (int r = 0; r < 16; ++r) { const float pv = fexp2(s[r]); s[r] = pv; rsum += pv; }
        ls[c] += rsum;
        pf[c][0] = packfrag(s, 0); pf[c][1] = packfrag(s, 1);
      }
      _Pragma("unroll") for (int d = 0; d < 4; ++d) {
        const int vrow = 32 * d + lr;
        const char* vp = st + 16384 + vrow * 128;
        const bf16x8 v0 = *(const bf16x8*)(vp + (((kb * 4 + lh) ^ swz(vrow)) << 4));
        const bf16x8 v1 = *(const bf16x8*)(vp + (((kb * 4 + 2 + lh) ^ swz(vrow)) << 4));
        _Pragma("unroll") for (int c = 0; c < 2; ++c) { O[c][d] = MFMA32(v0, pf[c][0], O[c][d]); O[c][d] = MFMA32(v1, pf[c][1], O[c][d]); }
      }
    }
  }
  _Pragma("unroll") for (int c = 0; c < 2; ++c) ls[c] = xsum32(ls[c]);
  if (part) {
    dattn_merge4(O, m, ls, smem, lane, w);
    if (w == 0) {
      float* pb = (float*)P.merged + (size_t)it * DA_PART + lane;
      _Pragma("unroll") for (int c = 0; c < 2; ++c) {
        _Pragma("unroll") for (int d = 0; d < 4; ++d) {
          float* pp = pb + (c * 4 + d) * 1024;
          asm volatile("" : "+v"(pp));
          _Pragma("unroll") for (int r = 0; r < 16; ++r) pp[r * 64] = O[c][d][r];
        }
        pb[8192 + c * 64] = m[c]; pb[8192 + 128 + c * 64] = ls[c];
      }
    }
    return;
  }
  dattn_finish(P, l, bh, q0, O, ls, lr, lh);
}
DI void da_qk(f32x16& s, const char* st, int c, int kb, int lr, int lh, const bf16x8 (&qf)[4]) {
  s = zero16();
  const int krow = kb * 32 + kswap(lr);
  const char* kp = st + c * 8192 + krow * 128;
  _Pragma("unroll") for (int ks = 0; ks < 4; ++ks) s = MFMA32(*(const bf16x8*)(kp + (((2 * ks + lh) ^ swz(krow)) << 4)), qf[ks], s);
}
DI void dattn_item8(const Params& P, int l, int it, char* smem_wg) {
  int tid = rtid(); asm volatile("" : "+v"(tid));
  const int lane = tid & 63, w = __builtin_amdgcn_readfirstlane(tid >> 6), g = w & 3, c = w >> 2, lr = lane & 31, lh = lane >> 5;
  const int bh = it & 7, jq = it >> 3;
  const int q0 = jq * 128 + 32 * g;
  constexpr int NT8 = (L + 127) / 128;
  bf16x8 qf[4];
  _Pragma("unroll") for (int ks = 0; ks < 4; ++ks) qf[ks] = ldfrag(P.qa + ((size_t)(bh * 2 + c) * L + q0 + lr) * 64 + 16 * ks + 8 * lh);
  f32x16 O[4];
  float m, ls = 0.f;
  {
    f32x16 s = zero16();
    const bf16_t* kp = P.ka + ((size_t)(bh * 2 + c) * L + kswap(lr)) * 64 + 8 * lh;
    _Pragma("unroll") for (int ks = 0; ks < 4; ++ks) s = MFMA32(ldfrag(kp + 16 * ks), qf[ks], s);
    float mx = s[0];
    _Pragma("unroll") for (int r = 1; r < 16; ++r) mx = fmaxf(mx, s[r]);
    m = xmax32(mx);
    _Pragma("unroll") for (int d = 0; d < 4; ++d) O[d] = zero16();
  }
  const unsigned vk = (unsigned)((g * 8 + (lane >> 3)) * 128 + (((lane & 7) ^ (4 * (g & 1) + (lane >> 4))) << 4));
  const unsigned vv = (unsigned)((g * 8 + (lane >> 3)) * (LK * 2) + (((lane & 7) ^ (4 * (g & 1) + (lane >> 4))) << 4));
  constexpr int ST8 = 2 * DA_STAGE;
  __syncthreads();
  dattn_issue(P, bh, c * 64, smem_wg + c * DA_STAGE, vk, vv, g);
  for (int t = 0; t < NT8; ++t) {
    __syncthreads();
    if (t + 1 < NT8) dattn_issue(P, bh, (t + 1) * 128 + c * 64, smem_wg + ((t + 1) & 1) * ST8 + c * DA_STAGE, vk, vv, g);
    const char* stt = smem_wg + (t & 1) * ST8;
    f32x16 S[4];
    _Pragma("unroll") for (int b = 0; b < 4; ++b) da_qk(S[b], stt + (b >> 1) * DA_STAGE, c, b & 1, lr, lh, qf);
    if (t == NT8 - 1) {
      asm volatile("; last key tile: mask" ::: "memory");
      _Pragma("unroll") for (int b = 0; b < 4; ++b) _Pragma("unroll") for (int r = 0; r < 16; ++r) if (t * 128 + b * 32 + keyoff(r, lh) >= L) S[b][r] = -3.0e38f;
    }
    float mx = S[0][0];
    _Pragma("unroll") for (int b = 0; b < 4; ++b) _Pragma("unroll") for (int r = 0; r < 16; ++r) mx = fmaxf(mx, S[b][r]);
    if (__any(mx - m > DA_THR)) {
      asm volatile("; rare: move the softmax reference" ::: "memory");
      const float dlt = fmaxf(xmax32(mx) - m, 0.f);
      const float al = fexp2(-dlt);
      m += dlt; ls *= al;
      _Pragma("unroll") for (int d = 0; d < 4; ++d) _Pragma("unroll") for (int r = 0; r < 16; ++r) O[d][r] *= al;
    }
    f32x2 rs2 = mk2(0.f, 0.f);
    const f32x2 mm = mk2(m, m);
    _Pragma("unroll") for (int h2 = 0; h2 < 2; ++h2) {
      bf16x8 pf[2][2];
      _Pragma("unroll") for (int kb = 0; kb < 2; ++kb) {
        f32x16& s = S[2 * h2 + kb];
        _Pragma("unroll") for (int i = 0; i < 8; ++i) {
          f32x2 x = mk2(s[2 * i], s[2 * i + 1]) - mm;
          x.x = fexp2(x.x); x.y = fexp2(x.y);
          s[2 * i] = x.x; s[2 * i + 1] = x.y;
          rs2 += x;
        }
        pf[kb][0] = packfrag(s, 0); pf[kb][1] = packfrag(s, 1);
      }
      const char* st = stt + h2 * DA_STAGE;
      _Pragma("unroll") for (int kb = 0; kb < 2; ++kb) _Pragma("unroll") for (int d = 0; d < 4; ++d) {
        const int vrow = 32 * d + lr;
        const char* vp = st + 16384 + vrow * 128;
        const bf16x8 v0 = *(const bf16x8*)(vp + (((kb * 4 + lh) ^ swz(vrow)) << 4));
        const bf16x8 v1 = *(const bf16x8*)(vp + (((kb * 4 + 2 + lh) ^ swz(vrow)) << 4));
        O[d] = MFMA32(v0, pf[kb][0], O[d]); O[d] = MFMA32(v1, pf[kb][1], O[d]);
      }
    }
    ls += rs2.x + rs2.y;
  }
  ls = xsum32(ls);
  float* xf = (float*)smem_wg + g * 4096;
  __syncthreads();
  if (c == 1) {
    const float i1 = P.lam[l] / ls;
    _Pragma("unroll") for (int d = 0; d < 4; ++d) _Pragma("unroll") for (int r = 0; r < 16; ++r) xf[(d * 16 + r) * 64 + lane] = O[d][r] * i1;
  }
  __syncthreads();
  if (c == 0) {
    const int b = bh >> 2, hh = bh & 3;
    const float omli = P.lam[2 + l], i0 = 1.f / ls;
    float ss = 0.f;
    _Pragma("unroll") for (int d = 0; d < 4; ++d) _Pragma("unroll") for (int r = 0; r < 16; ++r) { const float o = O[d][r] * i0 - xf[(d * 16 + r) * 64 + lane]; O[d][r] = o; ss += o * o; }
    ss = xsum32(ss);
    const float rs = rsqrtf(ss * (1.f / 128.f) + LN_EPS);
    const size_t tok = (size_t)b * L + q0 + lr;
    _Pragma("unroll") for (int d = 0; d < 4; ++d) _Pragma("unroll") for (int rg = 0; rg < 4; ++rg) {
      const int dv = 32 * d + 8 * rg + 4 * lh;
      const f32x4 g4 = *(const f32x4*)(P.diff_g + l * 128 + dv);
      u32x2 ou;
      ou.x = pk2(O[d][4 * rg + 0] * rs * g4.x * omli, O[d][4 * rg + 1] * rs * g4.y * omli);
      ou.y = pk2(O[d][4 * rg + 2] * rs * g4.z * omli, O[d][4 * rg + 3] * rs * g4.w * omli);
      *(u32x2*)(P.oa + tok * 512 + hh * 128 + dv) = ou;
    }
  }
}
DI void dattn_item16(const Params& P, int l, int it, char* smem_wg) {
  int tid = rtid(); asm volatile("" : "+v"(tid));
  const int lane = tid & 63, w = __builtin_amdgcn_readfirstlane(tid >> 6), w4 = w & 3, ih = w >> 2, lr = lane & 31, lh = lane >> 5;
  const int bh = it & 7, jq = it >> 3;
  const int q0 = jq * 256 + 32 * w;
  constexpr int NTILE = (L + 63) / 64;
  bf16x8 qf[2][4];
  _Pragma("unroll") for (int c = 0; c < 2; ++c) _Pragma("unroll") for (int ks = 0; ks < 4; ++ks)
    qf[c][ks] = ldfrag(P.qa + ((size_t)(bh * 2 + c) * L + q0 + lr) * 64 + 16 * ks + 8 * lh);
  f32x16 O[2][4];
  float m[2], ls[2];
  _Pragma("unroll") for (int c = 0; c < 2; ++c) {
    f32x16 s = zero16();
    const bf16_t* kp = P.ka + ((size_t)(bh * 2 + c) * L + kswap(lr)) * 64 + 8 * lh;
    _Pragma("unroll") for (int ks = 0; ks < 4; ++ks) s = MFMA32(ldfrag(kp + 16 * ks), qf[c][ks], s);
    float mx = s[0];
    _Pragma("unroll") for (int r = 1; r < 16; ++r) mx = fmaxf(mx, s[r]);
    m[c] = xmax32(mx); ls[c] = 0.f;
    _Pragma("unroll") for (int d = 0; d < 4; ++d) O[c][d] = zero16();
  }
  const unsigned sw16 = (unsigned)(((lane & 7) ^ (4 * (w4 & 1) + (lane >> 4))) << 4);
  const char* gsrc = ih == 0 ? (const char*)(P.ka + (size_t)(bh * 2) * L * 64) + (size_t)(w4 * 8 + (lane >> 3)) * 128 + sw16
                             : (const char*)(P.vaT + (size_t)bh * 128 * LK) + (size_t)(w4 * 8 + (lane >> 3)) * (LK * 2) + sw16;
#define DA16_ISSUE(t_, st_) _Pragma("unroll") for (int i_ = 0; i_ < 4; ++i_) { \
    const char* src_ = ih == 0 ? gsrc + (size_t)(t_) * (64 * 128) + (size_t)(i_ >> 1) * (L * 128) + (i_ & 1) * 4096 : gsrc + (size_t)(t_) * 128 + (size_t)i_ * 32 * LK * 2; \
    __builtin_amdgcn_global_load_lds((const unsigned*)src_, (lds_u32*)(smem_wg + (st_) * DA_STAGE + ((ih * 4 + i_) * 4 + w4) * 1024), 16, 0, 0); }
  __syncthreads();
  DA16_ISSUE(0, 0)
  for (int t = 0; t < NTILE; ++t) {
    __syncthreads();
    if (t + 1 < NTILE) { DA16_ISSUE(t + 1, (t + 1) & 1) }
    const char* st = smem_wg + (t & 1) * DA_STAGE;
    _Pragma("unroll") for (int kb = 0; kb < 2; ++kb) {
      bf16x8 pf[2][2];
      _Pragma("unroll") for (int c = 0; c < 2; ++c) {
        f32x16 s;
        _Pragma("unroll") for (int r = 0; r < 16; ++r) s[r] = -m[c];
        const int krow = kb * 32 + kswap(lr);
        const char* kp = st + c * 8192 + krow * 128;
        _Pragma("unroll") for (int ks = 0; ks < 4; ++ks) s = MFMA32(*(const bf16x8*)(kp + (((2 * ks + lh) ^ swz(krow)) << 4)), qf[c][ks], s);
        if (t == NTILE - 1) {
          _Pragma("unroll") for (int r = 0; r < 16; ++r) if (t * 64 + kb * 32 + keyoff(r, lh) >= L) s[r] = -3.0e38f;
        }
        float mx = s[0];
        _Pragma("unroll") for (int r = 1; r < 16; ++r) mx = fmaxf(mx, s[r]);
        if (__any(mx > DA_THR)) {
          asm volatile("; rare: move the softmax reference" ::: "memory");
          const float dlt = fmaxf(xmax32(mx), 0.f);
          const float al = fexp2(-dlt);
          m[c] += dlt; ls[c] *= al;
          _Pragma("unroll") for (int d = 0; d < 4; ++d) _Pragma("unroll") for (int r = 0; r < 16; ++r) O[c][d][r] *= al;
          _Pragma("unroll") for (int r = 0; r < 16; ++r) s[r] -= dlt;
        }
        float rsum = 0.f;
        _Pragma("unroll") for (int r = 0; r < 16; ++r) { const float pv = fexp2(s[r]); s[r] = pv; rsum += pv; }
        ls[c] += rsum;
        pf[c][0] = packfrag(s, 0); pf[c][1] = packfrag(s, 1);
      }
      _Pragma("unroll") for (int d = 0; d < 4; ++d) {
        const int vrow = 32 * d + lr;
        const char* vp = st + 16384 + vrow * 128;
        const bf16x8 v0 = *(const bf16x8*)(vp + (((kb * 4 + lh) ^ swz(vrow)) << 4));
        const bf16x8 v1 = *(const bf16x8*)(vp + (((kb * 4 + 2 + lh) ^ swz(vrow)) << 4));
        _Pragma("unroll") for (int c = 0; c < 2; ++c) { O[c][d] = MFMA32(v0, pf[c][0], O[c][d]); O[c][d] = MFMA32(v1, pf[c][1], O[c][d]); }
      }
    }
  }
#undef DA16_ISSUE
  _Pragma("unroll") for (int c = 0; c < 2; ++c) ls[c] = xsum32(ls[c]);
  dattn_finish(P, l, bh, q0, O, ls, lr, lh);
}
DI void dattn_combine(const Params& P, int l, int bh, char* smem) {
  const int tid = otid(), lane = tid & 63, w = tid >> 6, lr = lane & 31, lh = lane >> 5;
  f32x16 O[2][4];
  float m[2], ls[2];
  __syncthreads();
  for (int k = 0; k < 16; ++k) {
    const float* pb = (const float*)P.merged + (size_t)(bh + 8 * (w * 16 + k)) * DA_PART + lane;
    _Pragma("unroll") for (int c = 0; c < 2; ++c) {
      const float mb = pb[8192 + c * 64], lb = pb[8192 + 128 + c * 64];
      float fa, fb;
      if (k == 0) { m[c] = mb; ls[c] = lb; fa = 0.f; fb = 1.f; }
      else { const float M = fmaxf(m[c], mb); fa = fexp2(m[c] - M); fb = fexp2(mb - M); ls[c] = ls[c] * fa + lb * fb; m[c] = M; }
      _Pragma("unroll") for (int d = 0; d < 4; ++d) {
        const float* pp = pb + (c * 4 + d) * 1024;
        asm volatile("" : "+v"(pp));
        _Pragma("unroll") for (int r = 0; r < 16; ++r) {
          const float ov = pp[r * 64];
          O[c][d][r] = k == 0 ? ov : O[c][d][r] * fa + ov * fb;
        }
      }
    }
  }
  dattn_merge4(O, m, ls, smem, lane, w);
  if (w == 0) dattn_finish(P, l, bh, 8192, O, ls, lr, lh);
}

DI void swa_item(const Params& P, int l, int it, char* smem) {
  const int tid = otid(), lane = tid & 63, w = tid >> 6, lr = lane & 31, lh = lane >> 5;
  const int NQT = (L + 31) / 32;
  const int bk = it / NQT, qt = it % NQT, b = bk >> 1, kv = bk & 1, hq = kv * 4 + w;
  const int q0 = qt * 32;
  const int qi = min(q0 + lr, L - 1);
  bf16x8 qf[4];
  _Pragma("unroll") for (int ks = 0; ks < 4; ++ks) qf[ks] = ldfrag(P.qb + ((size_t)(b * 8 + hq) * L + qi) * 64 + 16 * ks + 8 * lh);
  f32x16 O[2]; O[0] = zero16(); O[1] = zero16();
  float m = P.sink[l * 8 + hq] * 1.44269504088896341f, ls = 1.f;
  const bf16_t* kbase = P.kb + (size_t)(b * 2 + kv) * L * 64;
  const bf16_t* vbase = P.vbT + (size_t)(b * 2 + kv) * 64 * LK;
  const int qpos = q0 + lr;
  char* sK = smem;
  char* sV = smem + 5 * 4096;
  bf16x8 ta[5], tb[5];
#define SWA_LOAD(ph_) _Pragma("unroll") for (int i = 0; i < 5; ++i) { \
    { const int rr_ = 40 * w + 8 * i + (lane >> 3), bb_ = rr_ >> 5, bi_ = 5 * (ph_) + bb_; const int k1_ = bi_ == 0 ? 0 : q0 - 160 + 32 * bi_; \
      const int krow_ = min(max(k1_ + (rr_ & 31), 0), L - 1); ta[i] = ldfrag(kbase + (size_t)krow_ * 64 + (lane & 7) * 8); } \
    { const int j_ = 5 * w + i, bb_ = j_ >> 2, bi_ = 5 * (ph_) + bb_; const int k0_ = bi_ == 0 ? 0 : q0 - 160 + 32 * bi_; const int kc0_ = min(max(k0_, 0), LK - 32); \
      tb[i] = ldfrag(vbase + (size_t)(16 * (j_ & 3) + (lane >> 2)) * LK + kc0_ + (lane & 3) * 8); } }
#define SWA_STORE() _Pragma("unroll") for (int i = 0; i < 5; ++i) { \
    { const int rr_ = 40 * w + 8 * i + (lane >> 3), bb_ = rr_ >> 5, r_ = rr_ & 31; *(bf16x8*)(sK + bb_ * 4096 + r_ * 128 + (((lane & 7) ^ swz(r_)) << 4)) = ta[i]; } \
    { const int j_ = 5 * w + i, bb_ = j_ >> 2, rv_ = 16 * (j_ & 3) + (lane >> 2); *(bf16x8*)(sV + bb_ * 4096 + rv_ * 64 + (((lane & 3) ^ ((rv_ >> 2) & 3)) << 4)) = tb[i]; } }
  SWA_LOAD(0)
  __syncthreads();
  SWA_STORE()
  __syncthreads();
  SWA_LOAD(1)
  __builtin_amdgcn_sched_barrier(0);
  _Pragma("unroll") for (int ph = 0; ph < 2; ++ph) {
    if (ph == 1) { __syncthreads(); SWA_STORE() __syncthreads(); }
    _Pragma("unroll") for (int bb = 0; bb < 5; ++bb) {
      const int bi = 5 * ph + bb;
      const int k0 = bi == 0 ? 0 : q0 - 160 + 32 * bi;
      f32x16 s = zero16();
      {
        const int krow = kswap(lr);
        _Pragma("unroll") for (int ks = 0; ks < 4; ++ks) s = MFMA32(*(const bf16x8*)(sK + bb * 4096 + krow * 128 + (((2 * ks + lh) ^ swz(krow)) << 4)), qf[ks], s);
      }
      float mx = -3.0e38f;
      _Pragma("unroll") for (int r = 0; r < 16; ++r) {
        const int kj = k0 + keyoff(r, lh);
        bool ok;
        if (bi == 0) ok = kj < NMETA;
        else ok = kj >= NMETA && kj < L && kj >= qpos - 128 && kj <= qpos + 128;
        const float v = ok ? s[r] : -3.0e38f;
        s[r] = v; mx = fmaxf(mx, v);
      }
      mx = xmax32(mx);
      const float mn = fmaxf(m, mx);
      const float al = fexp2(m - mn);
      float rsum = 0.f;
      _Pragma("unroll") for (int r = 0; r < 16; ++r) { const float pv = fexp2(s[r] - mn); s[r] = pv; rsum += pv; }
      rsum = xsum32(rsum);
      ls = ls * al + rsum; m = mn;
      _Pragma("unroll") for (int d = 0; d < 2; ++d) _Pragma("unroll") for (int r = 0; r < 16; ++r) O[d][r] *= al;
      const bf16x8 p0 = packfrag(s, 0), p1 = packfrag(s, 1);
      _Pragma("unroll") for (int d = 0; d < 2; ++d) {
        const int vrow = 32 * d + lr;
        const char* vp = sV + bb * 4096 + vrow * 64;
        const int sx = (vrow >> 2) & 3;
        O[d] = MFMA32(*(const bf16x8*)(vp + ((lh ^ sx) << 4)), p0, O[d]);
        O[d] = MFMA32(*(const bf16x8*)(vp + (((2 + lh) ^ sx) << 4)), p1, O[d]);
      }
    }
  }
#undef SWA_LOAD
#undef SWA_STORE
  if (qpos < L) {
    const float inv = 1.f / ls;
    const size_t tok = (size_t)b * L + qpos;
    _Pragma("unroll") for (int d = 0; d < 2; ++d) _Pragma("unroll") for (int rg = 0; rg < 4; ++rg) {
      const int dv = 32 * d + 8 * rg + 4 * lh;
      u32x2 ou;
      ou.x = pk2(O[d][4 * rg + 0] * inv, O[d][4 * rg + 1] * inv);
      ou.y = pk2(O[d][4 * rg + 2] * inv, O[d][4 * rg + 3] * inv);
      *(u32x2*)(P.ob + tok * 512 + hq * 64 + dv) = ou;
    }
  }
}

constexpr int P3_MT = TP / 128, P3_NT = D / 128;
DI void tail_reduce(const f32x16& acc, char* smem_wg, int w, int lane, float (&v)[2]) {
  float* red = (float*)smem_wg;
  __syncthreads();
  _Pragma("unroll") for (int r = 0; r < 16; ++r) red[(w * 16 + r) * 64 + lane] = acc[r];
  __syncthreads();
  _Pragma("unroll") for (int j = 0; j < 2; ++j) {
    float s = 0.f;
    _Pragma("unroll") for (int x = 0; x < 8; ++x) s += red[(x * 16 + 2 * w + j) * 64 + lane];
    v[j] = s;
  }
  __syncthreads();
}
DI void p3a_tail(const Params& P, char* smem_wg, int wg) {
  int tid = rtid(); asm volatile("" : "+v"(tid));
  const int lane = tid & 63, w = tid >> 6, lr = lane & 31, lh = lane >> 5;
  const int n0 = 32 * wg, k0 = 64 * w + 8 * lh;
  f32x16 tot = zero16();
  _Pragma("unroll 1") for (int br = 0; br < 3; ++br) {
    const bf16_t* A = P.oa + ((size_t)br * TP + 16384 + lr) * 512 + k0;
    const bf16_t* B = P.w_br_t + ((size_t)br * 1024 + n0 + lr) * 512 + k0;
    f32x16 part = zero16();
    _Pragma("unroll") for (int ks = 0; ks < 4; ++ks) part = MFMA32(ldfrag(A + 16 * ks), ldfrag(B + 16 * ks), part);
    _Pragma("unroll") for (int r = 0; r < 16; ++r) tot[r] += bf2f(P.gz[(size_t)(16384 + crow(r, lh)) * 3072 + br * 1024 + n0 + lr]) * part[r];
  }
  float v[2];
  tail_reduce(tot, smem_wg, w, lane, v);
  _Pragma("unroll") for (int j = 0; j < 2; ++j) P.merged[(size_t)(16384 + crow(2 * w + j, lh)) * D + n0 + lr] = f2bf(v[j]);
}
DI void p3b_tail(const Params& P, char* smem_wg, int wg) {
  int tid = rtid(); asm volatile("" : "+v"(tid));
  const int lane = tid & 63, w = tid >> 6, lr = lane & 31, lh = lane >> 5;
  const int n0 = 32 * wg, k0 = 128 * w + 8 * lh;
  const bf16_t* A = P.merged + (size_t)(16384 + lr) * D + k0;
  const bf16_t* B = P.w_out_t + (size_t)(n0 + lr) * D + k0;
  f32x16 acc = zero16();
  _Pragma("unroll") for (int ks = 0; ks < 8; ++ks) acc = MFMA32(ldfrag(A + 16 * ks), ldfrag(B + 16 * ks), acc);
  float v[2];
  tail_reduce(acc, smem_wg, w, lane, v);
  _Pragma("unroll") for (int j = 0; j < 2; ++j) { float* hp = P.h + (size_t)(16384 + crow(2 * w + j, lh)) * D + n0 + lr; *hp = ALPHA * (*hp) + v[j]; }
}
struct SchedP3a {
  static constexpr bool GATHER = false;
  const char* A; const char* B; int G, c;
  DI bool next(int i, g8::Unit& u) const {
    const int ti = i / 3, br = i - 3 * ti; int pm, pn;
    if (!g8::grid_unit(ti, G, c, 64, 4, pm, pn)) return false;
    u.pm = pm; u.pn = pn; u.tag = br;
    u.a = A + ((size_t)br * TP + (size_t)pm * 256) * 512 * 2; u.b = B + ((size_t)br * 1024 + (size_t)pn * 256) * 512 * 2; return true;
  }
  DI void arows(const g8::Unit&, int, unsigned (&)[2]) const {}
};
struct EpiP3a {
  static constexpr bool PERM = true;
  const bf16_t* gz; bf16_t* merged;
  DI bool keep(const g8::Unit& u) const { return u.tag < 2; }
  DI void operator()(g8::f32x4 (&acc)[2][2][4][2], const g8::Unit& u, int wr, int wc, int fr, int fq) const {
    const int br = u.tag;
    const bf16_t* g0 = gz + (size_t)(u.pm * 256 + 64 * wr + fr) * 3072 + br * 1024 + u.pn * 256 + 32 * wc + 8 * fq;
    _Pragma("unroll") for (int ai = 0; ai < 2; ++ai) {
      u32x4 ga[4][2], gb[4][2];
      _Pragma("unroll") for (int m = 0; m < 4; ++m) _Pragma("unroll") for (int bj = 0; bj < 2; ++bj) ga[m][bj] = *(const u32x4*)(g0 + (size_t)(128 * ai + 16 * m) * 3072 + 128 * bj);
      if (br < 2) {
        _Pragma("unroll") for (int m = 0; m < 4; ++m) _Pragma("unroll") for (int bj = 0; bj < 2; ++bj) gb[m][bj] = *(const u32x4*)(g0 + (size_t)(128 * ai + 16 * m) * 3072 + 128 * bj + 1024);
        __builtin_amdgcn_sched_barrier(0);
        _Pragma("unroll") for (int m = 0; m < 4; ++m) _Pragma("unroll") for (int bj = 0; bj < 2; ++bj) {
          const u32x4 a = ga[m][bj], b = gb[m][bj];
          acc[ai][bj][m][0][0] *= bflo(a.x) * frcp(bflo(b.x)); acc[ai][bj][m][0][1] *= bfhi(a.x) * frcp(bfhi(b.x));
          acc[ai][bj][m][0][2] *= bflo(a.y) * frcp(bflo(b.y)); acc[ai][bj][m][0][3] *= bfhi(a.y) * frcp(bfhi(b.y));
          acc[ai][bj][m][1][0] *= bflo(a.z) * frcp(bflo(b.z)); acc[ai][bj][m][1][1] *= bfhi(a.z) * frcp(bfhi(b.z));
          acc[ai][bj][m][1][2] *= bflo(a.w) * frcp(bflo(b.w)); acc[ai][bj][m][1][3] *= bfhi(a.w) * frcp(bfhi(b.w));
        }
      } else {
        __builtin_amdgcn_sched_barrier(0);
        _Pragma("unroll") for (int m = 0; m < 4; ++m) _Pragma("unroll") for (int bj = 0; bj < 2; ++bj) {
          const u32x4 a = ga[m][bj];
          u32x4 o;
          o.x = pk2(acc[ai][bj][m][0][0] * bflo(a.x), acc[ai][bj][m][0][1] * bfhi(a.x)); o.y = pk2(acc[ai][bj][m][0][2] * bflo(a.y), acc[ai][bj][m][0][3] * bfhi(a.y));
          o.z = pk2(acc[ai][bj][m][1][0] * bflo(a.z), acc[ai][bj][m][1][1] * bfhi(a.z)); o.w = pk2(acc[ai][bj][m][1][2] * bflo(a.w), acc[ai][bj][m][1][3] * bfhi(a.w));
          *(u32x4*)(merged + (size_t)(u.pm * 256 + 128 * ai + 64 * wr + 16 * m + fr) * D + u.pn * 256 + 128 * bj + 32 * wc + 8 * fq) = o;
        }
      }
      __builtin_amdgcn_sched_barrier(0);
    }
  }
};
DI void phase_p3a(const Params& P, int l, char* smem, char* smem_wg, int bid, int nblk) {
  if ((bid >> 1) < 32) p3a_tail(P, smem_wg, bid >> 1);
  {
    SchedP3a S; S.A = (const char*)P.oa; S.B = (const char*)P.w_br_t; S.G = nblk >> 1; S.c = bid >> 1;
    EpiP3a E; E.gz = P.gz; E.merged = P.merged;
    g8::gemm_phase((g8::lds_u8*)smem_wg, 512, S, E);
  }
}
struct SchedP3b {
  static constexpr bool GATHER = false;
  const char* A; const char* B; int G, c;
  DI bool next(int i, g8::Unit& u) const { int pm, pn; if (!g8::grid_unit(i, G, c, 64, 4, pm, pn)) return false; u.pm = pm; u.pn = pn; u.tag = 0; u.a = A + (size_t)pm * 256 * D * 2; u.b = B + (size_t)pn * 256 * D * 2; return true; }
  DI void arows(const g8::Unit&, int, unsigned (&)[2]) const {}
};
struct EpiP3b {
  static constexpr bool PERM = false;
  float* h;
  DI bool keep(const g8::Unit&) const { return false; }
  DI void operator()(g8::f32x4 (&acc)[2][2][4][2], const g8::Unit& u, int wr, int wc, int fr, int fq) const {
    float* h0 = h + (size_t)(u.pm * 256 + 64 * wr + fr) * D + u.pn * 256 + 32 * wc + 4 * fq;
    _Pragma("unroll") for (int ai = 0; ai < 2; ++ai) {
      g8::f32x4 hv[4][2][2];
      _Pragma("unroll") for (int m = 0; m < 4; ++m) _Pragma("unroll") for (int bj = 0; bj < 2; ++bj) _Pragma("unroll") for (int n = 0; n < 2; ++n)
        hv[m][bj][n] = *(const g8::f32x4*)(h0 + (size_t)(128 * ai + 16 * m) * D + 128 * bj + 16 * n);
      __builtin_amdgcn_sched_barrier(0);
      _Pragma("unroll") for (int m = 0; m < 4; ++m) _Pragma("unroll") for (int bj = 0; bj < 2; ++bj) _Pragma("unroll") for (int n = 0; n < 2; ++n)
        *(g8::f32x4*)(h0 + (size_t)(128 * ai + 16 * m) * D + 128 * bj + 16 * n) = ALPHA * hv[m][bj][n] + acc[ai][bj][m][n];
      __builtin_amdgcn_sched_barrier(0);
    }
  }
};
DI void phase_p3b(const Params& P, int l, char* smem, char* smem_wg, int bid, int nblk) {
  if ((bid >> 1) < 32) p3b_tail(P, smem_wg, bid >> 1);
  {
    SchedP3b S; S.A = (const char*)P.merged; S.B = (const char*)P.w_out_t; S.G = nblk >> 1; S.c = bid >> 1;
    EpiP3b E; E.h = P.h;
    g8::gemm_phase(( g8::lds_u8*)smem_wg, D, S, E);
  }
}

typedef __attribute__((ext_vector_type(4))) float f32x4v;
DI void phase_router_prep(const Params& P, int bid, int nblk) {
  const int gtid = bid * NT + otid(), gn = nblk * NT;
  for (int i = gtid; i < 2 * 64 * 3 * 64 * 4; i += gn) {
    const int sidx = i & 3, lane = (i >> 2) & 63, n = (i >> 8) % 3, chunk = ((i >> 8) / 3) & 63, l = (i >> 8) / 192;
    const int c = 16 * chunk + 4 * (lane >> 4) + sidx, j = lane & 15;
    float wv = 0.f;
    if (n < 2) wv = P.w_re[((size_t)l * D + c) * 32 + 16 * n + j];
    else if (j < 4) wv = P.w_rg[((size_t)l * D + c) * 4 + j];
    P.rwp[i] = wv * P.ln1_g[l * D + c];
  }
  const int wv_ = gtid >> 6, lane = gtid & 63;
  if (wv_ < 2 * 36) {
    const int l = wv_ / 36, o = wv_ % 36;
    float sg = 0.f, sb = 0.f;
    for (int c = lane; c < D; c += 64) {
      const float wv = o < 32 ? P.w_re[((size_t)l * D + c) * 32 + o] : P.w_rg[((size_t)l * D + c) * 4 + o - 32];
      sg += P.ln1_g[l * D + c] * wv; sb += P.ln1_b[l * D + c] * wv;
    }
    sg = wave_sum(sg); sb = wave_sum(sb);
    if (lane == 0) { P.rgb[(l * 2 + 0) * 48 + o] = sg; P.rgb[(l * 2 + 1) * 48 + o] = sb + (o < 32 ? P.b_re[l * 32 + o] : P.b_rg[l * 4 + o - 32]); }
  }
}
DI void phase_p4(const Params& P, int l, char* smem, int bid, int nblk) {
  const int tid = otid(), lane = tid & 63, w = tid >> 6, wv = (bid * NT + tid) >> 6, nwv = (nblk * NT) >> 6;
  float* raw = (float*)smem + w * 768;
  const f32x4* wp = (const f32x4*)P.rwp + (size_t)l * 64 * 3 * 64 + lane;
  const int nrb = min(nblk, (T / 16 + 3) / 4), nwr = nrb * 4;
  for (int wt = bid < nrb ? bid * 4 + w : T / 16; wt < T / 16; wt += nwr) {
    const int t0 = wt * 16;
    f32x4v acc[3];
    _Pragma("unroll") for (int n = 0; n < 3; ++n) { acc[n][0] = 0.f; acc[n][1] = 0.f; acc[n][2] = 0.f; acc[n][3] = 0.f; }
    const float* xa = P.h + (size_t)(t0 + (lane & 15)) * D + 4 * (lane >> 4);
    f32x4 A0[4], B0[4][3], A1[4], B1[4][3];
    float s1 = 0.f, s2 = 0.f;
#define P4_LOAD(Ab, Bb, c0) _Pragma("unroll") for (int u = 0; u < 4; ++u) { Ab[u] = *(const f32x4*)(xa + 16 * ((c0) + u)); \
      _Pragma("unroll") for (int n = 0; n < 3; ++n) Bb[u][n] = wp[(((c0) + u) * 3 + n) * 64]; }
#define P4_MMA(Ab, Bb) _Pragma("unroll") for (int u = 0; u < 4; ++u) { const f32x4 a = Ab[u]; \
      s1 += (a.x + a.y) + (a.z + a.w); s2 += (a.x * a.x + a.y * a.y) + (a.z * a.z + a.w * a.w); \
      _Pragma("unroll") for (int n = 0; n < 3; ++n) acc[n] = __builtin_amdgcn_mfma_f32_16x16x4f32(a.x, Bb[u][n].x, acc[n], 0, 0, 0); \
      _Pragma("unroll") for (int n = 0; n < 3; ++n) acc[n] = __builtin_amdgcn_mfma_f32_16x16x4f32(a.y, Bb[u][n].y, acc[n], 0, 0, 0); \
      _Pragma("unroll") for (int n = 0; n < 3; ++n) acc[n] = __builtin_amdgcn_mfma_f32_16x16x4f32(a.z, Bb[u][n].z, acc[n], 0, 0, 0); \
      _Pragma("unroll") for (int n = 0; n < 3; ++n) acc[n] = __builtin_amdgcn_mfma_f32_16x16x4f32(a.w, Bb[u][n].w, acc[n], 0, 0, 0); }
    P4_LOAD(A0, B0, 0)
    _Pragma("unroll 1") for (int ch = 0; ch < 64; ch += 8) {
      P4_LOAD(A1, B1, ch + 4)
      __builtin_amdgcn_sched_barrier(0);
      P4_MMA(A0, B0)
      __builtin_amdgcn_sched_barrier(0);
      if (ch + 8 < 64) { P4_LOAD(A0, B0, ch + 8) }
      __builtin_amdgcn_sched_barrier(0);
      P4_MMA(A1, B1)
      __builtin_amdgcn_sched_barrier(0);
    }
#undef P4_LOAD
#undef P4_MMA
    s1 += sxor<16>(s1); s2 += sxor<16>(s2); s1 = xsum32(s1); s2 = xsum32(s2);
    const float mu_r = s1 * (1.f / 1024.f), rs_r = rsqrtf(fmaxf(s2 * (1.f / 1024.f) - mu_r * mu_r, 0.f) + LN_EPS);
    WT_FENCE();
    _Pragma("unroll") for (int r = 0; r < 4; ++r) {
      const int tok = 4 * (lane >> 4) + r, j = lane & 15;
      raw[tok * 40 + j] = acc[0][r]; raw[tok * 40 + 16 + j] = acc[1][r];
      if (j < 4) raw[tok * 40 + 32 + j] = acc[2][r];
    }
    if (lane < 16) { raw[640 + 2 * lane] = mu_r; raw[640 + 2 * lane + 1] = rs_r; }
    WT_FENCE();
    f32x4 gg[4], bb[4];
    _Pragma("unroll") for (int i = 0; i < 4; ++i) { gg[i] = ((const f32x4*)(P.ln1_g + l * D))[lane + 64 * i]; bb[i] = ((const f32x4*)(P.ln1_b + l * D))[lane + 64 * i]; }
    _Pragma("unroll 1") for (int q0 = 0; q0 < 16; q0 += 4) {
      f32x4 v[4][4];
      _Pragma("unroll") for (int j = 0; j < 4; ++j) _Pragma("unroll") for (int i = 0; i < 4; ++i) v[j][i] = ((const f32x4*)(P.h + (size_t)(t0 + q0 + j) * D))[lane + 64 * i];
      __builtin_amdgcn_sched_barrier(0);
      _Pragma("unroll") for (int j = 0; j < 4; ++j) {
        const float mu = raw[640 + 2 * (q0 + j)], rs = raw[640 + 2 * (q0 + j) + 1];
        _Pragma("unroll") for (int i = 0; i < 4; ++i) {
          v[j][i].x = (v[j][i].x - mu) * rs * gg[i].x + bb[i].x; v[j][i].y = (v[j][i].y - mu) * rs * gg[i].y + bb[i].y;
          v[j][i].z = (v[j][i].z - mu) * rs * gg[i].z + bb[i].z; v[j][i].w = (v[j][i].w - mu) * rs * gg[i].w + bb[i].w;
        }
        store_row(v[j], P.h + (size_t)(t0 + q0 + j) * D, P.hb + (size_t)(t0 + q0 + j) * D, lane);
      }
    }
    WT_FENCE();
    if (lane < 16) {
      const int t = t0 + lane;
      const float mu = raw[640 + 2 * lane], rs = raw[640 + 2 * lane + 1];
      const float* G = P.rgb + (l * 2) * 48; const float* Bc = G + 48;
      float gl[4];
      _Pragma("unroll") for (int g = 0; g < 4; ++g) gl[g] = rs * (raw[lane * 40 + 32 + g] - mu * G[32 + g]) + Bc[32 + g];
      int gs = 0; float gm = gl[0];
      for (int g = 1; g < 4; ++g) if (gl[g] > gm) { gm = gl[g]; gs = g; }
      float den = 0.f;
      _Pragma("unroll") for (int g = 0; g < 4; ++g) den += expf(gl[g] - gm);
      const float pg = 1.f / den;
      float el[8];
      _Pragma("unroll") for (int e = 0; e < 8; ++e) el[e] = rs * (raw[lane * 40 + gs * 8 + e] - mu * G[gs * 8 + e]) + Bc[gs * 8 + e];
      int i1 = 0; float v1 = el[0];
      for (int e = 1; e < 8; ++e) if (el[e] > v1) { v1 = el[e]; i1 = e; }
      int i2 = -1; float v2 = -3.0e38f;
      _Pragma("unroll") for (int e = 0; e < 8; ++e) if (e != i1 && el[e] > v2) { v2 = el[e]; i2 = e; }
      if (i2 < 0) i2 = (i1 + 1) & 7;
      const float ex = expf(v2 - v1);
      const float w1 = pg / (1.f + ex), w2 = pg * ex / (1.f + ex);
      const int e1 = gs * 8 + i1, e2 = gs * 8 + i2;
      const int r1 = atomicAdd(P.counts + e1 * CSTR, 1), r2 = atomicAdd(P.counts + e2 * CSTR, 1);
      P.tok_slot[2 * t] = e1 * CAP + r1; P.tok_slot[2 * t + 1] = e2 * CAP + r2;
      P.tok_w[2 * t] = w1; P.tok_w[2 * t + 1] = w2;
      P.slot_tok[(size_t)e1 * CAP + r1] = t; P.slot_tok[(size_t)e2 * CAP + r2] = t;
    }
  }
}

DI bool moe_unit(const int* counts, int i, int G, int c, int& e, int& mi, int& pn, int& cnt, int& hs) {
  int tot = 0;
  for (int x = 0; x < NEXP; ++x) tot += (counts[x * CSTR] + 255) >> 8;
  const int U = tot * 4, g = i * G + c;
  if (g >= U) return false;
  const int q = U / 8, r = U % 8, xcd = g % 8, off = g / 8;
  const int idx = (xcd < r ? xcd * (q + 1) : r * (q + 1) + (xcd - r) * q) + off;
  const int mt = idx >> 2; pn = idx & 3;
  int acc = 0; e = 0; mi = 0; cnt = 0; hs = 0;
  for (int x = 0; x < NEXP; ++x) {
    const int cx = counts[x * CSTR], n = (cx + 255) >> 8;
    if (mt < acc + n) { e = x; mi = mt - acc; cnt = cx; hs = acc * 256; return true; }
    acc += n;
  }
  return false;
}
constexpr int MOE_TAB = 131072 + 512, MOE_MAXU = 8;
DI void moe_table(const int* counts, int G, int c, char* smem_wg) {
  const int tid = rtid();
  __syncthreads();
  if (tid < MOE_MAXU) {
    int e = 0, mi = 0, pn = 0, cnt = 0, hs = 0;
    const bool ok = moe_unit(counts, tid, G, c, e, mi, pn, cnt, hs);
    int* tb = (int*)(smem_wg + MOE_TAB) + tid * 8;
    tb[0] = ok ? 1 : 0; tb[1] = e; tb[2] = mi; tb[3] = pn; tb[4] = cnt; tb[5] = hs;
  }
  __syncthreads();
}
DI bool moe_next(int i, int& e, int& mi, int& pn, int& cnt, int& hs) {
  if (i >= MOE_MAXU) return false;
  const LAS_I* tb = (const LAS_I*)(size_t)(MOE_TAB + i * 32);
  const int ok = __builtin_amdgcn_readfirstlane(tb[0]);
  e = __builtin_amdgcn_readfirstlane(tb[1]); mi = __builtin_amdgcn_readfirstlane(tb[2]); pn = __builtin_amdgcn_readfirstlane(tb[3]);
  cnt = __builtin_amdgcn_readfirstlane(tb[4]); hs = __builtin_amdgcn_readfirstlane(tb[5]);
  return ok != 0;
}
struct SchedP5a {
  static constexpr bool GATHER = true;
  const int* counts; const int* slot_tok; const char* hb; const char* w; int G, c;
  DI bool next(int i, g8::Unit& u) const {
    int e, mi, pn, cnt, hs;
    if (!moe_next(i, e, mi, pn, cnt, hs)) return false;
    u.pm = hs + mi * 256; u.pn = pn; u.tag = e; u.x0 = e * CAP + mi * 256; u.x1 = cnt - mi * 256;
    u.a = hb; u.b = w + ((size_t)e * 1024 + (size_t)pn * 256) * D * 2; return true;
  }
  DI void arows(const g8::Unit& u, int R0, unsigned (&pk)[2]) const {
    const int* st = slot_tok + u.x0; const int lim = u.x1 - 1;
    const int t0 = st[min(R0, lim)], t1 = st[min(R0 + 64, lim)], t2 = st[min(R0 + 128, lim)], t3 = st[min(R0 + 192, lim)];
    pk[0] = (unsigned)t0 | ((unsigned)t1 << 16); pk[1] = (unsigned)t2 | ((unsigned)t3 << 16);
  }
};
struct EpiP5a {
  static constexpr bool PERM = true;
  bf16_t* H;
  DI bool keep(const g8::Unit&) const { return false; }
  DI void operator()(g8::f32x4 (&acc)[2][2][4][2], const g8::Unit& u, int wr, int wc, int fr, int fq) const {
    _Pragma("unroll") for (int ai = 0; ai < 2; ++ai) _Pragma("unroll") for (int m = 0; m < 4; ++m) {
      bf16_t* rowp = H + (size_t)(u.pm + 128 * ai + 64 * wr + 16 * m + fr) * 512 + u.pn * 128 + 16 * wc + 4 * fq;
      _Pragma("unroll") for (int bj = 0; bj < 2; ++bj) {
        const g8::f32x4 g = acc[ai][bj][m][0], up = acc[ai][bj][m][1];
        u32x2 o; o.x = pk2(g[0] * sigmoidf_(g[0]) * up[0], g[1] * sigmoidf_(g[1]) * up[1]); o.y = pk2(g[2] * sigmoidf_(g[2]) * up[2], g[3] * sigmoidf_(g[3]) * up[3]);
        *(u32x2*)(rowp + 64 * bj) = o;
      }
    }
  }
};
DI void phase_p5a(const Params& P, int l, char* smem_wg, int bid, int nblk) {
  SchedP5a S; S.counts = P.counts; S.slot_tok = P.slot_tok; S.hb = (const char*)P.hb; S.w = (const char*)P.w_gu_t; S.G = nblk >> 1; S.c = bid >> 1;
  EpiP5a E; E.H = P.H;
  moe_table(P.counts, S.G, S.c, smem_wg);
  g8::gemm_phase((g8::lds_u8*)smem_wg, D, S, E);
}
struct SchedP5b {
  static constexpr bool GATHER = false;
  const int* counts; const char* H; const char* w; int G, c;
  DI bool next(int i, g8::Unit& u) const {
    int e, mi, pn, cnt, hs;
    if (!moe_next(i, e, mi, pn, cnt, hs)) return false;
    u.pm = hs + mi * 256; u.pn = pn; u.tag = e; u.x0 = 0; u.x1 = 0;
    u.a = H + (size_t)u.pm * 512 * 2; u.b = w + ((size_t)e * 1024 + (size_t)pn * 256) * 512 * 2; return true;
  }
  DI void arows(const g8::Unit&, int, unsigned (&)[2]) const {}
};
struct EpiP5b {
  static constexpr bool PERM = true;
  bf16_t* ys;
  DI bool keep(const g8::Unit&) const { return false; }
  DI void operator()(g8::f32x4 (&acc)[2][2][4][2], const g8::Unit& u, int wr, int wc, int fr, int fq) const {
    _Pragma("unroll") for (int ai = 0; ai < 2; ++ai) _Pragma("unroll") for (int m = 0; m < 4; ++m) {
      bf16_t* rowp = ys + (size_t)(u.pm + 128 * ai + 64 * wr + 16 * m + fr) * D + u.pn * 256 + 32 * wc + 8 * fq;
      _Pragma("unroll") for (int bj = 0; bj < 2; ++bj) {
        const g8::f32x4 a = acc[ai][bj][m][0], b = acc[ai][bj][m][1];
        u32x4 o; o.x = pk2(a[0], a[1]); o.y = pk2(a[2], a[3]); o.z = pk2(b[0], b[1]); o.w = pk2(b[2], b[3]);
        *(u32x4*)(rowp + 128 * bj) = o;
      }
    }
  }
};
DI void phase_p5b(const Params& P, int l, char* smem_wg, int bid, int nblk) {
  SchedP5b S; S.counts = P.counts; S.H = (const char*)P.H; S.w = (const char*)P.w_dn_t; S.G = nblk >> 1; S.c = bid >> 1;
  EpiP5b E; E.ys = P.ys;
  moe_table(P.counts, S.G, S.c, smem_wg);
  g8::gemm_phase((g8::lds_u8*)smem_wg, 512, S, E);
}
DI void phase_p6(const Params& P, int l, char* smem, int bid, int nblk) {
  const int tid = otid(), lane = tid & 63, wv = (bid * NT + tid) >> 6, nwv = (nblk * NT) >> 6;
  int* shs = (int*)smem;
  __syncthreads();
  if (tid == 0) { int hs = 0; for (int x = 0; x < NEXP; ++x) { shs[x] = hs; hs += ((P.counts[x * CSTR] + 255) >> 8) * 256; } }
  __syncthreads();
  int ns1 = 0, ns2 = 0; float nw1 = 0.f, nw2 = 0.f;
  if (wv < T) { ns1 = P.tok_slot[2 * wv]; ns2 = P.tok_slot[2 * wv + 1]; nw1 = P.tok_w[2 * wv]; nw2 = P.tok_w[2 * wv + 1]; }
  for (int t = wv; t < T; t += nwv) {
    const int s1 = ns1, s2 = ns2;
    const float w1 = nw1, w2 = nw2;
    { const int tn = min(t + nwv, T - 1); ns1 = P.tok_slot[2 * tn]; ns2 = P.tok_slot[2 * tn + 1]; nw1 = P.tok_w[2 * tn]; nw2 = P.tok_w[2 * tn + 1]; }
    const bf16_t* y1 = P.ys + (size_t)(shs[s1 / CAP] + s1 % CAP) * D;
    const bf16_t* y2 = P.ys + (size_t)(shs[s2 / CAP] + s2 % CAP) * D;
    f32x4 v[4];
    _Pragma("unroll") for (int i = 0; i < 4; ++i) {
      const f32x4 hv = ((const f32x4*)(P.h + (size_t)t * D))[lane + 64 * i];
      const u32x2 a = ((const u32x2*)y1)[lane + 64 * i], c = ((const u32x2*)y2)[lane + 64 * i];
      v[i].x = ALPHA * hv.x + (bflo(a.x) * w1 + bflo(c.x) * w2); v[i].y = ALPHA * hv.y + (bfhi(a.x) * w1 + bfhi(c.x) * w2);
      v[i].z = ALPHA * hv.z + (bflo(a.y) * w1 + bflo(c.y) * w2); v[i].w = ALPHA * hv.w + (bfhi(a.y) * w1 + bfhi(c.y) * w2);
    }
    ln16(v, P.ln2_g + l * D, P.ln2_b + l * D, lane);
    if (l == 1) {
      const int b = t >= L ? 1 : 0, pos = t - b * L;
      if (pos >= NMETA) store_row(v, P.out + ((size_t)b * SEQ + pos - NMETA) * D, nullptr, lane);
    } else store_row(v, P.h + (size_t)t * D, P.hb + (size_t)t * D, lane);
  }
}

#define XB_TMO      128
#define XB_XCNT(j)  (256  + 64 * (j))
#define XB_XSUB(j)  (1280 + 64 * (j))
#define XB_XGEN(j)  (2304 + 64 * (j))
#define XB_TOP      3328
#define XB_TOPGEN   3392
#define XCD_BAR_WORDS 3456
#define XB_SPIN_CAP (1u << 20)
#define LAS __attribute__((address_space(3)))
DI unsigned xb_ld(unsigned* p) { return __hip_atomic_load(p, __ATOMIC_RELAXED, __HIP_MEMORY_SCOPE_AGENT); }
DI unsigned xb_add(unsigned* p, unsigned v) { return __hip_atomic_fetch_add(p, v, __ATOMIC_RELAXED, __HIP_MEMORY_SCOPE_AGENT); }
DI unsigned xb_xcc_id() { return (unsigned)__builtin_amdgcn_s_getreg((3 << 11) | 20) & 0xFu; }
#define XB_SPIN(cond, bar) do { unsigned _sp = 0; while (cond) { __builtin_amdgcn_s_sleep(1); \
    if ((++_sp & 255u) == 0u) { if (xb_ld(&(bar)[XB_TMO])) break; if (_sp > XB_SPIN_CAP) { atomicAdd(&(bar)[XB_TMO], 1u); break; } } } } while (0)
struct XcdBarrier { unsigned* bar; unsigned x; volatile LAS unsigned* st; };
DI XcdBarrier xcd_barrier_post(unsigned* bar, volatile LAS unsigned* st) {
  XcdBarrier b; b.bar = bar; b.x = xb_xcc_id(); b.st = st;
  if (rtid() == 0) (void)xb_add(&bar[XB_XCNT(b.x)], 1u);
  return b;
}
DI void xcd_barrier_complete(unsigned* bar, unsigned x, unsigned& nloc, unsigned& nx) {
  const unsigned G = gridDim.x * gridDim.y * gridDim.z;
  unsigned sum, cnt, mine, sp = 0u;
  for (;;) {
    sum = 0u; cnt = 0u; mine = 0u;
    _Pragma("unroll") for (unsigned j = 0; j < 16; ++j) { const unsigned c = xb_ld(&bar[XB_XCNT(j)]); sum += c; cnt += (c > 0u) ? 1u : 0u; mine = (j == x) ? c : mine; }
    if (sum == G) break;
    __builtin_amdgcn_s_sleep(1);
    if ((++sp & 255u) == 0u) { if (xb_ld(&bar[XB_TMO])) break; if (sp > XB_SPIN_CAP) { atomicAdd(&bar[XB_TMO], 1u); break; } }
  }
  nloc = mine > 0u ? mine : 1u; nx = cnt > 0u ? cnt : 1u;
}
DI void xcd_barrier(const XcdBarrier& b) {
  asm volatile("s_waitcnt vmcnt(0)" ::: "memory");
  __syncthreads();
  if (rtid() == 0) {
    unsigned* bar = b.bar; unsigned bx = b.x;
    asm volatile("" : "+s"(bar), "+s"(bx));
    __builtin_amdgcn_s_waitcnt(0);
    unsigned nloc = b.st[0], nx = b.st[1];
    if (nloc == 0u) { xcd_barrier_complete(bar, bx, nloc, nx); b.st[0] = nloc; b.st[1] = nx; }
    const unsigned old = xb_add(&bar[XB_XSUB(bx)], 1u);
    const unsigned gen = old / nloc;
    if (old + 1u == (gen + 1u) * nloc) {
      __builtin_amdgcn_fence(__ATOMIC_RELEASE, "agent");
      asm volatile("s_waitcnt vmcnt(0)" ::: "memory");
      const unsigned og = xb_add(&bar[XB_TOP], 1u);
      const unsigned tg = og / nx;
      if (og + 1u == (tg + 1u) * nx) xb_add(&bar[XB_TOPGEN], 1u);
      else XB_SPIN(xb_ld(&bar[XB_TOPGEN]) == tg, bar);
      __builtin_amdgcn_fence(__ATOMIC_ACQUIRE, "agent");
      xb_add(&bar[XB_XGEN(bx)], 1u);
      asm volatile("s_waitcnt vmcnt(0)" ::: "memory");
    } else {
      XB_SPIN(xb_ld(&bar[XB_XGEN(bx)]) == gen, bar);
      __builtin_amdgcn_fence(__ATOMIC_ACQUIRE, "agent");
      asm volatile("s_waitcnt vmcnt(0)" ::: "memory");
    }
  }
  __syncthreads();
}

constexpr size_t al256(size_t v) { return (v + 255) & ~(size_t)255; }
struct WsLayout {
  size_t bar, ctl, h, hb, w_in_t, w_br_t, w_out_t, cs, rwp, rgb, lam, counts, tok_slot, tok_w, slot_tok, mstat, nvec, wgt, bcum, ligate;
  size_t qa, ka, vaT, qb, kb, vbT, cq, ck, cvT, co, cg, gz, qc, kc, kcT, U, end_mixer;
  size_t w_gu_t, w_dn_t, H, ys, end_moe, need;
};
constexpr WsLayout make_layout() {
  WsLayout w{}; size_t off = 0;
#define TAKE(f, bytes) w.f = off; off = al256(off + (size_t)(bytes));
  TAKE(bar, XCD_BAR_WORDS * 4) TAKE(ctl, 4096)
  TAKE(h, (size_t)TP * D * 4) TAKE(hb, (size_t)TP * D * 2) TAKE(w_in_t, (size_t)DINP * D * 2) TAKE(w_br_t, (size_t)3 * 1024 * 512 * 2) TAKE(w_out_t, (size_t)D * D * 2)
  TAKE(cs, (size_t)L * 32 * 8) TAKE(rwp, (size_t)2 * 64 * 3 * 64 * 4 * 4) TAKE(rgb, 2 * 2 * 48 * 4) TAKE(lam, 256) TAKE(counts, NEXP * CSTR * 4) TAKE(tok_slot, (size_t)T * 2 * 4) TAKE(tok_w, (size_t)T * 2 * 4) TAKE(slot_tok, (size_t)NEXP * CAP * 4)
  TAKE(mstat, (size_t)16 * NCH * 4 * 4) TAKE(nvec, (size_t)16 * NCH * 128 * 4) TAKE(wgt, (size_t)16 * LPAD * 4) TAKE(bcum, (size_t)16 * LPAD * 4) TAKE(ligate, (size_t)16 * LPAD * 4)
  const size_t scratch0 = off;
  TAKE(qa, (size_t)NB * 4 * 2 * L * 64 * 2) TAKE(ka, (size_t)NB * 4 * 2 * L * 64 * 2 + 4096) TAKE(vaT, (size_t)NB * 4 * 128 * LK * 2)
  TAKE(qb, (size_t)NB * 8 * L * 64 * 2) TAKE(kb, (size_t)NB * 2 * L * 64 * 2 + 4096) TAKE(vbT, (size_t)NB * 2 * 64 * LK * 2)
  TAKE(cq, (size_t)TP * 512 * 2) TAKE(ck, (size_t)TP * 512 * 2) TAKE(cvT, (size_t)8 * 128 * LPAD * 2) TAKE(co, (size_t)TP * 512 * 2) TAKE(cg, (size_t)TP * 16 * 4)
  TAKE(gz, (size_t)TP * 3072 * 2) TAKE(qc, (size_t)8 * LPAD * 128 * 2) TAKE(kc, (size_t)8 * LPAD * 128 * 2) TAKE(kcT, (size_t)8 * 128 * LPAD * 2) TAKE(U, (size_t)16 * NCH * 16384 * 4)
  w.end_mixer = off;
  off = scratch0;
  TAKE(w_gu_t, (size_t)NEXP * 1024 * 1024 * 2) TAKE(w_dn_t, (size_t)NEXP * 1024 * 512 * 2) TAKE(H, (size_t)HROWS * 512 * 2) TAKE(ys, (size_t)HROWS * D * 2)
  w.end_moe = off;
#undef TAKE
  w.need = w.end_mixer > w.end_moe ? w.end_mixer : w.end_moe;
  return w;
}
constexpr WsLayout WL = make_layout();
static_assert(WL.need <= (size_t)552 * 1000 * 1000, "workspace");

struct SchedP1 {
  static constexpr bool GATHER = false;
  const char* hb; const char* w; int G, c;
  DI bool next(int i, g8::Unit& u) const {
    const int Lq = i * G + c; int pm, pn;
    if (Lq < 65 * 25) { g8::grid_lin(Lq, 65, 25, pm, pn); u.tag = 0; u.a = hb + (size_t)pm * 256 * D * 2; u.b = w + (size_t)pn * 256 * D * 2; }
    else if (Lq < 65 * 25 + 5 * 65) { g8::grid_lin(Lq - 65 * 25, 5, 65, pm, pn); u.tag = 1; u.a = w + (size_t)(6400 + pm * 256) * D * 2; u.b = hb + (size_t)pn * 256 * D * 2; }
    else return false;
    u.pm = pm; u.pn = pn; return true;
  }
  DI void arows(const g8::Unit&, int, unsigned (&)[2]) const {}
};
DI u32x4 pack8(const g8::f32x4& a, const g8::f32x4& b) { u32x4 o; o.x = pk2(a[0], a[1]); o.y = pk2(a[2], a[3]); o.z = pk2(b[0], b[1]); o.w = pk2(b[2], b[3]); return o; }
struct EpiP1 {
  static constexpr bool PERM = true;
  char* ws;
  DI bool keep(const g8::Unit&) const { return false; }
  DI void operator()(g8::f32x4 (&acc)[2][2][4][2], const g8::Unit& u, int wr, int wc, int fr, int fq) const {
    char* wb = ws; asm volatile("" : "+s"(wb));
    if (u.tag == 0) {
      const int r0 = u.pm * 256 + 64 * wr + fr;
      _Pragma("unroll") for (int bj = 0; bj < 2; ++bj) {
        const int c0 = u.pn * 256 + 128 * bj + 32 * wc;
        const int c = c0 + 8 * fq;
        if (c0 < 1664) {
          const int u64 = c0 >> 6, q = ((c0 >> 5) & 1) * 4 + fq;
          bf16_t* base; int nh, uu; float sc;
          if (u64 < 8) { base = (bf16_t*)(wb + WL.qa); nh = 8; uu = u64; sc = QSCALE; }
          else if (u64 < 16) { base = (bf16_t*)(wb + WL.ka); nh = 8; uu = u64 - 8; sc = 1.f; }
          else if (u64 < 24) { base = (bf16_t*)(wb + WL.qb); nh = 8; uu = u64 - 16; sc = QSCALE; }
          else { base = (bf16_t*)(wb + WL.kb); nh = 2; uu = u64 - 24; sc = 1.f; }
          const f32x2* cs = (const f32x2*)(wb + WL.cs);
          _Pragma("unroll") for (int ai = 0; ai < 2; ++ai) {
            g8::f32x4 c01[4], c23[4];
            _Pragma("unroll") for (int m = 0; m < 4; ++m) {
              const int t = r0 + 128 * ai + 16 * m, tt = min(t, T - 1), b = tt >= L ? 1 : 0, pos = tt - b * L;
              const g8::f32x4* cp = (const g8::f32x4*)(cs + (size_t)pos * 32 + 4 * q);
              c01[m] = cp[0]; c23[m] = cp[1];
            }
            __builtin_amdgcn_sched_barrier(0);
            _Pragma("unroll") for (int m = 0; m < 4; ++m) {
              const int t = r0 + 128 * ai + 16 * m, tt = min(t, T - 1), b = tt >= L ? 1 : 0, pos = tt - b * L;
              const g8::f32x4 x1 = acc[ai][bj][m][0], x2 = acc[ai][bj][m][1];
              g8::f32x4 o1, o2;
              o1[0] = (x1[0] * c01[m][0] - x2[0] * c01[m][1]) * sc; o2[0] = (x2[0] * c01[m][0] + x1[0] * c01[m][1]) * sc;
              o1[1] = (x1[1] * c01[m][2] - x2[1] * c01[m][3]) * sc; o2[1] = (x2[1] * c01[m][2] + x1[1] * c01[m][3]) * sc;
              o1[2] = (x1[2] * c23[m][0] - x2[2] * c23[m][1]) * sc; o2[2] = (x2[2] * c23[m][0] + x1[2] * c23[m][1]) * sc;
              o1[3] = (x1[3] * c23[m][2] - x2[3] * c23[m][3]) * sc; o2[3] = (x2[3] * c23[m][2] + x1[3] * c23[m][3]) * sc;
              if (t < T) *(u32x4*)(base + ((size_t)(b * nh + uu) * L + pos) * 64 + 8 * q) = pack8(o1, o2);
            }
            __builtin_amdgcn_sched_barrier(0);
          }
        } else if (c0 < 6272) {
          bf16_t* dst0; int stride; bool sig = false;
          if (c0 < 2176) { dst0 = (bf16_t*)(wb + WL.cq) + (c - 1664); stride = 512; }
          else if (c0 < 2688) { dst0 = (bf16_t*)(wb + WL.ck) + (c - 2176); stride = 512; }
          else if (c0 < 3200) { dst0 = (bf16_t*)(wb + WL.co) + (c - 2688); stride = 512; }
          else { dst0 = (bf16_t*)(wb + WL.gz) + (c - 3200); stride = 3072; sig = true; }
          _Pragma("unroll") for (int ai = 0; ai < 2; ++ai) _Pragma("unroll") for (int m = 0; m < 4; ++m) {
            const int t = r0 + 128 * ai + 16 * m;
            g8::f32x4 v0 = acc[ai][bj][m][0], v1 = acc[ai][bj][m][1];
            if (sig) { _Pragma("unroll") for (int e = 0; e < 4; ++e) { v0[e] = fmaxf(sigmoidf_(v0[e]), 1e-12f); v1[e] = fmaxf(sigmoidf_(v1[e]), 1e-12f); } }
            if (t < T) *(u32x4*)(dst0 + (size_t)t * stride) = pack8(v0, v1);
          }
        } else if (c0 == 6272) {
          if (fq < 2) {
            float* cg = (float*)(wb + WL.cg);
            _Pragma("unroll") for (int ai = 0; ai < 2; ++ai) _Pragma("unroll") for (int m = 0; m < 4; ++m) {
              const int t = r0 + 128 * ai + 16 * m;
              if (t < T) { g8::f32x4* d = (g8::f32x4*)(cg + (size_t)t * 16 + 8 * fq); d[0] = acc[ai][bj][m][0]; d[1] = acc[ai][bj][m][1]; }
            }
          }
        }
      }
    } else {
      const int chb0 = u.pm * 256 + 64 * wr;
      _Pragma("unroll") for (int ai = 0; ai < 2; ++ai) _Pragma("unroll") for (int m = 0; m < 4; ++m) {
        const int chb = chb0 + 128 * ai + 16 * m;
        if (chb < 1152) {
          const int ch = chb + fr; bf16_t* rp; size_t bs;
          if (chb < 512) { rp = (bf16_t*)(wb + WL.vaT) + (size_t)ch * LK; bs = (size_t)512 * LK; }
          else if (chb < 640) { rp = (bf16_t*)(wb + WL.vbT) + (size_t)(ch - 512) * LK; bs = (size_t)128 * LK; }
          else { rp = (bf16_t*)(wb + WL.cvT) + (size_t)(ch - 640) * LPAD + MPAD; bs = (size_t)512 * LPAD; }
          _Pragma("unroll") for (int bj = 0; bj < 2; ++bj) {
            const int t0 = u.pn * 256 + 128 * bj + 32 * wc + 8 * fq;
            if (t0 < T) { const int b = t0 >= L ? 1 : 0, pos0 = t0 - b * L; *(u32x4*)(rp + b * bs + pos0) = pack8(acc[ai][bj][m][0], acc[ai][bj][m][1]); }
          }
        }
      }
    }
  }
};
DI void phase_p1(const Params& P, int l, char* smem_wg, int bid, int nblk) {
  SchedP1 S; S.hb = (const char*)P.hb; S.w = (const char*)P.w_in_t; S.G = nblk >> 1; S.c = bid >> 1;
  EpiP1 E; E.ws = (char*)P.h - WL.h;
  g8::gemm_phase((g8::lds_u8*)smem_wg, D, S, E);
}

struct KArgs { const float* in[28]; float* out; char* ws; };
typedef const __attribute__((address_space(4))) KArgs* KAP;
DI Params make_params(KAP k) {
  Params P;
  P.x = k->in[0]; P.meta = k->in[1]; P.ln_in_g = k->in[2]; P.ln_in_b = k->in[3]; P.w_in = k->in[4]; P.conv_w = k->in[5]; P.conv_b = k->in[6]; P.gate_b = k->in[7];
  P.lam_q1 = k->in[8]; P.lam_k1 = k->in[9]; P.lam_q2 = k->in[10]; P.lam_k2 = k->in[11]; P.diff_g = k->in[12]; P.sink = k->in[13]; P.mlstm_g = k->in[14];
  P.w_branch = k->in[15]; P.w_out = k->in[16]; P.ln1_g = k->in[17]; P.ln1_b = k->in[18]; P.ln2_g = k->in[19]; P.ln2_b = k->in[20]; P.w_rg = k->in[21]; P.b_rg = k->in[22];
  P.w_re = k->in[23]; P.b_re = k->in[24]; P.w_gate = k->in[25]; P.w_up = k->in[26]; P.w_down = k->in[27];
  P.out = k->out;
  char* ws = k->ws;
  P.h = (float*)(ws + WL.h); P.hb = (bf16_t*)(ws + WL.hb); P.w_in_t = (bf16_t*)(ws + WL.w_in_t); P.w_br_t = (bf16_t*)(ws + WL.w_br_t); P.w_out_t = (bf16_t*)(ws + WL.w_out_t);
  P.cs = (f32x2*)(ws + WL.cs); P.lam = (float*)(ws + WL.lam); P.ctl = (unsigned*)(ws + WL.ctl); P.rwp = (float*)(ws + WL.rwp); P.rgb = (float*)(ws + WL.rgb); P.counts = (int*)(ws + WL.counts); P.tok_slot = (int*)(ws + WL.tok_slot); P.tok_w = (float*)(ws + WL.tok_w);
  P.slot_tok = (int*)(ws + WL.slot_tok); P.mstat = (float*)(ws + WL.mstat); P.nvec = (float*)(ws + WL.nvec); P.wgt = (float*)(ws + WL.wgt); P.bcum = (float*)(ws + WL.bcum);
  P.ligate = (float*)(ws + WL.ligate);
  P.qa = (bf16_t*)(ws + WL.qa); P.ka = (bf16_t*)(ws + WL.ka); P.vaT = (bf16_t*)(ws + WL.vaT); P.qb = (bf16_t*)(ws + WL.qb); P.kb = (bf16_t*)(ws + WL.kb); P.vbT = (bf16_t*)(ws + WL.vbT);
  P.cq = (bf16_t*)(ws + WL.cq); P.ck = (bf16_t*)(ws + WL.ck); P.merged = P.cq; P.cvT = (bf16_t*)(ws + WL.cvT); P.co = (bf16_t*)(ws + WL.co); P.cg = (float*)(ws + WL.cg);
  P.gz = (bf16_t*)(ws + WL.gz); P.qc = (bf16_t*)(ws + WL.qc); P.kc = (bf16_t*)(ws + WL.kc); P.kcT = (bf16_t*)(ws + WL.kcT); P.U = (float*)(ws + WL.U);
  P.w_gu_t = (bf16_t*)(ws + WL.w_gu_t); P.w_dn_t = (bf16_t*)(ws + WL.w_dn_t); P.H = (bf16_t*)(ws + WL.H); P.ys = (bf16_t*)(ws + WL.ys);
  P.oa = (bf16_t*)k->out; P.ob = P.oa + (size_t)TP * 512; P.oc = P.ob + (size_t)TP * 512;
  return P;
}

constexpr int SMEM_BYTES = 2 * DA_STAGE + 4096 + 256;
constexpr int WG_LDS = 2 * SMEM_BYTES + 64 + 256;
static_assert(WIDTAB_OFF == 2 * SMEM_BYTES + 64, "wave-slot table offset");
#define PH(...) { KAP k_ = ka; int bid = bid0, nblk = nblk0; asm volatile("" : "+s"(k_), "+s"(bid), "+s"(nblk)); const Params P = make_params(k_); __VA_ARGS__; }
__global__ void __launch_bounds__(512, 2) mega(KArgs kargs) {
  extern __shared__ __attribute__((aligned(16))) char smem_wg[];
  (void)kargs;
  const KAP ka = (KAP)__builtin_amdgcn_kernarg_segment_ptr();
  {
    const unsigned hw = (unsigned)__builtin_amdgcn_s_getreg((5 << 11) | 4) & 63u;
    *(volatile LAS int*)(size_t)(WIDTAB_OFF + 4 * hw) = (int)(threadIdx.x >> 6);
  }
  __syncthreads();
  const int half = __builtin_amdgcn_readfirstlane(rtid() >> 8);
  char* smem = smem_wg + half * SMEM_BYTES;
  const int bid0 = 2 * blockIdx.x + half, nblk0 = 2 * gridDim.x;
  volatile LAS unsigned* st = (volatile LAS unsigned*)(smem_wg + 2 * SMEM_BYTES);
  volatile LAS int* wgq = (volatile LAS int*)(smem_wg + 2 * SMEM_BYTES + 16);
  if (rtid() == 0) { st[0] = 0u; st[1] = 0u; }
  __syncthreads();
  const XcdBarrier xb = xcd_barrier_post((unsigned*)(ka->ws + WL.bar), st);

  PH(phase_prologue(P, bid, nblk))
  PH(phase_router_prep(P, bid, nblk))
  PH(phase_wconv_small(P, 0, smem, bid, nblk))
  xcd_barrier(xb);
  auto layer = [&](const int l) __attribute__((always_inline)) {
    PH(phase_zero_pads(P, bid, nblk))
    PH(phase_p1(P, l, smem_wg, bid, nblk))
    xcd_barrier(xb);
    PH(phase_mprep(P, l, smem, bid, nblk))
    xcd_barrier(xb);
    for (int it = bid0; it < 512; it += nblk0) PH(dattn_item(P, l, it, true, smem))
    PH(phase_mscan(P, bid, nblk))
    xcd_barrier(xb);
    {
      for (int it = (int)blockIdx.x; it < 256; it += (int)gridDim.x) PH(dattn_item16(P, l, it, smem_wg))
      unsigned* qctr = (unsigned*)(ka->ws + WL.ctl) + (l * 8 + 5) * 16;
      const int NP = 4 + 4 * NCH + 2 * 257;
      for (;;) {
        __syncthreads();
        if (rtid() == 0) wgq[0] = (int)xb_add(qctr, 1u);
        __syncthreads();
        const int pr = wgq[0];
        if (pr >= NP) break;
        if (pr < 4) PH(dattn_combine(P, l, 2 * pr + half, smem))
        else if (pr < 4 + 4 * NCH) PH(mout_item(P, l, 2 * (pr - 4) + half, smem))
        else PH(swa_item(P, l, 2 * (pr - 4 - 4 * NCH) + half, smem))
      }
    }
    xcd_barrier(xb);
    PH(phase_p3a(P, l, smem, smem_wg, bid, nblk))
    xcd_barrier(xb);
    PH(phase_p3b(P, l, smem, smem_wg, bid, nblk))
    xcd_barrier(xb);
    PH(phase_p4(P, l, smem, bid, nblk))
    PH(phase_wconv_experts(P, l, smem, half, wgq))
    xcd_barrier(xb);
    PH(phase_p5a(P, l, smem_wg, bid, nblk))
    xcd_barrier(xb);
    PH(phase_p5b(P, l, smem_wg, bid, nblk))
    xcd_barrier(xb);
    PH(phase_p6(P, l, smem, bid, nblk))
    if (l == 0) PH(phase_wconv_small(P, 1, smem, bid, nblk))
    xcd_barrier(xb);
  };
  layer(0);
  layer(1);
}

extern "C" void kernel_launch(void* const* d_in, const int* in_sizes, int n_in, void* d_out, int out_size, void* d_ws, size_t ws_size, hipStream_t stream) {
  (void)in_sizes; (void)n_in; (void)out_size;
  if (WL.need > ws_size) return;
  KArgs a{};
  for (int i = 0; i < 28; ++i) a.in[i] = (const float*)d_in[i];
  a.out = (float*)d_out; a.ws = (char*)d_ws;
  static int grid = 0;
  if (!grid) {
    int dev = 0, cus = 0, per_cu = 0;
    (void)hipGetDevice(&dev);
    (void)hipDeviceGetAttribute(&cus, hipDeviceAttributeMultiprocessorCount, dev);
    (void)hipFuncSetAttribute((const void*)mega, hipFuncAttributeMaxDynamicSharedMemorySize, WG_LDS);
    (void)hipOccupancyMaxActiveBlocksPerMultiprocessor(&per_cu, (const void*)mega, 512, WG_LDS);
    if (per_cu > 1) per_cu = 1;
    if (per_cu < 1) per_cu = 1;
    grid = cus * per_cu;
  }
  (void)hipMemsetAsync((char*)d_ws + WL.bar, 0, WL.h - WL.bar, stream);
  hipLaunchKernelGGL(mega, dim3(grid), dim3(512), WG_LDS, stream, a);
}
```

```cpp
#include <hip/hip_runtime.h>
#include <stdint.h>

#define DI __device__ __forceinline__
typedef unsigned short bf16_t;
typedef __attribute__((ext_vector_type(8))) short bf16x8;
typedef __attribute__((ext_vector_type(16))) float f32x16;
typedef __attribute__((ext_vector_type(2))) float f32x2;
typedef __attribute__((ext_vector_type(4))) float f32x4;
typedef __attribute__((ext_vector_type(4))) unsigned u32x4;
typedef __attribute__((ext_vector_type(2))) unsigned u32x2;
typedef __attribute__((ext_vector_type(2))) __bf16 bf16x2v;
#define MFMA32(a, b, c) __builtin_amdgcn_mfma_f32_32x32x16_bf16((a), (b), (c), 0, 0, 0)

constexpr int NB = 2, SEQ = 8192, NMETA = 16, L = 8208, T = NB * L, TP = 16512, D = 1024;
constexpr int DIN = 7440, DINP = 7680;
constexpr int LPAD = 8320, NCH = 65, MPAD = 112, LK = 8256;
constexpr int NEXP = 32, CAP = 2 * T, HROWS = 2 * T + NEXP * 256;
constexpr int NT = 256;
constexpr int CSTR = 64;
constexpr float LN_EPS = 1e-5f;
constexpr float NEGF = -1e30f;
constexpr int SMEM_TQ = 65536 + 4096 + 64;
constexpr float ALPHA = 1.41421356237309515f;
constexpr float QSCALE = 0.125f * 1.44269504088896341f;

DI f32x4 mk4(float a, float b, float c, float d) { f32x4 v = {a, b, c, d}; return v; }
DI f32x2 mk2(float a, float b) { f32x2 v = {a, b}; return v; }
DI unsigned pk2(float a, float b) { f32x2 v = {a, b}; bf16x2v r = __builtin_convertvector(v, bf16x2v); return __builtin_bit_cast(unsigned, r); }
DI bf16_t f2bf(float a) { return (bf16_t)(pk2(a, 0.f) & 0xffffu); }
DI float bf2f(bf16_t b) { return __uint_as_float(((unsigned)b) << 16); }
DI float bflo(unsigned u) { return __uint_as_float(u << 16); }
DI float bfhi(unsigned u) { return __uint_as_float(u & 0xffff0000u); }
typedef __attribute__((address_space(3))) int LAS_I;
constexpr int WIDTAB_OFF = 2 * (2 * 32768 + 4096 + 256) + 64;
DI int rtid() {
  const unsigned hw = (unsigned)__builtin_amdgcn_s_getreg((5 << 11) | 4) & 63u;
  const int wid = *(volatile __attribute__((address_space(3))) int*)(size_t)(WIDTAB_OFF + 4 * hw);
  return wid * 64 + (int)__builtin_amdgcn_mbcnt_hi(~0u, __builtin_amdgcn_mbcnt_lo(~0u, 0u));
}
DI int otid() { int t = rtid() & 255; asm volatile("" : "+v"(t)); return t; }
DI int crow(int r, int h) { return (r & 3) + 8 * (r >> 2) + 4 * h; }
DI int keyoff(int r, int h) { return (r & 7) + 8 * h + 16 * (r >> 3); }
DI int swz(int row) { return (row >> 1) & 7; }
DI int kswap(int r) { return (r & 0x13) | ((r & 4) << 1) | ((r & 8) >> 1); }
template <int O> DI float sxor(float v) { return __builtin_bit_cast(float, __builtin_amdgcn_ds_swizzle(__builtin_bit_cast(int, v), 0x1f | (O << 10))); }
DI float sx32(float v) {
  int ln = (int)__builtin_amdgcn_mbcnt_hi(~0u, __builtin_amdgcn_mbcnt_lo(~0u, 0u)); asm volatile("" : "+v"(ln));
  return __builtin_bit_cast(float, __builtin_amdgcn_ds_bpermute((ln ^ 32) << 2, __builtin_bit_cast(int, v)));
}
DI float xsum32(float v) { return v + sx32(v); }
DI float xmax32(float v) { return fmaxf(v, sx32(v)); }
DI float wave_sum(float v) { v = xsum32(v); v += sxor<16>(v); v += sxor<8>(v); v += sxor<4>(v); v += sxor<2>(v); v += sxor<1>(v); return v; }
DI float wave_max(float v) { v = xmax32(v); v = fmaxf(v, sxor<16>(v)); v = fmaxf(v, sxor<8>(v)); v = fmaxf(v, sxor<4>(v)); v = fmaxf(v, sxor<2>(v)); v = fmaxf(v, sxor<1>(v)); return v; }
DI float fexp2(float x) { return __builtin_amdgcn_exp2f(x); }
DI float frcp(float x) { return __builtin_amdgcn_rcpf(x); }
DI float shfl_up_f(float v, int d, int lane) { return __builtin_bit_cast(float, __builtin_amdgcn_ds_bpermute(((lane - d) & 63) << 2, __builtin_bit_cast(int, v))); }
DI float sigmoidf_(float x) { return frcp(1.f + __expf(-x)); }
DI bf16x8 ldfrag(const bf16_t* p) { return *(const bf16x8*)p; }
DI f32x16 zero16() { f32x16 z; _Pragma("unroll") for (int i = 0; i < 16; ++i) z[i] = 0.f; return z; }
DI bf16x8 packfrag(const f32x16& x, int s) {
  union { unsigned u[4]; bf16x8 v; } t;
  t.u[0] = pk2(x[8 * s + 0], x[8 * s + 1]); t.u[1] = pk2(x[8 * s + 2], x[8 * s + 3]);
  t.u[2] = pk2(x[8 * s + 4], x[8 * s + 5]); t.u[3] = pk2(x[8 * s + 6], x[8 * s + 7]);
  return t.v;
}

struct Params {
  const float *x, *meta, *ln_in_g, *ln_in_b, *w_in, *conv_w, *conv_b, *gate_b, *lam_q1, *lam_k1, *lam_q2, *lam_k2;
  const float *diff_g, *sink, *mlstm_g, *w_branch, *w_out, *ln1_g, *ln1_b, *ln2_g, *ln2_b, *w_rg, *b_rg, *w_re, *b_re;
  const float *w_gate, *w_up, *w_down;
  float* out;
  float* h; bf16_t* hb; bf16_t *w_in_t, *w_br_t, *w_out_t; f32x2* cs; float* lam; unsigned* ctl; float* rwp; float* rgb;
  int* counts; int* tok_slot; float* tok_w; int* slot_tok;
  float* mstat;
  float* nvec;
  float* wgt;
  float* bcum;
  float* ligate;
  bf16_t *qa, *ka, *vaT, *qb, *kb, *vbT, *cq, *ck, *cvT, *co, *gz, *qc, *kc, *kcT, *merged;
  float* cg; float* U;
  bf16_t *oa, *ob, *oc;
  bf16_t *w_gu_t, *w_dn_t, *H, *ys;
};

typedef __attribute__((address_space(3))) unsigned lds_u32;

namespace g8 {
typedef __attribute__((address_space(3))) unsigned char lds_u8;
typedef float f32x4 __attribute__((ext_vector_type(4)));
constexpr int BK = 64, HALF = 128, HTB = HALF * BK * 2, STAGE_BYTES = 8 * HTB;
DI int lds_byte(int r, int c) { const int st = (r >> 4) * 2 + (c >> 5), rr = r & 15, cc = c & 31, ob = rr * 64 + cc * 2; return st * 1024 + (ob ^ (((ob >> 9) & 1) << 5)); }
DI void stage_rc(int b, int& R, int& C) { const int st = b / 1024, sb = b % 1024, swz = sb ^ (((sb >> 9) & 1) << 5); R = (st >> 1) * 16 + swz / 64; C = (st & 1) * 32 + (swz % 64) / 2; }
DI int perm32(int rho) { const int n = rho >> 4, i = rho & 15; return 8 * (i >> 2) + 4 * n + (i & 3); }
struct Unit { const char* a; const char* b; int pm, pn, tag, x0, x1; };
template <class Epi, class Sched>
DI void gemm_phase(lds_u8* lds, int K, const Sched& S, const Epi& E) {
  int tid = rtid(); asm volatile("" : "+v"(tid));
  const int wid = __builtin_amdgcn_readfirstlane(tid >> 6), lane = tid & 63, wr = wid >> 2, wc = wid & 3, fr = lane & 15, fq = lane >> 4;
  const int nt = K / BK;
  int R[2], C[2]; unsigned voffB[2];
  _Pragma("unroll") for (int i = 0; i < 2; ++i) { stage_rc(tid * 16 + i * 8192, R[i], C[i]); const int Rb = Epi::PERM ? ((R[i] & ~31) + perm32(R[i] & 31)) : R[i]; voffB[i] = (unsigned)(Rb * K + C[i]) * 2u; }
  const size_t kstep = (size_t)(BK * 2), hstep = (size_t)HALF * K * 2;
  const unsigned ldsw = (unsigned)wid * 1024u;
  const int aoff = lds_byte(wr * 64 + fr, fq * 8), boff = lds_byte(wc * 32 + fr, fq * 8);
#define G8_SA(b, h) (((b) * 2 + (h)) * HTB)
#define G8_SB(b, h) ((4 + (b) * 2 + (h)) * HTB)
#define G8_STAGE(bufoff, gbase, voff) do { _Pragma("unroll") for (int _i = 0; _i < 2; ++_i) \
    __builtin_amdgcn_global_load_lds((const unsigned*)((const char*)(gbase) + (voff)[_i]), (lds_u32*)(lds + (bufoff) + ldsw + _i * 8192), 16, 0, 0); } while (0)
#define G8_LDA(dst, b, h) do { _Pragma("unroll") for (int m = 0; m < 4; ++m) _Pragma("unroll") for (int k = 0; k < 2; ++k) dst[m][k] = *(const __attribute__((address_space(3))) bf16x8*)(lds + G8_SA(b, h) + aoff + m * 2048 + k * 1024); } while (0)
#define G8_LDB(dst, b, h) do { _Pragma("unroll") for (int n = 0; n < 2; ++n) _Pragma("unroll") for (int k = 0; k < 2; ++k) dst[n][k] = *(const __attribute__((address_space(3))) bf16x8*)(lds + G8_SB(b, h) + boff + n * 2048 + k * 1024); } while (0)
#define G8_MMA(ai, bj, At, Bt) do { __builtin_amdgcn_s_setprio(1); _Pragma("unroll") for (int m = 0; m < 4; ++m) _Pragma("unroll") for (int n = 0; n < 2; ++n) _Pragma("unroll") for (int k = 0; k < 2; ++k) \
    acc[ai][bj][m][n] = __builtin_amdgcn_mfma_f32_16x16x32_bf16(Bt[n][k], At[m][k], acc[ai][bj][m][n], 0, 0, 0); __builtin_amdgcn_s_setprio(0); } while (0)
#define G8_WAIT_V(n) asm volatile("s_waitcnt vmcnt(" #n ")" ::: "memory")
#define G8_WAIT_L(n) asm volatile("s_waitcnt lgkmcnt(" #n ")" ::: "memory")
#define G8_BAR __builtin_amdgcn_s_barrier()
#define G8_SCHED __builtin_amdgcn_sched_barrier(0)
  Unit cur, nxt; int ui = 0;
  if (!S.next(0, cur)) return;
  f32x4 acc[2][2][4][2];
  _Pragma("unroll") for (int a = 0; a < 2; ++a) _Pragma("unroll") for (int b = 0; b < 2; ++b) _Pragma("unroll") for (int m = 0; m < 4; ++m) _Pragma("unroll") for (int n = 0; n < 2; ++n) acc[a][b][m][n] = (f32x4){0.f, 0.f, 0.f, 0.f};
  bf16x8 At[4][2], B0[2][2], B1[2][2];
  constexpr bool GA = Sched::GATHER;
  unsigned voffA[2]; unsigned cpk[2], npk[2];
  _Pragma("unroll") for (int i = 0; i < 2; ++i) voffA[i] = (unsigned)(R[i] * K + C[i]) * 2u;
  const unsigned gc2 = (unsigned)C[0] * 2u, gk2 = (unsigned)K * 2u;
  if (GA) S.arows(cur, R[0], cpk);
#define G8_STAGE_G(bufoff, base, pk) do { const unsigned _v[2] = { ((pk) & 0xffffu) * gk2 + gc2, ((pk) >> 16) * gk2 + gc2 }; G8_STAGE(bufoff, base, _v); } while (0)
#define G8_STAGE_A(bufoff, base, h, nx) do { if (GA) { if (nx) G8_STAGE_G(bufoff, base, npk[h]); else G8_STAGE_G(bufoff, base, cpk[h]); } else G8_STAGE(bufoff, (base) + (h) * hstep, voffA); } while (0)
  const char* cA = cur.a; const char* cB = cur.b;
  G8_STAGE(G8_SB(0, 0), cB, voffB); G8_STAGE_A(G8_SA(0, 0), cA, 0, false); G8_STAGE(G8_SB(0, 1), cB + hstep, voffB); G8_STAGE_A(G8_SA(0, 1), cA, 1, false);
  if (wr == 1) G8_BAR;
  G8_WAIT_V(4); G8_BAR;
  G8_STAGE(G8_SB(1, 0), cB + kstep, voffB); G8_STAGE_A(G8_SA(1, 0), cA + kstep, 0, false); G8_STAGE(G8_SB(1, 1), cB + hstep + kstep, voffB);
  G8_WAIT_V(6); G8_BAR;
  for (;;) {
    const bool has_next = S.next(ui + 1, nxt);
    const char* nA = has_next ? nxt.a : cA; const char* nB = has_next ? nxt.b : cB;
    if (GA) { if (has_next) S.arows(nxt, R[0], npk); else { npk[0] = cpk[0]; npk[1] = cpk[1]; } }
    for (int t = 0; t < nt; t += 2) {
      const bool last = (t == nt - 2);
      const char* a1 = cA + (size_t)(t + 1) * kstep;
      const char* a2 = last ? nA : cA + (size_t)(t + 2) * kstep; const char* b2 = last ? nB : cB + (size_t)(t + 2) * kstep;
      const char* a3 = a2 + kstep; const char* b3 = b2 + kstep;
      G8_LDB(B0, 0, 0); G8_SCHED; G8_LDA(At, 0, 0); G8_STAGE_A(G8_SA(1, 1), a1, 1, false);
      G8_WAIT_L(8); G8_BAR; G8_WAIT_L(0); G8_MMA(0, 0, At, B0); G8_BAR; G8_SCHED;
      G8_LDB(B1, 0, 1); G8_STAGE(G8_SB(0, 0), b2, voffB);
      G8_BAR; G8_WAIT_L(0); G8_MMA(0, 1, At, B1); G8_BAR;
      G8_LDA(At, 0, 1); G8_STAGE_A(G8_SA(0, 0), a2, 0, last);
      G8_BAR; G8_WAIT_L(0); G8_MMA(1, 0, At, B0); G8_BAR; G8_SCHED;
      G8_STAGE(G8_SB(0, 1), b2 + hstep, voffB);
      G8_WAIT_V(6); G8_BAR; G8_MMA(1, 1, At, B1); G8_BAR;
      G8_LDB(B0, 1, 0); G8_SCHED; G8_LDA(At, 1, 0); G8_STAGE_A(G8_SA(0, 1), a2, 1, last);
      G8_WAIT_L(8); G8_BAR; G8_WAIT_L(0); G8_MMA(0, 0, At, B0); G8_BAR; G8_SCHED;
      G8_LDB(B1, 1, 1); G8_STAGE(G8_SB(1, 0), b3, voffB);
      G8_BAR; G8_WAIT_L(0); G8_MMA(0, 1, At, B1); G8_BAR;
      G8_LDA(At, 1, 1); G8_STAGE_A(G8_SA(1, 0), a3, 0, last);
      G8_BAR; G8_WAIT_L(0); G8_MMA(1, 0, At, B0); G8_BAR; G8_SCHED;
      G8_STAGE(G8_SB(1, 1), b3 + hstep, voffB);
      G8_WAIT_V(6); G8_BAR; G8_MMA(1, 1, At, B1); G8_BAR;
    }
    E(acc, cur, wr, wc, fr, fq);
    if (!has_next) break;
    if (!E.keep(cur)) { _Pragma("unroll") for (int a = 0; a < 2; ++a) _Pragma("unroll") for (int b = 0; b < 2; ++b) _Pragma("unroll") for (int m = 0; m < 4; ++m) _Pragma("unroll") for (int n = 0; n < 2; ++n) acc[a][b][m][n] = (f32x4){0.f, 0.f, 0.f, 0.f}; }
    cur = nxt; cA = nA; cB = nB; ++ui;
    if (GA) { cpk[0] = npk[0]; cpk[1] = npk[1]; }
  }
  G8_WAIT_V(0);
  if (wr == 0) G8_BAR;
  G8_BAR;
#undef G8_SA
#undef G8_SB
#undef G8_STAGE
#undef G8_STAGE_A
#undef G8_STAGE_G
#undef G8_LDA
#undef G8_LDB
#undef G8_MMA
#undef G8_WAIT_V
#undef G8_WAIT_L
#undef G8_BAR
#undef G8_SCHED
}
DI void grid_lin(int wgid, int nM, int nN, int& pm, int& pn) {
  const int nwg = nM * nN;
  { const int q = nwg / 8, r = nwg % 8, xcd = wgid % 8, off = wgid / 8; wgid = (xcd < r ? xcd * (q + 1) : r * (q + 1) + (xcd - r) * q) + off; }
  const int nig = 8 * nN, gid = wgid / nig, fm = gid * 8, gsz = (nM - fm) < 8 ? (nM - fm) : 8;
  pm = fm + ((wgid % nig) % gsz); pn = (wgid % nig) / gsz;
}
DI bool grid_unit(int i, int G, int c, int nM, int nN, int& pm, int& pn) {
  const int nwg = nM * nN; const long Lq = (long)i * G + c; if (Lq >= nwg) return false;
  int wgid = (int)Lq; { const int q = nwg / 8, r = nwg % 8, xcd = wgid % 8, off = wgid / 8; wgid = (xcd < r ? xcd * (q + 1) : r * (q + 1) + (xcd - r) * q) + off; }
  const int nig = 8 * nN, gid = wgid / nig, fm = gid * 8, gsz = (nM - fm) < 8 ? (nM - fm) : 8;
  pm = fm + ((wgid % nig) % gsz); pn = (wgid % nig) / gsz; return true;
}
}

DI int ropep(int x) { const int d = x & 63; return (x & ~63) + 8 * ((d & 31) >> 2) + 4 * (d >> 5) + (d & 3); }
DI int wmap(int mode, int n) {
  if (mode == 1) {
    if (n < 512) return ropep(n);
    if (n < 1024) return 512 + ropep(n - 512);
    if (n < 1536) return 6400 + (n - 1024);
    if (n < 2048) return 1024 + ropep(n - 1536);
    if (n < 2176) return 1536 + ropep(n - 2048);
    if (n < 2304) return 6400 + 512 + (n - 2176);
    if (n < 2816) return 1664 + (n - 2304);
    if (n < 3328) return 2176 + (n - 2816);
    if (n < 3840) return 6400 + 640 + (n - 3328);
    if (n < 4352) return 2688 + (n - 3840);
    if (n < 4368) return 6272 + (n - 4352);
    return 3200 + (n - 4368);
  }
  if (mode == 2) return 8 * (n >> 2) + (n & 3);
  if (mode == 3) return 8 * (n >> 2) + 4 + (n & 3);
  return n;
}
struct CvJob { const float* src; bf16_t* dst; int K, N, mode, tk, tn; };
DI void cv_load(const CvJob& j, int tid, f32x4 (&v)[4]) {
  const int kk = tid >> 4, c4 = tid & 15, n = j.tn * 64 + 4 * c4;
  _Pragma("unroll") for (int i = 0; i < 4; ++i) {
    v[i] = mk4(0.f, 0.f, 0.f, 0.f);
    if (n < j.N) v[i] = *(const f32x4*)(j.src + (size_t)(j.tk * 64 + kk + 16 * i) * j.N + n);
  }
}
DI void cv_finish(const CvJob& j, int tid, const f32x4 (&v)[4], char* smem) {
  bf16_t* sT = (bf16_t*)smem;
  const int kk = tid >> 4, c4 = tid & 15;
  __syncthreads();
  _Pragma("unroll") for (int i = 0; i < 4; ++i) {
    const int k = kk + 16 * i;
    sT[(4 * c4 + 0) * 72 + k] = f2bf(v[i].x); sT[(4 * c4 + 1) * 72 + k] = f2bf(v[i].y);
    sT[(4 * c4 + 2) * 72 + k] = f2bf(v[i].z); sT[(4 * c4 + 3) * 72 + k] = f2bf(v[i].w);
  }
  __syncthreads();
  const int nn = tid >> 2, kc = tid & 3;
  const int ng = j.tn * 64 + nn;
  if (ng < j.N) {
    const u32x4 v0 = *(const u32x4*)(sT + nn * 72 + 16 * kc);
    const u32x4 v1 = *(const u32x4*)(sT + nn * 72 + 16 * kc + 8);
    bf16_t* d = j.dst + (size_t)wmap(j.mode, ng) * j.K + j.tk * 64 + 16 * kc;
    *(u32x4*)d = v0; *(u32x4*)(d + 8) = v1;
  }
}

constexpr int WS_TILES_IN = 16 * 117, WS_TILES_BR = 3 * 8 * 16, WS_TILES_OUT = 16 * 16;
constexpr int WS_TILES = WS_TILES_IN + WS_TILES_BR + WS_TILES_OUT;
DI CvJob ws_job(const Params& P, int l, int it) {
  CvJob j;
  if (it < WS_TILES_IN) { j.src = P.w_in + (size_t)l * D * DIN; j.K = D; j.N = DIN; j.dst = P.w_in_t; j.mode = 1; j.tk = it / 117; j.tn = it % 117; }
  else if (it < WS_TILES_IN + WS_TILES_BR) {
    const int q = it - WS_TILES_IN, i = q / 128, r = q % 128;
    j.src = P.w_branch + ((size_t)l * 3 + i) * 512 * 1024; j.K = 512; j.N = 1024; j.dst = P.w_br_t + (size_t)i * 1024 * 512; j.mode = 0; j.tk = r / 16; j.tn = r % 16;
  } else {
    const int q = it - WS_TILES_IN - WS_TILES_BR;
    j.src = P.w_out + (size_t)l * D * D; j.K = D; j.N = D; j.dst = P.w_out_t; j.mode = 0; j.tk = q / 16; j.tn = q % 16;
  }
  return j;
}
DI void phase_wconv_small(const Params& P, int l, char* smem, int bid, int nblk) {
  const int tid = otid();
  if (bid >= WS_TILES) return;
  CvJob j = ws_job(P, l, bid); f32x4 v[4];
  cv_load(j, tid, v);
  for (int it = bid; it < WS_TILES; it += nblk) {
    CvJob jn = j; f32x4 vn[4];
    _Pragma("unroll") for (int i = 0; i < 4; ++i) vn[i] = v[i];
    if (it + nblk < WS_TILES) { jn = ws_job(P, l, it + nblk); cv_load(jn, tid, vn); }
    cv_finish(j, tid, v, smem);
    j = jn;
    _Pragma("unroll") for (int i = 0; i < 4; ++i) v[i] = vn[i];
  }
}
constexpr int WE_TILES = NEXP * 384;
DI CvJob we_job(const Params& P, int l, int it) {
  const int e = it / 384, q = it % 384, which = q / 128, r = q % 128;
  const size_t eo = (size_t)l * NEXP + e;
  CvJob j;
  if (which == 0) { j.src = P.w_gate + eo * 1024 * 512; j.K = 1024; j.N = 512; j.dst = P.w_gu_t + (size_t)e * 1024 * 1024; j.mode = 2; j.tk = r / 8; j.tn = r % 8; }
  else if (which == 1) { j.src = P.w_up + eo * 1024 * 512; j.K = 1024; j.N = 512; j.dst = P.w_gu_t + (size_t)e * 1024 * 1024; j.mode = 3; j.tk = r / 8; j.tn = r % 8; }
  else { j.src = P.w_down + eo * 512 * 1024; j.K = 512; j.N = 1024; j.dst = P.w_dn_t + (size_t)e * 1024 * 512; j.mode = 0; j.tk = r / 16; j.tn = r % 16; }
  return j;
}
DI void phase_wconv_experts(const Params& P, int l, char* smem, int half, volatile __attribute__((address_space(3))) int* wgslot) {
  unsigned* ctr = P.ctl + (l * 8 + 6) * 16;
  const int tid = otid();
  for (;;) {
    __syncthreads();
    if (rtid() == 0) wgslot[0] = (int)__hip_atomic_fetch_add(ctr, 2u, __ATOMIC_RELAXED, __HIP_MEMORY_SCOPE_AGENT);
    __syncthreads();
    const int c0 = (wgslot[0] + half) * 8;
    if (c0 >= WE_TILES) break;
    CvJob j = we_job(P, l, c0); f32x4 v[4];
    cv_load(j, tid, v);
    for (int it = c0; it < c0 + 8; ++it) {
      CvJob jn = j; f32x4 vn[4];
      _Pragma("unroll") for (int i = 0; i < 4; ++i) vn[i] = v[i];
      if (it + 1 < c0 + 8) { jn = we_job(P, l, it + 1); cv_load(jn, tid, vn); }
      cv_finish(j, tid, v, smem);
      j = jn;
      _Pragma("unroll") for (int i = 0; i < 4; ++i) v[i] = vn[i];
    }
  }
}

DI void ln16(f32x4 (&v)[4], const float* g, const float* b, int lane) {
  float s = 0.f;
  _Pragma("unroll") for (int i = 0; i < 4; ++i) s += v[i].x + v[i].y + v[i].z + v[i].w;
  const float mu = wave_sum(s) * (1.f / 1024.f);
  float q = 0.f;
  _Pragma("unroll") for (int i = 0; i < 4; ++i) { v[i].x -= mu; v[i].y -= mu; v[i].z -= mu; v[i].w -= mu; q += v[i].x * v[i].x + v[i].y * v[i].y + v[i].z * v[i].z + v[i].w * v[i].w; }
  const float rs = rsqrtf(wave_sum(q) * (1.f / 1024.f) + LN_EPS);
  _Pragma("unroll") for (int i = 0; i < 4; ++i) {
    const f32x4 gg = ((const f32x4*)g)[lane + 64 * i], bb = ((const f32x4*)b)[lane + 64 * i];
    v[i].x = v[i].x * rs * gg.x + bb.x; v[i].y = v[i].y * rs * gg.y + bb.y; v[i].z = v[i].z * rs * gg.z + bb.z; v[i].w = v[i].w * rs * gg.w + bb.w;
  }
}
DI void store_row(const f32x4 (&v)[4], float* hf, bf16_t* hbf, int lane) {
  _Pragma("unroll") for (int i = 0; i < 4; ++i) {
    if (hf) ((f32x4*)hf)[lane + 64 * i] = v[i];
    if (hbf) { u32x2 u; u.x = pk2(v[i].x, v[i].y); u.y = pk2(v[i].z, v[i].w); ((u32x2*)hbf)[lane + 64 * i] = u; }
  }
}

DI void phase_prologue(const Params& P, int bid, int nblk) {
  const int tid = otid(), gtid = bid * NT + tid, gn = nblk * NT;
  for (int i = gtid; i < L * 32; i += gn) {
    const int pos = i >> 5, f = i & 31;
    const float e = (float)(2 * f) / 64.0f;
    const float pw = (float)pow(10000.0, (double)e);
    const float inv = 1.0f / pw;
    const float ang = (float)pos * inv;
    P.cs[i] = mk2((float)cos((double)ang), (float)sin((double)ang));
  }
  if (gtid < 2) {
    const int l = gtid;
    float s1 = 0.f, s2 = 0.f;
    for (int i = 0; i < 64; ++i) { s1 += P.lam_q1[l * 64 + i] * P.lam_k1[l * 64 + i]; s2 += P.lam_q2[l * 64 + i] * P.lam_k2[l * 64 + i]; }
    const float li = (float)(0.8 - 0.6 * exp(-0.3 * (double)l));
    P.lam[l] = expf(s1) - expf(s2) + li;
    P.lam[2 + l] = (float)(1.0 - (0.8 - 0.6 * exp(-0.3 * (double)l)));
  }
  const int lane = tid & 63, wv = (bid * NT + tid) >> 6, nwv = (nblk * NT) >> 6;
  for (int t = wv; t < T; t += nwv) {
    const int b = t >= L ? 1 : 0, pos = t - b * L;
    const float* src = pos < NMETA ? P.meta + (size_t)pos * D : P.x + ((size_t)b * SEQ + (pos - NMETA)) * D;
    f32x4 v[4];
    _Pragma("unroll") for (int i = 0; i < 4; ++i) v[i] = ((const f32x4*)src)[lane + 64 * i];
    ln16(v, P.ln_in_g, P.ln_in_b, lane);
    store_row(v, P.h + (size_t)t * D, P.hb + (size_t)t * D, lane);
  }
}
DI void phase_zero_pads(const Params& P, int bid, int nblk) {
  const int gtid = bid * NT + otid(), gn = nblk * NT;
  for (int i = gtid; i < 8 * 128 * (LK - L); i += gn) { const int r = i / (LK - L), cidx = i % (LK - L); P.vaT[(size_t)r * LK + L + cidx] = 0; }
  for (int i = gtid; i < 4 * 64 * (LK - L); i += gn) { const int r = i / (LK - L), cidx = i % (LK - L); P.vbT[(size_t)r * LK + L + cidx] = 0; }
  for (int i = gtid; i < 8 * 128 * MPAD; i += gn) { const int r = i / MPAD, cidx = i % MPAD; P.cvT[(size_t)r * LPAD + cidx] = 0; }
  for (int i = gtid; i < 8 * MPAD * 128; i += gn) { const int bh = i / (MPAD * 128), r = i % (MPAD * 128); P.qc[(size_t)bh * LPAD * 128 + r] = 0; P.kc[(size_t)bh * LPAD * 128 + r] = 0; }
  if (gtid < NEXP) P.counts[gtid * CSTR] = 0;
}

#define WT_FENCE() asm volatile("s_waitcnt lgkmcnt(0)" ::: "memory")
DI float logsigmoidf_(float x) { return fminf(x, 0.f) - log1pf(__expf(-fabsf(x))); }
DI void phase_mprep(const Params& P, int l, char* smem, int bid, int nblk) {
  const int tid = otid();
  float* sli = (float*)smem;
  float* slf = sli + 256;
  float* sb = slf + 256;
  float* sw = sb + 256;
  float* sred = sw + 256;
  float* sst = sred + 16 * 256;
  for (int it = bid; it < 8 * NCH; it += nblk) {
    const int bh = it < 8 * (NCH - 1) ? it / (NCH - 1) : it - 8 * (NCH - 1), n = it < 8 * (NCH - 1) ? 1 + it % (NCH - 1) : 0, b = bh >> 2, hh = bh & 3;
    __syncthreads();
    if (tid < 128) {
      const int p = 128 * n + tid, pos = p - MPAD;
      float lif = NEGF, lff = 0.f, lib = NEGF, lfb = 0.f;
      if (pos >= 0) {
        const float* g = P.cg + (size_t)(b * L + pos) * 16;
        const float* gb = P.gate_b + l * 16;
        lif = g[0 + hh] + gb[0 + hh]; lff = logsigmoidf_(g[4 + hh] + gb[4 + hh]);
        lib = g[8 + hh] + gb[8 + hh]; lfb = logsigmoidf_(g[12 + hh] + gb[12 + hh]);
      }
      sli[tid] = lif; sli[128 + tid] = lib; slf[tid] = lff; slf[128 + tid] = lfb;
    }
    __syncthreads();
    if (tid < 128) {
      const int t2 = otid(), wd = t2 >> 6, ln = t2 & 63;
      const int i0 = wd == 0 ? 2 * ln : 127 - 2 * ln, i1 = wd == 0 ? 2 * ln + 1 : 126 - 2 * ln;
      const float e0 = slf[wd * 128 + i0], e1 = slf[wd * 128 + i1];
      float scan = e0 + e1;
      _Pragma("unroll") for (int d = 1; d < 64; d <<= 1) { const float tt = shfl_up_f(scan, d, ln); if (ln >= d) scan += tt; }
      float excl = shfl_up_f(scan, 1, ln); if (ln == 0) excl = 0.f;
      sb[wd * 128 + i0] = excl + e0; sb[wd * 128 + i1] = excl + e0 + e1;
    }
    __syncthreads();
    if (tid < 128) {
      const int dir = tid >> 6, lane = tid & 63;
      const float g = dir == 0 ? sb[127] : sb[128];
      const float a0 = g - sb[dir * 128 + lane] + sli[dir * 128 + lane];
      const float a1 = g - sb[dir * 128 + lane + 64] + sli[dir * 128 + lane + 64];
      const float am = wave_max(fmaxf(a0, a1));
      const float w0 = __expf(a0 - am), w1 = __expf(a1 - am);
      sw[dir * 128 + lane] = w0; sw[dir * 128 + lane + 64] = w1;
      const size_t base = ((size_t)dir * 8 + bh) * LPAD + 128 * n;
      P.wgt[base + lane] = w0; P.wgt[base + lane + 64] = w1;
      P.bcum[base + lane] = sb[dir * 128 + lane]; P.bcum[base + lane + 64] = sb[dir * 128 + lane + 64];
      P.ligate[base + lane] = sli[dir * 128 + lane]; P.ligate[base + lane + 64] = sli[dir * 128 + lane + 64];
      if (lane == 0) { float* ms = P.mstat + ((size_t)(dir * 8 + bh) * NCH + n) * 4; ms[0] = g; ms[1] = am; }
    }
    __syncthreads();
    bf16_t* skT = (bf16_t*)(smem + 32768);
    if (n == 0) { for (int i = tid; i < 128 * MPAD; i += NT) skT[(i / MPAD) * 136 + (i % MPAD)] = 0; }
    const int tid3 = otid();
    const int dg = tid3 & 15, tl = tid3 >> 4;
    float nf[8], nbk[8];
    _Pragma("unroll") for (int j = 0; j < 8; ++j) { nf[j] = 0.f; nbk[j] = 0.f; }
    const int ch = hh * 128 + dg * 8;
    float cw[2][3][8], cb[2][8];
    _Pragma("unroll") for (int j = 0; j < 8; ++j) {
      _Pragma("unroll") for (int ww = 0; ww < 3; ++ww) { cw[0][ww][j] = P.conv_w[((size_t)l * 3 + ww) * 1024 + ch + j]; cw[1][ww][j] = P.conv_w[((size_t)l * 3 + ww) * 1024 + 512 + ch + j]; }
      cb[0][j] = P.conv_b[l * 1024 + ch + j]; cb[1][j] = P.conv_b[l * 1024 + 512 + ch + j];
    }
    _Pragma("unroll 1") for (int hb4 = 0; hb4 < 8; hb4 += 4) {
      u32x4 uq[4][3], uk[4][3];
      _Pragma("unroll") for (int i4 = 0; i4 < 4; ++i4) {
        const int pos = 128 * n + tl + 16 * (hb4 + i4) - MPAD;
        _Pragma("unroll") for (int ww = 0; ww < 3; ++ww) {
          const int pp = min(max(pos + ww - 1, 0), L - 1);
          uq[i4][ww] = *(const u32x4*)(P.cq + (size_t)(b * L + pp) * 512 + ch);
          uk[i4][ww] = *(const u32x4*)(P.ck + (size_t)(b * L + pp) * 512 + ch);
        }
      }
      __builtin_amdgcn_sched_barrier(0);
      _Pragma("unroll") for (int i4 = 0; i4 < 4; ++i4) {
        const int tau = tl + 16 * (hb4 + i4), p = 128 * n + tau, pos = p - MPAD;
        float q[8], k[8];
        _Pragma("unroll") for (int j = 0; j < 8; ++j) { q[j] = cb[0][j]; k[j] = cb[1][j]; }
        _Pragma("unroll") for (int ww = 0; ww < 3; ++ww) {
          const int pp = pos + ww - 1;
          const float vm = (pp >= 0 && pp < L) ? 1.f : 0.f;
          const unsigned aq[4] = {uq[i4][ww].x, uq[i4][ww].y, uq[i4][ww].z, uq[i4][ww].w}, ak[4] = {uk[i4][ww].x, uk[i4][ww].y, uk[i4][ww].z, uk[i4][ww].w};
          _Pragma("unroll") for (int j = 0; j < 4; ++j) {
            q[2 * j] += bflo(aq[j]) * (cw[0][ww][2 * j] * vm); q[2 * j + 1] += bfhi(aq[j]) * (cw[0][ww][2 * j + 1] * vm);
            k[2 * j] += bflo(ak[j]) * (cw[1][ww][2 * j] * vm); k[2 * j + 1] += bfhi(ak[j]) * (cw[1][ww][2 * j + 1] * vm);
          }
        }
        const float wf = sw[tau], wb = sw[128 + tau];
        _Pragma("unroll") for (int j = 0; j < 8; ++j) {
          q[j] = q[j] * sigmoidf_(q[j]);
          k[j] = k[j] * sigmoidf_(k[j]) * 0.08838834764831845f;
          nf[j] += wf * k[j]; nbk[j] += wb * k[j];
        }
        if (pos >= 0) {
          u32x4 oq, ok;
          oq.x = pk2(q[0], q[1]); oq.y = pk2(q[2], q[3]); oq.z = pk2(q[4], q[5]); oq.w = pk2(q[6], q[7]);
          ok.x = pk2(k[0], k[1]); ok.y = pk2(k[2], k[3]); ok.z = pk2(k[4], k[5]); ok.w = pk2(k[6], k[7]);
          *(u32x4*)(P.qc + ((size_t)bh * LPAD + p) * 128 + dg * 8) = oq;
          *(u32x4*)(P.kc + ((size_t)bh * LPAD + p) * 128 + dg * 8) = ok;
          _Pragma("unroll") for (int j = 0; j < 8; ++j) skT[(dg * 8 + j) * 136 + tau] = f2bf(k[j]);
        }
      }
    }
    _Pragma("unroll") for (int j = 0; j < 8; ++j) { sred[tl * 256 + dg * 8 + j] = nf[j]; sred[tl * 256 + 128 + dg * 8 + j] = nbk[j]; }
    __syncthreads();
    {
      const int tid2 = otid();
      const int lane = tid2 & 63, w = tid2 >> 6, wi = w >> 1, wj = w & 1, lr = lane & 31, lh = lane >> 5;
      unsigned vo = (unsigned)((bh * 128 + 64 * wi + lr) * LPAD + 128 * n + 8 * lh);
      asm volatile("" : "+v"(vo));
      _Pragma("unroll 1") for (int dir = 0; dir < 2; ++dir) {
        f32x16 acc[2][2];
        _Pragma("unroll") for (int i = 0; i < 2; ++i) _Pragma("unroll") for (int j = 0; j < 2; ++j) acc[i][j] = zero16();
        unsigned koff = (unsigned)((64 * wj + lr) * 136 + 8 * lh);
        asm volatile("" : "+v"(koff));
        _Pragma("unroll") for (int ks = 0; ks < 8; ++ks) {
          if (n == 0 && ks < 7) continue;
          const int tau = 16 * ks + 8 * lh;
          const f32x4 w0 = *(const f32x4*)(sw + dir * 128 + tau), w1 = *(const f32x4*)(sw + dir * 128 + tau + 4);
          bf16x8 bq[2];
          _Pragma("unroll") for (int i = 0; i < 2; ++i) {
            const u32x4 kr = *(const u32x4*)(skT + koff + (32 * i) * 136 + 16 * ks);
            union { unsigned u[4]; bf16x8 v; } tt;
            tt.u[0] = pk2(bflo(kr.x) * w0.x, bfhi(kr.x) * w0.y); tt.u[1] = pk2(bflo(kr.y) * w0.z, bfhi(kr.y) * w0.w);
            tt.u[2] = pk2(bflo(kr.z) * w1.x, bfhi(kr.z) * w1.y); tt.u[3] = pk2(bflo(kr.w) * w1.z, bfhi(kr.w) * w1.w);
            bq[i] = tt.v;
          }
          bf16x8 af[2];
          _Pragma("unroll") for (int i = 0; i < 2; ++i) af[i] = ldfrag(P.cvT + vo + (unsigned)(32 * i) * LPAD + 16 * ks);
          _Pragma("unroll") for (int i = 0; i < 2; ++i) _Pragma("unroll") for (int j = 0; j < 2; ++j) acc[i][j] = MFMA32(af[i], bq[j], acc[i][j]);
        }
        float* U = P.U + ((size_t)(dir * 8 + bh) * NCH + n) * 16384;
        _Pragma("unroll") for (int i = 0; i < 2; ++i) _Pragma("unroll") for (int j = 0; j < 2; ++j) _Pragma("unroll") for (int r = 0; r < 16; ++r)
          U[(64 * wi + 32 * i + crow(r, lh)) * 128 + 64 * wj + 32 * j + lr] = acc[i][j][r];
      }
    }
    {
      float s = 0.f;
      _Pragma("unroll") for (int i = 0; i < 16; ++i) s += sred[i * 256 + tid];
      const int dir = tid >> 7, dk = tid & 127;
      P.nvec[((size_t)(dir * 8 + bh) * NCH + n) * 128 + dk] = s;
    }
  }
}

DI void phase_mscan(const Params& P, int bid, int nblk) {
  for (int gt = bid * NT + otid(); gt < 16 * 4096 + 256; gt += nblk * NT) {
    if (gt < 16 * 4096) {
      const int seq = gt >> 12, e = gt & 4095, dir = seq >> 3;
      float C[4] = {0.f, 0.f, 0.f, 0.f};
      float m = 0.f;
      _Pragma("unroll") for (int hb = 0; hb < 3; ++hb) {
        constexpr int SBm = 22;
        const int sb = hb * SBm, cnt = hb < 2 ? SBm : NCH - 2 * SBm;
        f32x4 u0[SBm]; float gg[SBm], aa[SBm];
        _Pragma("unroll") for (int k = 0; k < SBm; ++k) if (k < cnt) {
          const int n = dir == 0 ? sb + k : NCH - 1 - sb - k;
          const size_t item = (size_t)seq * NCH + n;
          u0[k] = *(const f32x4*)(P.U + item * 16384 + e * 4);
          gg[k] = P.mstat[item * 4]; aa[k] = P.mstat[item * 4 + 1];
        }
        asm volatile("s_waitcnt vmcnt(0)" ::: "memory");
        _Pragma("unroll") for (int k = 0; k < SBm; ++k) if (k < cnt) {
          const int n = dir == 0 ? sb + k : NCH - 1 - sb - k;
          const size_t item = (size_t)seq * NCH + n;
          const float mn = fmaxf(gg[k] + m, aa[k]);
          const float decay = __expf(gg[k] + m - mn), f = __expf(aa[k] - mn);
          u32x2 cb; cb.x = pk2(C[0], C[1]); cb.y = pk2(C[2], C[3]);
          *(u32x2*)((char*)(P.U + item * 16384) + (size_t)(e >> 1) * 32 + (e & 1) * 8) = cb;
          C[0] = decay * C[0] + f * u0[k].x; C[1] = decay * C[1] + f * u0[k].y; C[2] = decay * C[2] + f * u0[k].z; C[3] = decay * C[3] + f * u0[k].w;
          m = mn;
        }
      }
    } else {
      constexpr int SB = 13;
      const int q = gt - 16 * 4096, seq = q >> 4, e = q & 15, dir = seq >> 3;
      float nst[8];
      _Pragma("unroll") for (int j = 0; j < 8; ++j) nst[j] = 0.f;
      float m = 0.f;
      for (int sb = 0; sb < NCH; sb += SB) {
        f32x4 n0[SB], n1[SB]; float gg[SB], aa[SB];
        _Pragma("unroll") for (int k = 0; k < SB; ++k) {
          const int n = dir == 0 ? sb + k : NCH - 1 - sb - k;
          const size_t item = (size_t)seq * NCH + n;
          const float* np = P.nvec + item * 128 + e * 8;
          n0[k] = *(const f32x4*)np; n1[k] = *(const f32x4*)(np + 4);
          gg[k] = P.mstat[item * 4]; aa[k] = P.mstat[item * 4 + 1];
        }
        _Pragma("unroll") for (int k = 0; k < SB; ++k) {
          const int n = dir == 0 ? sb + k : NCH - 1 - sb - k;
          const size_t item = (size_t)seq * NCH + n;
          const float mn = fmaxf(gg[k] + m, aa[k]);
          const float decay = __expf(gg[k] + m - mn), f = __expf(aa[k] - mn);
          float* np = P.nvec + item * 128 + e * 8;
          *(f32x4*)np = mk4(nst[0], nst[1], nst[2], nst[3]); *(f32x4*)(np + 4) = mk4(nst[4], nst[5], nst[6], nst[7]);
          nst[0] = decay * nst[0] + f * n0[k].x; nst[1] = decay * nst[1] + f * n0[k].y; nst[2] = decay * nst[2] + f * n0[k].z; nst[3] = decay * nst[3] + f * n0[k].w;
          nst[4] = decay * nst[4] + f * n1[k].x; nst[5] = decay * nst[5] + f * n1[k].y; nst[6] = decay * nst[6] + f * n1[k].z; nst[7] = decay * nst[7] + f * n1[k].w;
          if (e == 0) P.mstat[item * 4 + 2] = m;
          m = mn;
        }
      }
    }
  }
}
DI void mout_item(const Params& P, int l, int it, char* smem) {
  const int tid = otid(), lane = tid & 63, w = tid >> 6, lr = lane & 31, lh = lane >> 5;
  const int bh = it / NCH, n = it % NCH, b = bh >> 2, hh = bh & 3;
  char* sK = smem;
  char* sV = smem + 32768;
  float* sb = (float*)(smem + 65536);
  float* sc = sb + 256;
  float* spm = sc + 256;
  float* snp = spm + 256;
  __syncthreads();
  {
    const int rin = lane >> 4, cpos = lane & 15;
    _Pragma("unroll") for (int i = 0; i < 16; ++i) {
      const int dir = i >> 3, R = (i & 7) * 4 + w, row = 4 * R + rin;
      const char* src = (const char*)(P.U + ((size_t)(dir * 8 + bh) * NCH + n) * 16384) + (size_t)row * 512 + (cpos ^ (row & 15)) * 32;
      __builtin_amdgcn_global_load_lds((const unsigned*)src, (lds_u32*)(smem + dir * 32768 + R * 1024), 16, 0, 0);
    }
  }
  {
    const int dir = tid >> 7, tau = tid & 127;
    const size_t base = ((size_t)dir * 8 + bh) * LPAD + 128 * n + tau;
    const float bb = P.bcum[base], li = P.ligate[base];
    sb[tid] = bb; sc[tid] = li - bb;
    snp[tid] = P.nvec[((size_t)(dir * 8 + bh) * NCH + n) * 128 + tau];
  }
  __syncthreads();
  if (w < 2) {
    const int i0 = w == 0 ? 2 * lane : 127 - 2 * lane, i1 = w == 0 ? 2 * lane + 1 : 126 - 2 * lane;
    const float e0 = sc[w * 128 + i0], e1 = sc[w * 128 + i1];
    const float p1 = fmaxf(e0, e1);
    float scan = p1;
    _Pragma("unroll") for (int d = 1; d < 64; d <<= 1) { const float tt = shfl_up_f(scan, d, lane); if (lane >= d) scan = fmaxf(scan, tt); }
    float excl = shfl_up_f(scan, 1, lane); if (lane == 0) excl = -3.0e38f;
    spm[w * 128 + i0] = fmaxf(excl, e0); spm[w * 128 + i1] = fmaxf(excl, p1);
  }
  __syncthreads();
  const int t = 32 * w + lr, p = 128 * n + t;
  bf16x8 qf[8];
  _Pragma("unroll") for (int ks = 0; ks < 8; ++ks) qf[ks] = ldfrag(P.qc + ((size_t)bh * LPAD + p) * 128 + 16 * ks + 8 * lh);
  f32x16 acc[2][4];
  float btv[2], mtv[2], den0[2];
  _Pragma("unroll") for (int dir = 0; dir < 2; ++dir) {
    const size_t item = (size_t)(dir * 8 + bh) * NCH + n;
    const float mprev = P.mstat[item * 4 + 2];
    const float bt = sb[dir * 128 + t];
    const float mt = bt + fmaxf(mprev, spm[dir * 128 + t]);
    const float inter = __expf(bt + mprev - mt);
    float qn = 0.f;
    _Pragma("unroll") for (int ks = 0; ks < 8; ++ks) {
      union { bf16x8 v; unsigned u[4]; } tt; tt.v = qf[ks];
      const float* np = snp + dir * 128 + 16 * ks + 8 * lh;
      _Pragma("unroll") for (int j = 0; j < 4; ++j) qn += bflo(tt.u[j]) * np[2 * j] + bfhi(tt.u[j]) * np[2 * j + 1];
    }
    qn = xsum32(qn);
    btv[dir] = bt; mtv[dir] = mt; den0[dir] = inter * qn;
    const char* sU = smem + dir * 32768;
    _Pragma("unroll") for (int d = 0; d < 4; ++d) {
      const int urow = 32 * d + lr;
      acc[dir][d] = zero16();
      _Pragma("unroll") for (int ks = 0; ks < 8; ++ks) acc[dir][d] = MFMA32(*(const bf16x8*)(sU + urow * 256 + (((2 * ks + lh) ^ (urow & 15)) << 4)), qf[ks], acc[dir][d]);
      _Pragma("unroll") for (int r = 0; r < 16; ++r) acc[dir][d][r] *= inter;
    }
  }
  __syncthreads();
  {
    const int rin = lane >> 4, cpos = lane & 15;
    _Pragma("unroll") for (int i = 0; i < 16; ++i) {
      const int R = i * 4 + w, row = (i < 8 ? 4 * R : 4 * (R - 32)) + rin;
      const int ce = (cpos ^ (row & 15)) * 8;
      const bf16_t* src = i < 8 ? P.kc + ((size_t)bh * LPAD + 128 * n + row) * 128 + ce : P.cvT + ((size_t)bh * 128 + row) * LPAD + 128 * n + ce;
      __builtin_amdgcn_global_load_lds((const unsigned*)src, (lds_u32*)(smem + R * 1024), 16, 0, 0);
    }
  }
  __syncthreads();
  _Pragma("unroll") for (int dir = 0; dir < 2; ++dir) {
    const float bt = btv[dir], mt = mtv[dir];
    float den = 0.f;
    const int st0 = dir == 0 ? 0 : w, st1 = dir == 0 ? w : 3;
    for (int st = st0; st <= st1; ++st) {
      f32x16 s = zero16();
      _Pragma("unroll") for (int ks = 0; ks < 8; ++ks) {
        const int krow = 32 * st + kswap(lr);
        s = MFMA32(*(const bf16x8*)(sK + krow * 256 + (((2 * ks + lh) ^ (krow & 15)) << 4)), qf[ks], s);
      }
      _Pragma("unroll") for (int r = 0; r < 16; ++r) {
        const int sidx = 32 * st + keyoff(r, lh);
        const bool ok = dir == 0 ? (sidx <= t) : (sidx >= t);
        const float dd = __expf(fminf(bt + sc[dir * 128 + sidx] - mt, 0.f));
        const float pv = ok ? s[r] * dd : 0.f;
        s[r] = pv; den += pv;
      }
      const bf16x8 p0 = packfrag(s, 0), p1 = packfrag(s, 1);
      _Pragma("unroll") for (int d = 0; d < 4; ++d) {
        const int vrow = 32 * d + lr;
        const char* vp = sV + vrow * 256;
        acc[dir][d] = MFMA32(*(const bf16x8*)(vp + (((4 * st + lh) ^ (vrow & 15)) << 4)), p0, acc[dir][d]);
        acc[dir][d] = MFMA32(*(const bf16x8*)(vp + (((4 * st + 2 + lh) ^ (vrow & 15)) << 4)), p1, acc[dir][d]);
      }
    }
    den = xsum32(den);
    den = den0[dir] + den;
    const float sca = frcp(fmaxf(fabsf(den), __expf(-mt)));
    _Pragma("unroll") for (int d = 0; d < 4; ++d) _Pragma("unroll") for (int r = 0; r < 16; ++r) acc[dir][d][r] *= sca;
  }
  float hacc[4][16];
  _Pragma("unroll") for (int d = 0; d < 4; ++d) _Pragma("unroll") for (int r = 0; r < 16; ++r) hacc[d][r] = acc[0][d][r] + acc[1][d][r];
  float s1 = 0.f;
  _Pragma("unroll") for (int d = 0; d < 4; ++d) _Pragma("unroll") for (int r = 0; r < 16; ++r) s1 += hacc[d][r];
  s1 = xsum32(s1);
  const float mu = s1 * (1.f / 128.f);
  float s2 = 0.f;
  _Pragma("unroll") for (int d = 0; d < 4; ++d) _Pragma("unroll") for (int r = 0; r < 16; ++r) { hacc[d][r] -= mu; s2 += hacc[d][r] * hacc[d][r]; }
  s2 = xsum32(s2);
  const float rs = rsqrtf(s2 * (1.f / 128.f) + LN_EPS);
  const int pos = p - MPAD;
  if (pos >= 0) {
    const size_t tok = (size_t)b * L + pos;
    _Pragma("unroll") for (int d = 0; d < 4; ++d) _Pragma("unroll") for (int rg = 0; rg < 4; ++rg) {
      const int dv = 32 * d + 8 * rg + 4 * lh;
      const int col = hh * 128 + dv;
      const u32x2 cu = *(const u32x2*)(P.co + tok * 512 + col);
      const f32x4 g4 = *(const f32x4*)(P.mlstm_g + l * 512 + col);
      const float o0 = hacc[d][4 * rg + 0] * rs * g4.x * sigmoidf_(bflo(cu.x));
      const float o1 = hacc[d][4 * rg + 1] * rs * g4.y * sigmoidf_(bfhi(cu.x));
      const float o2 = hacc[d][4 * rg + 2] * rs * g4.z * sigmoidf_(bflo(cu.y));
      const float o3 = hacc[d][4 * rg + 3] * rs * g4.w * sigmoidf_(bfhi(cu.y));
      u32x2 ou; ou.x = pk2(o0, o1); ou.y = pk2(o2, o3);
      *(u32x2*)(P.oc + tok * 512 + col) = ou;
    }
  }
}

constexpr int DA_STAGE = 32768;
constexpr float DA_THR = 8.f;
DI void dattn_issue(const Params& P, int bh, int k0, char* stage, unsigned vk, unsigned vv, int w) {
  const char* kb0 = (const char*)(P.ka + ((size_t)(bh * 2) * L + k0) * 64);
  const char* vb0 = (const char*)(P.vaT + (size_t)bh * 128 * LK + k0);
  _Pragma("unroll") for (int i = 0; i < 8; ++i) {
    const char* src = i < 4 ? kb0 + (size_t)(i >> 1) * (L * 128) + (i & 1) * 4096 + vk : vb0 + (size_t)(i - 4) * 32 * LK * 2 + vv;
    __builtin_amdgcn_global_load_lds((const unsigned*)src, (lds_u32*)(stage + (i * 4 + w) * 1024), 16, 0, 0);
  }
}
DI void dattn_merge4(f32x16 (&O)[2][4], float (&m)[2], float (&ls)[2], char* smem, int lane, int w) {
  float* xf = (float*)smem;
  for (int src = 1; src < 4; ++src) {
    __syncthreads();
    if (w == src) {
      _Pragma("unroll") for (int c = 0; c < 2; ++c) {
        _Pragma("unroll") for (int d = 0; d < 4; ++d) _Pragma("unroll") for (int r = 0; r < 16; ++r) xf[((c * 4 + d) * 16 + r) * 64 + lane] = O[c][d][r];
        xf[8192 + c * 64 + lane] = m[c]; xf[8192 + 128 + c * 64 + lane] = ls[c];
      }
    }
    __syncthreads();
    if (w == 0) {
      _Pragma("unroll") for (int c = 0; c < 2; ++c) {
        const float mb = xf[8192 + c * 64 + lane], lb = xf[8192 + 128 + c * 64 + lane];
        const float M = fmaxf(m[c], mb), fa = fexp2(m[c] - M), fb = fexp2(mb - M);
        ls[c] = ls[c] * fa + lb * fb; m[c] = M;
        _Pragma("unroll") for (int d = 0; d < 4; ++d) _Pragma("unroll") for (int r = 0; r < 16; ++r) O[c][d][r] = O[c][d][r] * fa + xf[((c * 4 + d) * 16 + r) * 64 + lane] * fb;
      }
    }
  }
}
DI void dattn_finish(const Params& P, int l, int bh, int q0, f32x16 (&O)[2][4], const float (&ls)[2], int lr, int lh) {
  const int b = bh >> 2, hh = bh & 3;
  const float lam = P.lam[l], omli = P.lam[2 + l];
  const float i0 = 1.f / ls[0], i1 = lam / ls[1];
  float ss = 0.f;
  _Pragma("unroll") for (int d = 0; d < 4; ++d) _Pragma("unroll") for (int r = 0; r < 16; ++r) { const float o = O[0][d][r] * i0 - O[1][d][r] * i1; O[0][d][r] = o; ss += o * o; }
  ss = xsum32(ss);
  const float rs = rsqrtf(ss * (1.f / 128.f) + LN_EPS);
  if (q0 + lr < L) {
    const size_t tok = (size_t)b * L + q0 + lr;
    _Pragma("unroll") for (int d = 0; d < 4; ++d) _Pragma("unroll") for (int rg = 0; rg < 4; ++rg) {
      const int dv = 32 * d + 8 * rg + 4 * lh;
      const f32x4 g4 = *(const f32x4*)(P.diff_g + l * 128 + dv);
      u32x2 ou;
      ou.x = pk2(O[0][d][4 * rg + 0] * rs * g4.x * omli, O[0][d][4 * rg + 1] * rs * g4.y * omli);
      ou.y = pk2(O[0][d][4 * rg + 2] * rs * g4.z * omli, O[0][d][4 * rg + 3] * rs * g4.w * omli);
      *(u32x2*)(P.oa + tok * 512 + hh * 128 + dv) = ou;
    }
  }
}
constexpr int DA_PART = 2 * 4 * 16 * 64 + 256;
DI void dattn_item(const Params& P, int l, int it, bool part, char* smem) {
  const int tid = otid(), lane = tid & 63, w = tid >> 6, lr = lane & 31, lh = lane >> 5;
  const int bh = it & 7, jq = it >> 3;
  const int q0 = part ? 8192 : jq * 128 + 32 * w;
  const int qi = min(q0 + lr, L - 1);
  constexpr int NTILE = (L + 63) / 64;
  const int t0 = part ? 2 * jq : 0, t1 = part ? (jq == 63 ? NTILE : 2 * jq + 2) : NTILE;
  bf16x8 qf[2][4];
  _Pragma("unroll") for (int c = 0; c < 2; ++c) _Pragma("unroll") for (int ks = 0; ks < 4; ++ks)
    qf[c][ks] = ldfrag(P.qa + ((size_t)(bh * 2 + c) * L + qi) * 64 + 16 * ks + 8 * lh);
  f32x16 O[2][4];
  float m[2], ls[2];
  _Pragma("unroll") for (int c = 0; c < 2; ++c) {
    f32x16 s = zero16();
    const bf16_t* kp = P.ka + ((size_t)(bh * 2 + c) * L + t0 * 64 + kswap(lr)) * 64 + 8 * lh;
    _Pragma("unroll") for (int ks = 0; ks < 4; ++ks) s = MFMA32(ldfrag(kp + 16 * ks), qf[c][ks], s);
    float mx = s[0];
    _Pragma("unroll") for (int r = 1; r < 16; ++r) mx = fmaxf(mx, s[r]);
    m[c] = xmax32(mx); ls[c] = 0.f;
    _Pragma("unroll") for (int d = 0; d < 4; ++d) O[c][d] = zero16();
  }
  const unsigned vk = (unsigned)((w * 8 + (lane >> 3)) * 128 + (((lane & 7) ^ (4 * (w & 1) + (lane >> 4))) << 4));
  const unsigned vv = (unsigned)((w * 8 + (lane >> 3)) * (LK * 2) + (((lane & 7) ^ (4 * (w & 1) + (lane >> 4))) << 4));
  __syncthreads();
  dattn_issue(P, bh, t0 * 64, smem + (t0 & 1) * DA_STAGE, vk, vv, w);
  for (int t = t0; t < t1; ++t) {
    __syncthreads();
    if (t + 1 < t1) dattn_issue(P, bh, (t + 1) * 64, smem + ((t + 1) & 1) * DA_STAGE, vk, vv, w);
    const char* st = smem + (t & 1) * DA_STAGE;
    _Pragma("unroll") for (int kb = 0; kb < 2; ++kb) {
      if (part && ((((t - t0) * 2 + kb) & 3) != w)) continue;
      bf16x8 pf[2][2];
      _Pragma("unroll") for (int c = 0; c < 2; ++c) {
        f32x16 s;
        _Pragma("unroll") for (int r = 0; r < 16; ++r) s[r] = -m[c];
        const int krow = kb * 32 + kswap(lr);
        const char* kp = st + c * 8192 + krow * 128;
        _Pragma("unroll") for (int ks = 0; ks < 4; ++ks) s = MFMA32(*(const bf16x8*)(kp + (((2 * ks + lh) ^ swz(krow)) << 4)), qf[c][ks], s);
        if (t == NTILE - 1) {
          _Pragma("unroll") for (int r = 0; r < 16; ++r) if (t * 64 + kb * 32 + keyoff(r, lh) >= L) s[r] = -3.0e38f;
        }
        float mx = s[0];
        _Pragma("unroll") for (int r = 1; r < 16; ++r) mx = fmaxf(mx, s[r]);
        if (__any(mx > DA_THR)) {
          asm volatile("; rare: move the softmax reference" ::: "memory");
          const float dlt = fmaxf(xmax32(mx), 0.f);
          const float al = fexp2(-dlt);
          m[c] += dlt; ls[c] *= al;
          _Pragma("unroll") for (int d = 0; d < 4; ++d) _Pragma("unroll") for (int r = 0; r < 16; ++r) O[c][d][r] *= al;
          _Pragma("unroll") for (int r = 0; r < 16; ++r) s[r] -= dlt;
        }
        float rsum = 0.f;
        _Pragma("unroll") for (int r = 0; r < 16; ++r) { const float pv = fexp2(s[r]); s[r] = pv; rsum += pv; }
        ls[c] += rsum;
        pf[c][0] = packfrag(s, 0); pf[c][1] = packfrag(s, 1);
      }
      _Pragma("unroll") for (int d = 0; d < 4; ++d) {
        const int vrow = 32 * d + lr;
        const char* vp = st + 16384 + vrow * 128;
        const bf16x8 v0 = *(const bf16x8*)(vp + (((kb * 4 + lh) ^ swz(vrow)) << 4));
        const bf16x8 v1 = *(const bf16x8*)(vp + (((kb * 4 + 2 + lh) ^ swz(vrow)) << 4));
        _Pragma("unroll") for (int c = 0; c < 2; ++c) { O[c][d] = MFMA32(v0, pf[c][0], O[c][d]); O[c][d] = MFMA32(v1, pf[c][1], O[c][d]); }
      }
    }
  }
  _Pragma("unroll") for (int c = 0; c < 2; ++c) ls[c] = xsum32(ls[c]);
  if (part) {
    dattn_merge4(O, m, ls, smem, lane, w);
    if (w == 0) {
      float* pb = (float*)P.merged + (size_t)it * DA_PART + lane;
      _Pragma("unroll") for (int c = 0; c < 2; ++c) {
        _Pragma("unroll") for (int d = 0; d < 4; ++d) {
          float* pp = pb + (c * 4 + d) * 1024;
          asm volatile("" : "+v"(pp));
          _Pragma("unroll") for (int r = 0; r < 16; ++r) pp[r * 64] = O[c][d][r];
        }
        pb[8192 + c * 64] = m[c]; pb[8192 + 128 + c * 64] = ls[c];
      }
    }
    return;
  }
  dattn_finish(P, l, bh, q0, O, ls, lr, lh);
}
DI void dattn_item16(const Params& P, int l, int it, char* smem_wg) {
  int tid = rtid(); asm volatile("" : "+v"(tid));
  const int lane = tid & 63, w = __builtin_amdgcn_readfirstlane(tid >> 6), w4 = w & 3, ih = w >> 2, lr = lane & 31, lh = lane >> 5;
  const int bh = it & 7, jq = it >> 3;
  const int q0 = jq * 256 + 32 * w;
  constexpr int NTILE = (L + 63) / 64;
  bf16x8 qf[2][4];
  _Pragma("unroll") for (int c = 0; c < 2; ++c) _Pragma("unroll") for (int ks = 0; ks < 4; ++ks)
    qf[c][ks] = ldfrag(P.qa + ((size_t)(bh * 2 + c) * L + q0 + lr) * 64 + 16 * ks + 8 * lh);
  f32x16 O[2][4];
  float m[2], ls[2];
  _Pragma("unroll") for (int c = 0; c < 2; ++c) {
    f32x16 s = zero16();
    const bf16_t* kp = P.ka + ((size_t)(bh * 2 + c) * L + kswap(lr)) * 64 + 8 * lh;
    _Pragma("unroll") for (int ks = 0; ks < 4; ++ks) s = MFMA32(ldfrag(kp + 16 * ks), qf[c][ks], s);
    float mx = s[0];
    _Pragma("unroll") for (int r = 1; r < 16; ++r) mx = fmaxf(mx, s[r]);
    m[c] = xmax32(mx); ls[c] = 0.f;
    _Pragma("unroll") for (int d = 0; d < 4; ++d) O[c][d] = zero16();
  }
  const unsigned sw16 = (unsigned)(((lane & 7) ^ (4 * (w4 & 1) + (lane >> 4))) << 4);
  const char* gsrc = ih == 0 ? (const char*)(P.ka + (size_t)(bh * 2) * L * 64) + (size_t)(w4 * 8 + (lane >> 3)) * 128 + sw16
                             : (const char*)(P.vaT + (size_t)bh * 128 * LK) + (size_t)(w4 * 8 + (lane >> 3)) * (LK * 2) + sw16;
#define DA16_ISSUE(t_, st_) _Pragma("unroll") for (int i_ = 0; i_ < 4; ++i_) { \
    const char* src_ = ih == 0 ? gsrc + (size_t)(t_) * (64 * 128) + (size_t)(i_ >> 1) * (L * 128) + (i_ & 1) * 4096 : gsrc + (size_t)(t_) * 128 + (size_t)i_ * 32 * LK * 2; \
    __builtin_amdgcn_global_load_lds((const unsigned*)src_, (lds_u32*)(smem_wg + (st_) * DA_STAGE + ((ih * 4 + i_) * 4 + w4) * 1024), 16, 0, 0); }
  __syncthreads();
  DA16_ISSUE(0, 0)
  for (int t = 0; t < NTILE; ++t) {
    __syncthreads();
    if (t + 1 < NTILE) { DA16_ISSUE(t + 1, (t + 1) & 1) }
    const char* st = smem_wg + (t & 1) * DA_STAGE;
    _Pragma("unroll") for (int kb = 0; kb < 2; ++kb) {
      bf16x8 pf[2][2];
      _Pragma("unroll") for (int c = 0; c < 2; ++c) {
        f32x16 s;
        _Pragma("unroll") for (int r = 0; r < 16; ++r) s[r] = -m[c];
        const int krow = kb * 32 + kswap(lr);
        const char* kp = st + c * 8192 + krow * 128;
        _Pragma("unroll") for (int ks = 0; ks < 4; ++ks) s = MFMA32(*(const bf16x8*)(kp + (((2 * ks + lh) ^ swz(krow)) << 4)), qf[c][ks], s);
        if (t == NTILE - 1) {
          _Pragma("unroll") for (int r = 0; r < 16; ++r) if (t * 64 + kb * 32 + keyoff(r, lh) >= L) s[r] = -3.0e38f;
        }
        float mx = s[0];
        _Pragma("unroll") for (int r = 1; r < 16; ++r) mx = fmaxf(mx, s[r]);
        if (__any(mx > DA_THR)) {
          asm volatile("; rare: move the softmax reference" ::: "memory");
          const float dlt = fmaxf(xmax32(mx), 0.f);
          const float al = fexp2(-dlt);
          m[c] += dlt; ls[c] *= al;
          _Pragma("unroll") for (int d = 0; d < 4; ++d) _Pragma("unroll") for (int r = 0; r < 16; ++r) O[c][d][r] *= al;
          _Pragma("unroll") for (int r = 0; r < 16; ++r) s[r] -= dlt;
        }
        float rsum = 0.f;
        _Pragma("unroll") for (int r = 0; r < 16; ++r) { const float pv = fexp2(s[r]); s[r] = pv; rsum += pv; }
        ls[c] += rsum;
        pf[c][0] = packfrag(s, 0); pf[c][1] = packfrag(s, 1);
      }
      _Pragma("unroll") for (int d = 0; d < 4; ++d) {
        const int vrow = 32 * d + lr;
        const char* vp = st + 16384 + vrow * 128;
        const bf16x8 v0 = *(const bf16x8*)(vp + (((kb * 4 + lh) ^ swz(vrow)) << 4));
        const bf16x8 v1 = *(const bf16x8*)(vp + (((kb * 4 + 2 + lh) ^ swz(vrow)) << 4));
        _Pragma("unroll") for (int c = 0; c < 2; ++c) { O[c][d] = MFMA32(v0, pf[c][0], O[c][d]); O[c][d] = MFMA32(v1, pf[c][1], O[c][d]); }
      }
    }
  }
#undef DA16_ISSUE
  _Pragma("unroll") for (int c = 0; c < 2; ++c) ls[c] = xsum32(ls[c]);
  dattn_finish(P, l, bh, q0, O, ls, lr, lh);
}
DI void dattn_combine(const Params& P, int l, int bh, char* smem) {
  const int tid = otid(), lane = tid & 63, w = tid >> 6, lr = lane & 31, lh = lane >> 5;
  f32x16 O[2][4];
  float m[2], ls[2];
  __syncthreads();
  for (int k = 0; k < 16; ++k) {
    const float* pb = (const float*)P.merged + (size_t)(bh + 8 * (w * 16 + k)) * DA_PART + lane;
    _Pragma("unroll") for (int c = 0; c < 2; ++c) {
      const float mb = pb[8192 + c * 64], lb = pb[8192 + 128 + c * 64];
      float fa, fb;
      if (k == 0) { m[c] = mb; ls[c] = lb; fa = 0.f; fb = 1.f; }
      else { const float M = fmaxf(m[c], mb); fa = fexp2(m[c] - M); fb = fexp2(mb - M); ls[c] = ls[c] * fa + lb * fb; m[c] = M; }
      _Pragma("unroll") for (int d = 0; d < 4; ++d) {
        const float* pp = pb + (c * 4 + d) * 1024;
        asm volatile("" : "+v"(pp));
        _Pragma("unroll") for (int r = 0; r < 16; ++r) {
          const float ov = pp[r * 64];
          O[c][d][r] = k == 0 ? ov : O[c][d][r] * fa + ov * fb;
        }
      }
    }
  }
  dattn_merge4(O, m, ls, smem, lane, w);
  if (w == 0) dattn_finish(P, l, bh, 8192, O, ls, lr, lh);
}

DI void swa_item(const Params& P, int l, int it, char* smem) {
  const int tid = otid(), lane = tid & 63, w = tid >> 6, lr = lane & 31, lh = lane >> 5;
  const int NQT = (L + 31) / 32;
  const int bk = it / NQT, qt = it % NQT, b = bk >> 1, kv = bk & 1, hq = kv * 4 + w;
  const int q0 = qt * 32;
  const int qi = min(q0 + lr, L - 1);
  bf16x8 qf[4];
  _Pragma("unroll") for (int ks = 0; ks < 4; ++ks) qf[ks] = ldfrag(P.qb + ((size_t)(b * 8 + hq) * L + qi) * 64 + 16 * ks + 8 * lh);
  f32x16 O[2]; O[0] = zero16(); O[1] = zero16();
  float m = P.sink[l * 8 + hq] * 1.44269504088896341f, ls = 1.f;
  const bf16_t* kbase = P.kb + (size_t)(b * 2 + kv) * L * 64;
  const bf16_t* vbase = P.vbT + (size_t)(b * 2 + kv) * 64 * LK;
  const int qpos = q0 + lr;
  char* sK = smem;
  char* sV = smem + 5 * 4096;
  bf16x8 ta[5], tb[5];
#define SWA_LOAD(ph_) _Pragma("unroll") for (int i = 0; i < 5; ++i) { \
    { const int rr_ = 40 * w + 8 * i + (lane >> 3), bb_ = rr_ >> 5, bi_ = 5 * (ph_) + bb_; const int k1_ = bi_ == 0 ? 0 : q0 - 160 + 32 * bi_; \
      const int krow_ = min(max(k1_ + (rr_ & 31), 0), L - 1); ta[i] = ldfrag(kbase + (size_t)krow_ * 64 + (lane & 7) * 8); } \
    { const int j_ = 5 * w + i, bb_ = j_ >> 2, bi_ = 5 * (ph_) + bb_; const int k0_ = bi_ == 0 ? 0 : q0 - 160 + 32 * bi_; const int kc0_ = min(max(k0_, 0), LK - 32); \
      tb[i] = ldfrag(vbase + (size_t)(16 * (j_ & 3) + (lane >> 2)) * LK + kc0_ + (lane & 3) * 8); } }
#define SWA_STORE() _Pragma("unroll") for (int i = 0; i < 5; ++i) { \
    { const int rr_ = 40 * w + 8 * i + (lane >> 3), bb_ = rr_ >> 5, r_ = rr_ & 31; *(bf16x8*)(sK + bb_ * 4096 + r_ * 128 + (((lane & 7) ^ swz(r_)) << 4)) = ta[i]; } \
    { const int j_ = 5 * w + i, bb_ = j_ >> 2, rv_ = 16 * (j_ & 3) + (lane >> 2); *(bf16x8*)(sV + bb_ * 4096 + rv_ * 64 + (((lane & 3) ^ ((rv_ >> 2) & 3)) << 4)) = tb[i]; } }
  SWA_LOAD(0)
  __syncthreads();
  SWA_STORE()
  __syncthreads();
  SWA_LOAD(1)
  __builtin_amdgcn_sched_barrier(0);
  _Pragma("unroll") for (int ph = 0; ph < 2; ++ph) {
    if (ph == 1) { __syncthreads(); SWA_STORE() __syncthreads(); }
    _Pragma("unroll") for (int bb = 0; bb < 5; ++bb) {
      const int bi = 5 * ph + bb;
      const int k0 = bi == 0 ? 0 : q0 - 160 + 32 * bi;
      f32x16 s = zero16();
      {
        const int krow = kswap(lr);
        _Pragma("unroll") for (int ks = 0; ks < 4; ++ks) s = MFMA32(*(const bf16x8*)(sK + bb * 4096 + krow * 128 + (((2 * ks + lh) ^ swz(krow)) << 4)), qf[ks], s);
      }
      float mx = -3.0e38f;
      _Pragma("unroll") for (int r = 0; r < 16; ++r) {
        const int kj = k0 + keyoff(r, lh);
        bool ok;
        if (bi == 0) ok = kj < NMETA;
        else ok = kj >= NMETA && kj < L && kj >= qpos - 128 && kj <= qpos + 128;
        const float v = ok ? s[r] : -3.0e38f;
        s[r] = v; mx = fmaxf(mx, v);
      }
      mx = xmax32(mx);
      const float mn = fmaxf(m, mx);
      const float al = fexp2(m - mn);
      float rsum = 0.f;
      _Pragma("unroll") for (int r = 0; r < 16; ++r) { const float pv = fexp2(s[r] - mn); s[r] = pv; rsum += pv; }
      rsum = xsum32(rsum);
      ls = ls * al + rsum; m = mn;
      _Pragma("unroll") for (int d = 0; d < 2; ++d) _Pragma("unroll") for (int r = 0; r < 16; ++r) O[d][r] *= al;
      const bf16x8 p0 = packfrag(s, 0), p1 = packfrag(s, 1);
      _Pragma("unroll") for (int d = 0; d < 2; ++d) {
        const int vrow = 32 * d + lr;
        const char* vp = sV + bb * 4096 + vrow * 64;
        const int sx = (vrow >> 2) & 3;
        O[d] = MFMA32(*(const bf16x8*)(vp + ((lh ^ sx) << 4)), p0, O[d]);
        O[d] = MFMA32(*(const bf16x8*)(vp + (((2 + lh) ^ sx) << 4)), p1, O[d]);
      }
    }
  }
#undef SWA_LOAD
#undef SWA_STORE
  if (qpos < L) {
    const float inv = 1.f / ls;
    const size_t tok = (size_t)b * L + qpos;
    _Pragma("unroll") for (int d = 0; d < 2; ++d) _Pragma("unroll") for (int rg = 0; rg < 4; ++rg) {
      const int dv = 32 * d + 8 * rg + 4 * lh;
      u32x2 ou;
      ou.x = pk2(O[d][4 * rg + 0] * inv, O[d][4 * rg + 1] * inv);
      ou.y = pk2(O[d][4 * rg + 2] * inv, O[d][4 * rg + 3] * inv);
      *(u32x2*)(P.ob + tok * 512 + hq * 64 + dv) = ou;
    }
  }
}

constexpr int P3_MT = TP / 128, P3_NT = D / 128;
DI void tail_reduce(const f32x16& acc, char* smem_wg, int w, int lane, float (&v)[2]) {
  float* red = (float*)smem_wg;
  __syncthreads();
  _Pragma("unroll") for (int r = 0; r < 16; ++r) red[(w * 16 + r) * 64 + lane] = acc[r];
  __syncthreads();
  _Pragma("unroll") for (int j = 0; j < 2; ++j) {
    float s = 0.f;
    _Pragma("unroll") for (int x = 0; x < 8; ++x) s += red[(x * 16 + 2 * w + j) * 64 + lane];
    v[j] = s;
  }
  __syncthreads();
}
DI void p3a_tail(const Params& P, char* smem_wg, int wg) {
  int tid = rtid(); asm volatile("" : "+v"(tid));
  const int lane = tid & 63, w = tid >> 6, lr = lane & 31, lh = lane >> 5;
  const int n0 = 32 * wg, k0 = 64 * w + 8 * lh;
  f32x16 tot = zero16();
  _Pragma("unroll 1") for (int br = 0; br < 3; ++br) {
    const bf16_t* A = P.oa + ((size_t)br * TP + 16384 + lr) * 512 + k0;
    const bf16_t* B = P.w_br_t + ((size_t)br * 1024 + n0 + lr) * 512 + k0;
    f32x16 part = zero16();
    _Pragma("unroll") for (int ks = 0; ks < 4; ++ks) part = MFMA32(ldfrag(A + 16 * ks), ldfrag(B + 16 * ks), part);
    _Pragma("unroll") for (int r = 0; r < 16; ++r) tot[r] += bf2f(P.gz[(size_t)(16384 + crow(r, lh)) * 3072 + br * 1024 + n0 + lr]) * part[r];
  }
  float v[2];
  tail_reduce(tot, smem_wg, w, lane, v);
  _Pragma("unroll") for (int j = 0; j < 2; ++j) P.merged[(size_t)(16384 + crow(2 * w + j, lh)) * D + n0 + lr] = f2bf(v[j]);
}
DI void p3b_tail(const Params& P, char* smem_wg, int wg) {
  int tid = rtid(); asm volatile("" : "+v"(tid));
  const int lane = tid & 63, w = tid >> 6, lr = lane & 31, lh = lane >> 5;
  const int n0 = 32 * wg, k0 = 128 * w + 8 * lh;
  const bf16_t* A = P.merged + (size_t)(16384 + lr) * D + k0;
  const bf16_t* B = P.w_out_t + (size_t)(n0 + lr) * D + k0;
  f32x16 acc = zero16();
  _Pragma("unroll") for (int ks = 0; ks < 8; ++ks) acc = MFMA32(ldfrag(A + 16 * ks), ldfrag(B + 16 * ks), acc);
  float v[2];
  tail_reduce(acc, smem_wg, w, lane, v);
  _Pragma("unroll") for (int j = 0; j < 2; ++j) { float* hp = P.h + (size_t)(16384 + crow(2 * w + j, lh)) * D + n0 + lr; *hp = ALPHA * (*hp) + v[j]; }
}
struct SchedP3a {
  static constexpr bool GATHER = false;
  const char* A; const char* B; int G, c;
  DI bool next(int i, g8::Unit& u) const {
    const int ti = i / 3, br = i - 3 * ti; int pm, pn;
    if (!g8::grid_unit(ti, G, c, 64, 4, pm, pn)) return false;
    u.pm = pm; u.pn = pn; u.tag = br;
    u.a = A + ((size_t)br * TP + (size_t)pm * 256) * 512 * 2; u.b = B + ((size_t)br * 1024 + (size_t)pn * 256) * 512 * 2; return true;
  }
  DI void arows(const g8::Unit&, int, unsigned (&)[2]) const {}
};
struct EpiP3a {
  static constexpr bool PERM = true;
  const bf16_t* gz; bf16_t* merged;
  DI bool keep(const g8::Unit& u) const { return u.tag < 2; }
  DI void operator()(g8::f32x4 (&acc)[2][2][4][2], const g8::Unit& u, int wr, int wc, int fr, int fq) const {
    const int br = u.tag;
    const bf16_t* g0 = gz + (size_t)(u.pm * 256 + 64 * wr + fr) * 3072 + br * 1024 + u.pn * 256 + 32 * wc + 8 * fq;
    _Pragma("unroll") for (int ai = 0; ai < 2; ++ai) {
      u32x4 ga[4][2], gb[4][2];
      _Pragma("unroll") for (int m = 0; m < 4; ++m) _Pragma("unroll") for (int bj = 0; bj < 2; ++bj) ga[m][bj] = *(const u32x4*)(g0 + (size_t)(128 * ai + 16 * m) * 3072 + 128 * bj);
      if (br < 2) {
        _Pragma("unroll") for (int m = 0; m < 4; ++m) _Pragma("unroll") for (int bj = 0; bj < 2; ++bj) gb[m][bj] = *(const u32x4*)(g0 + (size_t)(128 * ai + 16 * m) * 3072 + 128 * bj + 1024);
        __builtin_amdgcn_sched_barrier(0);
        _Pragma("unroll") for (int m = 0; m < 4; ++m) _Pragma("unroll") for (int bj = 0; bj < 2; ++bj) {
          const u32x4 a = ga[m][bj], b = gb[m][bj];
          acc[ai][bj][m][0][0] *= bflo(a.x) * frcp(bflo(b.x)); acc[ai][bj][m][0][1] *= bfhi(a.x) * frcp(bfhi(b.x));
          acc[ai][bj][m][0][2] *= bflo(a.y) * frcp(bflo(b.y)); acc[ai][bj][m][0][3] *= bfhi(a.y) * frcp(bfhi(b.y));
          acc[ai][bj][m][1][0] *= bflo(a.z) * frcp(bflo(b.z)); acc[ai][bj][m][1][1] *= bfhi(a.z) * frcp(bfhi(b.z));
          acc[ai][bj][m][1][2] *= bflo(a.w) * frcp(bflo(b.w)); acc[ai][bj][m][1][3] *= bfhi(a.w) * frcp(bfhi(b.w));
        }
      } else {
        __builtin_amdgcn_sched_barrier(0);
        _Pragma("unroll") for (int m = 0; m < 4; ++m) _Pragma("unroll") for (int bj = 0; bj < 2; ++bj) {
          const u32x4 a = ga[m][bj];
          u32x4 o;
          o.x = pk2(acc[ai][bj][m][0][0] * bflo(a.x), acc[ai][bj][m][0][1] * bfhi(a.x)); o.y = pk2(acc[ai][bj][m][0][2] * bflo(a.y), acc[ai][bj][m][0][3] * bfhi(a.y));
          o.z = pk2(acc[ai][bj][m][1][0] * bflo(a.z), acc[ai][bj][m][1][1] * bfhi(a.z)); o.w = pk2(acc[ai][bj][m][1][2] * bflo(a.w), acc[ai][bj][m][1][3] * bfhi(a.w));
          *(u32x4*)(merged + (size_t)(u.pm * 256 + 128 * ai + 64 * wr + 16 * m + fr) * D + u.pn * 256 + 128 * bj + 32 * wc + 8 * fq) = o;
        }
      }
      __builtin_amdgcn_sched_barrier(0);
    }
  }
};
DI void phase_p3a(const Params& P, int l, char* smem, char* smem_wg, int bid, int nblk) {
  if ((bid >> 1) < 32) p3a_tail(P, smem_wg, bid >> 1);
  {
    SchedP3a S; S.A = (const char*)P.oa; S.B = (const char*)P.w_br_t; S.G = nblk >> 1; S.c = bid >> 1;
    EpiP3a E; E.gz = P.gz; E.merged = P.merged;
    g8::gemm_phase((g8::lds_u8*)smem_wg, 512, S, E);
  }
}
struct SchedP3b {
  static constexpr bool GATHER = false;
  const char* A; const char* B; int G, c;
  DI bool next(int i, g8::Unit& u) const { int pm, pn; if (!g8::grid_unit(i, G, c, 64, 4, pm, pn)) return false; u.pm = pm; u.pn = pn; u.tag = 0; u.a = A + (size_t)pm * 256 * D * 2; u.b = B + (size_t)pn * 256 * D * 2; return true; }
  DI void arows(const g8::Unit&, int, unsigned (&)[2]) const {}
};
struct EpiP3b {
  static constexpr bool PERM = false;
  float* h;
  DI bool keep(const g8::Unit&) const { return false; }
  DI void operator()(g8::f32x4 (&acc)[2][2][4][2], const g8::Unit& u, int wr, int wc, int fr, int fq) const {
    float* h0 = h + (size_t)(u.pm * 256 + 64 * wr + fr) * D + u.pn * 256 + 32 * wc + 4 * fq;
    _Pragma("unroll") for (int ai = 0; ai < 2; ++ai) {
      g8::f32x4 hv[4][2][2];
      _Pragma("unroll") for (int m = 0; m < 4; ++m) _Pragma("unroll") for (int bj = 0; bj < 2; ++bj) _Pragma("unroll") for (int n = 0; n < 2; ++n)
        hv[m][bj][n] = *(const g8::f32x4*)(h0 + (size_t)(128 * ai + 16 * m) * D + 128 * bj + 16 * n);
      __builtin_amdgcn_sched_barrier(0);
      _Pragma("unroll") for (int m = 0; m < 4; ++m) _Pragma("unroll") for (int bj = 0; bj < 2; ++bj) _Pragma("unroll") for (int n = 0; n < 2; ++n)
        *(g8::f32x4*)(h0 + (size_t)(128 * ai + 16 * m) * D + 128 * bj + 16 * n) = ALPHA * hv[m][bj][n] + acc[ai][bj][m][n];
      __builtin_amdgcn_sched_barrier(0);
    }
  }
};
DI void phase_p3b(const Params& P, int l, char* smem, char* smem_wg, int bid, int nblk) {
  if ((bid >> 1) < 32) p3b_tail(P, smem_wg, bid >> 1);
  {
    SchedP3b S; S.A = (const char*)P.merged; S.B = (const char*)P.w_out_t; S.G = nblk >> 1; S.c = bid >> 1;
    EpiP3b E; E.h = P.h;
    g8::gemm_phase(( g8::lds_u8*)smem_wg, D, S, E);
  }
}

typedef __attribute__((ext_vector_type(4))) float f32x4v;
DI void phase_router_prep(const Params& P, int bid, int nblk) {
  const int gtid = bid * NT + otid(), gn = nblk * NT;
  for (int i = gtid; i < 2 * 64 * 3 * 64 * 4; i += gn) {
    const int sidx = i & 3, lane = (i >> 2) & 63, n = (i >> 8) % 3, chunk = ((i >> 8) / 3) & 63, l = (i >> 8) / 192;
    const int c = 16 * chunk + 4 * (lane >> 4) + sidx, j = lane & 15;
    float wv = 0.f;
    if (n < 2) wv = P.w_re[((size_t)l * D + c) * 32 + 16 * n + j];
    else if (j < 4) wv = P.w_rg[((size_t)l * D + c) * 4 + j];
    P.rwp[i] = wv * P.ln1_g[l * D + c];
  }
  const int wv_ = gtid >> 6, lane = gtid & 63;
  if (wv_ < 2 * 36) {
    const int l = wv_ / 36, o = wv_ % 36;
    float sg = 0.f, sb = 0.f;
    for (int c = lane; c < D; c += 64) {
      const float wv = o < 32 ? P.w_re[((size_t)l * D + c) * 32 + o] : P.w_rg[((size_t)l * D + c) * 4 + o - 32];
      sg += P.ln1_g[l * D + c] * wv; sb += P.ln1_b[l * D + c] * wv;
    }
    sg = wave_sum(sg); sb = wave_sum(sb);
    if (lane == 0) { P.rgb[(l * 2 + 0) * 48 + o] = sg; P.rgb[(l * 2 + 1) * 48 + o] = sb + (o < 32 ? P.b_re[l * 32 + o] : P.b_rg[l * 4 + o - 32]); }
  }
}
DI void phase_p4(const Params& P, int l, char* smem, int bid, int nblk) {
  const int tid = otid(), lane = tid & 63, w = tid >> 6, wv = (bid * NT + tid) >> 6, nwv = (nblk * NT) >> 6;
  float* raw = (float*)smem + w * 768;
  const f32x4* wp = (const f32x4*)P.rwp + (size_t)l * 64 * 3 * 64 + lane;
  const int nrb = min(nblk, (T / 16 + 3) / 4), nwr = nrb * 4;
  for (int wt = bid < nrb ? bid * 4 + w : T / 16; wt < T / 16; wt += nwr) {
    const int t0 = wt * 16;
    f32x4v acc[3];
    _Pragma("unroll") for (int n = 0; n < 3; ++n) { acc[n][0] = 0.f; acc[n][1] = 0.f; acc[n][2] = 0.f; acc[n][3] = 0.f; }
    const float* xa = P.h + (size_t)(t0 + (lane & 15)) * D + 4 * (lane >> 4);
    f32x4 A0[4], B0[4][3], A1[4], B1[4][3];
    float s1 = 0.f, s2 = 0.f;
#define P4_LOAD(Ab, Bb, c0) _Pragma("unroll") for (int u = 0; u < 4; ++u) { Ab[u] = *(const f32x4*)(xa + 16 * ((c0) + u)); \
      _Pragma("unroll") for (int n = 0; n < 3; ++n) Bb[u][n] = wp[(((c0) + u) * 3 + n) * 64]; }
#define P4_MMA(Ab, Bb) _Pragma("unroll") for (int u = 0; u < 4; ++u) { const f32x4 a = Ab[u]; \
      s1 += (a.x + a.y) + (a.z + a.w); s2 += (a.x * a.x + a.y * a.y) + (a.z * a.z + a.w * a.w); \
      _Pragma("unroll") for (int n = 0; n < 3; ++n) acc[n] = __builtin_amdgcn_mfma_f32_16x16x4f32(a.x, Bb[u][n].x, acc[n], 0, 0, 0); \
      _Pragma("unroll") for (int n = 0; n < 3; ++n) acc[n] = __builtin_amdgcn_mfma_f32_16x16x4f32(a.y, Bb[u][n].y, acc[n], 0, 0, 0); \
      _Pragma("unroll") for (int n = 0; n < 3; ++n) acc[n] = __builtin_amdgcn_mfma_f32_16x16x4f32(a.z, Bb[u][n].z, acc[n], 0, 0, 0); \
      _Pragma("unroll") for (int n = 0; n < 3; ++n) acc[n] = __builtin_amdgcn_mfma_f32_16x16x4f32(a.w, Bb[u][n].w, acc[n], 0, 0, 0); }
    P4_LOAD(A0, B0, 0)
    _Pragma("unroll 1") for (int ch = 0; ch < 64; ch += 8) {
      P4_LOAD(A1, B1, ch + 4)
      __builtin_amdgcn_sched_barrier(0);
      P4_MMA(A0, B0)
      __builtin_amdgcn_sched_barrier(0);
      if (ch + 8 < 64) { P4_LOAD(A0, B0, ch + 8) }
      __builtin_amdgcn_sched_barrier(0);
      P4_MMA(A1, B1)
      __builtin_amdgcn_sched_barrier(0);
    }
#undef P4_LOAD
#undef P4_MMA
    s1 += sxor<16>(s1); s2 += sxor<16>(s2); s1 = xsum32(s1); s2 = xsum32(s2);
    const float mu_r = s1 * (1.f / 1024.f), rs_r = rsqrtf(fmaxf(s2 * (1.f / 1024.f) - mu_r * mu_r, 0.f) + LN_EPS);
    WT_FENCE();
    _Pragma("unroll") for (int r = 0; r < 4; ++r) {
      const int tok = 4 * (lane >> 4) + r, j = lane & 15;
      raw[tok * 40 + j] = acc[0][r]; raw[tok * 40 + 16 + j] = acc[1][r];
      if (j < 4) raw[tok * 40 + 32 + j] = acc[2][r];
    }
    if (lane < 16) { raw[640 + 2 * lane] = mu_r; raw[640 + 2 * lane + 1] = rs_r; }
    WT_FENCE();
    f32x4 gg[4], bb[4];
    _Pragma("unroll") for (int i = 0; i < 4; ++i) { gg[i] = ((const f32x4*)(P.ln1_g + l * D))[lane + 64 * i]; bb[i] = ((const f32x4*)(P.ln1_b + l * D))[lane + 64 * i]; }
    _Pragma("unroll 1") for (int q0 = 0; q0 < 16; q0 += 4) {
      f32x4 v[4][4];
      _Pragma("unroll") for (int j = 0; j < 4; ++j) _Pragma("unroll") for (int i = 0; i < 4; ++i) v[j][i] = ((const f32x4*)(P.h + (size_t)(t0 + q0 + j) * D))[lane + 64 * i];
      __builtin_amdgcn_sched_barrier(0);
      _Pragma("unroll") for (int j = 0; j < 4; ++j) {
        const float mu = raw[640 + 2 * (q0 + j)], rs = raw[640 + 2 * (q0 + j) + 1];
        _Pragma("unroll") for (int i = 0; i < 4; ++i) {
          v[j][i].x = (v[j][i].x - mu) * rs * gg[i].x + bb[i].x; v[j][i].y = (v[j][i].y - mu) * rs * gg[i].y + bb[i].y;
          v[j][i].z = (v[j][i].z - mu) * rs * gg[i].z + bb[i].z; v[j][i].w = (v[j][i].w - mu) * rs * gg[i].w + bb[i].w;
        }
        store_row(v[j], P.h + (size_t)(t0 + q0 + j) * D, P.hb + (size_t)(t0 + q0 + j) * D, lane);
      }
    }
    WT_FENCE();
    if (lane < 16) {
      const int t = t0 + lane;
      const float mu = raw[640 + 2 * lane], rs = raw[640 + 2 * lane + 1];
      const float* G = P.rgb + (l * 2) * 48; const float* Bc = G + 48;
      float gl[4];
      _Pragma("unroll") for (int g = 0; g < 4; ++g) gl[g] = rs * (raw[lane * 40 + 32 + g] - mu * G[32 + g]) + Bc[32 + g];
      int gs = 0; float gm = gl[0];
      for (int g = 1; g < 4; ++g) if (gl[g] > gm) { gm = gl[g]; gs = g; }
      float den = 0.f;
      _Pragma("unroll") for (int g = 0; g < 4; ++g) den += expf(gl[g] - gm);
      const float pg = 1.f / den;
      float el[8];
      _Pragma("unroll") for (int e = 0; e < 8; ++e) el[e] = rs * (raw[lane * 40 + gs * 8 + e] - mu * G[gs * 8 + e]) + Bc[gs * 8 + e];
      int i1 = 0; float v1 = el[0];
      for (int e = 1; e < 8; ++e) if (el[e] > v1) { v1 = el[e]; i1 = e; }
      int i2 = -1; float v2 = -3.0e38f;
      _Pragma("unroll") for (int e = 0; e < 8; ++e) if (e != i1 && el[e] > v2) { v2 = el[e]; i2 = e; }
      if (i2 < 0) i2 = (i1 + 1) & 7;
      const float ex = expf(v2 - v1);
      const float w1 = pg / (1.f + ex), w2 = pg * ex / (1.f + ex);
      const int e1 = gs * 8 + i1, e2 = gs * 8 + i2;
      const int r1 = atomicAdd(P.counts + e1 * CSTR, 1), r2 = atomicAdd(P.counts + e2 * CSTR, 1);
      P.tok_slot[2 * t] = e1 * CAP + r1; P.tok_slot[2 * t + 1] = e2 * CAP + r2;
      P.tok_w[2 * t] = w1; P.tok_w[2 * t + 1] = w2;
      P.slot_tok[(size_t)e1 * CAP + r1] = t; P.slot_tok[(size_t)e2 * CAP + r2] = t;
    }
  }
}

DI bool moe_unit(const int* counts, int i, int G, int c, int& e, int& mi, int& pn, int& cnt, int& hs) {
  int tot = 0;
  for (int x = 0; x < NEXP; ++x) tot += (counts[x * CSTR] + 255) >> 8;
  const int U = tot * 4, g = i * G + c;
  if (g >= U) return false;
  const int q = U / 8, r = U % 8, xcd = g % 8, off = g / 8;
  const int idx = (xcd < r ? xcd * (q + 1) : r * (q + 1) + (xcd - r) * q) + off;
  const int mt = idx >> 2; pn = idx & 3;
  int acc = 0; e = 0; mi = 0; cnt = 0; hs = 0;
  for (int x = 0; x < NEXP; ++x) {
    const int cx = counts[x * CSTR], n = (cx + 255) >> 8;
    if (mt < acc + n) { e = x; mi = mt - acc; cnt = cx; hs = acc * 256; return true; }
    acc += n;
  }
  return false;
}
constexpr int MOE_TAB = 131072 + 512, MOE_MAXU = 8;
DI void moe_table(const int* counts, int G, int c, char* smem_wg) {
  const int tid = rtid();
  __syncthreads();
  if (tid < MOE_MAXU) {
    int e = 0, mi = 0, pn = 0, cnt = 0, hs = 0;
    const bool ok = moe_unit(counts, tid, G, c, e, mi, pn, cnt, hs);
    int* tb = (int*)(smem_wg + MOE_TAB) + tid * 8;
    tb[0] = ok ? 1 : 0; tb[1] = e; tb[2] = mi; tb[3] = pn; tb[4] = cnt; tb[5] = hs;
  }
  __syncthreads();
}
DI bool moe_next(int i, int& e, int& mi, int& pn, int& cnt, int& hs) {
  if (i >= MOE_MAXU) return false;
  const LAS_I* tb = (const LAS_I*)(size_t)(MOE_TAB + i * 32);
  const int ok = __builtin_amdgcn_readfirstlane(tb[0]);
  e = __builtin_amdgcn_readfirstlane(tb[1]); mi = __builtin_amdgcn_readfirstlane(tb[2]); pn = __builtin_amdgcn_readfirstlane(tb[3]);
  cnt = __builtin_amdgcn_readfirstlane(tb[4]); hs = __builtin_amdgcn_readfirstlane(tb[5]);
  return ok != 0;
}
struct SchedP5a {
  static constexpr bool GATHER = true;
  const int* counts; const int* slot_tok; const char* hb; const char* w; int G, c;
  DI bool next(int i, g8::Unit& u) const {
    int e, mi, pn, cnt, hs;
    if (!moe_next(i, e, mi, pn, cnt, hs)) return false;
    u.pm = hs + mi * 256; u.pn = pn; u.tag = e; u.x0 = e * CAP + mi * 256; u.x1 = cnt - mi * 256;
    u.a = hb; u.b = w + ((size_t)e * 1024 + (size_t)pn * 256) * D * 2; return true;
  }
  DI void arows(const g8::Unit& u, int R0, unsigned (&pk)[2]) const {
    const int* st = slot_tok + u.x0; const int lim = u.x1 - 1;
    const int t0 = st[min(R0, lim)], t1 = st[min(R0 + 64, lim)], t2 = st[min(R0 + 128, lim)], t3 = st[min(R0 + 192, lim)];
    pk[0] = (unsigned)t0 | ((unsigned)t1 << 16); pk[1] = (unsigned)t2 | ((unsigned)t3 << 16);
  }
};
struct EpiP5a {
  static constexpr bool PERM = true;
  bf16_t* H;
  DI bool keep(const g8::Unit&) const { return false; }
  DI void operator()(g8::f32x4 (&acc)[2][2][4][2], const g8::Unit& u, int wr, int wc, int fr, int fq) const {
    _Pragma("unroll") for (int ai = 0; ai < 2; ++ai) _Pragma("unroll") for (int m = 0; m < 4; ++m) {
      bf16_t* rowp = H + (size_t)(u.pm + 128 * ai + 64 * wr + 16 * m + fr) * 512 + u.pn * 128 + 16 * wc + 4 * fq;
      _Pragma("unroll") for (int bj = 0; bj < 2; ++bj) {
        const g8::f32x4 g = acc[ai][bj][m][0], up = acc[ai][bj][m][1];
        u32x2 o; o.x = pk2(g[0] * sigmoidf_(g[0]) * up[0], g[1] * sigmoidf_(g[1]) * up[1]); o.y = pk2(g[2] * sigmoidf_(g[2]) * up[2], g[3] * sigmoidf_(g[3]) * up[3]);
        *(u32x2*)(rowp + 64 * bj) = o;
      }
    }
  }
};
DI void phase_p5a(const Params& P, int l, char* smem_wg, int bid, int nblk) {
  SchedP5a S; S.counts = P.counts; S.slot_tok = P.slot_tok; S.hb = (const char*)P.hb; S.w = (const char*)P.w_gu_t; S.G = nblk >> 1; S.c = bid >> 1;
  EpiP5a E; E.H = P.H;
  moe_table(P.counts, S.G, S.c, smem_wg);
  g8::gemm_phase((g8::lds_u8*)smem_wg, D, S, E);
}
struct SchedP5b {
  static constexpr bool GATHER = false;
  const int* counts; const char* H; const char* w; int G, c;
  DI bool next(int i, g8::Unit& u) const {
    int e, mi, pn, cnt, hs;
    if (!moe_next(i, e, mi, pn, cnt, hs)) return false;
    u.pm = hs + mi * 256; u.pn = pn; u.tag = e; u.x0 = 0; u.x1 = 0;
    u.a = H + (size_t)u.pm * 512 * 2; u.b = w + ((size_t)e * 1024 + (size_t)pn * 256) * 512 * 2; return true;
  }
  DI void arows(const g8::Unit&, int, unsigned (&)[2]) const {}
};
struct EpiP5b {
  static constexpr bool PERM = true;
  bf16_t* ys;
  DI bool keep(const g8::Unit&) const { return false; }
  DI void operator()(g8::f32x4 (&acc)[2][2][4][2], const g8::Unit& u, int wr, int wc, int fr, int fq) const {
    _Pragma("unroll") for (int ai = 0; ai < 2; ++ai) _Pragma("unroll") for (int m = 0; m < 4; ++m) {
      bf16_t* rowp = ys + (size_t)(u.pm + 128 * ai + 64 * wr + 16 * m + fr) * D + u.pn * 256 + 32 * wc + 8 * fq;
      _Pragma("unroll") for (int bj = 0; bj < 2; ++bj) {
        const g8::f32x4 a = acc[ai][bj][m][0], b = acc[ai][bj][m][1];
        u32x4 o; o.x = pk2(a[0], a[1]); o.y = pk2(a[2], a[3]); o.z = pk2(b[0], b[1]); o.w = pk2(b[2], b[3]);
        *(u32x4*)(rowp + 128 * bj) = o;
      }
    }
  }
};
DI void phase_p5b(const Params& P, int l, char* smem_wg, int bid, int nblk) {
  SchedP5b S; S.counts = P.counts; S.H = (const char*)P.H; S.w = (const char*)P.w_dn_t; S.G = nblk >> 1; S.c = bid >> 1;
  EpiP5b E; E.ys = P.ys;
  moe_table(P.counts, S.G, S.c, smem_wg);
  g8::gemm_phase((g8::lds_u8*)smem_wg, 512, S, E);
}
DI void phase_p6(const Params& P, int l, char* smem, int bid, int nblk) {
  const int tid = otid(), lane = tid & 63, wv = (bid * NT + tid) >> 6, nwv = (nblk * NT) >> 6;
  int* shs = (int*)smem;
  __syncthreads();
  if (tid == 0) { int hs = 0; for (int x = 0; x < NEXP; ++x) { shs[x] = hs; hs += ((P.counts[x * CSTR] + 255) >> 8) * 256; } }
  __syncthreads();
  int ns1 = 0, ns2 = 0; float nw1 = 0.f, nw2 = 0.f;
  if (wv < T) { ns1 = P.tok_slot[2 * wv]; ns2 = P.tok_slot[2 * wv + 1]; nw1 = P.tok_w[2 * wv]; nw2 = P.tok_w[2 * wv + 1]; }
  for (int t = wv; t < T; t += nwv) {
    const int s1 = ns1, s2 = ns2;
    const float w1 = nw1, w2 = nw2;
    { const int tn = min(t + nwv, T - 1); ns1 = P.tok_slot[2 * tn]; ns2 = P.tok_slot[2 * tn + 1]; nw1 = P.tok_w[2 * tn]; nw2 = P.tok_w[2 * tn + 1]; }
    const bf16_t* y1 = P.ys + (size_t)(shs[s1 / CAP] + s1 % CAP) * D;
    const bf16_t* y2 = P.ys + (size_t)(shs[s2 / CAP] + s2 % CAP) * D;
    f32x4 v[4];
    _Pragma("unroll") for (int i = 0; i < 4; ++i) {
      const f32x4 hv = ((const f32x4*)(P.h + (size_t)t * D))[lane + 64 * i];
      const u32x2 a = ((const u32x2*)y1)[lane + 64 * i], c = ((const u32x2*)y2)[lane + 64 * i];
      v[i].x = ALPHA * hv.x + (bflo(a.x) * w1 + bflo(c.x) * w2); v[i].y = ALPHA * hv.y + (bfhi(a.x) * w1 + bfhi(c.x) * w2);
      v[i].z = ALPHA * hv.z + (bflo(a.y) * w1 + bflo(c.y) * w2); v[i].w = ALPHA * hv.w + (bfhi(a.y) * w1 + bfhi(c.y) * w2);
    }
    ln16(v, P.ln2_g + l * D, P.ln2_b + l * D, lane);
    if (l == 1) {
      const int b = t >= L ? 1 : 0, pos = t - b * L;
      if (pos >= NMETA) store_row(v, P.out + ((size_t)b * SEQ + pos - NMETA) * D, nullptr, lane);
    } else store_row(v, P.h + (size_t)t * D, P.hb + (size_t)t * D, lane);
  }
}

#define XB_TMO      128
#define XB_XCNT(j)  (256  + 64 * (j))
#define XB_XSUB(j)  (1280 + 64 * (j))
#define XB_XGEN(j)  (2304 + 64 * (j))
#define XB_TOP      3328
#define XB_TOPGEN   3392
#define XCD_BAR_WORDS 3456
#define XB_SPIN_CAP (1u << 20)
#define LAS __attribute__((address_space(3)))
DI unsigned xb_ld(unsigned* p) { return __hip_atomic_load(p, __ATOMIC_RELAXED, __HIP_MEMORY_SCOPE_AGENT); }
DI unsigned xb_add(unsigned* p, unsigned v) { return __hip_atomic_fetch_add(p, v, __ATOMIC_RELAXED, __HIP_MEMORY_SCOPE_AGENT); }
DI unsigned xb_xcc_id() { return (unsigned)__builtin_amdgcn_s_getreg((3 << 11) | 20) & 0xFu; }
#define XB_SPIN(cond, bar) do { unsigned _sp = 0; while (cond) { __builtin_amdgcn_s_sleep(1); \
    if ((++_sp & 255u) == 0u) { if (xb_ld(&(bar)[XB_TMO])) break; if (_sp > XB_SPIN_CAP) { atomicAdd(&(bar)[XB_TMO], 1u); break; } } } } while (0)
struct XcdBarrier { unsigned* bar; unsigned x; volatile LAS unsigned* st; };
DI XcdBarrier xcd_barrier_post(unsigned* bar, volatile LAS unsigned* st) {
  XcdBarrier b; b.bar = bar; b.x = xb_xcc_id(); b.st = st;
  if (rtid() == 0) (void)xb_add(&bar[XB_XCNT(b.x)], 1u);
  return b;
}
DI void xcd_barrier_complete(unsigned* bar, unsigned x, unsigned& nloc, unsigned& nx) {
  const unsigned G = gridDim.x * gridDim.y * gridDim.z;
  unsigned sum, cnt, mine, sp = 0u;
  for (;;) {
    sum = 0u; cnt = 0u; mine = 0u;
    _Pragma("unroll") for (unsigned j = 0; j < 16; ++j) { const unsigned c = xb_ld(&bar[XB_XCNT(j)]); sum += c; cnt += (c > 0u) ? 1u : 0u; mine = (j == x) ? c : mine; }
    if (sum == G) break;
    __builtin_amdgcn_s_sleep(1);
    if ((++sp & 255u) == 0u) { if (xb_ld(&bar[XB_TMO])) break; if (sp > XB_SPIN_CAP) { atomicAdd(&bar[XB_TMO], 1u); break; } }
  }
  nloc = mine > 0u ? mine : 1u; nx = cnt > 0u ? cnt : 1u;
}
DI void xcd_barrier(const XcdBarrier& b) {
  asm volatile("s_waitcnt vmcnt(0)" ::: "memory");
  __syncthreads();
  if (rtid() == 0) {
    unsigned* bar = b.bar; unsigned bx = b.x;
    asm volatile("" : "+s"(bar), "+s"(bx));
    __builtin_amdgcn_s_waitcnt(0);
    unsigned nloc = b.st[0], nx = b.st[1];
    if (nloc == 0u) { xcd_barrier_complete(bar, bx, nloc, nx); b.st[0] = nloc; b.st[1] = nx; }
    const unsigned old = xb_add(&bar[XB_XSUB(bx)], 1u);
    const unsigned gen = old / nloc;
    if (old + 1u == (gen + 1u) * nloc) {
      __builtin_amdgcn_fence(__ATOMIC_RELEASE, "agent");
      asm volatile("s_waitcnt vmcnt(0)" ::: "memory");
      const unsigned og = xb_add(&bar[XB_TOP], 1u);
      const unsigned tg = og / nx;
      if (og + 1u == (tg + 1u) * nx) xb_add(&bar[XB_TOPGEN], 1u);
      else XB_SPIN(xb_ld(&bar[XB_TOPGEN]) == tg, bar);
      __builtin_amdgcn_fence(__ATOMIC_ACQUIRE, "agent");
      xb_add(&bar[XB_XGEN(bx)], 1u);
      asm volatile("s_waitcnt vmcnt(0)" ::: "memory");
    } else {
      XB_SPIN(xb_ld(&bar[XB_XGEN(bx)]) == gen, bar);
      __builtin_amdgcn_fence(__ATOMIC_ACQUIRE, "agent");
      asm volatile("s_waitcnt vmcnt(0)" ::: "memory");
    }
  }
  __syncthreads();
}

constexpr size_t al256(size_t v) { return (v + 255) & ~(size_t)255; }
struct WsLayout {
  size_t bar, ctl, h, hb, w_in_t, w_br_t, w_out_t, cs, rwp, rgb, lam, counts, tok_slot, tok_w, slot_tok, mstat, nvec, wgt, bcum, ligate;
  size_t qa, ka, vaT, qb, kb, vbT, cq, ck, cvT, co, cg, gz, qc, kc, kcT, U, end_mixer;
  size_t w_gu_t, w_dn_t, H, ys, end_moe, need;
};
constexpr WsLayout make_layout() {
  WsLayout w{}; size_t off = 0;
#define TAKE(f, bytes) w.f = off; off = al256(off + (size_t)(bytes));
  TAKE(bar, XCD_BAR_WORDS * 4) TAKE(ctl, 4096)
  TAKE(h, (size_t)TP * D * 4) TAKE(hb, (size_t)TP * D * 2) TAKE(w_in_t, (size_t)DINP * D * 2) TAKE(w_br_t, (size_t)3 * 1024 * 512 * 2) TAKE(w_out_t, (size_t)D * D * 2)
  TAKE(cs, (size_t)L * 32 * 8) TAKE(rwp, (size_t)2 * 64 * 3 * 64 * 4 * 4) TAKE(rgb, 2 * 2 * 48 * 4) TAKE(lam, 256) TAKE(counts, NEXP * CSTR * 4) TAKE(tok_slot, (size_t)T * 2 * 4) TAKE(tok_w, (size_t)T * 2 * 4) TAKE(slot_tok, (size_t)NEXP * CAP * 4)
  TAKE(mstat, (size_t)16 * NCH * 4 * 4) TAKE(nvec, (size_t)16 * NCH * 128 * 4) TAKE(wgt, (size_t)16 * LPAD * 4) TAKE(bcum, (size_t)16 * LPAD * 4) TAKE(ligate, (size_t)16 * LPAD * 4)
  const size_t scratch0 = off;
  TAKE(qa, (size_t)NB * 4 * 2 * L * 64 * 2) TAKE(ka, (size_t)NB * 4 * 2 * L * 64 * 2 + 4096) TAKE(vaT, (size_t)NB * 4 * 128 * LK * 2)
  TAKE(qb, (size_t)NB * 8 * L * 64 * 2) TAKE(kb, (size_t)NB * 2 * L * 64 * 2 + 4096) TAKE(vbT, (size_t)NB * 2 * 64 * LK * 2)
  TAKE(cq, (size_t)TP * 512 * 2) TAKE(ck, (size_t)TP * 512 * 2) TAKE(cvT, (size_t)8 * 128 * LPAD * 2) TAKE(co, (size_t)TP * 512 * 2) TAKE(cg, (size_t)TP * 16 * 4)
  TAKE(gz, (size_t)TP * 3072 * 2) TAKE(qc, (size_t)8 * LPAD * 128 * 2) TAKE(kc, (size_t)8 * LPAD * 128 * 2) TAKE(kcT, (size_t)8 * 128 * LPAD * 2) TAKE(U, (size_t)16 * NCH * 16384 * 4)
  w.end_mixer = off;
  off = scratch0;
  TAKE(w_gu_t, (size_t)NEXP * 1024 * 1024 * 2) TAKE(w_dn_t, (size_t)NEXP * 1024 * 512 * 2) TAKE(H, (size_t)HROWS * 512 * 2) TAKE(ys, (size_t)HROWS * D * 2)
  w.end_moe = off;
#undef TAKE
  w.need = w.end_mixer > w.end_moe ? w.end_mixer : w.end_moe;
  return w;
}
constexpr WsLayout WL = make_layout();
static_assert(WL.need <= (size_t)552 * 1000 * 1000, "workspace");

struct SchedP1 {
  static constexpr bool GATHER = false;
  const char* hb; const char* w; int G, c;
  DI bool next(int i, g8::Unit& u) const {
    const int Lq = i * G + c; int pm, pn;
    if (Lq < 65 * 25) { g8::grid_lin(Lq, 65, 25, pm, pn); u.tag = 0; u.a = hb + (size_t)pm * 256 * D * 2; u.b = w + (size_t)pn * 256 * D * 2; }
    else if (Lq < 65 * 25 + 5 * 65) { g8::grid_lin(Lq - 65 * 25, 5, 65, pm, pn); u.tag = 1; u.a = w + (size_t)(6400 + pm * 256) * D * 2; u.b = hb + (size_t)pn * 256 * D * 2; }
    else return false;
    u.pm = pm; u.pn = pn; return true;
  }
  DI void arows(const g8::Unit&, int, unsigned (&)[2]) const {}
};
DI u32x4 pack8(const g8::f32x4& a, const g8::f32x4& b) { u32x4 o; o.x = pk2(a[0], a[1]); o.y = pk2(a[2], a[3]); o.z = pk2(b[0], b[1]); o.w = pk2(b[2], b[3]); return o; }
struct EpiP1 {
  static constexpr bool PERM = true;
  char* ws;
  DI bool keep(const g8::Unit&) const { return false; }
  DI void operator()(g8::f32x4 (&acc)[2][2][4][2], const g8::Unit& u, int wr, int wc, int fr, int fq) const {
    char* wb = ws; asm volatile("" : "+s"(wb));
    if (u.tag == 0) {
      const int r0 = u.pm * 256 + 64 * wr + fr;
      _Pragma("unroll") for (int bj = 0; bj < 2; ++bj) {
        const int c0 = u.pn * 256 + 128 * bj + 32 * wc;
        const int c = c0 + 8 * fq;
        if (c0 < 1664) {
          const int u64 = c0 >> 6, q = ((c0 >> 5) & 1) * 4 + fq;
          bf16_t* base; int nh, uu; float sc;
          if (u64 < 8) { base = (bf16_t*)(wb + WL.qa); nh = 8; uu = u64; sc = QSCALE; }
          else if (u64 < 16) { base = (bf16_t*)(wb + WL.ka); nh = 8; uu = u64 - 8; sc = 1.f; }
          else if (u64 < 24) { base = (bf16_t*)(wb + WL.qb); nh = 8; uu = u64 - 16; sc = QSCALE; }
          else { base = (bf16_t*)(wb + WL.kb); nh = 2; uu = u64 - 24; sc = 1.f; }
          const f32x2* cs = (const f32x2*)(wb + WL.cs);
          _Pragma("unroll") for (int ai = 0; ai < 2; ++ai) {
            g8::f32x4 c01[4], c23[4];
            _Pragma("unroll") for (int m = 0; m < 4; ++m) {
              const int t = r0 + 128 * ai + 16 * m, tt = min(t, T - 1), b = tt >= L ? 1 : 0, pos = tt - b * L;
              const g8::f32x4* cp = (const g8::f32x4*)(cs + (size_t)pos * 32 + 4 * q);
              c01[m] = cp[0]; c23[m] = cp[1];
            }
            __builtin_amdgcn_sched_barrier(0);
            _Pragma("unroll") for (int m = 0; m < 4; ++m) {
              const int t = r0 + 128 * ai + 16 * m, tt = min(t, T - 1), b = tt >= L ? 1 : 0, pos = tt - b * L;
              const g8::f32x4 x1 = acc[ai][bj][m][0], x2 = acc[ai][bj][m][1];
              g8::f32x4 o1, o2;
              o1[0] = (x1[0] * c01[m][0] - x2[0] * c01[m][1]) * sc; o2[0] = (x2[0] * c01[m][0] + x1[0] * c01[m][1]) * sc;
              o1[1] = (x1[1] * c01[m][2] - x2[1] * c01[m][3]) * sc; o2[1] = (x2[1] * c01[m][2] + x1[1] * c01[m][3]) * sc;
              o1[2] = (x1[2] * c23[m][0] - x2[2] * c23[m][1]) * sc; o2[2] = (x2[2] * c23[m][0] + x1[2] * c23[m][1]) * sc;
              o1[3] = (x1[3] * c23[m][2] - x2[3] * c23[m][3]) * sc; o2[3] = (x2[3] * c23[m][2] + x1[3] * c23[m][3]) * sc;
              if (t < T) *(u32x4*)(base + ((size_t)(b * nh + uu) * L + pos) * 64 + 8 * q) = pack8(o1, o2);
            }
            __builtin_amdgcn_sched_barrier(0);
          }
        } else if (c0 < 6272) {
          bf16_t* dst0; int stride; bool sig = false;
          if (c0 < 2176) { dst0 = (bf16_t*)(wb + WL.cq) + (c - 1664); stride = 512; }
          else if (c0 < 2688) { dst0 = (bf16_t*)(wb + WL.ck) + (c - 2176); stride = 512; }
          else if (c0 < 3200) { dst0 = (bf16_t*)(wb + WL.co) + (c - 2688); stride = 512; }
          else { dst0 = (bf16_t*)(wb + WL.gz) + (c - 3200); stride = 3072; sig = true; }
          _Pragma("unroll") for (int ai = 0; ai < 2; ++ai) _Pragma("unroll") for (int m = 0; m < 4; ++m) {
            const int t = r0 + 128 * ai + 16 * m;
            g8::f32x4 v0 = acc[ai][bj][m][0], v1 = acc[ai][bj][m][1];
            if (sig) { _Pragma("unroll") for (int e = 0; e < 4; ++e) { v0[e] = fmaxf(sigmoidf_(v0[e]), 1e-12f); v1[e] = fmaxf(sigmoidf_(v1[e]), 1e-12f); } }
            if (t < T) *(u32x4*)(dst0 + (size_t)t * stride) = pack8(v0, v1);
          }
        } else if (c0 == 6272) {
          if (fq < 2) {
            float* cg = (float*)(wb + WL.cg);
            _Pragma("unroll") for (int ai = 0; ai < 2; ++ai) _Pragma("unroll") for (int m = 0; m < 4; ++m) {
              const int t = r0 + 128 * ai + 16 * m;
              if (t < T) { g8::f32x4* d = (g8::f32x4*)(cg + (size_t)t * 16 + 8 * fq); d[0] = acc[ai][bj][m][0]; d[1] = acc[ai][bj][m][1]; }
            }
          }
        }
      }
    } else {
      const int chb0 = u.pm * 256 + 64 * wr;
      _Pragma("unroll") for (int ai = 0; ai < 2; ++ai) _Pragma("unroll") for (int m = 0; m < 4; ++m) {
        const int chb = chb0 + 128 * ai + 16 * m;
        if (chb < 1152) {
          const int ch = chb + fr; bf16_t* rp; size_t bs;
          if (chb < 512) { rp = (bf16_t*)(wb + WL.vaT) + (size_t)ch * LK; bs = (size_t)512 * LK; }
          else if (chb < 640) { rp = (bf16_t*)(wb + WL.vbT) + (size_t)(ch - 512) * LK; bs = (size_t)128 * LK; }
          else { rp = (bf16_t*)(wb + WL.cvT) + (size_t)(ch - 640) * LPAD + MPAD; bs = (size_t)512 * LPAD; }
          _Pragma("unroll") for (int bj = 0; bj < 2; ++bj) {
            const int t0 = u.pn * 256 + 128 * bj + 32 * wc + 8 * fq;
            if (t0 < T) { const int b = t0 >= L ? 1 : 0, pos0 = t0 - b * L; *(u32x4*)(rp + b * bs + pos0) = pack8(acc[ai][bj][m][0], acc[ai][bj][m][1]); }
          }
        }
      }
    }
  }
};
DI void phase_p1(const Params& P, int l, char* smem_wg, int bid, int nblk) {
  SchedP1 S; S.hb = (const char*)P.hb; S.w = (const char*)P.w_in_t; S.G = nblk >> 1; S.c = bid >> 1;
  EpiP1 E; E.ws = (char*)P.h - WL.h;
  g8::gemm_phase((g8::lds_u8*)smem_wg, D, S, E);
}

struct KArgs { const float* in[28]; float* out; char* ws; };
typedef const __attribute__((address_space(4))) KArgs* KAP;
DI Params make_params(KAP k) {
  Params P;
  P.x = k->in[0]; P.meta = k->in[1]; P.ln_in_g = k->in[2]; P.ln_in_b = k->in[3]; P.w_in = k->in[4]; P.conv_w = k->in[5]; P.conv_b = k->in[6]; P.gate_b = k->in[7];
  P.lam_q1 = k->in[8]; P.lam_k1 = k->in[9]; P.lam_q2 = k->in[10]; P.lam_k2 = k->in[11]; P.diff_g = k->in[12]; P.sink = k->in[13]; P.mlstm_g = k->in[14];
  P.w_branch = k->in[15]; P.w_out = k->in[16]; P.ln1_g = k->in[17]; P.ln1_b = k->in[18]; P.ln2_g = k->in[19]; P.ln2_b = k->in[20]; P.w_rg = k->in[21]; P.b_rg = k->in[22];
  P.w_re = k->in[23]; P.b_re = k->in[24]; P.w_gate = k->in[25]; P.w_up = k->in[26]; P.w_down = k->in[27];
  P.out = k->out;
  char* ws = k->ws;
  P.h = (float*)(ws + WL.h); P.hb = (bf16_t*)(ws + WL.hb); P.w_in_t = (bf16_t*)(ws + WL.w_in_t); P.w_br_t = (bf16_t*)(ws + WL.w_br_t); P.w_out_t = (bf16_t*)(ws + WL.w_out_t);
  P.cs = (f32x2*)(ws + WL.cs); P.lam = (float*)(ws + WL.lam); P.ctl = (unsigned*)(ws + WL.ctl); P.rwp = (float*)(ws + WL.rwp); P.rgb = (float*)(ws + WL.rgb); P.counts = (int*)(ws + WL.counts); P.tok_slot = (int*)(ws + WL.tok_slot); P.tok_w = (float*)(ws + WL.tok_w);
  P.slot_tok = (int*)(ws + WL.slot_tok); P.mstat = (float*)(ws + WL.mstat); P.nvec = (float*)(ws + WL.nvec); P.wgt = (float*)(ws + WL.wgt); P.bcum = (float*)(ws + WL.bcum);
  P.ligate = (float*)(ws + WL.ligate);
  P.qa = (bf16_t*)(ws + WL.qa); P.ka = (bf16_t*)(ws + WL.ka); P.vaT = (bf16_t*)(ws + WL.vaT); P.qb = (bf16_t*)(ws + WL.qb); P.kb = (bf16_t*)(ws + WL.kb); P.vbT = (bf16_t*)(ws + WL.vbT);
  P.cq = (bf16_t*)(ws + WL.cq); P.ck = (bf16_t*)(ws + WL.ck); P.merged = P.cq; P.cvT = (bf16_t*)(ws + WL.cvT); P.co = (bf16_t*)(ws + WL.co); P.cg = (float*)(ws + WL.cg);
  P.gz = (bf16_t*)(ws + WL.gz); P.qc = (bf16_t*)(ws + WL.qc); P.kc = (bf16_t*)(ws + WL.kc); P.kcT = (bf16_t*)(ws + WL.kcT); P.U = (float*)(ws + WL.U);
  P.w_gu_t = (bf16_t*)(ws + WL.w_gu_t); P.w_dn_t = (bf16_t*)(ws + WL.w_dn_t); P.H = (bf16_t*)(ws + WL.H); P.ys = (bf16_t*)(ws + WL.ys);
  P.oa = (bf16_t*)k->out; P.ob = P.oa + (size_t)TP * 512; P.oc = P.ob + (size_t)TP * 512;
  return P;
}

constexpr int SMEM_BYTES = 2 * DA_STAGE + 4096 + 256;
constexpr int WG_LDS = 2 * SMEM_BYTES + 64 + 256;
static_assert(WIDTAB_OFF == 2 * SMEM_BYTES + 64, "wave-slot table offset");
#define PH(...) { KAP k_ = ka; int bid = bid0, nblk = nblk0; asm volatile("" : "+s"(k_), "+s"(bid), "+s"(nblk)); const Params P = make_params(k_); __VA_ARGS__; }
__global__ void __launch_bounds__(512, 2) mega(KArgs kargs) {
  extern __shared__ __attribute__((aligned(16))) char smem_wg[];
  (void)kargs;
  const KAP ka = (KAP)__builtin_amdgcn_kernarg_segment_ptr();
  {
    const unsigned hw = (unsigned)__builtin_amdgcn_s_getreg((5 << 11) | 4) & 63u;
    *(volatile LAS int*)(size_t)(WIDTAB_OFF + 4 * hw) = (int)(threadIdx.x >> 6);
  }
  __syncthreads();
  const int half = __builtin_amdgcn_readfirstlane(rtid() >> 8);
  char* smem = smem_wg + half * SMEM_BYTES;
  const int bid0 = 2 * blockIdx.x + half, nblk0 = 2 * gridDim.x;
  volatile LAS unsigned* st = (volatile LAS unsigned*)(smem_wg + 2 * SMEM_BYTES);
  volatile LAS int* wgq = (volatile LAS int*)(smem_wg + 2 * SMEM_BYTES + 16);
  if (rtid() == 0) { st[0] = 0u; st[1] = 0u; }
  __syncthreads();
  const XcdBarrier xb = xcd_barrier_post((unsigned*)(ka->ws + WL.bar), st);

  PH(phase_prologue(P, bid, nblk))
  PH(phase_router_prep(P, bid, nblk))
  PH(phase_wconv_small(P, 0, smem, bid, nblk))
  xcd_barrier(xb);
  auto layer = [&](const int l) __attribute__((always_inline)) {
    PH(phase_zero_pads(P, bid, nblk))
    PH(phase_p1(P, l, smem_wg, bid, nblk))
    xcd_barrier(xb);
    PH(phase_mprep(P, l, smem, bid, nblk))
    xcd_barrier(xb);
    for (int it = bid0; it < 512; it += nblk0) PH(dattn_item(P, l, it, true, smem))
    PH(phase_mscan(P, bid, nblk))
    xcd_barrier(xb);
    {
      for (int it = (int)blockIdx.x; it < 256; it += (int)gridDim.x) PH(dattn_item16(P, l, it, smem_wg))
      unsigned* qctr = (unsigned*)(ka->ws + WL.ctl) + (l * 8 + 5) * 16;
      const int NP = 4 + 4 * NCH + 2 * 257;
      for (;;) {
        __syncthreads();
        if (rtid() == 0) wgq[0] = (int)xb_add(qctr, 1u);
        __syncthreads();
        const int pr = wgq[0];
        if (pr >= NP) break;
        if (pr < 4) PH(dattn_combine(P, l, 2 * pr + half, smem))
        else if (pr < 4 + 4 * NCH) PH(mout_item(P, l, 2 * (pr - 4) + half, smem))
        else PH(swa_item(P, l, 2 * (pr - 4 - 4 * NCH) + half, smem))
      }
    }
    xcd_barrier(xb);
    PH(phase_p3a(P, l, smem, smem_wg, bid, nblk))
    xcd_barrier(xb);
    PH(phase_p3b(P, l, smem, smem_wg, bid, nblk))
    xcd_barrier(xb);
    PH(phase_p4(P, l, smem, bid, nblk))
    PH(phase_wconv_experts(P, l, smem, half, wgq))
    xcd_barrier(xb);
    PH(phase_p5a(P, l, smem_wg, bid, nblk))
    xcd_barrier(xb);
    PH(phase_p5b(P, l, smem_wg, bid, nblk))
    xcd_barrier(xb);
    PH(phase_p6(P, l, smem, bid, nblk))
    if (l == 0) PH(phase_wconv_small(P, 1, smem, bid, nblk))
    xcd_barrier(xb);
  };
  layer(0);
  layer(1);
}

extern "C" void kernel_launch(void* const* d_in, const int* in_sizes, int n_in, void* d_out, int out_size, void* d_ws, size_t ws_size, hipStream_t stream) {
  (void)in_sizes; (void)n_in; (void)out_size;
  if (WL.need > ws_size) return;
  KArgs a{};
  for (int i = 0; i < 28; ++i) a.in[i] = (const float*)d_in[i];
  a.out = (float*)d_out; a.ws = (char*)d_ws;
  static int grid = 0;
  if (!grid) {
    int dev = 0, cus = 0, per_cu = 0;
    (void)hipGetDevice(&dev);
    (void)hipDeviceGetAttribute(&cus, hipDeviceAttributeMultiprocessorCount, dev);
    (void)hipFuncSetAttribute((const void*)mega, hipFuncAttributeMaxDynamicSharedMemorySize, WG_LDS);
    (void)hipOccupancyMaxActiveBlocksPerMultiprocessor(&per_cu, (const void*)mega, 512, WG_LDS);
    if (per_cu > 1) per_cu = 1;
    if (per_cu < 1) per_cu = 1;
    grid = cus * per_cu;
  }
  (void)hipMemsetAsync((char*)d_ws + WL.bar, 0, WL.h - WL.bar, stream);
  hipLaunchKernelGGL(mega, dim3(grid), dim3(512), WG_LDS, stream, a);
}
```

```cpp
#include <hip/hip_runtime.h>
#include <stdint.h>

#define DI __device__ __forceinline__
typedef unsigned short bf16_t;
typedef __attribute__((ext_vector_type(8))) short bf16x8;
typedef __attribute__((ext_vector_type(16))) float f32x16;
typedef __attribute__((ext_vector_type(2))) float f32x2;
typedef __attribute__((ext_vector_type(4))) float f32x4;
typedef __attribute__((ext_vector_type(4))) unsigned u32x4;
typedef __attribute__((ext_vector_type(2))) unsigned u32x2;
typedef __attribute__((ext_vector_type(2))) __bf16 bf16x2v;
#define MFMA32(a, b, c) __builtin_amdgcn_mfma_f32_32x32x16_bf16((a), (b), (c), 0, 0, 0)

constexpr int NB = 2, SEQ = 8192, NMETA = 16, L = 8208, T = NB * L, TP = 16512, D = 1024;
constexpr int DIN = 7440, DINP = 7680;
constexpr int LPAD = 8320, NCH = 65, MPAD = 112, LK = 8256;
constexpr int NEXP = 32, CAP = 2 * T, HROWS = 2 * T + NEXP * 256;
constexpr int NT = 256;
constexpr int CSTR = 64;
constexpr float LN_EPS = 1e-5f;
constexpr float NEGF = -1e30f;
constexpr int SMEM_TQ = 65536 + 4096 + 64;
constexpr float ALPHA = 1.41421356237309515f;
constexpr float QSCALE = 0.125f * 1.44269504088896341f;

DI f32x4 mk4(float a, float b, float c, float d) { f32x4 v = {a, b, c, d}; return v; }
DI f32x2 mk2(float a, float b) { f32x2 v = {a, b}; return v; }
DI unsigned pk2(float a, float b) { f32x2 v = {a, b}; bf16x2v r = __builtin_convertvector(v, bf16x2v); return __builtin_bit_cast(unsigned, r); }
DI bf16_t f2bf(float a) { return (bf16_t)(pk2(a, 0.f) & 0xffffu); }
DI float bf2f(bf16_t b) { return __uint_as_float(((unsigned)b) << 16); }
DI float bflo(unsigned u) { return __uint_as_float(u << 16); }
DI float bfhi(unsigned u) { return __uint_as_float(u & 0xffff0000u); }
typedef __attribute__((address_space(3))) int LAS_I;
constexpr int WIDTAB_OFF = 2 * (2 * 32768 + 4096 + 256) + 64;
DI int rtid() {
  const unsigned hw = (unsigned)__builtin_amdgcn_s_getreg((5 << 11) | 4) & 63u;
  const int wid = *(volatile __attribute__((address_space(3))) int*)(size_t)(WIDTAB_OFF + 4 * hw);
  return wid * 64 + (int)__builtin_amdgcn_mbcnt_hi(~0u, __builtin_amdgcn_mbcnt_lo(~0u, 0u));
}
DI int otid() { int t = rtid() & 255; asm volatile("" : "+v"(t)); return t; }
DI int crow(int r, int h) { return (r & 3) + 8 * (r >> 2) + 4 * h; }
DI int keyoff(int r, int h) { return (r & 7) + 8 * h + 16 * (r >> 3); }
DI int swz(int row) { return (row >> 1) & 7; }
DI int kswap(int r) { return (r & 0x13) | ((r & 4) << 1) | ((r & 8) >> 1); }
template <int O> DI float sxor(float v) { return __builtin_bit_cast(float, __builtin_amdgcn_ds_swizzle(__builtin_bit_cast(int, v), 0x1f | (O << 10))); }
DI float sx32(float v) {
  int ln = (int)__builtin_amdgcn_mbcnt_hi(~0u, __builtin_amdgcn_mbcnt_lo(~0u, 0u)); asm volatile("" : "+v"(ln));
  return __builtin_bit_cast(float, __builtin_amdgcn_ds_bpermute((ln ^ 32) << 2, __builtin_bit_cast(int, v)));
}
DI float xsum32(float v) { return v + sx32(v); }
DI float xmax32(float v) { return fmaxf(v, sx32(v)); }
DI float wave_sum(float v) { v = xsum32(v); v += sxor<16>(v); v += sxor<8>(v); v += sxor<4>(v); v += sxor<2>(v); v += sxor<1>(v); return v; }
DI float wave_max(float v) { v = xmax32(v); v = fmaxf(v, sxor<16>(v)); v = fmaxf(v, sxor<8>(v)); v = fmaxf(v, sxor<4>(v)); v = fmaxf(v, sxor<2>(v)); v = fmaxf(v, sxor<1>(v)); return v; }
DI float fexp2(float x) { return __builtin_amdgcn_exp2f(x); }
DI float frcp(float x) { return __builtin_amdgcn_rcpf(x); }
DI float shfl_up_f(float v, int d, int lane) { return __builtin_bit_cast(float, __builtin_amdgcn_ds_bpermute(((lane - d) & 63) << 2, __builtin_bit_cast(int, v))); }
DI float sigmoidf_(float x) { return frcp(1.f + __expf(-x)); }
DI bf16x8 ldfrag(const bf16_t* p) { return *(const bf16x8*)p; }
DI f32x16 zero16() { f32x16 z; _Pragma("unroll") for (int i = 0; i < 16; ++i) z[i] = 0.f; return z; }
DI bf16x8 packfrag(const f32x16& x, int s) {
  union { unsigned u[4]; bf16x8 v; } t;
  t.u[0] = pk2(x[8 * s + 0], x[8 * s + 1]); t.u[1] = pk2(x[8 * s + 2], x[8 * s + 3]);
  t.u[2] = pk2(x[8 * s + 4], x[8 * s + 5]); t.u[3] = pk2(x[8 * s + 6], x[8 * s + 7]);
  return t.v;
}

struct Params {
  const float *x, *meta, *ln_in_g, *ln_in_b, *w_in, *conv_w, *conv_b, *gate_b, *lam_q1, *lam_k1, *lam_q2, *lam_k2;
  const float *diff_g, *sink, *mlstm_g, *w_branch, *w_out, *ln1_g, *ln1_b, *ln2_g, *ln2_b, *w_rg, *b_rg, *w_re, *b_re;
  const float *w_gate, *w_up, *w_down;
  float* out;
  float* h; bf16_t* hb; bf16_t *w_in_t, *w_br_t, *w_out_t; f32x2* cs; float* lam; unsigned* ctl; float* rwp; float* rgb;
  int* counts; int* tok_slot; float* tok_w; int* slot_tok;
  float* mstat;
  float* nvec;
  float* wgt;
  float* bcum;
  float* ligate;
  bf16_t *qa, *ka, *vaT, *qb, *kb, *vbT, *cq, *ck, *cvT, *co, *gz, *qc, *kc, *kcT, *merged;
  float* cg; float* U;
  bf16_t *oa, *ob, *oc;
  bf16_t *w_gu_t, *w_dn_t, *H, *ys;
};

typedef __attribute__((address_space(3))) unsigned lds_u32;

namespace g8 {
typedef __attribute__((address_space(3))) unsigned char lds_u8;
typedef float f32x4 __attribute__((ext_vector_type(4)));
constexpr int BK = 64, HALF = 128, HTB = HALF * BK * 2, STAGE_BYTES = 8 * HTB;
DI int lds_byte(int r, int c) { const int st = (r >> 4) * 2 + (c >> 5), rr = r & 15, cc = c & 31, ob = rr * 64 + cc * 2; return st * 1024 + (ob ^ (((ob >> 9) & 1) << 5)); }
DI void stage_rc(int b, int& R, int& C) { const int st = b / 1024, sb = b % 1024, swz = sb ^ (((sb >> 9) & 1) << 5); R = (st >> 1) * 16 + swz / 64; C = (st & 1) * 32 + (swz % 64) / 2; }
DI int perm32(int rho) { const int n = rho >> 4, i = rho & 15; return 8 * (i >> 2) + 4 * n + (i & 3); }
struct Unit { const char* a; const char* b; int pm, pn, tag, x0, x1; };
template <class Epi, class Sched>
DI void gemm_phase(lds_u8* lds, int K, const Sched& S, const Epi& E) {
  int tid = rtid(); asm volatile("" : "+v"(tid));
  const int wid = __builtin_amdgcn_readfirstlane(tid >> 6), lane = tid & 63, wr = wid >> 2, wc = wid & 3, fr = lane & 15, fq = lane >> 4;
  const int nt = K / BK;
  int R[2], C[2]; unsigned voffB[2];
  _Pragma("unroll") for (int i = 0; i < 2; ++i) { stage_rc(tid * 16 + i * 8192, R[i], C[i]); const int Rb = Epi::PERM ? ((R[i] & ~31) + perm32(R[i] & 31)) : R[i]; voffB[i] = (unsigned)(Rb * K + C[i]) * 2u; }
  const size_t kstep = (size_t)(BK * 2), hstep = (size_t)HALF * K * 2;
  const unsigned ldsw = (unsigned)wid * 1024u;
  const int aoff = lds_byte(wr * 64 + fr, fq * 8), boff = lds_byte(wc * 32 + fr, fq * 8);
#define G8_SA(b, h) (((b) * 2 + (h)) * HTB)
#define G8_SB(b, h) ((4 + (b) * 2 + (h)) * HTB)
#define G8_STAGE(bufoff, gbase, voff) do { _Pragma("unroll") for (int _i = 0; _i < 2; ++_i) \
    __builtin_amdgcn_global_load_lds((const unsigned*)((const char*)(gbase) + (voff)[_i]), (lds_u32*)(lds + (bufoff) + ldsw + _i * 8192), 16, 0, 0); } while (0)
#define G8_LDA(dst, b, h) do { _Pragma("unroll") for (int m = 0; m < 4; ++m) _Pragma("unroll") for (int k = 0; k < 2; ++k) dst[m][k] = *(const __attribute__((address_space(3))) bf16x8*)(lds + G8_SA(b, h) + aoff + m * 2048 + k * 1024); } while (0)
#define G8_LDB(dst, b, h) do { _Pragma("unroll") for (int n = 0; n < 2; ++n) _Pragma("unroll") for (int k = 0; k < 2; ++k) dst[n][k] = *(const __attribute__((address_space(3))) bf16x8*)(lds + G8_SB(b, h) + boff + n * 2048 + k * 1024); } while (0)
#define G8_MMA(ai, bj, At, Bt) do { __builtin_amdgcn_s_setprio(1); _Pragma("unroll") for (int m = 0; m < 4; ++m) _Pragma("unroll") for (int n = 0; n < 2; ++n) _Pragma("unroll") for (int k = 0; k < 2; ++k) \
    acc[ai][bj][m][n] = __builtin_amdgcn_mfma_f32_16x16x32_bf16(Bt[n][k], At[m][k], acc[ai][bj][m][n], 0, 0, 0); __builtin_amdgcn_s_setprio(0); } while (0)
#define G8_WAIT_V(n) asm volatile("s_waitcnt vmcnt(" #n ")" ::: "memory")
#define G8_WAIT_L(n) asm volatile("s_waitcnt lgkmcnt(" #n ")" ::: "memory")
#define G8_BAR __builtin_amdgcn_s_barrier()
#define G8_SCHED __builtin_amdgcn_sched_barrier(0)
  Unit cur, nxt; int ui = 0;
  if (!S.next(0, cur)) return;
  f32x4 acc[2][2][4][2];
  _Pragma("unroll") for (int a = 0; a < 2; ++a) _Pragma("unroll") for (int b = 0; b < 2; ++b) _Pragma("unroll") for (int m = 0; m < 4; ++m) _Pragma("unroll") for (int n = 0; n < 2; ++n) acc[a][b][m][n] = (f32x4){0.f, 0.f, 0.f, 0.f};
  bf16x8 At[4][2], B0[2][2], B1[2][2];
  constexpr bool GA = Sched::GATHER;
  unsigned voffA[2]; unsigned cpk[2], npk[2];
  _Pragma("unroll") for (int i = 0; i < 2; ++i) voffA[i] = (unsigned)(R[i] * K + C[i]) * 2u;
  const unsigned gc2 = (unsigned)C[0] * 2u, gk2 = (unsigned)K * 2u;
  if (GA) S.arows(cur, R[0], cpk);
#define G8_STAGE_G(bufoff, base, pk) do { const unsigned _v[2] = { ((pk) & 0xffffu) * gk2 + gc2, ((pk) >> 16) * gk2 + gc2 }; G8_STAGE(bufoff, base, _v); } while (0)
#define G8_STAGE_A(bufoff, base, h, nx) do { if (GA) { if (nx) G8_STAGE_G(bufoff, base, npk[h]); else G8_STAGE_G(bufoff, base, cpk[h]); } else G8_STAGE(bufoff, (base) + (h) * hstep, voffA); } while (0)
  const char* cA = cur.a; const char* cB = cur.b;
  G8_STAGE(G8_SB(0, 0), cB, voffB); G8_STAGE_A(G8_SA(0, 0), cA, 0, false); G8_STAGE(G8_SB(0, 1), cB + hstep, voffB); G8_STAGE_A(G8_SA(0, 1), cA, 1, false);
  if (wr == 1) G8_BAR;
  G8_WAIT_V(4); G8_BAR;
  G8_STAGE(G8_SB(1, 0), cB + kstep, voffB); G8_STAGE_A(G8_SA(1, 0), cA + kstep, 0, false); G8_STAGE(G8_SB(1, 1), cB + hstep + kstep, voffB);
  G8_WAIT_V(6); G8_BAR;
  for (;;) {
    const bool has_next = S.next(ui + 1, nxt);
    const char* nA = has_next ? nxt.a : cA; const char* nB = has_next ? nxt.b : cB;
    if (GA) { if (has_next) S.arows(nxt, R[0], npk); else { npk[0] = cpk[0]; npk[1] = cpk[1]; } }
    for (int t = 0; t < nt; t += 2) {
      const bool last = (t == nt - 2);
      const char* a1 = cA + (size_t)(t + 1) * kstep;
      const char* a2 = last ? nA : cA + (size_t)(t + 2) * kstep; const char* b2 = last ? nB : cB + (size_t)(t + 2) * kstep;
      const char* a3 = a2 + kstep; const char* b3 = b2 + kstep;
      G8_LDB(B0, 0, 0); G8_SCHED; G8_LDA(At, 0, 0); G8_STAGE_A(G8_SA(1, 1), a1, 1, false);
      G8_WAIT_L(8); G8_BAR; G8_WAIT_L(0); G8_MMA(0, 0, At, B0); G8_BAR; G8_SCHED;
      G8_LDB(B1, 0, 1); G8_STAGE(G8_SB(0, 0), b2, voffB);
      G8_BAR; G8_WAIT_L(0); G8_MMA(0, 1, At, B1); G8_BAR;
      G8_LDA(At, 0, 1); G8_STAGE_A(G8_SA(0, 0), a2, 0, last);
      G8_BAR; G8_WAIT_L(0); G8_MMA(1, 0, At, B0); G8_BAR; G8_SCHED;
      G8_STAGE(G8_SB(0, 1), b2 + hstep, voffB);
      G8_WAIT_V(6); G8_BAR; G8_MMA(1, 1, At, B1); G8_BAR;
      G8_LDB(B0, 1, 0); G8_SCHED; G8_LDA(At, 1, 0); G8_STAGE_A(G8_SA(0, 1), a2, 1, last);
      G8_WAIT_L(8); G8_BAR; G8_WAIT_L(0); G8_MMA(0, 0, At, B0); G8_BAR; G8_SCHED;
      G8_LDB(B1, 1, 1); G8_STAGE(G8_SB(1, 0), b3, voffB);
      G8_BAR; G8_WAIT_L(0); G8_MMA(0, 1, At, B1); G8_BAR;
      G8_LDA(At, 1, 1); G8_STAGE_A(G8_SA(1, 0), a3, 0, last);
      G8_BAR; G8_WAIT_L(0); G8_MMA(1, 0, At, B0); G8_BAR; G8_SCHED;
      G8_STAGE(G8_SB(1, 1), b3 + hstep, voffB);
      G8_WAIT_V(6); G8_BAR; G8_MMA(1, 1, At, B1); G8_BAR;
    }
    E(acc, cur, wr, wc, fr, fq);
    if (!has_next) break;
    if (!E.keep(cur)) { _Pragma("unroll") for (int a = 0; a < 2; ++a) _Pragma("unroll") for (int b = 0; b < 2; ++b) _Pragma("unroll") for (int m = 0; m < 4; ++m) _Pragma("unroll") for (int n = 0; n < 2; ++n) acc[a][b][m][n] = (f32x4){0.f, 0.f, 0.f, 0.f}; }
    cur = nxt; cA = nA; cB = nB; ++ui;
    if (GA) { cpk[0] = npk[0]; cpk[1] = npk[1]; }
  }
  G8_WAIT_V(0);
  if (wr == 0) G8_BAR;
  G8_BAR;
#undef G8_SA
#undef G8_SB
#undef G8_STAGE
#undef G8_STAGE_A
#undef G8_STAGE_G
#undef G8_LDA
#undef G8_LDB
#undef G8_MMA
#undef G8_WAIT_V
#undef G8_WAIT_L
#undef G8_BAR
#undef G8_SCHED
}
DI void grid_lin(int wgid, int nM, int nN, int& pm, int& pn) {
  const int nwg = nM * nN;
  { const int q = nwg / 8, r = nwg % 8, xcd = wgid % 8, off = wgid / 8; wgid = (xcd < r ? xcd * (q + 1) : r * (q + 1) + (xcd - r) * q) + off; }
  const int nig = 8 * nN, gid = wgid / nig, fm = gid * 8, gsz = (nM - fm) < 8 ? (nM - fm) : 8;
  pm = fm + ((wgid % nig) % gsz); pn = (wgid % nig) / gsz;
}
DI bool grid_unit(int i, int G, int c, int nM, int nN, int& pm, int& pn) {
  const int nwg = nM * nN; const long Lq = (long)i * G + c; if (Lq >= nwg) return false;
  int wgid = (int)Lq; { const int q = nwg / 8, r = nwg % 8, xcd = wgid % 8, off = wgid / 8; wgid = (xcd < r ? xcd * (q + 1) : r * (q + 1) + (xcd - r) * q) + off; }
  const int nig = 8 * nN, gid = wgid / nig, fm = gid * 8, gsz = (nM - fm) < 8 ? (nM - fm) : 8;
  pm = fm + ((wgid % nig) % gsz); pn = (wgid % nig) / gsz; return true;
}
}

DI int ropep(int x) { const int d = x & 63; return (x & ~63) + 8 * ((d & 31) >> 2) + 4 * (d >> 5) + (d & 3); }
DI int wmap(int mode, int n) {
  if (mode == 1) {
    if (n < 512) return ropep(n);
    if (n < 1024) return 512 + ropep(n - 512);
    if (n < 1536) return 6400 + (n - 1024);
    if (n < 2048) return 1024 + ropep(n - 1536);
    if (n < 2176) return 1536 + ropep(n - 2048);
    if (n < 2304) return 6400 + 512 + (n - 2176);
    if (n < 2816) return 1664 + (n - 2304);
    if (n < 3328) return 2176 + (n - 2816);
    if (n < 3840) return 6400 + 640 + (n - 3328);
    if (n < 4352) return 2688 + (n - 3840);
    if (n < 4368) return 6272 + (n - 4352);
    return 3200 + (n - 4368);
  }
  if (mode == 2) return 8 * (n >> 2) + (n & 3);
  if (mode == 3) return 8 * (n >> 2) + 4 + (n & 3);
  return n;
}
struct CvJob { const float* src; bf16_t* dst; int K, N, mode, tk, tn; };
DI void cv_load(const CvJob& j, int tid, f32x4 (&v)[4]) {
  const int kk = tid >> 4, c4 = tid & 15, n = j.tn * 64 + 4 * c4;
  _Pragma("unroll") for (int i = 0; i < 4; ++i) {
    v[i] = mk4(0.f, 0.f, 0.f, 0.f);
    if (n < j.N) v[i] = *(const f32x4*)(j.src + (size_t)(j.tk * 64 + kk + 16 * i) * j.N + n);
  }
}
DI void cv_finish(const CvJob& j, int tid, const f32x4 (&v)[4], char* smem, int par) {
  bf16_t* sT = (bf16_t*)(smem + par * 9216);
  const int kk = tid >> 4, c4 = tid & 15;
  _Pragma("unroll") for (int i = 0; i < 4; ++i) {
    const int k = kk + 16 * i;
    sT[(4 * c4 + 0) * 72 + k] = f2bf(v[i].x); sT[(4 * c4 + 1) * 72 + k] = f2bf(v[i].y);
    sT[(4 * c4 + 2) * 72 + k] = f2bf(v[i].z); sT[(4 * c4 + 3) * 72 + k] = f2bf(v[i].w);
  }
  __syncthreads();
  const int nn = tid >> 2, kc = tid & 3;
  const int ng = j.tn * 64 + nn;
  if (ng < j.N) {
    const u32x4 v0 = *(const u32x4*)(sT + nn * 72 + 16 * kc);
    const u32x4 v1 = *(const u32x4*)(sT + nn * 72 + 16 * kc + 8);
    bf16_t* d = j.dst + (size_t)wmap(j.mode, ng) * j.K + j.tk * 64 + 16 * kc;
    *(u32x4*)d = v0; *(u32x4*)(d + 8) = v1;
  }
}

constexpr int WS_TILES_IN = 16 * 117, WS_TILES_BR = 3 * 8 * 16, WS_TILES_OUT = 16 * 16;
constexpr int WS_TILES = WS_TILES_IN + WS_TILES_BR + WS_TILES_OUT;
DI CvJob ws_job(const Params& P, int l, int it) {
  CvJob j;
  if (it < WS_TILES_IN) { j.src = P.w_in + (size_t)l * D * DIN; j.K = D; j.N = DIN; j.dst = P.w_in_t; j.mode = 1; j.tk = it / 117; j.tn = it % 117; }
  else if (it < WS_TILES_IN + WS_TILES_BR) {
    const int q = it - WS_TILES_IN, i = q / 128, r = q % 128;
    j.src = P.w_branch + ((size_t)l * 3 + i) * 512 * 1024; j.K = 512; j.N = 1024; j.dst = P.w_br_t + (size_t)i * 1024 * 512; j.mode = 0; j.tk = r / 16; j.tn = r % 16;
  } else {
    const int q = it - WS_TILES_IN - WS_TILES_BR;
    j.src = P.w_out + (size_t)l * D * D; j.K = D; j.N = D; j.dst = P.w_out_t; j.mode = 0; j.tk = q / 16; j.tn = q % 16;
  }
  return j;
}
DI void phase_wconv_small(const Params& P, int l, char* smem, int bid, int nblk) {
  const int tid = otid();
  if (bid >= WS_TILES) return;
  CvJob j = ws_job(P, l, bid); f32x4 v[4];
  cv_load(j, tid, v);
  int par = 0;
  __syncthreads();
  for (int it = bid; it < WS_TILES; it += nblk) {
    CvJob jn = j; f32x4 vn[4];
    _Pragma("unroll") for (int i = 0; i < 4; ++i) vn[i] = v[i];
    if (it + nblk < WS_TILES) { jn = ws_job(P, l, it + nblk); cv_load(jn, tid, vn); }
    cv_finish(j, tid, v, smem, par); par ^= 1;
    j = jn;
    _Pragma("unroll") for (int i = 0; i < 4; ++i) v[i] = vn[i];
  }
}
constexpr int WE_TILES = NEXP * 384;
DI CvJob we_job(const Params& P, int l, int it) {
  const int e = it / 384, q = it % 384, which = q / 128, r = q % 128;
  const size_t eo = (size_t)l * NEXP + e;
  CvJob j;
  if (which == 0) { j.src = P.w_gate + eo * 1024 * 512; j.K = 1024; j.N = 512; j.dst = P.w_gu_t + (size_t)e * 1024 * 1024; j.mode = 2; j.tk = r / 8; j.tn = r % 8; }
  else if (which == 1) { j.src = P.w_up + eo * 1024 * 512; j.K = 1024; j.N = 512; j.dst = P.w_gu_t + (size_t)e * 1024 * 1024; j.mode = 3; j.tk = r / 8; j.tn = r % 8; }
  else { j.src = P.w_down + eo * 512 * 1024; j.K = 512; j.N = 1024; j.dst = P.w_dn_t + (size_t)e * 1024 * 512; j.mode = 0; j.tk = r / 16; j.tn = r % 16; }
  return j;
}
DI void phase_wconv_experts(const Params& P, int l, char* smem, int half, volatile __attribute__((address_space(3))) int* wgslot) {
  unsigned* ctr = P.ctl + (l * 8 + 6) * 16;
  const int tid = otid();
  for (;;) {
    __syncthreads();
    if (rtid() == 0) wgslot[0] = (int)__hip_atomic_fetch_add(ctr, 2u, __ATOMIC_RELAXED, __HIP_MEMORY_SCOPE_AGENT);
    __syncthreads();
    constexpr int WE_BIG = (WE_TILES * 3 / 4) / 8;
    const int cid = wgslot[0] + half;
    const int c0 = cid < WE_BIG ? cid * 8 : WE_BIG * 8 + (cid - WE_BIG) * 2, cn = cid < WE_BIG ? 8 : 2;
    if (c0 >= WE_TILES) break;
    CvJob j = we_job(P, l, c0); f32x4 v[4];
    cv_load(j, tid, v);
    for (int it = c0; it < c0 + cn; ++it) {
      CvJob jn = j; f32x4 vn[4];
      _Pragma("unroll") for (int i = 0; i < 4; ++i) vn[i] = v[i];
      if (it + 1 < c0 + cn) { jn = we_job(P, l, it + 1); cv_load(jn, tid, vn); }
      cv_finish(j, tid, v, smem, it & 1);
      j = jn;
      _Pragma("unroll") for (int i = 0; i < 4; ++i) v[i] = vn[i];
    }
  }
}

DI void ln16(f32x4 (&v)[4], const float* g, const float* b, int lane) {
  float s = 0.f;
  _Pragma("unroll") for (int i = 0; i < 4; ++i) s += v[i].x + v[i].y + v[i].z + v[i].w;
  const float mu = wave_sum(s) * (1.f / 1024.f);
  float q = 0.f;
  _Pragma("unroll") for (int i = 0; i < 4; ++i) { v[i].x -= mu; v[i].y -= mu; v[i].z -= mu; v[i].w -= mu; q += v[i].x * v[i].x + v[i].y * v[i].y + v[i].z * v[i].z + v[i].w * v[i].w; }
  const float rs = rsqrtf(wave_sum(q) * (1.f / 1024.f) + LN_EPS);
  _Pragma("unroll") for (int i = 0; i < 4; ++i) {
    const f32x4 gg = ((const f32x4*)g)[lane + 64 * i], bb = ((const f32x4*)b)[lane + 64 * i];
    v[i].x = v[i].x * rs * gg.x + bb.x; v[i].y = v[i].y * rs * gg.y + bb.y; v[i].z = v[i].z * rs * gg.z + bb.z; v[i].w = v[i].w * rs * gg.w + bb.w;
  }
}
DI void store_row(const f32x4 (&v)[4], float* hf, bf16_t* hbf, int lane) {
  _Pragma("unroll") for (int i = 0; i < 4; ++i) {
    if (hf) ((f32x4*)hf)[lane + 64 * i] = v[i];
    if (hbf) { u32x2 u; u.x = pk2(v[i].x, v[i].y); u.y = pk2(v[i].z, v[i].w); ((u32x2*)hbf)[lane + 64 * i] = u; }
  }
}

DI void prologue_tables(const Params& P, int bid, int nblk) {
  const int tid = otid(), gtid = bid * NT + tid, gn = nblk * NT;
  for (int i = gtid; i < L * 32; i += gn) {
    const int pos = i >> 5, f = i & 31;
    const float e = (float)(2 * f) / 64.0f;
    const float inv = 1.0f / powf(10000.0f, e);
    const float ang = (float)pos * inv;
    P.cs[i] = mk2(cosf(ang), sinf(ang));
  }
  if (gtid < 2) {
    const int l = gtid;
    float s1 = 0.f, s2 = 0.f;
    for (int i = 0; i < 64; ++i) { s1 += P.lam_q1[l * 64 + i] * P.lam_k1[l * 64 + i]; s2 += P.lam_q2[l * 64 + i] * P.lam_k2[l * 64 + i]; }
    const float li = (float)(0.8 - 0.6 * exp(-0.3 * (double)l));
    P.lam[l] = expf(s1) - expf(s2) + li;
    P.lam[2 + l] = (float)(1.0 - (0.8 - 0.6 * exp(-0.3 * (double)l)));
  }
}
DI void prologue_rows(const Params& P, int bid, int nblk) {
  const int tid = otid();
  const int lane = tid & 63, wv = (bid * NT + tid) >> 6, nwv = (nblk * NT) >> 6;
  for (int t = wv; t < T; t += nwv) {
    const int b = t >= L ? 1 : 0, pos = t - b * L;
    const float* src = pos < NMETA ? P.meta + (size_t)pos * D : P.x + ((size_t)b * SEQ + (pos - NMETA)) * D;
    f32x4 v[4];
    _Pragma("unroll") for (int i = 0; i < 4; ++i) v[i] = ((const f32x4*)src)[lane + 64 * i];
    ln16(v, P.ln_in_g, P.ln_in_b, lane);
    store_row(v, P.h + (size_t)t * D, P.hb + (size_t)t * D, lane);
  }
}
DI void phase_prologue(const Params& P, int bid, int nblk) {
  if (bid & 1) { prologue_rows(P, bid, nblk); prologue_tables(P, bid, nblk); }
  else { prologue_tables(P, bid, nblk); prologue_rows(P, bid, nblk); }
}

DI void phase_zero_pads(const Params& P, int bid, int nblk) {
  const int gtid = bid * NT + otid(), gn = nblk * NT;
  for (int i = gtid; i < 8 * 128 * (LK - L); i += gn) { const int r = i / (LK - L), cidx = i % (LK - L); P.vaT[(size_t)r * LK + L + cidx] = 0; }
  for (int i = gtid; i < 4 * 64 * (LK - L); i += gn) { const int r = i / (LK - L), cidx = i % (LK - L); P.vbT[(size_t)r * LK + L + cidx] = 0; }
  for (int i = gtid; i < 8 * 128 * MPAD; i += gn) { const int r = i / MPAD, cidx = i % MPAD; P.cvT[(size_t)r * LPAD + cidx] = 0; }
  for (int i = gtid; i < 8 * MPAD * 128; i += gn) { const int bh = i / (MPAD * 128), r = i % (MPAD * 128); P.qc[(size_t)bh * LPAD * 128 + r] = 0; P.kc[(size_t)bh * LPAD * 128 + r] = 0; }
  if (gtid < NEXP) P.counts[gtid * CSTR] = 0;
}

#define WT_FENCE() asm volatile("s_waitcnt lgkmcnt(0)" ::: "memory")
DI float logsigmoidf_(float x) { return fminf(x, 0.f) - log1pf(__expf(-fabsf(x))); }
DI void phase_mprep(const Params& P, int l, char* smem, int bid, int nblk) {
  const int tid = otid();
  float* sli = (float*)smem;
  float* slf = sli + 256;
  float* sb = slf + 256;
  float* sw = sb + 256;
  float* sred = sw + 256;
  float* sst = sred + 16 * 256;
  for (int it = bid; it < 8 * NCH; it += nblk) {
    const int bh = it < 8 * (NCH - 1) ? it / (NCH - 1) : it - 8 * (NCH - 1), n = it < 8 * (NCH - 1) ? 1 + it % (NCH - 1) : 0, b = bh >> 2, hh = bh & 3;
    __syncthreads();
    if (tid < 128) {
      const int p = 128 * n + tid, pos = p - MPAD;
      float lif = NEGF, lff = 0.f, lib = NEGF, lfb = 0.f;
      if (pos >= 0) {
        const float* g = P.cg + (size_t)(b * L + pos) * 16;
        const float* gb = P.gate_b + l * 16;
        lif = g[0 + hh] + gb[0 + hh]; lff = logsigmoidf_(g[4 + hh] + gb[4 + hh]);
        lib = g[8 + hh] + gb[8 + hh]; lfb = logsigmoidf_(g[12 + hh] + gb[12 + hh]);
      }
      sli[tid] = lif; sli[128 + tid] = lib; slf[tid] = lff; slf[128 + tid] = lfb;
    }
    __syncthreads();
    if (tid < 128) {
      const int t2 = otid(), wd = t2 >> 6, ln = t2 & 63;
      const int i0 = wd == 0 ? 2 * ln : 127 - 2 * ln, i1 = wd == 0 ? 2 * ln + 1 : 126 - 2 * ln;
      const float e0 = slf[wd * 128 + i0], e1 = slf[wd * 128 + i1];
      float scan = e0 + e1;
      _Pragma("unroll") for (int d = 1; d < 64; d <<= 1) { const float tt = shfl_up_f(scan, d, ln); if (ln >= d) scan += tt; }
      float excl = shfl_up_f(scan, 1, ln); if (ln == 0) excl = 0.f;
      sb[wd * 128 + i0] = excl + e0; sb[wd * 128 + i1] = excl + e0 + e1;
    }
    __syncthreads();
    if (tid < 128) {
      const int dir = tid >> 6, lane = tid & 63;
      const float g = dir == 0 ? sb[127] : sb[128];
      const float a0 = g - sb[dir * 128 + lane] + sli[dir * 128 + lane];
      const float a1 = g - sb[dir * 128 + lane + 64] + sli[dir * 128 + lane + 64];
      const float am = wave_max(fmaxf(a0, a1));
      const float w0 = __expf(a0 - am), w1 = __expf(a1 - am);
      sw[dir * 128 + lane] = w0; sw[dir * 128 + lane + 64] = w1;
      const size_t base = ((size_t)dir * 8 + bh) * LPAD + 128 * n;
      P.wgt[base + lane] = w0; P.wgt[base + lane + 64] = w1;
      P.bcum[base + lane] = sb[dir * 128 + lane]; P.bcum[base + lane + 64] = sb[dir * 128 + lane + 64];
      P.ligate[base + lane] = sli[dir * 128 + lane]; P.ligate[base + lane + 64] = sli[dir * 128 + lane + 64];
      if (lane == 0) { float* ms = P.mstat + ((size_t)(dir * 8 + bh) * NCH + n) * 4; ms[0] = g; ms[1] = am; }
    }
    __syncthreads();
    bf16_t* skT = (bf16_t*)(smem + 32768);
    if (n == 0) { for (int i = tid; i < 128 * MPAD; i += NT) skT[(i / MPAD) * 136 + (i % MPAD)] = 0; }
    const int tid3 = otid();
    const int dg = tid3 & 15, tl = tid3 >> 4;
    float nf[8], nbk[8];
    _Pragma("unroll") for (int j = 0; j < 8; ++j) { nf[j] = 0.f; nbk[j] = 0.f; }
    const int ch = hh * 128 + dg * 8;
    float cw[2][3][8], cb[2][8];
    _Pragma("unroll") for (int j = 0; j < 8; ++j) {
      _Pragma("unroll") for (int ww = 0; ww < 3; ++ww) { cw[0][ww][j] = P.conv_w[((size_t)l * 3 + ww) * 1024 + ch + j]; cw[1][ww][j] = P.conv_w[((size_t)l * 3 + ww) * 1024 + 512 + ch + j]; }
      cb[0][j] = P.conv_b[l * 1024 + ch + j]; cb[1][j] = P.conv_b[l * 1024 + 512 + ch + j];
    }
    _Pragma("unroll 1") for (int hb4 = 0; hb4 < 8; hb4 += 4) {
      u32x4 uq[4][3], uk[4][3];
      _Pragma("unroll") for (int i4 = 0; i4 < 4; ++i4) {
        const int pos = 128 * n + tl + 16 * (hb4 + i4) - MPAD;
        _Pragma("unroll") for (int ww = 0; ww < 3; ++ww) {
          const int pp = min(max(pos + ww - 1, 0), L - 1);
          uq[i4][ww] = *(const u32x4*)(P.cq + (size_t)(b * L + pp) * 512 + ch);
          uk[i4][ww] = *(const u32x4*)(P.ck + (size_t)(b * L + pp) * 512 + ch);
        }
      }
      __builtin_amdgcn_sched_barrier(0);
      _Pragma("unroll") for (int i4 = 0; i4 < 4; ++i4) {
        const int tau = tl + 16 * (hb4 + i4), p = 128 * n + tau, pos = p - MPAD;
        float q[8], k[8];
        _Pragma("unroll") for (int j = 0; j < 8; ++j) { q[j] = cb[0][j]; k[j] = cb[1][j]; }
        _Pragma("unroll") for (int ww = 0; ww < 3; ++ww) {
          const int pp = pos + ww - 1;
          const float vm = (pp >= 0 && pp < L) ? 1.f : 0.f;
          const unsigned aq[4] = {uq[i4][ww].x, uq[i4][ww].y, uq[i4][ww].z, uq[i4][ww].w}, ak[4] = {uk[i4][ww].x, uk[i4][ww].y, uk[i4][ww].z, uk[i4][ww].w};
          _Pragma("unroll") for (int j = 0; j < 4; ++j) {
            q[2 * j] += bflo(aq[j]) * (cw[0][ww][2 * j] * vm); q[2 * j + 1] += bfhi(aq[j]) * (cw[0][ww][2 * j + 1] * vm);
            k[2 * j] += bflo(ak[j]) * (cw[1][ww][2 * j] * vm); k[2 * j + 1] += bfhi(ak[j]) * (cw[1][ww][2 * j + 1] * vm);
          }
        }
        const float wf = sw[tau], wb = sw[128 + tau];
        _Pragma("unroll") for (int j = 0; j < 8; ++j) {
          q[j] = q[j] * sigmoidf_(q[j]);
          k[j] = k[j] * sigmoidf_(k[j]) * 0.08838834764831845f;
          nf[j] += wf * k[j]; nbk[j] += wb * k[j];
        }
        if (pos >= 0) {
          u32x4 oq, ok;
          oq.x = pk2(q[0], q[1]); oq.y = pk2(q[2], q[3]); oq.z = pk2(q[4], q[5]); oq.w = pk2(q[6], q[7]);
          ok.x = pk2(k[0], k[1]); ok.y = pk2(k[2], k[3]); ok.z = pk2(k[4], k[5]); ok.w = pk2(k[6], k[7]);
          *(u32x4*)(P.qc + ((size_t)bh * LPAD + p) * 128 + dg * 8) = oq;
          *(u32x4*)(P.kc + ((size_t)bh * LPAD + p) * 128 + dg * 8) = ok;
          _Pragma("unroll") for (int j = 0; j < 8; ++j) skT[(dg * 8 + j) * 136 + tau] = f2bf(k[j]);
        }
      }
    }
    _Pragma("unroll") for (int j = 0; j < 8; ++j) { sred[tl * 256 + dg * 8 + j] = nf[j]; sred[tl * 256 + 128 + dg * 8 + j] = nbk[j]; }
    __syncthreads();
    {
      const int tid2 = otid();
      const int lane = tid2 & 63, w = tid2 >> 6, wi = w >> 1, wj = w & 1, lr = lane & 31, lh = lane >> 5;
      unsigned vo = (unsigned)((bh * 128 + 64 * wi + lr) * LPAD + 128 * n + 8 * lh);
      asm volatile("" : "+v"(vo));
      _Pragma("unroll 1") for (int dir = 0; dir < 2; ++dir) {
        f32x16 acc[2][2];
        _Pragma("unroll") for (int i = 0; i < 2; ++i) _Pragma("unroll") for (int j = 0; j < 2; ++j) acc[i][j] = zero16();
        unsigned koff = (unsigned)((64 * wj + lr) * 136 + 8 * lh);
        asm volatile("" : "+v"(koff));
        _Pragma("unroll") for (int ks = 0; ks < 8; ++ks) {
          if (n == 0 && ks < 7) continue;
          const int tau = 16 * ks + 8 * lh;
          const f32x4 w0 = *(const f32x4*)(sw + dir * 128 + tau), w1 = *(const f32x4*)(sw + dir * 128 + tau + 4);
          bf16x8 bq[2];
          _Pragma("unroll") for (int i = 0; i < 2; ++i) {
            const u32x4 kr = *(const u32x4*)(skT + koff + (32 * i) * 136 + 16 * ks);
            union { unsigned u[4]; bf16x8 v; } tt;
            tt.u[0] = pk2(bflo(kr.x) * w0.x, bfhi(kr.x) * w0.y); tt.u[1] = pk2(bflo(kr.y) * w0.z, bfhi(kr.y) * w0.w);
            tt.u[2] = pk2(bflo(kr.z) * w1.x, bfhi(kr.z) * w1.y); tt.u[3] = pk2(bflo(kr.w) * w1.z, bfhi(kr.w) * w1.w);
            bq[i] = tt.v;
          }
          bf16x8 af[2];
          _Pragma("unroll") for (int i = 0; i < 2; ++i) af[i] = ldfrag(P.cvT + vo + (unsigned)(32 * i) * LPAD + 16 * ks);
          _Pragma("unroll") for (int i = 0; i < 2; ++i) _Pragma("unroll") for (int j = 0; j < 2; ++j) acc[i][j] = MFMA32(af[i], bq[j], acc[i][j]);
        }
        float* U = P.U + ((size_t)(dir * 8 + bh) * NCH + n) * 16384;
        _Pragma("unroll") for (int i = 0; i < 2; ++i) _Pragma("unroll") for (int j = 0; j < 2; ++j) _Pragma("unroll") for (int r = 0; r < 16; ++r)
          U[(64 * wi + 32 * i + crow(r, lh)) * 128 + 64 * wj + 32 * j + lr] = acc[i][j][r];
      }
    }
    {
      float s = 0.f;
      _Pragma("unroll") for (int i = 0; i < 16; ++i) s += sred[i * 256 + tid];
      const int dir = tid >> 7, dk = tid & 127;
      P.nvec[((size_t)(dir * 8 + bh) * NCH + n) * 128 + dk] = s;
    }
  }
}

DI void phase_mscan(const Params& P, int bid, int nblk) {
  for (int gt = bid * NT + otid(); gt < 16 * 4096 + 256; gt += nblk * NT) {
    if (gt < 16 * 4096) {
      const int seq = gt >> 12, e = gt & 4095, dir = seq >> 3;
      float C[4] = {0.f, 0.f, 0.f, 0.f};
      float m = 0.f;
      _Pragma("unroll") for (int hb = 0; hb < 3; ++hb) {
        constexpr int SBm = 22;
        const int sb = hb * SBm, cnt = hb < 2 ? SBm : NCH - 2 * SBm;
        f32x4 u0[SBm]; float gg[SBm], aa[SBm];
        _Pragma("unroll") for (int k = 0; k < SBm; ++k) if (k < cnt) {
          const int n = dir == 0 ? sb + k : NCH - 1 - sb - k;
          const size_t item = (size_t)seq * NCH + n;
          u0[k] = *(const f32x4*)(P.U + item * 16384 + e * 4);
          gg[k] = P.mstat[item * 4]; aa[k] = P.mstat[item * 4 + 1];
        }
        asm volatile("s_waitcnt vmcnt(0)" ::: "memory");
        _Pragma("unroll") for (int k = 0; k < SBm; ++k) if (k < cnt) {
          const int n = dir == 0 ? sb + k : NCH - 1 - sb - k;
          const size_t item = (size_t)seq * NCH + n;
          const float mn = fmaxf(gg[k] + m, aa[k]);
          const float decay = __expf(gg[k] + m - mn), f = __expf(aa[k] - mn);
          u32x2 cb; cb.x = pk2(C[0], C[1]); cb.y = pk2(C[2], C[3]);
          *(u32x2*)((char*)(P.U + item * 16384) + (size_t)(e >> 1) * 32 + (e & 1) * 8) = cb;
          C[0] = decay * C[0] + f * u0[k].x; C[1] = decay * C[1] + f * u0[k].y; C[2] = decay * C[2] + f * u0[k].z; C[3] = decay * C[3] + f * u0[k].w;
          m = mn;
        }
      }
    } else {
      constexpr int SB = 13;
      const int q = gt - 16 * 4096, seq = q >> 4, e = q & 15, dir = seq >> 3;
      float nst[8];
      _Pragma("unroll") for (int j = 0; j < 8; ++j) nst[j] = 0.f;
      float m = 0.f;
      for (int sb = 0; sb < NCH; sb += SB) {
        f32x4 n0[SB], n1[SB]; float gg[SB], aa[SB];
        _Pragma("unroll") for (int k = 0; k < SB; ++k) {
          const int n = dir == 0 ? sb + k : NCH - 1 - sb - k;
          const size_t item = (size_t)seq * NCH + n;
          const float* np = P.nvec + item * 128 + e * 8;
          n0[k] = *(const f32x4*)np; n1[k] = *(const f32x4*)(np + 4);
          gg[k] = P.mstat[item * 4]; aa[k] = P.mstat[item * 4 + 1];
        }
        _Pragma("unroll") for (int k = 0; k < SB; ++k) {
          const int n = dir == 0 ? sb + k : NCH - 1 - sb - k;
          const size_t item = (size_t)seq * NCH + n;
          const float mn = fmaxf(gg[k] + m, aa[k]);
          const float decay = __expf(gg[k] + m - mn), f = __expf(aa[k] - mn);
          float* np = P.nvec + item * 128 + e * 8;
          *(f32x4*)np = mk4(nst[0], nst[1], nst[2], nst[3]); *(f32x4*)(np + 4) = mk4(nst[4], nst[5], nst[6], nst[7]);
          nst[0] = decay * nst[0] + f * n0[k].x; nst[1] = decay * nst[1] + f * n0[k].y; nst[2] = decay * nst[2] + f * n0[k].z; nst[3] = decay * nst[3] + f * n0[k].w;
          nst[4] = decay * nst[4] + f * n1[k].x; nst[5] = decay * nst[5] + f * n1[k].y; nst[6] = decay * nst[6] + f * n1[k].z; nst[7] = decay * nst[7] + f * n1[k].w;
          if (e == 0) P.mstat[item * 4 + 2] = m;
          m = mn;
        }
      }
    }
  }
}
DI void mout_item(const Params& P, int l, int it, char* smem) {
  const int tid = otid(), lane = tid & 63, w = tid >> 6, lr = lane & 31, lh = lane >> 5;
  const int bh = it / NCH, n = it % NCH, b = bh >> 2, hh = bh & 3;
  char* sK = smem;
  char* sV = smem + 32768;
  float* sb = (float*)(smem + 65536);
  float* sc = sb + 256;
  float* spm = sc + 256;
  float* snp = spm + 256;
  {
    const int rin = lane >> 4, cpos = lane & 15;
    _Pragma("unroll") for (int i = 0; i < 16; ++i) {
      const int dir = i >> 3, R = (i & 7) * 4 + w, row = 4 * R + rin;
      const char* src = (const char*)(P.U + ((size_t)(dir * 8 + bh) * NCH + n) * 16384) + (size_t)row * 512 + (cpos ^ (row & 15)) * 32;
      __builtin_amdgcn_global_load_lds((const unsigned*)src, (lds_u32*)(smem + dir * 32768 + R * 1024), 16, 0, 0);
    }
  }
  {
    const int dir = tid >> 7, tau = tid & 127;
    const size_t base = ((size_t)dir * 8 + bh) * LPAD + 128 * n + tau;
    const float bb = P.bcum[base], li = P.ligate[base];
    sb[tid] = bb; sc[tid] = li - bb;
    snp[tid] = P.nvec[((size_t)(dir * 8 + bh) * NCH + n) * 128 + tau];
  }
  __syncthreads();
  if (w < 2) {
    const int i0 = w == 0 ? 2 * lane : 127 - 2 * lane, i1 = w == 0 ? 2 * lane + 1 : 126 - 2 * lane;
    const float e0 = sc[w * 128 + i0], e1 = sc[w * 128 + i1];
    const float p1 = fmaxf(e0, e1);
    float scan = p1;
    _Pragma("unroll") for (int d = 1; d < 64; d <<= 1) { const float tt = shfl_up_f(scan, d, lane); if (lane >= d) scan = fmaxf(scan, tt); }
    float excl = shfl_up_f(scan, 1, lane); if (lane == 0) excl = -3.0e38f;
    spm[w * 128 + i0] = fmaxf(excl, e0); spm[w * 128 + i1] = fmaxf(excl, p1);
  }
  __syncthreads();
  const int t = 32 * w + lr, p = 128 * n + t;
  bf16x8 qf[8];
  _Pragma("unroll") for (int ks = 0; ks < 8; ++ks) qf[ks] = ldfrag(P.qc + ((size_t)bh * LPAD + p) * 128 + 16 * ks + 8 * lh);
  f32x16 acc[2][4];
  float btv[2], mtv[2], den0[2];
  _Pragma("unroll") for (int dir = 0; dir < 2; ++dir) {
    const size_t item = (size_t)(dir * 8 + bh) * NCH + n;
    const float mprev = P.mstat[item * 4 + 2];
    const float bt = sb[dir * 128 + t];
    const float mt = bt + fmaxf(mprev, spm[dir * 128 + t]);
    const float inter = __expf(bt + mprev - mt);
    float qn = 0.f;
    _Pragma("unroll") for (int ks = 0; ks < 8; ++ks) {
      union { bf16x8 v; unsigned u[4]; } tt; tt.v = qf[ks];
      const float* np = snp + dir * 128 + 16 * ks + 8 * lh;
      _Pragma("unroll") for (int j = 0; j < 4; ++j) qn += bflo(tt.u[j]) * np[2 * j] + bfhi(tt.u[j]) * np[2 * j + 1];
    }
    qn = xsum32(qn);
    btv[dir] = bt; mtv[dir] = mt; den0[dir] = inter * qn;
    const char* sU = smem + dir * 32768;
    _Pragma("unroll") for (int d = 0; d < 4; ++d) {
      const int urow = 32 * d + lr;
      acc[dir][d] = zero16();
      _Pragma("unroll") for (int ks = 0; ks < 8; ++ks) acc[dir][d] = MFMA32(*(const bf16x8*)(sU + urow * 256 + (((2 * ks + lh) ^ (urow & 15)) << 4)), qf[ks], acc[dir][d]);
      _Pragma("unroll") for (int r = 0; r < 16; ++r) acc[dir][d][r] *= inter;
    }
  }
  __syncthreads();
  {
    const int rin = lane >> 4, cpos = lane & 15;
    _Pragma("unroll") for (int i = 0; i < 16; ++i) {
      const int R = i * 4 + w, row = (i < 8 ? 4 * R : 4 * (R - 32)) + rin;
      const int ce = (cpos ^ (row & 15)) * 8;
      const bf16_t* src = i < 8 ? P.kc + ((size_t)bh * LPAD + 128 * n + row) * 128 + ce : P.cvT + ((size_t)bh * 128 + row) * LPAD + 128 * n + ce;
      __builtin_amdgcn_global_load_lds((const unsigned*)src, (lds_u32*)(smem + R * 1024), 16, 0, 0);
    }
  }
  __syncthreads();
  _Pragma("unroll") for (int dir = 0; dir < 2; ++dir) {
    const float bt = btv[dir], mt = mtv[dir];
    float den = 0.f;
    const int st0 = dir == 0 ? 0 : w, st1 = dir == 0 ? w : 3;
    for (int st = st0; st <= st1; ++st) {
      f32x16 s = zero16();
      _Pragma("unroll") for (int ks = 0; ks < 8; ++ks) {
        const int krow = 32 * st + kswap(lr);
        s = MFMA32(*(const bf16x8*)(sK + krow * 256 + (((2 * ks + lh) ^ (krow & 15)) << 4)), qf[ks], s);
      }
      _Pragma("unroll") for (int r = 0; r < 16; ++r) {
        const int sidx = 32 * st + keyoff(r, lh);
        const bool ok = dir == 0 ? (sidx <= t) : (sidx >= t);
        const float dd = __expf(fminf(bt + sc[dir * 128 + sidx] - mt, 0.f));
        const float pv = ok ? s[r] * dd : 0.f;
        s[r] = pv; den += pv;
      }
      const bf16x8 p0 = packfrag(s, 0), p1 = packfrag(s, 1);
      _Pragma("unroll") for (int d = 0; d < 4; ++d) {
        const int vrow = 32 * d + lr;
        const char* vp = sV + vrow * 256;
        acc[dir][d] = MFMA32(*(const bf16x8*)(vp + (((4 * st + lh) ^ (vrow & 15)) << 4)), p0, acc[dir][d]);
        acc[dir][d] = MFMA32(*(const bf16x8*)(vp + (((4 * st + 2 + lh) ^ (vrow & 15)) << 4)), p1, acc[dir][d]);
      }
    }
    den = xsum32(den);
    den = den0[dir] + den;
    const float sca = frcp(fmaxf(fabsf(den), __expf(-mt)));
    _Pragma("unroll") for (int d = 0; d < 4; ++d) _Pragma("unroll") for (int r = 0; r < 16; ++r) acc[dir][d][r] *= sca;
  }
  float hacc[4][16];
  _Pragma("unroll") for (int d = 0; d < 4; ++d) _Pragma("unroll") for (int r = 0; r < 16; ++r) hacc[d][r] = acc[0][d][r] + acc[1][d][r];
  float s1 = 0.f;
  _Pragma("unroll") for (int d = 0; d < 4; ++d) _Pragma("unroll") for (int r = 0; r < 16; ++r) s1 += hacc[d][r];
  s1 = xsum32(s1);
  const float mu = s1 * (1.f / 128.f);
  float s2 = 0.f;
  _Pragma("unroll") for (int d = 0; d < 4; ++d) _Pragma("unroll") for (int r = 0; r < 16; ++r) { hacc[d][r] -= mu; s2 += hacc[d][r] * hacc[d][r]; }
  s2 = xsum32(s2);
  const float rs = rsqrtf(s2 * (1.f / 128.f) + LN_EPS);
  const int pos = p - MPAD;
  if (pos >= 0) {
    const size_t tok = (size_t)b * L + pos;
    _Pragma("unroll") for (int d = 0; d < 4; ++d) _Pragma("unroll") for (int rg = 0; rg < 4; ++rg) {
      const int dv = 32 * d + 8 * rg + 4 * lh;
      const int col = hh * 128 + dv;
      const u32x2 cu = *(const u32x2*)(P.co + tok * 512 + col);
      const f32x4 g4 = *(const f32x4*)(P.mlstm_g + l * 512 + col);
      const float o0 = hacc[d][4 * rg + 0] * rs * g4.x * sigmoidf_(bflo(cu.x));
      const float o1 = hacc[d][4 * rg + 1] * rs * g4.y * sigmoidf_(bfhi(cu.x));
      const float o2 = hacc[d][4 * rg + 2] * rs * g4.z * sigmoidf_(bflo(cu.y));
      const float o3 = hacc[d][4 * rg + 3] * rs * g4.w * sigmoidf_(bfhi(cu.y));
      u32x2 ou; ou.x = pk2(o0, o1); ou.y = pk2(o2, o3);
      *(u32x2*)(P.oc + tok * 512 + col) = ou;
    }
  }
}

constexpr int DA_STAGE = 32768;
constexpr float DA_THR = 8.f;
DI void dattn_issue(const Params& P, int bh, int k0, char* stage, unsigned vk, unsigned vv, int w) {
  const char* kb0 = (const char*)(P.ka + ((size_t)(bh * 2) * L + k0) * 64);
  const char* vb0 = (const char*)(P.vaT + (size_t)bh * 128 * LK + k0);
  _Pragma("unroll") for (int i = 0; i < 8; ++i) {
    const char* src = i < 4 ? kb0 + (size_t)(i >> 1) * (L * 128) + (i & 1) * 4096 + vk : vb0 + (size_t)(i - 4) * 32 * LK * 2 + vv;
    __builtin_amdgcn_global_load_lds((const unsigned*)src, (lds_u32*)(stage + (i * 4 + w) * 1024), 16, 0, 0);
  }
}
DI void dattn_merge4(f32x16 (&O)[2][4], float (&m)[2], float (&ls)[2], char* smem, int lane, int w) {
  float* xf = (float*)smem;
  for (int src = 1; src < 4; ++src) {
    __syncthreads();
    if (w == src) {
      _Pragma("unroll") for (int c = 0; c < 2; ++c) {
        _Pragma("unroll") for (int d = 0; d < 4; ++d) _Pragma("unroll") for (int r = 0; r < 16; ++r) xf[((c * 4 + d) * 16 + r) * 64 + lane] = O[c][d][r];
        xf[8192 + c * 64 + lane] = m[c]; xf[8192 + 128 + c * 64 + lane] = ls[c];
      }
    }
    __syncthreads();
    if (w == 0) {
      _Pragma("unroll") for (int c = 0; c < 2; ++c) {
        const float mb = xf[8192 + c * 64 + lane], lb = xf[8192 + 128 + c * 64 + lane];
        const float M = fmaxf(m[c], mb), fa = fexp2(m[c] - M), fb = fexp2(mb - M);
        ls[c] = ls[c] * fa + lb * fb; m[c] = M;
        _Pragma("unroll") for (int d = 0; d < 4; ++d) _Pragma("unroll") for (int r = 0; r < 16; ++r) O[c][d][r] = O[c][d][r] * fa + xf[((c * 4 + d) * 16 + r) * 64 + lane] * fb;
      }
    }
  }
}
DI void dattn_finish(const Params& P, int l, int bh, int q0, f32x16 (&O)[2][4], const float (&ls)[2], int lr, int lh) {
  const int b = bh >> 2, hh = bh & 3;
  const float lam = P.lam[l], omli = P.lam[2 + l];
  const float i0 = 1.f / ls[0], i1 = lam / ls[1];
  float ss = 0.f;
  _Pragma("unroll") for (int d = 0; d < 4; ++d) _Pragma("unroll") for (int r = 0; r < 16; ++r) { const float o = O[0][d][r] * i0 - O[1][d][r] * i1; O[0][d][r] = o; ss += o * o; }
  ss = xsum32(ss);
  const float rs = rsqrtf(ss * (1.f / 128.f) + LN_EPS);
  if (q0 + lr < L) {
    const size_t tok = (size_t)b * L + q0 + lr;
    _Pragma("unroll") for (int d = 0; d < 4; ++d) _Pragma("unroll") for (int rg = 0; rg < 4; ++rg) {
      const int dv = 32 * d + 8 * rg + 4 * lh;
      const f32x4 g4 = *(const f32x4*)(P.diff_g + l * 128 + dv);
      u32x2 ou;
      ou.x = pk2(O[0][d][4 * rg + 0] * rs * g4.x * omli, O[0][d][4 * rg + 1] * rs * g4.y * omli);
      ou.y = pk2(O[0][d][4 * rg + 2] * rs * g4.z * omli, O[0][d][4 * rg + 3] * rs * g4.w * omli);
      *(u32x2*)(P.oa + tok * 512 + hh * 128 + dv) = ou;
    }
  }
}
constexpr int DA_PART = 2 * 4 * 16 * 64 + 256;
DI void dattn_item(const Params& P, int l, int it, bool part, char* smem) {
  const int tid = otid(), lane = tid & 63, w = tid >> 6, lr = lane & 31, lh = lane >> 5;
  const int bh = it & 7, jq = it >> 3;
  const int q0 = part ? 8192 : jq * 128 + 32 * w;
  const int qi = min(q0 + lr, L - 1);
  constexpr int NTILE = (L + 63) / 64;
  const int t0 = part ? 2 * jq : 0, t1 = part ? (jq == 63 ? NTILE : 2 * jq + 2) : NTILE;
  bf16x8 qf[2][4];
  _Pragma("unroll") for (int c = 0; c < 2; ++c) _Pragma("unroll") for (int ks = 0; ks < 4; ++ks)
    qf[c][ks] = ldfrag(P.qa + ((size_t)(bh * 2 + c) * L + qi) * 64 + 16 * ks + 8 * lh);
  f32x16 O[2][4];
  float m[2], ls[2];
  _Pragma("unroll") for (int c = 0; c < 2; ++c) {
    f32x16 s = zero16();
    const bf16_t* kp = P.ka + ((size_t)(bh * 2 + c) * L + t0 * 64 + kswap(lr)) * 64 + 8 * lh;
    _Pragma("unroll") for (int ks = 0; ks < 4; ++ks) s = MFMA32(ldfrag(kp + 16 * ks), qf[c][ks], s);
    float mx = s[0];
    _Pragma("unroll") for (int r = 1; r < 16; ++r) mx = fmaxf(mx, s[r]);
    m[c] = xmax32(mx); ls[c] = 0.f;
    _Pragma("unroll") for (int d = 0; d < 4; ++d) O[c][d] = zero16();
  }
  const unsigned vk = (unsigned)((w * 8 + (lane >> 3)) * 128 + (((lane & 7) ^ (4 * (w & 1) + (lane >> 4))) << 4));
  const unsigned vv = (unsigned)((w * 8 + (lane >> 3)) * (LK * 2) + (((lane & 7) ^ (4 * (w & 1) + (lane >> 4))) << 4));
  __syncthreads();
  dattn_issue(P, bh, t0 * 64, smem + (t0 & 1) * DA_STAGE, vk, vv, w);
  for (int t = t0; t < t1; ++t) {
    __syncthreads();
    if (t + 1 < t1) dattn_issue(P, bh, (t + 1) * 64, smem + ((t + 1) & 1) * DA_STAGE, vk, vv, w);
    const char* st = smem + (t & 1) * DA_STAGE;
    _Pragma("unroll") for (int kb = 0; kb < 2; ++kb) {
      if (part && ((((t - t0) * 2 + kb) & 3) != w)) continue;
      bf16x8 pf[2][2];
      _Pragma("unroll") for (int c = 0; c < 2; ++c) {
        f32x16 s;
        _Pragma("unroll") for (int r = 0; r < 16; ++r) s[r] = -m[c];
        const int krow = kb * 32 + kswap(lr);
        const char* kp = st + c * 8192 + krow * 128;
        _Pragma("unroll") for (int ks = 0; ks < 4; ++ks) s = MFMA32(*(const bf16x8*)(kp + (((2 * ks + lh) ^ swz(krow)) << 4)), qf[c][ks], s);
        if (t == NTILE - 1) {
          _Pragma("unroll") for (int r = 0; r < 16; ++r) if (t * 64 + kb * 32 + keyoff(r, lh) >= L) s[r] = -3.0e38f;
        }
        float mx = s[0];
        _Pragma("unroll") for (int r = 1; r < 16; ++r) mx = fmaxf(mx, s[r]);
        if (__any(mx > DA_THR)) {
          asm volatile("; rare: move the softmax reference" ::: "memory");
          const float dlt = fmaxf(xmax32(mx), 0.f);
          const float al = fexp2(-dlt);
          m[c] += dlt; ls[c] *= al;
          _Pragma("unroll") for (int d = 0; d < 4; ++d) _Pragma("unroll") for (int r = 0; r < 16; ++r) O[c][d][r] *= al;
          _Pragma("unroll") for (int r = 0; r < 16; ++r) s[r] -= dlt;
        }
        float rsum = 0.f;
        _Pragma("unroll") for (int r = 0; r < 16; ++r) { const float pv = fexp2(s[r]); s[r] = pv; rsum += pv; }
        ls[c] += rsum;
        pf[c][0] = packfrag(s, 0); pf[c][1] = packfrag(s, 1);
      }
      _Pragma("unroll") for (int d = 0; d < 4; ++d) {
        const int vrow = 32 * d + lr;
        const char* vp = st + 16384 + vrow * 128;
        const bf16x8 v0 = *(const bf16x8*)(vp + (((kb * 4 + lh) ^ swz(vrow)) << 4));
        const bf16x8 v1 = *(const bf16x8*)(vp + (((kb * 4 + 2 + lh) ^ swz(vrow)) << 4));
        _Pragma("unroll") for (int c = 0; c < 2; ++c) { O[c][d] = MFMA32(v0, pf[c][0], O[c][d]); O[c][d] = MFMA32(v1, pf[c][1], O[c][d]); }
      }
    }
  }
  _Pragma("unroll") for (int c = 0; c < 2; ++c) ls[c] = xsum32(ls[c]);
  if (part) {
    dattn_merge4(O, m, ls, smem, lane, w);
    if (w == 0) {
      float* pb = (float*)P.merged + (size_t)it * DA_PART + lane;
      _Pragma("unroll") for (int c = 0; c < 2; ++c) {
        _Pragma("unroll") for (int d = 0; d < 4; ++d) {
          float* pp = pb + (c * 4 + d) * 1024;
          asm volatile("" : "+v"(pp));
          _Pragma("unroll") for (int r = 0; r < 16; ++r) pp[r * 64] = O[c][d][r];
        }
        pb[8192 + c * 64] = m[c]; pb[8192 + 128 + c * 64] = ls[c];
      }
    }
    return;
  }
  dattn_finish(P, l, bh, q0, O, ls, lr, lh);
}
DI void dattn_item16(const Params& P, int l, int it, char* smem_wg) {
  int tid = rtid(); asm volatile("" : "+v"(tid));
  const int lane = tid & 63, w = __builtin_amdgcn_readfirstlane(tid >> 6), w4 = w & 3, ih = w >> 2, lr = lane & 31, lh = lane >> 5;
  const int bh = it & 7, jq = it >> 3;
  const int q0 = jq * 256 + 32 * w;
  constexpr int NTILE = (L + 63) / 64;
  bf16x8 qf[2][4];
  _Pragma("unroll") for (int c = 0; c < 2; ++c) _Pragma("unroll") for (int ks = 0; ks < 4; ++ks)
    qf[c][ks] = ldfrag(P.qa + ((size_t)(bh * 2 + c) * L + q0 + lr) * 64 + 16 * ks + 8 * lh);
  f32x16 O[2][4];
  float m[2], ls[2];
  _Pragma("unroll") for (int c = 0; c < 2; ++c) {
    f32x16 s = zero16();
    const bf16_t* kp = P.ka + ((size_t)(bh * 2 + c) * L + kswap(lr)) * 64 + 8 * lh;
    _Pragma("unroll") for (int ks = 0; ks < 4; ++ks) s = MFMA32(ldfrag(kp + 16 * ks), qf[c][ks], s);
    float mx = s[0];
    _Pragma("unroll") for (int r = 1; r < 16; ++r) mx = fmaxf(mx, s[r]);
    m[c] = xmax32(mx); ls[c] = 0.f;
    _Pragma("unroll") for (int d = 0; d < 4; ++d) O[c][d] = zero16();
  }
  const unsigned sw16 = (unsigned)(((lane & 7) ^ (4 * (w4 & 1) + (lane >> 4))) << 4);
  const char* gsrc = ih == 0 ? (const char*)(P.ka + (size_t)(bh * 2) * L * 64) + (size_t)(w4 * 8 + (lane >> 3)) * 128 + sw16
                             : (const char*)(P.vaT + (size_t)bh * 128 * LK) + (size_t)(w4 * 8 + (lane >> 3)) * (LK * 2) + sw16;
#define DA16_ISSUE(t_, st_) _Pragma("unroll") for (int i_ = 0; i_ < 4; ++i_) { \
    const char* src_ = ih == 0 ? gsrc + (size_t)(t_) * (64 * 128) + (size_t)(i_ >> 1) * (L * 128) + (i_ & 1) * 4096 : gsrc + (size_t)(t_) * 128 + (size_t)i_ * 32 * LK * 2; \
    __builtin_amdgcn_global_load_lds((const unsigned*)src_, (lds_u32*)(smem_wg + (st_) * DA_STAGE + ((ih * 4 + i_) * 4 + w4) * 1024), 16, 0, 0); }
  __syncthreads();
  DA16_ISSUE(0, 0)
  for (int t = 0; t < NTILE; ++t) {
    __syncthreads();
    if (t + 1 < NTILE) { DA16_ISSUE(t + 1, (t + 1) & 1) }
    const char* st = smem_wg + (t & 1) * DA_STAGE;
    _Pragma("unroll") for (int kb = 0; kb < 2; ++kb) {
      bf16x8 pf[2][2];
      _Pragma("unroll") for (int c = 0; c < 2; ++c) {
        f32x16 s;
        _Pragma("unroll") for (int r = 0; r < 16; ++r) s[r] = -m[c];
        const int krow = kb * 32 + kswap(lr);
        const char* kp = st + c * 8192 + krow * 128;
        _Pragma("unroll") for (int ks = 0; ks < 4; ++ks) s = MFMA32(*(const bf16x8*)(kp + (((2 * ks + lh) ^ swz(krow)) << 4)), qf[c][ks], s);
        if (t == NTILE - 1) {
          _Pragma("unroll") for (int r = 0; r < 16; ++r) if (t * 64 + kb * 32 + keyoff(r, lh) >= L) s[r] = -3.0e38f;
        }
        float mx = s[0];
        _Pragma("unroll") for (int r = 1; r < 16; ++r) mx = fmaxf(mx, s[r]);
        if (__any(mx > DA_THR)) {
          asm volatile("; rare: move the softmax reference" ::: "memory");
          const float dlt = fmaxf(xmax32(mx), 0.f);
          const float al = fexp2(-dlt);
          m[c] += dlt; ls[c] *= al;
          _Pragma("unroll") for (int d = 0; d < 4; ++d) _Pragma("unroll") for (int r = 0; r < 16; ++r) O[c][d][r] *= al;
          _Pragma("unroll") for (int r = 0; r < 16; ++r) s[r] -= dlt;
        }
        float rsum = 0.f;
        _Pragma("unroll") for (int r = 0; r < 16; ++r) { const float pv = fexp2(s[r]); s[r] = pv; rsum += pv; }
        ls[c] += rsum;
        pf[c][0] = packfrag(s, 0); pf[c][1] = packfrag(s, 1);
      }
      _Pragma("unroll") for (int d = 0; d < 4; ++d) {
        const int vrow = 32 * d + lr;
        const char* vp = st + 16384 + vrow * 128;
        const bf16x8 v0 = *(const bf16x8*)(vp + (((kb * 4 + lh) ^ swz(vrow)) << 4));
        const bf16x8 v1 = *(const bf16x8*)(vp + (((kb * 4 + 2 + lh) ^ swz(vrow)) << 4));
        _Pragma("unroll") for (int c = 0; c < 2; ++c) { O[c][d] = MFMA32(v0, pf[c][0], O[c][d]); O[c][d] = MFMA32(v1, pf[c][1], O[c][d]); }
      }
    }
  }
#undef DA16_ISSUE
  _Pragma("unroll") for (int c = 0; c < 2; ++c) ls[c] = xsum32(ls[c]);
  dattn_finish(P, l, bh, q0, O, ls, lr, lh);
}
DI void dattn_combine(const Params& P, int l, int bh, char* smem) {
  const int tid = otid(), lane = tid & 63, w = tid >> 6, lr = lane & 31, lh = lane >> 5;
  f32x16 O[2][4];
  float m[2], ls[2];
  for (int k = 0; k < 16; ++k) {
    const float* pb = (const float*)P.merged + (size_t)(bh + 8 * (w * 16 + k)) * DA_PART + lane;
    _Pragma("unroll") for (int c = 0; c < 2; ++c) {
      const float mb = pb[8192 + c * 64], lb = pb[8192 + 128 + c * 64];
      float fa, fb;
      if (k == 0) { m[c] = mb; ls[c] = lb; fa = 0.f; fb = 1.f; }
      else { const float M = fmaxf(m[c], mb); fa = fexp2(m[c] - M); fb = fexp2(mb - M); ls[c] = ls[c] * fa + lb * fb; m[c] = M; }
      _Pragma("unroll") for (int d = 0; d < 4; ++d) {
        const float* pp = pb + (c * 4 + d) * 1024;
        asm volatile("" : "+v"(pp));
        _Pragma("unroll") for (int r = 0; r < 16; ++r) {
          const float ov = pp[r * 64];
          O[c][d][r] = k == 0 ? ov : O[c][d][r] * fa + ov * fb;
        }
      }
    }
  }
  dattn_merge4(O, m, ls, smem, lane, w);
  if (w == 0) dattn_finish(P, l, bh, 8192, O, ls, lr, lh);
}

DI void swa_item(const Params& P, int l, int it, char* smem) {
  const int tid = otid(), lane = tid & 63, w = tid >> 6, lr = lane & 31, lh = lane >> 5;
  const int NQT = (L + 31) / 32;
  const int bk = it / NQT, qt = it % NQT, b = bk >> 1, kv = bk & 1, hq = kv * 4 + w;
  const int q0 = qt * 32;
  const int qi = min(q0 + lr, L - 1);
  bf16x8 qf[4];
  _Pragma("unroll") for (int ks = 0; ks < 4; ++ks) qf[ks] = ldfrag(P.qb + ((size_t)(b * 8 + hq) * L + qi) * 64 + 16 * ks + 8 * lh);
  f32x16 O[2]; O[0] = zero16(); O[1] = zero16();
  float m = P.sink[l * 8 + hq] * 1.44269504088896341f, ls = 1.f;
  const bf16_t* kbase = P.kb + (size_t)(b * 2 + kv) * L * 64;
  const bf16_t* vbase = P.vbT + (size_t)(b * 2 + kv) * 64 * LK;
  const int qpos = q0 + lr;
  char* sK = smem;
  char* sV = smem + 5 * 4096;
  bf16x8 ta[5], tb[5];
#define SWA_LOAD(ph_) _Pragma("unroll") for (int i = 0; i < 5; ++i) { \
    { const int rr_ = 40 * w + 8 * i + (lane >> 3), bb_ = rr_ >> 5, bi_ = 5 * (ph_) + bb_; const int k1_ = bi_ == 0 ? 0 : q0 - 160 + 32 * bi_; \
      const int krow_ = min(max(k1_ + (rr_ & 31), 0), L - 1); ta[i] = ldfrag(kbase + (size_t)krow_ * 64 + (lane & 7) * 8); } \
    { const int j_ = 5 * w + i, bb_ = j_ >> 2, bi_ = 5 * (ph_) + bb_; const int k0_ = bi_ == 0 ? 0 : q0 - 160 + 32 * bi_; const int kc0_ = min(max(k0_, 0), LK - 32); \
      tb[i] = ldfrag(vbase + (size_t)(16 * (j_ & 3) + (lane >> 2)) * LK + kc0_ + (lane & 3) * 8); } }
#define SWA_STORE() _Pragma("unroll") for (int i = 0; i < 5; ++i) { \
    { const int rr_ = 40 * w + 8 * i + (lane >> 3), bb_ = rr_ >> 5, r_ = rr_ & 31; *(bf16x8*)(sK + bb_ * 4096 + r_ * 128 + (((lane & 7) ^ swz(r_)) << 4)) = ta[i]; } \
    { const int j_ = 5 * w + i, bb_ = j_ >> 2, rv_ = 16 * (j_ & 3) + (lane >> 2); *(bf16x8*)(sV + bb_ * 4096 + rv_ * 64 + (((lane & 3) ^ ((rv_ >> 2) & 3)) << 4)) = tb[i]; } }
  SWA_LOAD(0)
  SWA_STORE()
  __syncthreads();
  SWA_LOAD(1)
  __builtin_amdgcn_sched_barrier(0);
  _Pragma("unroll") for (int ph = 0; ph < 2; ++ph) {
    if (ph == 1) { __syncthreads(); SWA_STORE() __syncthreads(); }
    _Pragma("unroll") for (int bb = 0; bb < 5; ++bb) {
      const int bi = 5 * ph + bb;
      const int k0 = bi == 0 ? 0 : q0 - 160 + 32 * bi;
      f32x16 s = zero16();
      {
        const int krow = kswap(lr);
        _Pragma("unroll") for (int ks = 0; ks < 4; ++ks) s = MFMA32(*(const bf16x8*)(sK + bb * 4096 + krow * 128 + (((2 * ks + lh) ^ swz(krow)) << 4)), qf[ks], s);
      }
      float mx = -3.0e38f;
      if (bi >= 2 && bi <= 8 && k0 >= NMETA && k0 + 32 <= L) {
        _Pragma("unroll") for (int r = 0; r < 16; ++r) mx = fmaxf(mx, s[r]);
      } else {
        _Pragma("unroll") for (int r = 0; r < 16; ++r) {
          const int kj = k0 + keyoff(r, lh);
          bool ok;
          if (bi == 0) ok = kj < NMETA;
          else if (bi == 1) ok = kj >= NMETA && kj >= qpos - 128;
          else if (bi == 9) ok = kj < L && kj <= qpos + 128;
          else ok = kj >= NMETA && kj < L;
          const float v = ok ? s[r] : -3.0e38f;
          s[r] = v; mx = fmaxf(mx, v);
        }
      }
      mx = xmax32(mx);
      const float mn = fmaxf(m, mx);
      const float al = fexp2(m - mn);
      float rsum = 0.f;
      _Pragma("unroll") for (int r = 0; r < 16; ++r) { const float pv = fexp2(s[r] - mn); s[r] = pv; rsum += pv; }
      rsum = xsum32(rsum);
      ls = ls * al + rsum; m = mn;
      _Pragma("unroll") for (int d = 0; d < 2; ++d) _Pragma("unroll") for (int r = 0; r < 16; ++r) O[d][r] *= al;
      const bf16x8 p0 = packfrag(s, 0), p1 = packfrag(s, 1);
      _Pragma("unroll") for (int d = 0; d < 2; ++d) {
        const int vrow = 32 * d + lr;
        const char* vp = sV + bb * 4096 + vrow * 64;
        const int sx = (vrow >> 2) & 3;
        O[d] = MFMA32(*(const bf16x8*)(vp + ((lh ^ sx) << 4)), p0, O[d]);
        O[d] = MFMA32(*(const bf16x8*)(vp + (((2 + lh) ^ sx) << 4)), p1, O[d]);
      }
    }
  }
#undef SWA_LOAD
#undef SWA_STORE
  if (qpos < L) {
    const float inv = 1.f / ls;
    const size_t tok = (size_t)b * L + qpos;
    _Pragma("unroll") for (int d = 0; d < 2; ++d) _Pragma("unroll") for (int rg = 0; rg < 4; ++rg) {
      const int dv = 32 * d + 8 * rg + 4 * lh;
      u32x2 ou;
      ou.x = pk2(O[d][4 * rg + 0] * inv, O[d][4 * rg + 1] * inv);
      ou.y = pk2(O[d][4 * rg + 2] * inv, O[d][4 * rg + 3] * inv);
      *(u32x2*)(P.ob + tok * 512 + hq * 64 + dv) = ou;
    }
  }
}

constexpr int P3_MT = TP / 128, P3_NT = D / 128;
DI void tail_reduce(const f32x16& acc, char* smem_wg, int w, int lane, float (&v)[2]) {
  float* red = (float*)smem_wg;
  __syncthreads();
  _Pragma("unroll") for (int r = 0; r < 16; ++r) red[(w * 16 + r) * 64 + lane] = acc[r];
  __syncthreads();
  _Pragma("unroll") for (int j = 0; j < 2; ++j) {
    float s = 0.f;
    _Pragma("unroll") for (int x = 0; x < 8; ++x) s += red[(x * 16 + 2 * w + j) * 64 + lane];
    v[j] = s;
  }
  __syncthreads();
}
DI void p3a_tail(const Params& P, char* smem_wg, int wg) {
  int tid = rtid(); asm volatile("" : "+v"(tid));
  const int lane = tid & 63, w = tid >> 6, lr = lane & 31, lh = lane >> 5;
  const int n0 = 32 * wg, k0 = 64 * w + 8 * lh;
  f32x16 tot = zero16();
  _Pragma("unroll 1") for (int br = 0; br < 3; ++br) {
    const bf16_t* A = P.oa + ((size_t)br * TP + 16384 + lr) * 512 + k0;
    const bf16_t* B = P.w_br_t + ((size_t)br * 1024 + n0 + lr) * 512 + k0;
    f32x16 part = zero16();
    _Pragma("unroll") for (int ks = 0; ks < 4; ++ks) part = MFMA32(ldfrag(A + 16 * ks), ldfrag(B + 16 * ks), part);
    _Pragma("unroll") for (int r = 0; r < 16; ++r) tot[r] += bf2f(P.gz[(size_t)(16384 + crow(r, lh)) * 3072 + br * 1024 + n0 + lr]) * part[r];
  }
  float v[2];
  tail_reduce(tot, smem_wg, w, lane, v);
  _Pragma("unroll") for (int j = 0; j < 2; ++j) P.merged[(size_t)(16384 + crow(2 * w + j, lh)) * D + n0 + lr] = f2bf(v[j]);
}
DI void p3b_tail(const Params& P, char* smem_wg, int wg) {
  int tid = rtid(); asm volatile("" : "+v"(tid));
  const int lane = tid & 63, w = tid >> 6, lr = lane & 31, lh = lane >> 5;
  const int n0 = 32 * wg, k0 = 128 * w + 8 * lh;
  const bf16_t* A = P.merged + (size_t)(16384 + lr) * D + k0;
  const bf16_t* B = P.w_out_t + (size_t)(n0 + lr) * D + k0;
  f32x16 acc = zero16();
  _Pragma("unroll") for (int ks = 0; ks < 8; ++ks) acc = MFMA32(ldfrag(A + 16 * ks), ldfrag(B + 16 * ks), acc);
  float v[2];
  tail_reduce(acc, smem_wg, w, lane, v);
  _Pragma("unroll") for (int j = 0; j < 2; ++j) { float* hp = P.h + (size_t)(16384 + crow(2 * w + j, lh)) * D + n0 + lr; *hp = ALPHA * (*hp) + v[j]; }
}
struct SchedP3a {
  static constexpr bool GATHER = false;
  const char* A; const char* B; int G, c;
  DI bool next(int i, g8::Unit& u) const {
    const int ti = i / 3, br = i - 3 * ti; int pm, pn;
    if (!g8::grid_unit(ti, G, c, 64, 4, pm, pn)) return false;
    u.pm = pm; u.pn = pn; u.tag = br;
    u.a = A + ((size_t)br * TP + (size_t)pm * 256) * 512 * 2; u.b = B + ((size_t)br * 1024 + (size_t)pn * 256) * 512 * 2; return true;
  }
  DI void arows(const g8::Unit&, int, unsigned (&)[2]) const {}
};
struct EpiP3a {
  static constexpr bool PERM = true;
  const bf16_t* gz; bf16_t* merged;
  DI bool keep(const g8::Unit& u) const { return u.tag < 2; }
  DI void operator()(g8::f32x4 (&acc)[2][2][4][2], const g8::Unit& u, int wr, int wc, int fr, int fq) const {
    const int br = u.tag;
    const bf16_t* g0 = gz + (size_t)(u.pm * 256 + 64 * wr + fr) * 3072 + br * 1024 + u.pn * 256 + 32 * wc + 8 * fq;
    _Pragma("unroll") for (int ai = 0; ai < 2; ++ai) {
      u32x4 ga[4][2], gb[4][2];
      _Pragma("unroll") for (int m = 0; m < 4; ++m) _Pragma("unroll") for (int bj = 0; bj < 2; ++bj) ga[m][bj] = *(const u32x4*)(g0 + (size_t)(128 * ai + 16 * m) * 3072 + 128 * bj);
      if (br < 2) {
        _Pragma("unroll") for (int m = 0; m < 4; ++m) _Pragma("unroll") for (int bj = 0; bj < 2; ++bj) gb[m][bj] = *(const u32x4*)(g0 + (size_t)(128 * ai + 16 * m) * 3072 + 128 * bj + 1024);
        __builtin_amdgcn_sched_barrier(0);
        _Pragma("unroll") for (int m = 0; m < 4; ++m) _Pragma("unroll") for (int bj = 0; bj < 2; ++bj) {
          const u32x4 a = ga[m][bj], b = gb[m][bj];
          acc[ai][bj][m][0][0] *= bflo(a.x) * frcp(bflo(b.x)); acc[ai][bj][m][0][1] *= bfhi(a.x) * frcp(bfhi(b.x));
          acc[ai][bj][m][0][2] *= bflo(a.y) * frcp(bflo(b.y)); acc[ai][bj][m][0][3] *= bfhi(a.y) * frcp(bfhi(b.y));
          acc[ai][bj][m][1][0] *= bflo(a.z) * frcp(bflo(b.z)); acc[ai][bj][m][1][1] *= bfhi(a.z) * frcp(bfhi(b.z));
          acc[ai][bj][m][1][2] *= bflo(a.w) * frcp(bflo(b.w)); acc[ai][bj][m][1][3] *= bfhi(a.w) * frcp(bfhi(b.w));
        }
      } else {
        __builtin_amdgcn_sched_barrier(0);
        _Pragma("unroll") for (int m = 0; m < 4; ++m) _Pragma("unroll") for (int bj = 0; bj < 2; ++bj) {
          const u32x4 a = ga[m][bj];
          u32x4 o;
          o.x = pk2(acc[ai][bj][m][0][0] * bflo(a.x), acc[ai][bj][m][0][1] * bfhi(a.x)); o.y = pk2(acc[ai][bj][m][0][2] * bflo(a.y), acc[ai][bj][m][0][3] * bfhi(a.y));
          o.z = pk2(acc[ai][bj][m][1][0] * bflo(a.z), acc[ai][bj][m][1][1] * bfhi(a.z)); o.w = pk2(acc[ai][bj][m][1][2] * bflo(a.w), acc[ai][bj][m][1][3] * bfhi(a.w));
          *(u32x4*)(merged + (size_t)(u.pm * 256 + 128 * ai + 64 * wr + 16 * m + fr) * D + u.pn * 256 + 128 * bj + 32 * wc + 8 * fq) = o;
        }
      }
      __builtin_amdgcn_sched_barrier(0);
    }
  }
};
DI void phase_p3a(const Params& P, int l, char* smem, char* smem_wg, int bid, int nblk) {
  if ((bid >> 1) < 32) p3a_tail(P, smem_wg, bid >> 1);
  {
    SchedP3a S; S.A = (const char*)P.oa; S.B = (const char*)P.w_br_t; S.G = nblk >> 1; S.c = bid >> 1;
    EpiP3a E; E.gz = P.gz; E.merged = P.merged;
    g8::gemm_phase((g8::lds_u8*)smem_wg, 512, S, E);
  }
}
struct SchedP3b {
  static constexpr bool GATHER = false;
  const char* A; const char* B; int G, c;
  DI bool next(int i, g8::Unit& u) const { int pm, pn; if (!g8::grid_unit(i, G, c, 64, 4, pm, pn)) return false; u.pm = pm; u.pn = pn; u.tag = 0; u.a = A + (size_t)pm * 256 * D * 2; u.b = B + (size_t)pn * 256 * D * 2; return true; }
  DI void arows(const g8::Unit&, int, unsigned (&)[2]) const {}
};
struct EpiP3b {
  static constexpr bool PERM = false;
  float* h;
  DI bool keep(const g8::Unit&) const { return false; }
  DI void operator()(g8::f32x4 (&acc)[2][2][4][2], const g8::Unit& u, int wr, int wc, int fr, int fq) const {
    float* h0 = h + (size_t)(u.pm * 256 + 64 * wr + fr) * D + u.pn * 256 + 32 * wc + 4 * fq;
    _Pragma("unroll") for (int ai = 0; ai < 2; ++ai) {
      g8::f32x4 hv[4][2][2];
      _Pragma("unroll") for (int m = 0; m < 4; ++m) _Pragma("unroll") for (int bj = 0; bj < 2; ++bj) _Pragma("unroll") for (int n = 0; n < 2; ++n)
        hv[m][bj][n] = *(const g8::f32x4*)(h0 + (size_t)(128 * ai + 16 * m) * D + 128 * bj + 16 * n);
      __builtin_amdgcn_sched_barrier(0);
      _Pragma("unroll") for (int m = 0; m < 4; ++m) _Pragma("unroll") for (int bj = 0; bj < 2; ++bj) _Pragma("unroll") for (int n = 0; n < 2; ++n)
        *(g8::f32x4*)(h0 + (size_t)(128 * ai + 16 * m) * D + 128 * bj + 16 * n) = ALPHA * hv[m][bj][n] + acc[ai][bj][m][n];
      __builtin_amdgcn_sched_barrier(0);
    }
  }
};
DI void phase_p3b(const Params& P, int l, char* smem, char* smem_wg, int bid, int nblk) {
  if ((bid >> 1) < 32) p3b_tail(P, smem_wg, bid >> 1);
  {
    SchedP3b S; S.A = (const char*)P.merged; S.B = (const char*)P.w_out_t; S.G = nblk >> 1; S.c = bid >> 1;
    EpiP3b E; E.h = P.h;
    g8::gemm_phase(( g8::lds_u8*)smem_wg, D, S, E);
  }
}

typedef __attribute__((ext_vector_type(4))) float f32x4v;
DI void phase_router_prep(const Params& P, int bid, int nblk) {
  const int gtid = bid * NT + otid(), gn = nblk * NT;
  for (int i = gtid; i < 2 * 64 * 3 * 64 * 4; i += gn) {
    const int sidx = i & 3, lane = (i >> 2) & 63, n = (i >> 8) % 3, chunk = ((i >> 8) / 3) & 63, l = (i >> 8) / 192;
    const int c = 16 * chunk + 4 * (lane >> 4) + sidx, j = lane & 15;
    float wv = 0.f;
    if (n < 2) wv = P.w_re[((size_t)l * D + c) * 32 + 16 * n + j];
    else if (j < 4) wv = P.w_rg[((size_t)l * D + c) * 4 + j];
    P.rwp[i] = wv * P.ln1_g[l * D + c];
  }
  const int wv_ = gtid >> 6, lane = gtid & 63;
  if (wv_ < 2 * 36) {
    const int l = wv_ / 36, o = wv_ % 36;
    float sg = 0.f, sb = 0.f;
    _Pragma("unroll") for (int c = lane; c < D; c += 64) {
      const float wv = o < 32 ? P.w_re[((size_t)l * D + c) * 32 + o] : P.w_rg[((size_t)l * D + c) * 4 + o - 32];
      sg += P.ln1_g[l * D + c] * wv; sb += P.ln1_b[l * D + c] * wv;
    }
    sg = wave_sum(sg); sb = wave_sum(sb);
    if (lane == 0) { P.rgb[(l * 2 + 0) * 48 + o] = sg; P.rgb[(l * 2 + 1) * 48 + o] = sb + (o < 32 ? P.b_re[l * 32 + o] : P.b_rg[l * 4 + o - 32]); }
  }
}
DI void phase_p4(const Params& P, int l, char* smem, int bid, int nblk) {
  const int tid = otid(), lane = tid & 63, w = tid >> 6, wv = (bid * NT + tid) >> 6, nwv = (nblk * NT) >> 6;
  float* raw = (float*)smem + w * 768;
  const f32x4* wp = (const f32x4*)P.rwp + (size_t)l * 64 * 3 * 64 + lane;
  const int nrb = min(nblk, (T / 16 + 3) / 4), nwr = nrb * 4;
  for (int wt = bid < nrb ? bid * 4 + w : T / 16; wt < T / 16; wt += nwr) {
    const int t0 = wt * 16;
    f32x4v acc[3];
    _Pragma("unroll") for (int n = 0; n < 3; ++n) { acc[n][0] = 0.f; acc[n][1] = 0.f; acc[n][2] = 0.f; acc[n][3] = 0.f; }
    const float* xa = P.h + (size_t)(t0 + (lane & 15)) * D + 4 * (lane >> 4);
    f32x4 A0[4], B0[4][3], A1[4], B1[4][3];
    float s1 = 0.f, s2 = 0.f;
#define P4_LOAD(Ab, Bb, c0) _Pragma("unroll") for (int u = 0; u < 4; ++u) { Ab[u] = *(const f32x4*)(xa + 16 * ((c0) + u)); \
      _Pragma("unroll") for (int n = 0; n < 3; ++n) Bb[u][n] = wp[(((c0) + u) * 3 + n) * 64]; }
#define P4_MMA(Ab, Bb) _Pragma("unroll") for (int u = 0; u < 4; ++u) { const f32x4 a = Ab[u]; \
      s1 += (a.x + a.y) + (a.z + a.w); s2 += (a.x * a.x + a.y * a.y) + (a.z * a.z + a.w * a.w); \
      _Pragma("unroll") for (int n = 0; n < 3; ++n) acc[n] = __builtin_amdgcn_mfma_f32_16x16x4f32(a.x, Bb[u][n].x, acc[n], 0, 0, 0); \
      _Pragma("unroll") for (int n = 0; n < 3; ++n) acc[n] = __builtin_amdgcn_mfma_f32_16x16x4f32(a.y, Bb[u][n].y, acc[n], 0, 0, 0); \
      _Pragma("unroll") for (int n = 0; n < 3; ++n) acc[n] = __builtin_amdgcn_mfma_f32_16x16x4f32(a.z, Bb[u][n].z, acc[n], 0, 0, 0); \
      _Pragma("unroll") for (int n = 0; n < 3; ++n) acc[n] = __builtin_amdgcn_mfma_f32_16x16x4f32(a.w, Bb[u][n].w, acc[n], 0, 0, 0); }
    P4_LOAD(A0, B0, 0)
    _Pragma("unroll 1") for (int ch = 0; ch < 64; ch += 8) {
      P4_LOAD(A1, B1, ch + 4)
      __builtin_amdgcn_sched_barrier(0);
      P4_MMA(A0, B0)
      __builtin_amdgcn_sched_barrier(0);
      if (ch + 8 < 64) { P4_LOAD(A0, B0, ch + 8) }
      __builtin_amdgcn_sched_barrier(0);
      P4_MMA(A1, B1)
      __builtin_amdgcn_sched_barrier(0);
    }
#undef P4_LOAD
#undef P4_MMA
    s1 += sxor<16>(s1); s2 += sxor<16>(s2); s1 = xsum32(s1); s2 = xsum32(s2);
    const float mu_r = s1 * (1.f / 1024.f), rs_r = rsqrtf(fmaxf(s2 * (1.f / 1024.f) - mu_r * mu_r, 0.f) + LN_EPS);
    WT_FENCE();
    _Pragma("unroll") for (int r = 0; r < 4; ++r) {
      const int tok = 4 * (lane >> 4) + r, j = lane & 15;
      raw[tok * 40 + j] = acc[0][r]; raw[tok * 40 + 16 + j] = acc[1][r];
      if (j < 4) raw[tok * 40 + 32 + j] = acc[2][r];
    }
    if (lane < 16) { raw[640 + 2 * lane] = mu_r; raw[640 + 2 * lane + 1] = rs_r; }
    WT_FENCE();
    f32x4 gg[4], bb[4];
    _Pragma("unroll") for (int i = 0; i < 4; ++i) { gg[i] = ((const f32x4*)(P.ln1_g + l * D))[lane + 64 * i]; bb[i] = ((const f32x4*)(P.ln1_b + l * D))[lane + 64 * i]; }
    _Pragma("unroll 1") for (int q0 = 0; q0 < 16; q0 += 4) {
      f32x4 v[4][4];
      _Pragma("unroll") for (int j = 0; j < 4; ++j) _Pragma("unroll") for (int i = 0; i < 4; ++i) v[j][i] = ((const f32x4*)(P.h + (size_t)(t0 + q0 + j) * D))[lane + 64 * i];
      __builtin_amdgcn_sched_barrier(0);
      _Pragma("unroll") for (int j = 0; j < 4; ++j) {
        const float mu = raw[640 + 2 * (q0 + j)], rs = raw[640 + 2 * (q0 + j) + 1];
        _Pragma("unroll") for (int i = 0; i < 4; ++i) {
          v[j][i].x = (v[j][i].x - mu) * rs * gg[i].x + bb[i].x; v[j][i].y = (v[j][i].y - mu) * rs * gg[i].y + bb[i].y;
          v[j][i].z = (v[j][i].z - mu) * rs * gg[i].z + bb[i].z; v[j][i].w = (v[j][i].w - mu) * rs * gg[i].w + bb[i].w;
        }
        store_row(v[j], P.h + (size_t)(t0 + q0 + j) * D, P.hb + (size_t)(t0 + q0 + j) * D, lane);
      }
    }
    WT_FENCE();
    if (lane < 16) {
      const int t = t0 + lane;
      const float mu = raw[640 + 2 * lane], rs = raw[640 + 2 * lane + 1];
      const float* G = P.rgb + (l * 2) * 48; const float* Bc = G + 48;
      float gl[4];
      _Pragma("unroll") for (int g = 0; g < 4; ++g) gl[g] = rs * (raw[lane * 40 + 32 + g] - mu * G[32 + g]) + Bc[32 + g];
      int gs = 0; float gm = gl[0];
      for (int g = 1; g < 4; ++g) if (gl[g] > gm) { gm = gl[g]; gs = g; }
      float den = 0.f;
      _Pragma("unroll") for (int g = 0; g < 4; ++g) den += expf(gl[g] - gm);
      const float pg = 1.f / den;
      float el[8];
      _Pragma("unroll") for (int e = 0; e < 8; ++e) el[e] = rs * (raw[lane * 40 + gs * 8 + e] - mu * G[gs * 8 + e]) + Bc[gs * 8 + e];
      int i1 = 0; float v1 = el[0];
      for (int e = 1; e < 8; ++e) if (el[e] > v1) { v1 = el[e]; i1 = e; }
      int i2 = -1; float v2 = -3.0e38f;
      _Pragma("unroll") for (int e = 0; e < 8; ++e) if (e != i1 && el[e] > v2) { v2 = el[e]; i2 = e; }
      if (i2 < 0) i2 = (i1 + 1) & 7;
      const float ex = expf(v2 - v1);
      const float w1 = pg / (1.f + ex), w2 = pg * ex / (1.f + ex);
      const int e1 = gs * 8 + i1, e2 = gs * 8 + i2;
      const int r1 = atomicAdd(P.counts + e1 * CSTR, 1), r2 = atomicAdd(P.counts + e2 * CSTR, 1);
      P.tok_slot[2 * t] = e1 * CAP + r1; P.tok_slot[2 * t + 1] = e2 * CAP + r2;
      P.tok_w[2 * t] = w1; P.tok_w[2 * t + 1] = w2;
      P.slot_tok[(size_t)e1 * CAP + r1] = t; P.slot_tok[(size_t)e2 * CAP + r2] = t;
    }
  }
}

template <int STR>
DI bool moe_unit(const int* counts, int i, int G, int c, int& e, int& mi, int& pn, int& cnt, int& hs) {
  int tot = 0;
  for (int x = 0; x < NEXP; ++x) tot += (counts[x * STR] + 255) >> 8;
  const int U = tot * 4, g = i * G + c;
  if (g >= U) return false;
  const int q = U / 8, r = U % 8, xcd = g % 8, off = g / 8;
  const int idx = (xcd < r ? xcd * (q + 1) : r * (q + 1) + (xcd - r) * q) + off;
  const int mt = idx >> 2; pn = idx & 3;
  int acc = 0; e = 0; mi = 0; cnt = 0; hs = 0;
  for (int x = 0; x < NEXP; ++x) {
    const int cx = counts[x * STR], n = (cx + 255) >> 8;
    if (mt < acc + n) { e = x; mi = mt - acc; cnt = cx; hs = acc * 256; return true; }
    acc += n;
  }
  return false;
}
constexpr int MOE_TAB = 131072 + 512, MOE_MAXU = 8;
DI void moe_table(const int* counts, int G, int c, char* smem_wg) {
  const int tid = rtid();
  int* cl = (int*)(smem_wg + MOE_TAB + 512);
  __syncthreads();
  if (tid < NEXP) cl[tid] = counts[tid * CSTR];
  __syncthreads();
  if (tid < MOE_MAXU) {
    int e = 0, mi = 0, pn = 0, cnt = 0, hs = 0;
    const bool ok = moe_unit<1>(cl, tid, G, c, e, mi, pn, cnt, hs);
    int* tb = (int*)(smem_wg + MOE_TAB) + tid * 8;
    tb[0] = ok ? 1 : 0; tb[1] = e; tb[2] = mi; tb[3] = pn; tb[4] = cnt; tb[5] = hs;
  }
  __syncthreads();
}
DI bool moe_next(int i, int& e, int& mi, int& pn, int& cnt, int& hs) {
  if (i >= MOE_MAXU) return false;
  const LAS_I* tb = (const LAS_I*)(size_t)(MOE_TAB + i * 32);
  const int ok = __builtin_amdgcn_readfirstlane(tb[0]);
  e = __builtin_amdgcn_readfirstlane(tb[1]); mi = __builtin_amdgcn_readfirstlane(tb[2]); pn = __builtin_amdgcn_readfirstlane(tb[3]);
  cnt = __builtin_amdgcn_readfirstlane(tb[4]); hs = __builtin_amdgcn_readfirstlane(tb[5]);
  return ok != 0;
}
struct SchedP5a {
  static constexpr bool GATHER = true;
  const int* counts; const int* slot_tok; const char* hb; const char* w; int G, c;
  DI bool next(int i, g8::Unit& u) const {
    int e, mi, pn, cnt, hs;
    if (!moe_next(i, e, mi, pn, cnt, hs)) return false;
    u.pm = hs + mi * 256; u.pn = pn; u.tag = e; u.x0 = e * CAP + mi * 256; u.x1 = cnt - mi * 256;
    u.a = hb; u.b = w + ((size_t)e * 1024 + (size_t)pn * 256) * D * 2; return true;
  }
  DI void arows(const g8::Unit& u, int R0, unsigned (&pk)[2]) const {
    const int* st = slot_tok + u.x0; const int lim = u.x1 - 1;
    const int t0 = st[min(R0, lim)], t1 = st[min(R0 + 64, lim)], t2 = st[min(R0 + 128, lim)], t3 = st[min(R0 + 192, lim)];
    pk[0] = (unsigned)t0 | ((unsigned)t1 << 16); pk[1] = (unsigned)t2 | ((unsigned)t3 << 16);
  }
};
struct EpiP5a {
  static constexpr bool PERM = true;
  bf16_t* H;
  DI bool keep(const g8::Unit&) const { return false; }
  DI void operator()(g8::f32x4 (&acc)[2][2][4][2], const g8::Unit& u, int wr, int wc, int fr, int fq) const {
    _Pragma("unroll") for (int ai = 0; ai < 2; ++ai) _Pragma("unroll") for (int m = 0; m < 4; ++m) {
      bf16_t* rowp = H + (size_t)(u.pm + 128 * ai + 64 * wr + 16 * m + fr) * 512 + u.pn * 128 + 16 * wc + 4 * fq;
      _Pragma("unroll") for (int bj = 0; bj < 2; ++bj) {
        const g8::f32x4 g = acc[ai][bj][m][0], up = acc[ai][bj][m][1];
        u32x2 o; o.x = pk2(g[0] * sigmoidf_(g[0]) * up[0], g[1] * sigmoidf_(g[1]) * up[1]); o.y = pk2(g[2] * sigmoidf_(g[2]) * up[2], g[3] * sigmoidf_(g[3]) * up[3]);
        *(u32x2*)(rowp + 64 * bj) = o;
      }
    }
  }
};
DI void phase_p5a(const Params& P, int l, char* smem_wg, int bid, int nblk) {
  SchedP5a S; S.counts = P.counts; S.slot_tok = P.slot_tok; S.hb = (const char*)P.hb; S.w = (const char*)P.w_gu_t; S.G = nblk >> 1; S.c = bid >> 1;
  EpiP5a E; E.H = P.H;
  moe_table(P.counts, S.G, S.c, smem_wg);
  g8::gemm_phase((g8::lds_u8*)smem_wg, D, S, E);
}
struct SchedP5b {
  static constexpr bool GATHER = false;
  const int* counts; const char* H; const char* w; int G, c;
  DI bool next(int i, g8::Unit& u) const {
    int e, mi, pn, cnt, hs;
    if (!moe_next(i, e, mi, pn, cnt, hs)) return false;
    u.pm = hs + mi * 256; u.pn = pn; u.tag = e; u.x0 = 0; u.x1 = 0;
    u.a = H + (size_t)u.pm * 512 * 2; u.b = w + ((size_t)e * 1024 + (size_t)pn * 256) * 512 * 2; return true;
  }
  DI void arows(const g8::Unit&, int, unsigned (&)[2]) const {}
};
struct EpiP5b {
  static constexpr bool PERM = true;
  bf16_t* ys;
  DI bool keep(const g8::Unit&) const { return false; }
  DI void operator()(g8::f32x4 (&acc)[2][2][4][2], const g8::Unit& u, int wr, int wc, int fr, int fq) const {
    _Pragma("unroll") for (int ai = 0; ai < 2; ++ai) _Pragma("unroll") for (int m = 0; m < 4; ++m) {
      bf16_t* rowp = ys + (size_t)(u.pm + 128 * ai + 64 * wr + 16 * m + fr) * D + u.pn * 256 + 32 * wc + 8 * fq;
      _Pragma("unroll") for (int bj = 0; bj < 2; ++bj) {
        const g8::f32x4 a = acc[ai][bj][m][0], b = acc[ai][bj][m][1];
        u32x4 o; o.x = pk2(a[0], a[1]); o.y = pk2(a[2], a[3]); o.z = pk2(b[0], b[1]); o.w = pk2(b[2], b[3]);
        *(u32x4*)(rowp + 128 * bj) = o;
      }
    }
  }
};
DI void phase_p5b(const Params& P, int l, char* smem_wg, int bid, int nblk) {
  SchedP5b S; S.counts = P.counts; S.H = (const char*)P.H; S.w = (const char*)P.w_dn_t; S.G = nblk >> 1; S.c = bid >> 1;
  EpiP5b E; E.ys = P.ys;
  moe_table(P.counts, S.G, S.c, smem_wg);
  g8::gemm_phase((g8::lds_u8*)smem_wg, 512, S, E);
}
DI void phase_p6(const Params& P, int l, char* smem, int bid, int nblk) {
  const int tid = otid(), lane = tid & 63, wv = (bid * NT + tid) >> 6, nwv = (nblk * NT) >> 6;
  int* shs = (int*)smem;
  __syncthreads();
  if (tid == 0) { int hs = 0; for (int x = 0; x < NEXP; ++x) { shs[x] = hs; hs += ((P.counts[x * CSTR] + 255) >> 8) * 256; } }
  __syncthreads();
  int ns1 = 0, ns2 = 0; float nw1 = 0.f, nw2 = 0.f;
  if (wv < T) { ns1 = P.tok_slot[2 * wv]; ns2 = P.tok_slot[2 * wv + 1]; nw1 = P.tok_w[2 * wv]; nw2 = P.tok_w[2 * wv + 1]; }
  for (int t = wv; t < T; t += nwv) {
    const int s1 = ns1, s2 = ns2;
    const float w1 = nw1, w2 = nw2;
    { const int tn = min(t + nwv, T - 1); ns1 = P.tok_slot[2 * tn]; ns2 = P.tok_slot[2 * tn + 1]; nw1 = P.tok_w[2 * tn]; nw2 = P.tok_w[2 * tn + 1]; }
    const bf16_t* y1 = P.ys + (size_t)(shs[s1 / CAP] + s1 % CAP) * D;
    const bf16_t* y2 = P.ys + (size_t)(shs[s2 / CAP] + s2 % CAP) * D;
    f32x4 v[4];
    _Pragma("unroll") for (int i = 0; i < 4; ++i) {
      const f32x4 hv = ((const f32x4*)(P.h + (size_t)t * D))[lane + 64 * i];
      const u32x2 a = ((const u32x2*)y1)[lane + 64 * i], c = ((const u32x2*)y2)[lane + 64 * i];
      v[i].x = ALPHA * hv.x + (bflo(a.x) * w1 + bflo(c.x) * w2); v[i].y = ALPHA * hv.y + (bfhi(a.x) * w1 + bfhi(c.x) * w2);
      v[i].z = ALPHA * hv.z + (bflo(a.y) * w1 + bflo(c.y) * w2); v[i].w = ALPHA * hv.w + (bfhi(a.y) * w1 + bfhi(c.y) * w2);
    }
    ln16(v, P.ln2_g + l * D, P.ln2_b + l * D, lane);
    if (l == 1) {
      const int b = t >= L ? 1 : 0, pos = t - b * L;
      if (pos >= NMETA) store_row(v, P.out + ((size_t)b * SEQ + pos - NMETA) * D, nullptr, lane);
    } else store_row(v, P.h + (size_t)t * D, P.hb + (size_t)t * D, lane);
  }
}

#define XB_TMO      128
#define XB_XCNT(j)  (256  + 64 * (j))
#define XB_XSUB(j)  (1280 + 64 * (j))
#define XB_XGEN(j)  (2304 + 64 * (j))
#define XB_TOP      3328
#define XB_TOPGEN   3392
#define XCD_BAR_WORDS 3456
#define XB_SPIN_CAP (1u << 20)
#define LAS __attribute__((address_space(3)))
DI unsigned xb_ld(unsigned* p) { return __hip_atomic_load(p, __ATOMIC_RELAXED, __HIP_MEMORY_SCOPE_AGENT); }
DI unsigned xb_add(unsigned* p, unsigned v) { return __hip_atomic_fetch_add(p, v, __ATOMIC_RELAXED, __HIP_MEMORY_SCOPE_AGENT); }
DI unsigned xb_xcc_id() { return (unsigned)__builtin_amdgcn_s_getreg((3 << 11) | 20) & 0xFu; }
#define XB_SPIN(cond, bar) do { unsigned _sp = 0; while (cond) { __builtin_amdgcn_s_sleep(1); \
    if ((++_sp & 255u) == 0u) { if (xb_ld(&(bar)[XB_TMO])) break; if (_sp > XB_SPIN_CAP) { atomicAdd(&(bar)[XB_TMO], 1u); break; } } } } while (0)
struct XcdBarrier { unsigned* bar; unsigned x; volatile LAS unsigned* st; };
DI XcdBarrier xcd_barrier_post(unsigned* bar, volatile LAS unsigned* st) {
  XcdBarrier b; b.bar = bar; b.x = xb_xcc_id(); b.st = st;
  if (rtid() == 0) (void)xb_add(&bar[XB_XCNT(b.x)], 1u);
  return b;
}
DI void xcd_barrier_complete(unsigned* bar, unsigned x, unsigned& nloc, unsigned& nx) {
  const unsigned G = gridDim.x * gridDim.y * gridDim.z;
  unsigned sum, cnt, mine, sp = 0u;
  for (;;) {
    sum = 0u; cnt = 0u; mine = 0u;
    _Pragma("unroll") for (unsigned j = 0; j < 16; ++j) { const unsigned c = xb_ld(&bar[XB_XCNT(j)]); sum += c; cnt += (c > 0u) ? 1u : 0u; mine = (j == x) ? c : mine; }
    if (sum == G) break;
    __builtin_amdgcn_s_sleep(1);
    if ((++sp & 255u) == 0u) { if (xb_ld(&bar[XB_TMO])) break; if (sp > XB_SPIN_CAP) { atomicAdd(&bar[XB_TMO], 1u); break; } }
  }
  nloc = mine > 0u ? mine : 1u; nx = cnt > 0u ? cnt : 1u;
}
DI void xcd_barrier(const XcdBarrier& b) {
  asm volatile("s_waitcnt vmcnt(0)" ::: "memory");
  __syncthreads();
  if (rtid() == 0) {
    unsigned* bar = b.bar; unsigned bx = b.x;
    asm volatile("" : "+s"(bar), "+s"(bx));
    __builtin_amdgcn_s_waitcnt(0);
    unsigned nloc = b.st[0], nx = b.st[1];
    if (nloc == 0u) { xcd_barrier_complete(bar, bx, nloc, nx); b.st[0] = nloc; b.st[1] = nx; }
    const unsigned old = xb_add(&bar[XB_XSUB(bx)], 1u);
    const unsigned gen = old / nloc;
    if (old + 1u == (gen + 1u) * nloc) {
      __builtin_amdgcn_fence(__ATOMIC_RELEASE, "agent");
      asm volatile("s_waitcnt vmcnt(0)" ::: "memory");
      const unsigned og = xb_add(&bar[XB_TOP], 1u);
      const unsigned tg = og / nx;
      if (og + 1u == (tg + 1u) * nx) xb_add(&bar[XB_TOPGEN], 1u);
      else XB_SPIN(xb_ld(&bar[XB_TOPGEN]) == tg, bar);
      __builtin_amdgcn_fence(__ATOMIC_ACQUIRE, "agent");
      xb_add(&bar[XB_XGEN(bx)], 1u);
      asm volatile("s_waitcnt vmcnt(0)" ::: "memory");
    } else {
      XB_SPIN(xb_ld(&bar[XB_XGEN(bx)]) == gen, bar);
      __builtin_amdgcn_fence(__ATOMIC_ACQUIRE, "agent");
      asm volatile("s_waitcnt vmcnt(0)" ::: "memory");
    }
  }
  __syncthreads();
}

constexpr size_t al256(size_t v) { return (v + 255) & ~(size_t)255; }
struct WsLayout {
  size_t bar, ctl, h, hb, w_in_t, w_br_t, w_out_t, cs, rwp, rgb, lam, counts, tok_slot, tok_w, slot_tok, mstat, nvec, wgt, bcum, ligate;
  size_t qa, ka, vaT, qb, kb, vbT, cq, ck, cvT, co, cg, gz, qc, kc, kcT, U, end_mixer;
  size_t w_gu_t, w_dn_t, H, ys, end_moe, need;
};
constexpr WsLayout make_layout() {
  WsLayout w{}; size_t off = 0;
#define TAKE(f, bytes) w.f = off; off = al256(off + (size_t)(bytes));
  TAKE(bar, XCD_BAR_WORDS * 4) TAKE(ctl, 4096)
  TAKE(h, (size_t)TP * D * 4) TAKE(hb, (size_t)TP * D * 2) TAKE(w_in_t, (size_t)DINP * D * 2) TAKE(w_br_t, (size_t)3 * 1024 * 512 * 2) TAKE(w_out_t, (size_t)D * D * 2)
  TAKE(cs, (size_t)L * 32 * 8) TAKE(rwp, (size_t)2 * 64 * 3 * 64 * 4 * 4) TAKE(rgb, 2 * 2 * 48 * 4) TAKE(lam, 256) TAKE(counts, NEXP * CSTR * 4) TAKE(tok_slot, (size_t)T * 2 * 4) TAKE(tok_w, (size_t)T * 2 * 4) TAKE(slot_tok, (size_t)NEXP * CAP * 4)
  TAKE(mstat, (size_t)16 * NCH * 4 * 4) TAKE(nvec, (size_t)16 * NCH * 128 * 4) TAKE(wgt, (size_t)16 * LPAD * 4) TAKE(bcum, (size_t)16 * LPAD * 4) TAKE(ligate, (size_t)16 * LPAD * 4)
  const size_t scratch0 = off;
  TAKE(qa, (size_t)NB * 4 * 2 * L * 64 * 2) TAKE(ka, (size_t)NB * 4 * 2 * L * 64 * 2 + 4096) TAKE(vaT, (size_t)NB * 4 * 128 * LK * 2)
  TAKE(qb, (size_t)NB * 8 * L * 64 * 2) TAKE(kb, (size_t)NB * 2 * L * 64 * 2 + 4096) TAKE(vbT, (size_t)NB * 2 * 64 * LK * 2)
  TAKE(cq, (size_t)TP * 512 * 2) TAKE(ck, (size_t)TP * 512 * 2) TAKE(cvT, (size_t)8 * 128 * LPAD * 2) TAKE(co, (size_t)TP * 512 * 2) TAKE(cg, (size_t)TP * 16 * 4)
  TAKE(gz, (size_t)TP * 3072 * 2) TAKE(qc, (size_t)8 * LPAD * 128 * 2) TAKE(kc, (size_t)8 * LPAD * 128 * 2) TAKE(kcT, (size_t)8 * 128 * LPAD * 2) TAKE(U, (size_t)16 * NCH * 16384 * 4)
  w.end_mixer = off;
  off = scratch0;
  TAKE(w_gu_t, (size_t)NEXP * 1024 * 1024 * 2) TAKE(w_dn_t, (size_t)NEXP * 1024 * 512 * 2) TAKE(H, (size_t)HROWS * 512 * 2) TAKE(ys, (size_t)HROWS * D * 2)
  w.end_moe = off;
#undef TAKE
  w.need = w.end_mixer > w.end_moe ? w.end_mixer : w.end_moe;
  return w;
}
constexpr WsLayout WL = make_layout();
static_assert(WL.need <= (size_t)552 * 1000 * 1000, "workspace");

struct SchedP1 {
  static constexpr bool GATHER = false;
  const char* hb; const char* w; int G, c;
  DI bool next(int i, g8::Unit& u) const {
    const int Lq = i * G + c; int pm, pn;
    if (Lq < 65 * 25) { g8::grid_lin(Lq, 65, 25, pm, pn); u.tag = 0; u.a = hb + (size_t)pm * 256 * D * 2; u.b = w + (size_t)pn * 256 * D * 2; }
    else if (Lq < 65 * 25 + 5 * 65) { g8::grid_lin(Lq - 65 * 25, 5, 65, pm, pn); u.tag = 1; u.a = w + (size_t)(6400 + pm * 256) * D * 2; u.b = hb + (size_t)pn * 256 * D * 2; }
    else return false;
    u.pm = pm; u.pn = pn; return true;
  }
  DI void arows(const g8::Unit&, int, unsigned (&)[2]) const {}
};
DI u32x4 pack8(const g8::f32x4& a, const g8::f32x4& b) { u32x4 o; o.x = pk2(a[0], a[1]); o.y = pk2(a[2], a[3]); o.z = pk2(b[0], b[1]); o.w = pk2(b[2], b[3]); return o; }
struct EpiP1 {
  static constexpr bool PERM = true;
  char* ws;
  DI bool keep(const g8::Unit&) const { return false; }
  DI void operator()(g8::f32x4 (&acc)[2][2][4][2], const g8::Unit& u, int wr, int wc, int fr, int fq) const {
    char* wb = ws; asm volatile("" : "+s"(wb));
    if (u.tag == 0) {
      const int r0 = u.pm * 256 + 64 * wr + fr;
      _Pragma("unroll") for (int bj = 0; bj < 2; ++bj) {
        const int c0 = u.pn * 256 + 128 * bj + 32 * wc;
        const int c = c0 + 8 * fq;
        if (c0 < 1664) {
          const int u64 = c0 >> 6, q = ((c0 >> 5) & 1) * 4 + fq;
          bf16_t* base; int nh, uu; float sc;
          if (u64 < 8) { base = (bf16_t*)(wb + WL.qa); nh = 8; uu = u64; sc = QSCALE; }
          else if (u64 < 16) { base = (bf16_t*)(wb + WL.ka); nh = 8; uu = u64 - 8; sc = 1.f; }
          else if (u64 < 24) { base = (bf16_t*)(wb + WL.qb); nh = 8; uu = u64 - 16; sc = QSCALE; }
          else { base = (bf16_t*)(wb + WL.kb); nh = 2; uu = u64 - 24; sc = 1.f; }
          const f32x2* cs = (const f32x2*)(wb + WL.cs);
          _Pragma("unroll") for (int ai = 0; ai < 2; ++ai) {
            g8::f32x4 c01[4], c23[4];
            _Pragma("unroll") for (int m = 0; m < 4; ++m) {
              const int t = r0 + 128 * ai + 16 * m, tt = min(t, T - 1), b = tt >= L ? 1 : 0, pos = tt - b * L;
              const g8::f32x4* cp = (const g8::f32x4*)(cs + (size_t)pos * 32 + 4 * q);
              c01[m] = cp[0]; c23[m] = cp[1];
            }
            __builtin_amdgcn_sched_barrier(0);
            _Pragma("unroll") for (int m = 0; m < 4; ++m) {
              const int t = r0 + 128 * ai + 16 * m, tt = min(t, T - 1), b = tt >= L ? 1 : 0, pos = tt - b * L;
              const g8::f32x4 x1 = acc[ai][bj][m][0], x2 = acc[ai][bj][m][1];
              g8::f32x4 o1, o2;
              o1[0] = (x1[0] * c01[m][0] - x2[0] * c01[m][1]) * sc; o2[0] = (x2[0] * c01[m][0] + x1[0] * c01[m][1]) * sc;
              o1[1] = (x1[1] * c01[m][2] - x2[1] * c01[m][3]) * sc; o2[1] = (x2[1] * c01[m][2] + x1[1] * c01[m][3]) * sc;
              o1[2] = (x1[2] * c23[m][0] - x2[2] * c23[m][1]) * sc; o2[2] = (x2[2] * c23[m][0] + x1[2] * c23[m][1]) * sc;
              o1[3] = (x1[3] * c23[m][2] - x2[3] * c23[m][3]) * sc; o2[3] = (x2[3] * c23[m][2] + x1[3] * c23[m][3]) * sc;
              if (t < T) *(u32x4*)(base + ((size_t)(b * nh + uu) * L + pos) * 64 + 8 * q) = pack8(o1, o2);
            }
            __builtin_amdgcn_sched_barrier(0);
          }
        } else if (c0 < 6272) {
          bf16_t* dst0; int stride; bool sig = false;
          if (c0 < 2176) { dst0 = (bf16_t*)(wb + WL.cq) + (c - 1664); stride = 512; }
          else if (c0 < 2688) { dst0 = (bf16_t*)(wb + WL.ck) + (c - 2176); stride = 512; }
          else if (c0 < 3200) { dst0 = (bf16_t*)(wb + WL.co) + (c - 2688); stride = 512; }
          else { dst0 = (bf16_t*)(wb + WL.gz) + (c - 3200); stride = 3072; sig = true; }
          _Pragma("unroll") for (int ai = 0; ai < 2; ++ai) _Pragma("unroll") for (int m = 0; m < 4; ++m) {
            const int t = r0 + 128 * ai + 16 * m;
            g8::f32x4 v0 = acc[ai][bj][m][0], v1 = acc[ai][bj][m][1];
            if (sig) { _Pragma("unroll") for (int e = 0; e < 4; ++e) { v0[e] = fmaxf(sigmoidf_(v0[e]), 1e-12f); v1[e] = fmaxf(sigmoidf_(v1[e]), 1e-12f); } }
            if (t < T) *(u32x4*)(dst0 + (size_t)t * stride) = pack8(v0, v1);
          }
        } else if (c0 == 6272) {
          if (fq < 2) {
            float* cg = (float*)(wb + WL.cg);
            _Pragma("unroll") for (int ai = 0; ai < 2; ++ai) _Pragma("unroll") for (int m = 0; m < 4; ++m) {
              const int t = r0 + 128 * ai + 16 * m;
              if (t < T) { g8::f32x4* d = (g8::f32x4*)(cg + (size_t)t * 16 + 8 * fq); d[0] = acc[ai][bj][m][0]; d[1] = acc[ai][bj][m][1]; }
            }
          }
        }
      }
    } else {
      const int chb0 = u.pm * 256 + 64 * wr;
      _Pragma("unroll") for (int ai = 0; ai < 2; ++ai) _Pragma("unroll") for (int m = 0; m < 4; ++m) {
        const int chb = chb0 + 128 * ai + 16 * m;
        if (chb < 1152) {
          const int ch = chb + fr; bf16_t* rp; size_t bs;
          if (chb < 512) { rp = (bf16_t*)(wb + WL.vaT) + (size_t)ch * LK; bs = (size_t)512 * LK; }
          else if (chb < 640) { rp = (bf16_t*)(wb + WL.vbT) + (size_t)(ch - 512) * LK; bs = (size_t)128 * LK; }
          else { rp = (bf16_t*)(wb + WL.cvT) + (size_t)(ch - 640) * LPAD + MPAD; bs = (size_t)512 * LPAD; }
          _Pragma("unroll") for (int bj = 0; bj < 2; ++bj) {
            const int t0 = u.pn * 256 + 128 * bj + 32 * wc + 8 * fq;
            if (t0 < T) { const int b = t0 >= L ? 1 : 0, pos0 = t0 - b * L; *(u32x4*)(rp + b * bs + pos0) = pack8(acc[ai][bj][m][0], acc[ai][bj][m][1]); }
          }
        }
      }
    }
  }
};
DI void phase_p1(const Params& P, int l, char* smem_wg, int bid, int nblk) {
  SchedP1 S; S.hb = (const char*)P.hb; S.w = (const char*)P.w_in_t; S.G = nblk >> 1; S.c = bid >> 1;
  EpiP1 E; E.ws = (char*)P.h - WL.h;
  g8::gemm_phase((g8::lds_u8*)smem_wg, D, S, E);
}

struct KArgs { const float* in[28]; float* out; char* ws; };
typedef const __attribute__((address_space(4))) KArgs* KAP;
DI Params make_params(KAP k) {
  Params P;
  P.x = k->in[0]; P.meta = k->in[1]; P.ln_in_g = k->in[2]; P.ln_in_b = k->in[3]; P.w_in = k->in[4]; P.conv_w = k->in[5]; P.conv_b = k->in[6]; P.gate_b = k->in[7];
  P.lam_q1 = k->in[8]; P.lam_k1 = k->in[9]; P.lam_q2 = k->in[10]; P.lam_k2 = k->in[11]; P.diff_g = k->in[12]; P.sink = k->in[13]; P.mlstm_g = k->in[14];
  P.w_branch = k->in[15]; P.w_out = k->in[16]; P.ln1_g = k->in[17]; P.ln1_b = k->in[18]; P.ln2_g = k->in[19]; P.ln2_b = k->in[20]; P.w_rg = k->in[21]; P.b_rg = k->in[22];
  P.w_re = k->in[23]; P.b_re = k->in[24]; P.w_gate = k->in[25]; P.w_up = k->in[26]; P.w_down = k->in[27];
  P.out = k->out;
  char* ws = k->ws;
  P.h = (float*)(ws + WL.h); P.hb = (bf16_t*)(ws + WL.hb); P.w_in_t = (bf16_t*)(ws + WL.w_in_t); P.w_br_t = (bf16_t*)(ws + WL.w_br_t); P.w_out_t = (bf16_t*)(ws + WL.w_out_t);
  P.cs = (f32x2*)(ws + WL.cs); P.lam = (float*)(ws + WL.lam); P.ctl = (unsigned*)(ws + WL.ctl); P.rwp = (float*)(ws + WL.rwp); P.rgb = (float*)(ws + WL.rgb); P.counts = (int*)(ws + WL.counts); P.tok_slot = (int*)(ws + WL.tok_slot); P.tok_w = (float*)(ws + WL.tok_w);
  P.slot_tok = (int*)(ws + WL.slot_tok); P.mstat = (float*)(ws + WL.mstat); P.nvec = (float*)(ws + WL.nvec); P.wgt = (float*)(ws + WL.wgt); P.bcum = (float*)(ws + WL.bcum);
  P.ligate = (float*)(ws + WL.ligate);
  P.qa = (bf16_t*)(ws + WL.qa); P.ka = (bf16_t*)(ws + WL.ka); P.vaT = (bf16_t*)(ws + WL.vaT); P.qb = (bf16_t*)(ws + WL.qb); P.kb = (bf16_t*)(ws + WL.kb); P.vbT = (bf16_t*)(ws + WL.vbT);
  P.cq = (bf16_t*)(ws + WL.cq); P.ck = (bf16_t*)(ws + WL.ck); P.merged = P.cq; P.cvT = (bf16_t*)(ws + WL.cvT); P.co = (bf16_t*)(ws + WL.co); P.cg = (float*)(ws + WL.cg);
  P.gz = (bf16_t*)(ws + WL.gz); P.qc = (bf16_t*)(ws + WL.qc); P.kc = (bf16_t*)(ws + WL.kc); P.kcT = (bf16_t*)(ws + WL.kcT); P.U = (float*)(ws + WL.U);
  P.w_gu_t = (bf16_t*)(ws + WL.w_gu_t); P.w_dn_t = (bf16_t*)(ws + WL.w_dn_t); P.H = (bf16_t*)(ws + WL.H); P.ys = (bf16_t*)(ws + WL.ys);
  P.oa = (bf16_t*)k->out; P.ob = P.oa + (size_t)TP * 512; P.oc = P.ob + (size_t)TP * 512;
  return P;
}

constexpr int SMEM_BYTES = 2 * DA_STAGE + 4096 + 256;
constexpr int WG_LDS = 2 * SMEM_BYTES + 64 + 256;
static_assert(WIDTAB_OFF == 2 * SMEM_BYTES + 64, "wave-slot table offset");
#define PH(...) { KAP k_ = ka; int bid = bid0, nblk = nblk0; asm volatile("" : "+s"(k_), "+s"(bid), "+s"(nblk)); const Params P = make_params(k_); __VA_ARGS__; }
__global__ void __launch_bounds__(512, 2) mega(KArgs kargs) {
  extern __shared__ __attribute__((aligned(16))) char smem_wg[];
  (void)kargs;
  const KAP ka = (KAP)__builtin_amdgcn_kernarg_segment_ptr();
  {
    const unsigned hw = (unsigned)__builtin_amdgcn_s_getreg((5 << 11) | 4) & 63u;
    *(volatile LAS int*)(size_t)(WIDTAB_OFF + 4 * hw) = (int)(threadIdx.x >> 6);
  }
  __syncthreads();
  const int half = __builtin_amdgcn_readfirstlane(rtid() >> 8);
  char* smem = smem_wg + half * SMEM_BYTES;
  const int bid0 = 2 * blockIdx.x + half, nblk0 = 2 * gridDim.x;
  volatile LAS unsigned* st = (volatile LAS unsigned*)(smem_wg + 2 * SMEM_BYTES);
  volatile LAS int* wgq = (volatile LAS int*)(smem_wg + 2 * SMEM_BYTES + 16);
  if (rtid() == 0) { st[0] = 0u; st[1] = 0u; }
  __syncthreads();
  const XcdBarrier xb = xcd_barrier_post((unsigned*)(ka->ws + WL.bar), st);

  PH(phase_prologue(P, bid, nblk))
  PH(phase_router_prep(P, bid, nblk))
  PH(phase_wconv_small(P, 0, smem, bid, nblk))
  xcd_barrier(xb);
  auto layer = [&](const int l) __attribute__((always_inline)) {
    PH(phase_zero_pads(P, bid, nblk))
    PH(phase_p1(P, l, smem_wg, bid, nblk))
    xcd_barrier(xb);
    PH(phase_mprep(P, l, smem, bid, nblk))
    xcd_barrier(xb);
    for (int it = bid0; it < 512; it += nblk0) PH(dattn_item(P, l, it, true, smem))
    PH(phase_mscan(P, bid, nblk))
    xcd_barrier(xb);
    {
      for (int it = (int)blockIdx.x; it < 256; it += (int)gridDim.x) PH(dattn_item16(P, l, it, smem_wg))
      unsigned* qctr = (unsigned*)(ka->ws + WL.ctl) + (l * 8 + 5) * 16;
      const int NP = 4 + 4 * NCH + 2 * 257;
      for (;;) {
        __syncthreads();
        if (rtid() == 0) wgq[0] = (int)xb_add(qctr, 1u);
        __syncthreads();
        const int pr = wgq[0];
        if (pr >= NP) break;
        if (pr < 4) PH(dattn_combine(P, l, 2 * pr + half, smem))
        else if (pr < 4 + 4 * NCH) PH(mout_item(P, l, 2 * (pr - 4) + half, smem))
        else PH(swa_item(P, l, 2 * (pr - 4 - 4 * NCH) + half, smem))
      }
    }
    xcd_barrier(xb);
    PH(phase_p3a(P, l, smem, smem_wg, bid, nblk))
    xcd_barrier(xb);
    PH(phase_p3b(P, l, smem, smem_wg, bid, nblk))
    xcd_barrier(xb);
    PH(phase_p4(P, l, smem, bid, nblk))
    PH(phase_wconv_experts(P, l, smem, half, wgq))
    xcd_barrier(xb);
    PH(phase_p5a(P, l, smem_wg, bid, nblk))
    xcd_barrier(xb);
    PH(phase_p5b(P, l, smem_wg, bid, nblk))
    xcd_barrier(xb);
    PH(phase_p6(P, l, smem, bid, nblk))
    if (l == 0) PH(phase_wconv_small(P, 1, smem, bid, nblk))
    xcd_barrier(xb);
  };
  layer(0);
  layer(1);
}

extern "C" void kernel_launch(void* const* d_in, const int* in_sizes, int n_in, void* d_out, int out_size, void* d_ws, size_t ws_size, hipStream_t stream) {
  (void)in_sizes; (void)n_in; (void)out_size;
  if (WL.need > ws_size) return;
  KArgs a{};
  for (int i = 0; i < 28; ++i) a.in[i] = (const float*)d_in[i];
  a.out = (float*)d_out; a.ws = (char*)d_ws;
  static int grid = 0;
  if (!grid) {
    int dev = 0, cus = 0, per_cu = 0;
    (void)hipGetDevice(&dev);
    (void)hipDeviceGetAttribute(&cus, hipDeviceAttributeMultiprocessorCount, dev);
    (void)hipFuncSetAttribute((const void*)mega, hipFuncAttributeMaxDynamicSharedMemorySize, WG_LDS);
    (void)hipOccupancyMaxActiveBlocksPerMultiprocessor(&per_cu, (const void*)mega, 512, WG_LDS);
    if (per_cu > 1) per_cu = 1;
    if (per_cu < 1) per_cu = 1;
    grid = cus * per_cu;
  }
  (void)hipMemsetAsync((char*)d_ws + WL.bar, 0, WL.h - WL.bar, stream);
  hipLaunchKernelGGL(mega, dim3(grid), dim3(512), WG_LDS, stream, a);
}
```
